# Optimizing an MI355X kernel written in HIP

```python
import jax
import jax.numpy as jnp
from jax import lax
import numpy as np

D_MODEL = 1024
BATCH = 2
SEQ = 8192
DEPTH = 1

DN_HEADS = 4
DN_HEAD_DIM = 128
DN_WIDTH = DN_HEADS * DN_HEAD_DIM
CONV_WIDTH = 4
DN_CHUNK = 64
SG_GROUPS = 4
SG_GROUP_DIM = 128
SG_WIDTH = SG_GROUPS * SG_GROUP_DIM
SG_CHUNK = 128
N_EXPERTS = 32
TOP_K = 4
D_FF = 1024
SWIGLU_LIMIT = 7.0
SWIGLU_ALPHA = 1.702
MOE_BLOCK = 128
RMS_EPS = 1e-6
LN_EPS = 1e-5
L2_EPS = 1e-6

OFF_QKV = 0
OFF_Z = OFF_QKV + 3 * DN_WIDTH
OFF_BETA = OFF_Z + DN_WIDTH
OFF_A = OFF_BETA + DN_HEADS
OFF_U = OFF_A + DN_HEADS
OFF_V = OFF_U + SG_WIDTH
OFF_GA = OFF_V + SG_WIDTH
OFF_GB = OFF_GA + D_MODEL
IN_COLS = OFF_GB + D_MODEL

kernel_name = 'hybrid_gdn_sgmlp_moe'


def rmsnorm(x, g):
    xf = x.astype(jnp.float32)
    y = xf * lax.rsqrt(jnp.mean(xf * xf, axis=-1, keepdims=True) + RMS_EPS)
    return (y * g.astype(jnp.float32)).astype(x.dtype)


def layernorm(x, g, b):
    xf = x.astype(jnp.float32)
    mu = jnp.mean(xf, axis=-1, keepdims=True)
    var = jnp.mean(jnp.square(xf - mu), axis=-1, keepdims=True)
    y = (xf - mu) * lax.rsqrt(var + LN_EPS)
    return (y * g.astype(jnp.float32) + b.astype(jnp.float32)).astype(x.dtype)


def l2norm(t):
    return t * lax.rsqrt(jnp.sum(t * t, axis=-1, keepdims=True) + L2_EPS)


def causal_depthwise_conv(x, w):
    c = x.shape[-1]
    return lax.conv_general_dilated(
        x, w.reshape(CONV_WIDTH, 1, c).astype(x.dtype), window_strides=(1,),
        padding=[(CONV_WIDTH - 1, 0)], dimension_numbers=('NWC', 'WIO', 'NWC'),
        feature_group_count=c)


def gated_delta_rule(q, k, v, beta, g):
    f32 = jnp.float32
    bsz, nh, s, dk = q.shape
    dv = v.shape[-1]
    c = DN_CHUNK
    nc = s // c
    q = (l2norm(q.astype(f32)) * (dk ** -0.5)).reshape(bsz, nh, nc, c, dk)
    k = l2norm(k.astype(f32)).reshape(bsz, nh, nc, c, dk)
    v = v.astype(f32).reshape(bsz, nh, nc, c, dv)
    beta = beta.astype(f32).reshape(bsz, nh, nc, c)
    gam = jnp.cumsum(g.astype(f32).reshape(bsz, nh, nc, c), axis=-1)
    incl = jnp.tril(jnp.ones((c, c), dtype=bool))
    strict = jnp.tril(jnp.ones((c, c), dtype=bool), k=-1)
    decay = jnp.exp(jnp.where(incl, gam[..., :, None] - gam[..., None, :], -jnp.inf))
    k_beta = k * beta[..., None]
    a = jnp.where(strict, jnp.einsum('bhnrd,bhnsd->bhnrs', k_beta, k) * decay, 0.0)
    eye = jnp.eye(c, dtype=f32)
    t_inv = lax.linalg.triangular_solve(eye + a, jnp.broadcast_to(eye, a.shape),
                                        left_side=True, lower=True, unit_diagonal=True)
    u = jnp.einsum('bhnrs,bhnsv->bhnrv', t_inv, v * beta[..., None])
    w = jnp.einsum('bhnrs,bhnsd->bhnrd', t_inv, k_beta * jnp.exp(gam)[..., None])
    qk = jnp.einsum('bhnrd,bhnsd->bhnrs', q, k) * decay
    g_last = gam[..., -1]
    q_dec = q * jnp.exp(gam)[..., None]
    k_dec = k * jnp.exp(g_last[..., None] - gam)[..., None]

    def step(state, xs):
        q_c, k_c, u_c, w_c, qk_c, gl_c = xs
        v_new = u_c - jnp.einsum('bhrd,bhdv->bhrv', w_c, state)
        o_c = jnp.einsum('bhrd,bhdv->bhrv', q_c, state) + jnp.einsum('bhrs,bhsv->bhrv', qk_c, v_new)
        state = state * jnp.exp(gl_c)[..., None, None] + jnp.einsum('bhrd,bhrv->bhdv', k_c, v_new)
        return state, o_c

    xs = tuple(jnp.moveaxis(t, 2, 0) for t in (q_dec, k_dec, u, w, qk, g_last))
    state0 = jnp.zeros((bsz, nh, dk, dv), f32)
    _, o = lax.scan(step, state0, xs)
    return jnp.moveaxis(o, 0, 2).reshape(bsz, nh, s, dv)


def routed_moe(h, w_router, b_router, w_gate_up, b_gate_up, w_down, b_down):
    f32 = jnp.float32
    n_tok = h.shape[0]
    logits = h.astype(f32) @ w_router.astype(f32) + b_router.astype(f32)
    top_logits, top_idx = lax.top_k(logits, TOP_K)
    top_w = jax.nn.softmax(top_logits, axis=-1)
    n_slots = n_tok * TOP_K
    e_flat = top_idx.reshape(n_slots)
    tok_flat = jnp.repeat(jnp.arange(n_tok, dtype=jnp.int32), TOP_K)
    w_flat = top_w.reshape(n_slots)
    order = jnp.argsort(e_flat)
    e_sorted = e_flat[order]
    counts = jnp.bincount(e_flat, length=N_EXPERTS)
    padded = (counts + MOE_BLOCK - 1) // MOE_BLOCK * MOE_BLOCK
    start = jnp.cumsum(counts) - counts
    pad_end = jnp.cumsum(padded)
    pad_start = pad_end - padded
    dest = pad_start[e_sorted] + (jnp.arange(n_slots, dtype=jnp.int32) - start[e_sorted])
    n_blocks = -(-n_slots // MOE_BLOCK) + N_EXPERTS
    n_pad = n_blocks * MOE_BLOCK
    buf_tok = jnp.zeros((n_pad,), jnp.int32).at[dest].set(tok_flat[order])
    buf_w = jnp.zeros((n_pad,), f32).at[dest].set(w_flat[order])
    block_expert = jnp.minimum(
        jnp.searchsorted(pad_end, jnp.arange(n_blocks, dtype=jnp.int32) * MOE_BLOCK, side='right'),
        N_EXPERTS - 1)

    def expert_block(args):
        tok, e = args
        xb = h[tok]
        gu = xb @ w_gate_up[e] + b_gate_up[e]
        x_glu = jnp.minimum(gu[:, :D_FF], SWIGLU_LIMIT)
        x_lin = jnp.clip(gu[:, D_FF:], -SWIGLU_LIMIT, SWIGLU_LIMIT)
        act = x_glu * jax.nn.sigmoid(SWIGLU_ALPHA * x_glu) * (x_lin + 1.0)
        return act @ w_down[e] + b_down[e]

    ys = lax.map(expert_block, (buf_tok.reshape(n_blocks, MOE_BLOCK), block_expert))
    ys = ys.reshape(n_pad, -1) * buf_w[:, None].astype(ys.dtype)
    return jax.ops.segment_sum(ys, buf_tok, num_segments=n_tok)


def hybrid_layer(x, norm1_g, w_in, conv_w, dn_a_log, dn_dt_bias, dn_norm_g, w_o_dn,
                 sg_ln_g, sg_ln_b, sg_w, sg_b, w_o_sg, w_out, norm2_g, w_router, b_router,
                 w_gate_up, b_gate_up, w_down, b_down):
    bsz, s, d = x.shape
    f32 = jnp.float32
    h = rmsnorm(x, norm1_g)
    proj = h @ w_in

    qkv = jax.nn.silu(causal_depthwise_conv(proj[..., OFF_QKV:OFF_Z], conv_w))
    q, k, v = jnp.split(qkv, 3, axis=-1)
    to_heads = lambda t: t.reshape(bsz, s, DN_HEADS, DN_HEAD_DIM).transpose(0, 2, 1, 3)
    beta = jax.nn.sigmoid(proj[..., OFF_BETA:OFF_A].astype(f32)).transpose(0, 2, 1)
    g = -jnp.exp(dn_a_log.astype(f32)) * jax.nn.softplus(
        proj[..., OFF_A:OFF_U].astype(f32) + dn_dt_bias.astype(f32))
    o = gated_delta_rule(to_heads(q), to_heads(k), to_heads(v), beta, g.transpose(0, 2, 1))
    o = o.astype(x.dtype).transpose(0, 2, 1, 3)
    z = proj[..., OFF_Z:OFF_BETA].reshape(bsz, s, DN_HEADS, DN_HEAD_DIM)
    y_a = (rmsnorm(o, dn_norm_g) * jax.nn.silu(z)).reshape(bsz, s, DN_WIDTH)

    uv = jax.nn.gelu(proj[..., OFF_U:OFF_GA], approximate=False)
    u, v_sg = uv[..., :SG_WIDTH], uv[..., SG_WIDTH:]
    v_sg = layernorm(v_sg, sg_ln_g, sg_ln_b).reshape(bsz, s // SG_CHUNK, SG_CHUNK, SG_GROUPS, SG_GROUP_DIM)
    w_s = jnp.where(jnp.tril(jnp.ones((SG_CHUNK, SG_CHUNK), dtype=bool)), sg_w, 0.0)
    v_mix = jnp.einsum('gts,bnsgc->bntgc', w_s, v_sg) + sg_b.T[None, None, :, :, None]
    y_b = u * v_mix.reshape(bsz, s, SG_WIDTH)

    gate_a = jax.nn.sigmoid(proj[..., OFF_GA:OFF_GB])
    gate_b = jax.nn.sigmoid(proj[..., OFF_GB:IN_COLS])
    merged = gate_a * (y_a @ w_o_dn) + gate_b * (y_b @ w_o_sg)
    x = x + merged @ w_out

    h2 = rmsnorm(x, norm2_g).reshape(bsz * s, d)
    y_moe = routed_moe(h2, w_router, b_router, w_gate_up, b_gate_up, w_down, b_down)
    return x + y_moe.reshape(bsz, s, d)


def setup_inputs(seed: int = 0) -> dict:
    key = jax.random.key(seed)
    ks = jax.random.split(key, 22)
    nrm = lambda k, shape, fan_in: jax.random.normal(k, shape, jnp.float32) * (fan_in ** -0.5)
    L = DEPTH
    return {
        'x': jax.random.normal(ks[0], (BATCH, SEQ, D_MODEL), jnp.float32),
        'norm1_g': 1.0 + 0.02 * jax.random.normal(ks[1], (L, D_MODEL), jnp.float32),
        'w_in': nrm(ks[2], (L, D_MODEL, IN_COLS), D_MODEL),
        'conv_w': nrm(ks[3], (L, CONV_WIDTH, 3 * DN_WIDTH), CONV_WIDTH),
        'dn_a_log': jnp.log(jax.random.uniform(ks[4], (L, DN_HEADS), jnp.float32, 1.0, 16.0)),
        'dn_dt_bias': 0.1 * jax.random.normal(ks[5], (L, DN_HEADS), jnp.float32),
        'dn_norm_g': 1.0 + 0.02 * jax.random.normal(ks[6], (L, DN_HEAD_DIM), jnp.float32),
        'w_o_dn': nrm(ks[7], (L, DN_WIDTH, D_MODEL), DN_WIDTH),
        'sg_ln_g': 1.0 + 0.02 * jax.random.normal(ks[8], (L, SG_WIDTH), jnp.float32),
        'sg_ln_b': 0.02 * jax.random.normal(ks[9], (L, SG_WIDTH), jnp.float32),
        'sg_w': nrm(ks[10], (L, SG_GROUPS, SG_CHUNK, SG_CHUNK), SG_CHUNK),
        'sg_b': 1.0 + 0.02 * jax.random.normal(ks[11], (L, SG_GROUPS, SG_CHUNK), jnp.float32),
        'w_o_sg': nrm(ks[12], (L, SG_WIDTH, D_MODEL), SG_WIDTH),
        'w_out': nrm(ks[13], (L, D_MODEL, D_MODEL), D_MODEL),
        'norm2_g': 1.0 + 0.02 * jax.random.normal(ks[14], (L, D_MODEL), jnp.float32),
        'w_router': nrm(ks[15], (L, D_MODEL, N_EXPERTS), D_MODEL),
        'b_router': 0.01 * jax.random.normal(ks[16], (L, N_EXPERTS), jnp.float32),
        'w_gate_up': nrm(ks[17], (L, N_EXPERTS, D_MODEL, 2 * D_FF), D_MODEL),
        'b_gate_up': 0.01 * jax.random.normal(ks[18], (L, N_EXPERTS, 2 * D_FF), jnp.float32),
        'w_down': nrm(ks[19], (L, N_EXPERTS, D_FF, D_MODEL), D_FF),
        'b_down': 0.01 * jax.random.normal(ks[20], (L, N_EXPERTS, D_MODEL), jnp.float32),
        'norm_f_g': 1.0 + 0.02 * jax.random.normal(ks[21], (D_MODEL,), jnp.float32),
    }


def reference(x, norm1_g, w_in, conv_w, dn_a_log, dn_dt_bias, dn_norm_g, w_o_dn,
              sg_ln_g, sg_ln_b, sg_w, sg_b, w_o_sg, w_out, norm2_g, w_router, b_router,
              w_gate_up, b_gate_up, w_down, b_down, norm_f_g):
    for layer in range(DEPTH):
        x = hybrid_layer(
            x, norm1_g[layer], w_in[layer], conv_w[layer], dn_a_log[layer], dn_dt_bias[layer],
            dn_norm_g[layer], w_o_dn[layer], sg_ln_g[layer], sg_ln_b[layer], sg_w[layer],
            sg_b[layer], w_o_sg[layer], w_out[layer], norm2_g[layer], w_router[layer],
            b_router[layer], w_gate_up[layer], b_gate_up[layer], w_down[layer], b_down[layer])
    return rmsnorm(x, norm_f_g)
```

```cpp
#include <hip/hip_runtime.h>
#include <cstdio>
#include <cstdint>
#include <cmath>

namespace nv {
constexpr int D = 1024, BATCH = 2, SEQ = 8192, NTOK = BATCH * SEQ;
constexpr int DNH = 4, DNHD = 128, DNW = 512, CONVW = 4;
constexpr int SGG = 4, SGD = 128, SGW = 512, SGC = 128;
constexpr int NE = 32, TOPK = 4, DFF = 1024;
constexpr int OFF_QKV = 0, OFF_Z = 1536, OFF_BETA = 2048, OFF_A = 2052, OFF_U = 2056, OFF_V = 2568, OFF_GA = 3080, OFF_GB = 4104, INC = 5128;
constexpr float RMS_EPS = 1e-6f, LN_EPS = 1e-5f, L2_EPS = 1e-6f;

__device__ __forceinline__ float wave_sum(float v) {
#pragma unroll
    for (int o = 1; o < 64; o <<= 1) v += __shfl_xor(v, o);
    return v;
}
__device__ __forceinline__ float sigmoidf_(float x) { return 1.f / (1.f + expf(-x)); }
__device__ __forceinline__ float siluf_(float x) { return x / (1.f + expf(-x)); }
__device__ __forceinline__ float geluf_(float x) { return 0.5f * x * (1.f + erff(x * 0.70710678118654752f)); }
__device__ __forceinline__ float softplusf_(float x) { return x > 20.f ? x : log1pf(expf(x)); }

__global__ void __launch_bounds__(256) rmsnorm_rows(const float* __restrict__ x, const float* __restrict__ g, float* __restrict__ out, int nrows) {
    const int lane = threadIdx.x & 63, w = (blockIdx.x * blockDim.x + threadIdx.x) >> 6;
    if (w >= nrows) return;
    const float4* xr = (const float4*)(x + (size_t)w * D) + lane;
    float4 v[4]; float s = 0.f;
#pragma unroll
    for (int j = 0; j < 4; ++j) { v[j] = xr[64 * j]; s += v[j].x * v[j].x + v[j].y * v[j].y + v[j].z * v[j].z + v[j].w * v[j].w; }
    const float r = rsqrtf(wave_sum(s) * (1.f / D) + RMS_EPS);
    float4* o = (float4*)(out + (size_t)w * D) + lane;
#pragma unroll
    for (int j = 0; j < 4; ++j) { const float4 gg = ((const float4*)g)[lane + 64 * j]; o[64 * j] = make_float4(v[j].x * r * gg.x, v[j].y * r * gg.y, v[j].z * r * gg.z, v[j].w * r * gg.w); }
}

struct GArgs {
    const float* A; int lda; const float* B; int ldb; float* C; int ldc; int M, N, K;
    const int* cnt; const int* off; const int* list; const float* bias; long bstride; int bias_stride;
};
template <int MODE>
__global__ void __launch_bounds__(256) gemm_f32(GArgs g) {
    __shared__ float As[16][65];
    __shared__ float Bs[16][64];
    __shared__ float Bs2[MODE == 1 ? 16 : 1][64];
    const int tid = threadIdx.x, tx = tid & 15, ty = tid >> 4;
    int M = g.M; const float* B = g.B; int rowbase = 0; const float* bias = g.bias;
    if (MODE != 0) { const int e = blockIdx.z; M = g.cnt[e]; rowbase = g.off[e]; B += (size_t)e * g.bstride; bias += (size_t)e * g.bias_stride; }
    const int m0 = blockIdx.y * 64, n0 = blockIdx.x * 64;
    if (m0 >= M) return;
    float acc[4][4], acc2[4][4];
#pragma unroll
    for (int i = 0; i < 4; ++i)
#pragma unroll
        for (int j = 0; j < 4; ++j) { acc[i][j] = 0.f; acc2[i][j] = 0.f; }
    const int ar = tid >> 2, ak = (tid & 3) * 4;
    long arow = -1;
    if (m0 + ar < M) { if (MODE == 1) arow = g.list[rowbase + m0 + ar]; else arow = rowbase + m0 + ar; }
    const int bk = tid >> 4, bn = (tid & 15) * 4;
    for (int k0 = 0; k0 < g.K; k0 += 16) {
        float4 av = make_float4(0.f, 0.f, 0.f, 0.f);
        if (arow >= 0) av = *(const float4*)(g.A + (size_t)arow * g.lda + k0 + ak);
        As[ak + 0][ar] = av.x; As[ak + 1][ar] = av.y; As[ak + 2][ar] = av.z; As[ak + 3][ar] = av.w;
        {
            const float* bp = B + (size_t)(k0 + bk) * g.ldb + n0 + bn;
            float b0 = 0.f, b1 = 0.f, b2 = 0.f, b3 = 0.f;
            if (n0 + bn + 3 < g.N) { const float4 t = *(const float4*)bp; b0 = t.x; b1 = t.y; b2 = t.z; b3 = t.w; }
            else { if (n0 + bn + 0 < g.N) b0 = bp[0]; if (n0 + bn + 1 < g.N) b1 = bp[1]; if (n0 + bn + 2 < g.N) b2 = bp[2]; if (n0 + bn + 3 < g.N) b3 = bp[3]; }
            Bs[bk][bn + 0] = b0; Bs[bk][bn + 1] = b1; Bs[bk][bn + 2] = b2; Bs[bk][bn + 3] = b3;
            if (MODE == 1) { const float4 t = *(const float4*)(bp + DFF); Bs2[bk][bn + 0] = t.x; Bs2[bk][bn + 1] = t.y; Bs2[bk][bn + 2] = t.z; Bs2[bk][bn + 3] = t.w; }
        }
        __syncthreads();
#pragma unroll
        for (int kk = 0; kk < 16; ++kk) {
            float a[4], b[4], b2[4];
#pragma unroll
            for (int i = 0; i < 4; ++i) a[i] = As[kk][ty * 4 + i];
#pragma unroll
            for (int j = 0; j < 4; ++j) { b[j] = Bs[kk][tx * 4 + j]; if (MODE == 1) b2[j] = Bs2[kk][tx * 4 + j]; }
#pragma unroll
            for (int i = 0; i < 4; ++i)
#pragma unroll
                for (int j = 0; j < 4; ++j) { acc[i][j] = fmaf(a[i], b[j], acc[i][j]); if (MODE == 1) acc2[i][j] = fmaf(a[i], b2[j], acc2[i][j]); }
        }
        __syncthreads();
    }
#pragma unroll
    for (int i = 0; i < 4; ++i) {
        const int m = m0 + ty * 4 + i; if (m >= M) continue;
#pragma unroll
        for (int j = 0; j < 4; ++j) {
            const int n = n0 + tx * 4 + j; if (n >= g.N) continue;
            if (MODE == 0) g.C[(size_t)m * g.ldc + n] = acc[i][j];
            else if (MODE == 1) {
                float xg = acc[i][j] + bias[n], xl = acc2[i][j] + bias[n + DFF];
                xg = fminf(xg, 7.f); xl = fminf(fmaxf(xl, -7.f), 7.f);
                g.C[(size_t)(rowbase + m) * g.ldc + n] = xg * sigmoidf_(1.702f * xg) * (xl + 1.f);
            } else g.C[(size_t)(rowbase + m) * g.ldc + n] = acc[i][j] + bias[n];
        }
    }
}

__global__ void __launch_bounds__(256) conv_silu(const float* __restrict__ proj, const float* __restrict__ cw, float* __restrict__ qkv) {
    const size_t idx = (size_t)blockIdx.x * 256 + threadIdx.x;
    if (idx >= (size_t)NTOK * 1536) return;
    const int c = (int)(idx % 1536); const int row = (int)(idx / 1536); const int t = row % SEQ;
    float s = 0.f;
#pragma unroll
    for (int k = 0; k < 4; ++k) { const int tt = t - 3 + k; if (tt >= 0) s += cw[k * 1536 + c] * proj[(size_t)(row - 3 + k) * INC + c]; }
    qkv[idx] = siluf_(s);
}

__global__ void __launch_bounds__(128) deltanet_rec(const float* __restrict__ qkv, const float* __restrict__ proj, const float* __restrict__ a_log, const float* __restrict__ dt_bias, float* __restrict__ o) {
    __shared__ float qs[2][128], ks[2][128], red[2][4];
    const int b = blockIdx.x / DNH, h = blockIdx.x % DNH, i = threadIdx.x, lane = i & 63, wv = i >> 6;
    float s[128];
#pragma unroll
    for (int d = 0; d < 128; ++d) s[d] = 0.f;
    const float A = expf(a_log[h]), dtb = dt_bias[h];
    for (int t = 0; t < SEQ; ++t) {
        const size_t row = (size_t)b * SEQ + t; const int p = t & 1;
        const float qr = qkv[row * 1536 + h * 128 + i], kr = qkv[row * 1536 + 512 + h * 128 + i], vr = qkv[row * 1536 + 1024 + h * 128 + i];
        const float sq = wave_sum(qr * qr), sk = wave_sum(kr * kr);
        if (lane == 0) { red[p][wv * 2] = sq; red[p][wv * 2 + 1] = sk; }
        __syncthreads();
        const float ssq = red[p][0] + red[p][2], ssk = red[p][1] + red[p][3];
        qs[p][i] = qr * rsqrtf(ssq + L2_EPS) * 0.08838834764831845f;
        ks[p][i] = kr * rsqrtf(ssk + L2_EPS);
        const float beta = sigmoidf_(proj[row * INC + OFF_BETA + h]);
        const float gg = -A * softplusf_(proj[row * INC + OFF_A + h] + dtb);
        const float eg = expf(gg);
        __syncthreads();
        float kS = 0.f;
#pragma unroll
        for (int d = 0; d < 128; ++d) kS = fmaf(ks[p][d], s[d], kS);
        const float vn = beta * (vr - eg * kS);
        float oo = 0.f;
#pragma unroll
        for (int d = 0; d < 128; ++d) { s[d] = fmaf(ks[p][d], vn, eg * s[d]); oo = fmaf(qs[p][d], s[d], oo); }
        o[row * DNW + h * 128 + i] = oo;
    }
}

__global__ void __launch_bounds__(256) ya_kernel(const float* __restrict__ o, const float* __restrict__ proj, const float* __restrict__ g, float* __restrict__ ya) {
    const int lane = threadIdx.x & 63; const size_t w = ((size_t)blockIdx.x * 256 + threadIdx.x) >> 6;
    if (w >= (size_t)NTOK * DNH) return;
    const size_t row = w / DNH; const int h = (int)(w % DNH);
    const float a = o[row * DNW + h * 128 + lane], b = o[row * DNW + h * 128 + 64 + lane];
    const float r = rsqrtf(wave_sum(a * a + b * b) * (1.f / 128.f) + RMS_EPS);
    const float z0 = proj[row * INC + OFF_Z + h * 128 + lane], z1 = proj[row * INC + OFF_Z + h * 128 + 64 + lane];
    ya[row * DNW + h * 128 + lane] = a * r * g[lane] * siluf_(z0);
    ya[row * DNW + h * 128 + 64 + lane] = b * r * g[64 + lane] * siluf_(z1);
}

__global__ void __launch_bounds__(256) sg_prep(const float* __restrict__ proj, const float* __restrict__ lg, const float* __restrict__ lb, float* __restrict__ u, float* __restrict__ vln) {
    const int lane = threadIdx.x & 63; const size_t row = ((size_t)blockIdx.x * 256 + threadIdx.x) >> 6;
    if (row >= NTOK) return;
    float v[8]; float s = 0.f;
#pragma unroll
    for (int j = 0; j < 8; ++j) { const int c = lane + 64 * j; u[row * SGW + c] = geluf_(proj[row * INC + OFF_U + c]); v[j] = geluf_(proj[row * INC + OFF_V + c]); s += v[j]; }
    const float mu = wave_sum(s) * (1.f / SGW); float q = 0.f;
#pragma unroll
    for (int j = 0; j < 8; ++j) { v[j] -= mu; q += v[j] * v[j]; }
    const float r = rsqrtf(wave_sum(q) * (1.f / SGW) + LN_EPS);
#pragma unroll
    for (int j = 0; j < 8; ++j) { const int c = lane + 64 * j; vln[row * SGW + c] = v[j] * r * lg[c] + lb[c]; }
}
__global__ void __launch_bounds__(256) sg_mix(const float* __restrict__ u, const float* __restrict__ vln, const float* __restrict__ sw, const float* __restrict__ sb, float* __restrict__ yb) {
    const size_t idx = (size_t)blockIdx.x * 256 + threadIdx.x;
    if (idx >= (size_t)NTOK * SGW) return;
    const int c = (int)(idx % SGW); const size_t row = idx / SGW; const int g = c / SGD; const int ti = (int)(row % SGC); const size_t base = row - ti;
    float acc = sb[g * SGC + ti];
    const float* wr = sw + ((size_t)g * SGC + ti) * SGC;
    for (int s = 0; s <= ti; ++s) acc = fmaf(wr[s], vln[(base + s) * SGW + c], acc);
    yb[idx] = u[idx] * acc;
}
__global__ void __launch_bounds__(256) merge_kernel(const float* __restrict__ proj, const float* __restrict__ t1, const float* __restrict__ t2, float* __restrict__ m) {
    const size_t idx = (size_t)blockIdx.x * 256 + threadIdx.x;
    if (idx >= (size_t)NTOK * D) return;
    const int c = (int)(idx % D); const size_t row = idx / D;
    m[idx] = sigmoidf_(proj[row * INC + OFF_GA + c]) * t1[idx] + sigmoidf_(proj[row * INC + OFF_GB + c]) * t2[idx];
}
__global__ void __launch_bounds__(256) add_kernel(const float* __restrict__ a, const float* __restrict__ b, float* __restrict__ o, size_t n) {
    const size_t idx = (size_t)blockIdx.x * 256 + threadIdx.x; if (idx < n) o[idx] = a[idx] + b[idx];
}
__global__ void __launch_bounds__(256) router_kernel(const float* __restrict__ h2, const float* __restrict__ wr, const float* __restrict__ br, int* __restrict__ tope, float* __restrict__ topw, int* __restrict__ pos, int* __restrict__ cnt) {
    __shared__ float hs[4][D]; __shared__ float lg[4][NE];
    const int lane = threadIdx.x & 63, wv = threadIdx.x >> 6; const size_t row = (size_t)blockIdx.x * 4 + wv;
    for (int j = lane; j < D; j += 64) hs[wv][j] = h2[row * D + j];
    __syncthreads();
    const int e = lane & 31, half = lane >> 5; float acc = 0.f;
    for (int k = half; k < D; k += 2) acc = fmaf(hs[wv][k], wr[k * NE + e], acc);
    acc += __shfl_xor(acc, 32);
    if (lane < 32) lg[wv][e] = acc + br[e];
    __syncthreads();
    if (lane == 0) {
        float l[NE];
#pragma unroll
        for (int j = 0; j < NE; ++j) l[j] = lg[wv][j];
        int sel[4]; float sv[4];
#pragma unroll
        for (int k = 0; k < 4; ++k) { int bi = 0; float bv = -INFINITY;
#pragma unroll
            for (int j = 0; j < NE; ++j) { const bool better = l[j] > bv; bv = better ? l[j] : bv; bi = better ? j : bi; }
            sel[k] = bi; sv[k] = bv;
#pragma unroll
            for (int j = 0; j < NE; ++j) l[j] = (j == bi) ? -INFINITY : l[j]; }
        float den = 0.f, ex[4];
#pragma unroll
        for (int k = 0; k < 4; ++k) { ex[k] = expf(sv[k] - sv[0]); den += ex[k]; }
#pragma unroll
        for (int k = 0; k < 4; ++k) { tope[row * 4 + k] = sel[k]; topw[row * 4 + k] = ex[k] / den; pos[row * 4 + k] = atomicAdd(&cnt[sel[k]], 1); }
    }
}
__global__ void offsets_kernel(const int* __restrict__ cnt, int* __restrict__ off) { if (threadIdx.x == 0) { int s = 0; for (int e = 0; e < NE; ++e) { off[e] = s; s += cnt[e]; } } }
__global__ void __launch_bounds__(256) fill_list(const int* __restrict__ tope, const int* __restrict__ pos, const int* __restrict__ off, int* __restrict__ list, int* __restrict__ slotof) {
    const int idx = blockIdx.x * 256 + threadIdx.x; if (idx >= NTOK * TOPK) return;
    const int slot = off[tope[idx]] + pos[idx]; list[slot] = idx / TOPK; slotof[idx] = slot;
}
__global__ void __launch_bounds__(256) final_kernel(const float* __restrict__ x1, const float* __restrict__ Y, const int* __restrict__ slotof, const float* __restrict__ topw, const float* __restrict__ g, float* __restrict__ out) {
    const int lane = threadIdx.x & 63; const size_t row = ((size_t)blockIdx.x * 256 + threadIdx.x) >> 6;
    if (row >= NTOK) return;
    float4 v[4];
#pragma unroll
    for (int j = 0; j < 4; ++j) v[j] = ((const float4*)(x1 + row * D))[lane + 64 * j];
#pragma unroll
    for (int k = 0; k < 4; ++k) { const int slot = slotof[row * 4 + k]; const float w = topw[row * 4 + k];
#pragma unroll
        for (int j = 0; j < 4; ++j) { const float4 y = ((const float4*)(Y + (size_t)slot * D))[lane + 64 * j]; v[j].x += w * y.x; v[j].y += w * y.y; v[j].z += w * y.z; v[j].w += w * y.w; } }
    float s = 0.f;
#pragma unroll
    for (int j = 0; j < 4; ++j) s += v[j].x * v[j].x + v[j].y * v[j].y + v[j].z * v[j].z + v[j].w * v[j].w;
    const float r = rsqrtf(wave_sum(s) * (1.f / D) + RMS_EPS);
#pragma unroll
    for (int j = 0; j < 4; ++j) { const float4 gg = ((const float4*)g)[lane + 64 * j]; ((float4*)(out + row * D))[lane + 64 * j] = make_float4(v[j].x * r * gg.x, v[j].y * r * gg.y, v[j].z * r * gg.z, v[j].w * r * gg.w); }
}
}

extern "C" void kernel_launch(void* const* d_in, const int* in_sizes, int n_in, void* d_out, int out_size, void* d_ws, size_t ws_size, hipStream_t stream) {
    using namespace nv;
    const float* x = (const float*)d_in[0]; const float* norm1_g = (const float*)d_in[1]; const float* w_in = (const float*)d_in[2]; const float* conv_w = (const float*)d_in[3];
    const float* a_log = (const float*)d_in[4]; const float* dt_bias = (const float*)d_in[5]; const float* dn_norm_g = (const float*)d_in[6]; const float* w_o_dn = (const float*)d_in[7];
    const float* sg_ln_g = (const float*)d_in[8]; const float* sg_ln_b = (const float*)d_in[9]; const float* sg_w = (const float*)d_in[10]; const float* sg_b = (const float*)d_in[11];
    const float* w_o_sg = (const float*)d_in[12]; const float* w_out = (const float*)d_in[13]; const float* norm2_g = (const float*)d_in[14]; const float* w_router = (const float*)d_in[15];
    const float* b_router = (const float*)d_in[16]; const float* w_gate_up = (const float*)d_in[17]; const float* b_gate_up = (const float*)d_in[18]; const float* w_down = (const float*)d_in[19];
    const float* b_down = (const float*)d_in[20]; const float* norm_f_g = (const float*)d_in[21];
    float* out = (float*)d_out;
    const size_t MiB = 1u << 20;
    if (n_in != 22 || ws_size < 960 * MiB) { fprintf(stderr, "kernel_launch: unexpected n_in %d / ws_size %zu\n", n_in, ws_size); return; }
    char* ws = (char*)d_ws;
    float* PROJ = (float*)(ws + 0); float* ACT = (float*)(ws + 0);
    float* QKV = (float*)(ws + 340 * MiB); float* O32 = (float*)(ws + 440 * MiB); float* YA = (float*)(ws + 474 * MiB); float* YB = (float*)(ws + 508 * MiB);
    float* U = (float*)(ws + 542 * MiB); float* VLN = (float*)(ws + 576 * MiB); float* Y = (float*)(ws + 340 * MiB);
    float* H = (float*)(ws + 612 * MiB); float* X1 = (float*)(ws + 676 * MiB); float* T1 = (float*)(ws + 740 * MiB); float* T2 = (float*)(ws + 804 * MiB); float* MERGED = (float*)(ws + 868 * MiB);
    char* small = ws + 932 * MiB;
    int* cnt = (int*)small; int* off = (int*)(small + 256); int* tope = (int*)(small + 1 * MiB); float* topw = (float*)(small + 2 * MiB); int* pos = (int*)(small + 3 * MiB);
    int* list = (int*)(small + 4 * MiB); int* slotof = (int*)(small + 5 * MiB);

    hipMemsetAsync(cnt, 0, 256, stream);
    rmsnorm_rows<<<NTOK / 4, 256, 0, stream>>>(x, norm1_g, H, NTOK);
    { GArgs g{}; g.A = H; g.lda = D; g.B = w_in; g.ldb = INC; g.C = PROJ; g.ldc = INC; g.M = NTOK; g.N = INC; g.K = D;
      gemm_f32<0><<<dim3((INC + 63) / 64, NTOK / 64, 1), 256, 0, stream>>>(g); }
    conv_silu<<<(unsigned)(((size_t)NTOK * 1536 + 255) / 256), 256, 0, stream>>>(PROJ, conv_w, QKV);
    deltanet_rec<<<BATCH * DNH, 128, 0, stream>>>(QKV, PROJ, a_log, dt_bias, O32);
    ya_kernel<<<NTOK * DNH / 4, 256, 0, stream>>>(O32, PROJ, dn_norm_g, YA);
    sg_prep<<<NTOK / 4, 256, 0, stream>>>(PROJ, sg_ln_g, sg_ln_b, U, VLN);
    sg_mix<<<NTOK * SGW / 256, 256, 0, stream>>>(U, VLN, sg_w, sg_b, YB);
    { GArgs g{}; g.A = YA; g.lda = DNW; g.B = w_o_dn; g.ldb = D; g.C = T1; g.ldc = D; g.M = NTOK; g.N = D; g.K = DNW;
      gemm_f32<0><<<dim3(D / 64, NTOK / 64, 1), 256, 0, stream>>>(g); }
    { GArgs g{}; g.A = YB; g.lda = SGW; g.B = w_o_sg; g.ldb = D; g.C = T2; g.ldc = D; g.M = NTOK; g.N = D; g.K = SGW;
      gemm_f32<0><<<dim3(D / 64, NTOK / 64, 1), 256, 0, stream>>>(g); }
    merge_kernel<<<NTOK * D / 256, 256, 0, stream>>>(PROJ, T1, T2, MERGED);
    { GArgs g{}; g.A = MERGED; g.lda = D; g.B = w_out; g.ldb = D; g.C = T1; g.ldc = D; g.M = NTOK; g.N = D; g.K = D;
      gemm_f32<0><<<dim3(D / 64, NTOK / 64, 1), 256, 0, stream>>>(g); }
    add_kernel<<<NTOK * D / 256, 256, 0, stream>>>(x, T1, X1, (size_t)NTOK * D);
    rmsnorm_rows<<<NTOK / 4, 256, 0, stream>>>(X1, norm2_g, H, NTOK);
    router_kernel<<<NTOK / 4, 256, 0, stream>>>(H, w_router, b_router, tope, topw, pos, cnt);
    offsets_kernel<<<1, 64, 0, stream>>>(cnt, off);
    fill_list<<<NTOK * TOPK / 256, 256, 0, stream>>>(tope, pos, off, list, slotof);
    { GArgs g{}; g.A = H; g.lda = D; g.B = w_gate_up; g.ldb = 2 * DFF; g.C = ACT; g.ldc = DFF; g.M = 0; g.N = DFF; g.K = D; g.cnt = cnt; g.off = off; g.list = list; g.bias = b_gate_up; g.bstride = (long)D * 2 * DFF; g.bias_stride = 2 * DFF;
      gemm_f32<1><<<dim3(DFF / 64, NTOK / 64, NE), 256, 0, stream>>>(g); }
    { GArgs g{}; g.A = ACT; g.lda = DFF; g.B = w_down; g.ldb = D; g.C = Y; g.ldc = D; g.M = 0; g.N = D; g.K = DFF; g.cnt = cnt; g.off = off; g.list = nullptr; g.bias = b_down; g.bstride = (long)DFF * D; g.bias_stride = D;
      gemm_f32<2><<<dim3(D / 64, NTOK / 64, NE), 256, 0, stream>>>(g); }
    final_kernel<<<NTOK / 4, 256, 0, stream>>>(X1, Y, slotof, topw, norm_f_g, out);
}
```

```cpp
#include <hip/hip_runtime.h>
#include <cstdio>
#include <cstdint>
#include <cmath>

#define GAS __attribute__((address_space(1)))
#define LAS __attribute__((address_space(3)))
typedef GAS unsigned gu32;
#define RLX_AGENT __ATOMIC_RELAXED, __HIP_MEMORY_SCOPE_AGENT

constexpr int NWAVES = 8, NTHR = 512;
constexpr int D = 1024, BATCH = 2, SEQ = 8192, NTOK = BATCH * SEQ;
constexpr int DNH = 4, DNW = 512;
constexpr int SGD = 128, SGW = 512, SGC = 128;
constexpr int NE = 32, TOPK = 4, DFF = 1024;
constexpr int OFF_Z = 1536, OFF_BETA = 2048, OFF_A = 2052, OFF_U = 2056, OFF_V = 2568, OFF_GA = 3080, OFF_GB = 4104, INC = 5128;
constexpr float RMS_EPS = 1e-6f, LN_EPS = 1e-5f, L2_EPS = 1e-6f;

constexpr size_t MiB = 1u << 20;
constexpr size_t WS_CTL = 0, CTL_ZERO_BYTES = 1 * MiB;
constexpr int CW_BAR = 4096;
constexpr int CW_CNT = 16384;
constexpr size_t WS_BASE = 2 * MiB;
constexpr size_t WS_NEED = 1020 * MiB;
constexpr int LDSCTL_OFF = 0, MISC_OFF = 320, RING_OFF = 1024, RING_BYTES = 131072, EXTRA_OFF = RING_OFF + RING_BYTES, LDS_BYTES = 147456;

#define XB_TMO      128
#define XB_XCNT(j)  (256  + 64 * (j))
#define XB_XSUB(j)  (1280 + 64 * (j))
#define XB_XGEN(j)  (2304 + 64 * (j))
#define XB_TOP      3328
#define XB_TOPGEN   3392
#define XCD_BAR_WORDS 3456
#define XB_SPIN_CAP (1u << 22)
__device__ __forceinline__ unsigned xb_ld(unsigned* p)              { return __hip_atomic_load(p, __ATOMIC_RELAXED, __HIP_MEMORY_SCOPE_AGENT); }
__device__ __forceinline__ unsigned xb_add(unsigned* p, unsigned v) { return __hip_atomic_fetch_add(p, v, __ATOMIC_RELAXED, __HIP_MEMORY_SCOPE_AGENT); }
__device__ __forceinline__ unsigned xb_xcc_id() { return (unsigned)__builtin_amdgcn_s_getreg((3 << 11) | 20) & 0xFu; }
#define XB_SPIN(cond, bar) do { unsigned _sp = 0; while (cond) { __builtin_amdgcn_s_sleep(1); \
    if ((++_sp & 255u) == 0u) { if (xb_ld(&(bar)[XB_TMO])) break; if (_sp > XB_SPIN_CAP) { atomicAdd(&(bar)[XB_TMO], 1u); break; } } } } while (0)
struct XcdBarrier { unsigned* bar; unsigned x; volatile LAS unsigned* st; };
__device__ __forceinline__ XcdBarrier xcd_barrier_post(unsigned* bar, volatile LAS unsigned* st) {
    XcdBarrier b; b.bar = bar; b.x = xb_xcc_id(); b.st = st;
    if (threadIdx.x == 0) (void)xb_add(&bar[XB_XCNT(b.x)], 1u);
    return b;
}
__device__ __forceinline__ void xcd_barrier_complete(unsigned* bar, unsigned x, unsigned& nloc, unsigned& nx) {
    const unsigned G = gridDim.x * gridDim.y * gridDim.z;
    unsigned sum, cnt, mine, sp = 0u;
    for (;;) {
        sum = 0u; cnt = 0u; mine = 0u;
#pragma unroll
        for (unsigned j = 0; j < 16; ++j) { const unsigned c = xb_ld(&bar[XB_XCNT(j)]); sum += c; cnt += (c > 0u) ? 1u : 0u; mine = (j == x) ? c : mine; }
        if (sum == G) break;
        __builtin_amdgcn_s_sleep(1);
        if ((++sp & 255u) == 0u) { if (xb_ld(&bar[XB_TMO])) break; if (sp > XB_SPIN_CAP) { atomicAdd(&bar[XB_TMO], 1u); break; } }
    }
    nloc = mine > 0u ? mine : 1u; nx = cnt > 0u ? cnt : 1u;
}
__device__ __forceinline__ void xcd_barrier(const XcdBarrier& b) {
    asm volatile("s_waitcnt vmcnt(0)" ::: "memory");
    __syncthreads();
    if (threadIdx.x == 0) {
        unsigned* bar = b.bar;
        __builtin_amdgcn_s_waitcnt(0);
        unsigned nloc = b.st[0], nx = b.st[1];
        if (nloc == 0u) { xcd_barrier_complete(bar, b.x, nloc, nx); b.st[0] = nloc; b.st[1] = nx; }
        const unsigned old = xb_add(&bar[XB_XSUB(b.x)], 1u);
        const unsigned gen = old / nloc;
        if (old + 1u == (gen + 1u) * nloc) {
            __builtin_amdgcn_fence(__ATOMIC_RELEASE, "agent");
            asm volatile("s_waitcnt vmcnt(0)" ::: "memory");
            const unsigned og = xb_add(&bar[XB_TOP], 1u);
            const unsigned tg = og / nx;
            if (og + 1u == (tg + 1u) * nx) xb_add(&bar[XB_TOPGEN], 1u);
            else XB_SPIN(xb_ld(&bar[XB_TOPGEN]) == tg, bar);
            __builtin_amdgcn_fence(__ATOMIC_ACQUIRE, "agent");
            xb_add(&bar[XB_XGEN(b.x)], 1u);
            asm volatile("s_waitcnt vmcnt(0)" ::: "memory");
        } else {
            XB_SPIN(xb_ld(&bar[XB_XGEN(b.x)]) == gen, bar);
            __builtin_amdgcn_fence(__ATOMIC_ACQUIRE, "agent");
            asm volatile("s_waitcnt vmcnt(0)" ::: "memory");
        }
    }
    __syncthreads();
}

__device__ __forceinline__ float dpp_xor1(float v) { return __builtin_bit_cast(float, __builtin_amdgcn_update_dpp(0, __builtin_bit_cast(int, v), 0xB1, 0xF, 0xF, true)); }
__device__ __forceinline__ float dpp_xor2(float v) { return __builtin_bit_cast(float, __builtin_amdgcn_update_dpp(0, __builtin_bit_cast(int, v), 0x4E, 0xF, 0xF, true)); }
__device__ __forceinline__ float dpp_qrev(float v) { return __builtin_bit_cast(float, __builtin_amdgcn_update_dpp(0, __builtin_bit_cast(int, v), 0x1B, 0xF, 0xF, true)); }
__device__ __forceinline__ float dpp_hmir(float v) { return __builtin_bit_cast(float, __builtin_amdgcn_update_dpp(0, __builtin_bit_cast(int, v), 0x141, 0xF, 0xF, true)); }
__device__ __forceinline__ float dpp_rmir(float v) { return __builtin_bit_cast(float, __builtin_amdgcn_update_dpp(0, __builtin_bit_cast(int, v), 0x140, 0xF, 0xF, true)); }
__device__ __forceinline__ float dpp_ror8(float v) { return __builtin_bit_cast(float, __builtin_amdgcn_update_dpp(0, __builtin_bit_cast(int, v), 0x128, 0xF, 0xF, true)); }
__device__ __forceinline__ float dpp_xor4(float v) { return dpp_qrev(dpp_hmir(v)); }
__device__ __forceinline__ float row16_sum(float v) { v += dpp_xor1(v); v += dpp_xor2(v); v += dpp_hmir(v); v += dpp_rmir(v); return v; }
__device__ __forceinline__ float rdlane(float v, int l) { return __builtin_bit_cast(float, __builtin_amdgcn_readlane(__builtin_bit_cast(int, v), l)); }
__device__ __forceinline__ float wave_sum(float v) { v = row16_sum(v); return (rdlane(v, 0) + rdlane(v, 16)) + (rdlane(v, 32) + rdlane(v, 48)); }
__device__ __forceinline__ void swap32(float& a, float& b) { asm volatile("s_nop 1\n\tv_permlane32_swap_b32 %0, %1" : "+v"(a), "+v"(b)); }
__device__ __forceinline__ void swap16(float& a, float& b) { asm volatile("s_nop 1\n\tv_permlane16_swap_b32 %0, %1" : "+v"(a), "+v"(b)); }
#define BFLY_SW32(acc, n) _Pragma("unroll") for (int i_ = 0; i_ < (n) / 2; ++i_) { float x_ = acc[i_], y_ = acc[i_ + (n) / 2]; swap32(x_, y_); acc[i_] = x_ + y_; }
#define BFLY_SW16(acc, n) _Pragma("unroll") for (int i_ = 0; i_ < (n) / 2; ++i_) { float x_ = acc[i_], y_ = acc[i_ + (n) / 2]; swap16(x_, y_); acc[i_] = x_ + y_; }
#define BFLY_DPP(acc, n, m, PERM) _Pragma("unroll") for (int i_ = 0; i_ < (n) / 2; ++i_) { const bool up_ = (lane & (m)) != 0; const float send_ = up_ ? acc[i_] : acc[i_ + (n) / 2]; const float keep_ = up_ ? acc[i_ + (n) / 2] : acc[i_]; acc[i_] = keep_ + PERM(send_); }
__device__ __forceinline__ float sigmoidf_(float x) { return 1.f / (1.f + expf(-x)); }
__device__ __forceinline__ float siluf_(float x) { return x / (1.f + expf(-x)); }
__device__ __forceinline__ float geluf_(float x) { return 0.5f * x * (1.f + erff(x * 0.70710678118654752f)); }
__device__ __forceinline__ float softplusf_(float x) { return x > 20.f ? x : log1pf(expf(x)); }

struct Ctx { int bid, nb, tid, lane, wave; LAS unsigned char* lds; LAS unsigned char* lds0; };

namespace pg8 {
#define PG8_LAS __attribute__((address_space(3)))
typedef unsigned short bf16_t;
typedef short bf16x8 __attribute__((ext_vector_type(8)));
typedef float f32x4 __attribute__((ext_vector_type(4)));
typedef unsigned u32x4 __attribute__((ext_vector_type(4)));
constexpr int BM = 256, BK = 64, HALF = 128, HTB = HALF * BK * 2  , STAGE_BYTES = 8 * HTB, NXCD = 8, WGM = 8;

__host__ __device__ __forceinline__ int lds_byte(int r, int c) { const int st = (r >> 4) * 2 + (c >> 5), rr = r & 15, cc = c & 31, ob = rr * 64 + cc * 2; return st * 1024 + (ob ^ (((ob >> 9) & 1) << 5)); }
__host__ __device__ __forceinline__ void stage_rc(int b, int& R, int& C) { const int st = b / 1024, sb = b % 1024, swz = sb ^ (((sb >> 9) & 1) << 5); R = (st >> 1) * 16 + swz / 64; C = (st & 1) * 32 + (swz % 64) / 2; }
__host__ __device__ __forceinline__ int perm32(int rho) { const int n = rho >> 4, i = rho & 15; return 8 * (i >> 2) + 4 * n + (i & 3); }

struct Unit { int pm, pn, x0, x1, rb; };
struct Gemm { const bf16_t* A; const bf16_t* Bt; int M, N, K; const int* rows; };

struct StaticOrder {
    int nM, nN, nwg, G, c;
    __host__ __device__ void init(int M, int N, int G_, int c_) { nM = M / BM; nN = N / BM; nwg = nM * nN; G = G_; c = c_; }
    __host__ __device__ bool next(int i, Unit& u) const {
        const long L = (long)i * G + c; if (L >= nwg) return false;
        int wgid = (int)L; { const int q = nwg / NXCD, r = nwg % NXCD, xcd = wgid % NXCD, off = wgid / NXCD; wgid = (xcd < r ? xcd * (q + 1) : r * (q + 1) + (xcd - r) * q) + off; }
        const int nig = WGM * nN, gid = wgid / nig, fm = gid * WGM, gsz = (nM - fm) < WGM ? (nM - fm) : WGM;
        u.pm = fm + ((wgid % nig) % gsz); u.pn = (wgid % nig) / gsz; u.x0 = 0; u.x1 = u.pn; u.rb = 0; return true;
    }
    __device__ __forceinline__ void a_ready(const Unit&) const {}
    __device__ __forceinline__ void done(const Unit&) const {}
};


template <class Epi, class Sched, bool ALIGN_EPI = false, bool SP2 = false, bool GATHER = false>
__device__ __forceinline__ void gemm_phase(PG8_LAS unsigned char* lds, const Gemm g, const Sched& S, const Epi& E) {
    int tid_ = threadIdx.x; asm volatile("" : "+v"(tid_));
    const int tid = tid_, wid = __builtin_amdgcn_readfirstlane(tid >> 6), lane = tid & 63, wr = wid >> 2, wc = wid & 3, fr = lane & 15, fq = lane >> 4;
    const int K = g.K, nt = K / BK;
    unsigned voffA[2], voffB[2]; int gR[2]; unsigned gC2[2];
#pragma unroll
    for (int i = 0; i < 2; ++i) { int R, C; stage_rc(tid * 16 + i * 8192, R, C); const int Rb = Epi::PERM ? ((R & ~31) + perm32(R & 31)) : R;
        voffA[i] = (unsigned)(R * K + C) * 2u; voffB[i] = (unsigned)(Rb * K + C) * 2u; gR[i] = R; gC2[i] = (unsigned)C * 2u; }
    static_assert(!GATHER || SP2, "GATHER is implemented for the SP2 loop only");
    unsigned gcur[2][2], gnxt[2][2]; int graw[4];
#define PG8_STAGE_A(bufoff, kptr, ktile, h, use_next) do { if constexpr (GATHER) { const unsigned sv_[2] = {(use_next) ? gnxt[h][0] : gcur[h][0], (use_next) ? gnxt[h][1] : gcur[h][1]}; \
        PG8_STAGE(bufoff, gA0 + (size_t)(ktile) * kstep, sv_); } else { PG8_STAGE(bufoff, (kptr) + ((h) ? hstep : 0), voffA); } } while (0)
    const size_t kstep = (size_t)(BK * 2);
    const size_t hstep = (size_t)HALF * K * 2;
    const size_t tstep = 2 * hstep;
    const unsigned ldsw = (unsigned)wid * 1024u;
    const int aoff = lds_byte(wr * 64 + fr, fq * 8), boff = lds_byte(wc * 32 + fr, fq * 8);
#define PG8_SA(b, h) (((b) * 2 + (h)) * HTB)
#define PG8_SB(b, h) ((4 + (b) * 2 + (h)) * HTB)
#define PG8_STAGE(bufoff, gbase, voff) do { _Pragma("unroll") for (int _i = 0; _i < 2; ++_i) \
        __builtin_amdgcn_global_load_lds((const unsigned*)((const char*)(gbase) + (voff)[_i]), (PG8_LAS unsigned*)(lds + (bufoff) + ldsw + _i * 8192), 16, 0, 0); } while (0)
#define PG8_LDA(dst, b, h) do { _Pragma("unroll") for (int m = 0; m < 4; ++m) _Pragma("unroll") for (int k = 0; k < 2; ++k) dst[m][k] = *(const PG8_LAS bf16x8*)(lds + PG8_SA(b, h) + aoff + m * 2048 + k * 1024); } while (0)
#define PG8_LDB(dst, b, h) do { _Pragma("unroll") for (int n = 0; n < 2; ++n) _Pragma("unroll") for (int k = 0; k < 2; ++k) dst[n][k] = *(const PG8_LAS bf16x8*)(lds + PG8_SB(b, h) + boff + n * 2048 + k * 1024); } while (0)
#define PG8_MMA(ai, bj, At, Bt) do { __builtin_amdgcn_s_setprio(1); _Pragma("unroll") for (int m = 0; m < 4; ++m) _Pragma("unroll") for (int n = 0; n < 2; ++n) _Pragma("unroll") for (int k = 0; k < 2; ++k) \
        acc[ai][bj][m][n] = __builtin_amdgcn_mfma_f32_16x16x32_bf16(Bt[n][k], At[m][k], acc[ai][bj][m][n], 0, 0, 0); __builtin_amdgcn_s_setprio(0); } while (0)
#define PG8_WAIT_V(n) asm volatile("s_waitcnt vmcnt(" #n ")" ::: "memory")
#define PG8_WAIT_L(n) asm volatile("s_waitcnt lgkmcnt(" #n ")" ::: "memory")
#define PG8_BAR __builtin_amdgcn_s_barrier()
#define PG8_SCHED __builtin_amdgcn_sched_barrier(0)
    Unit cur, nxt; int ui = 0;
    if (!S.next(0, cur)) return;
    f32x4 acc[2][2][4][2];
#pragma unroll
    for (int a = 0; a < 2; ++a)
#pragma unroll
        for (int b = 0; b < 2; ++b)
#pragma unroll
            for (int m = 0; m < 4; ++m)
#pragma unroll
                for (int n = 0; n < 2; ++n) acc[a][b][m][n] = (f32x4){0.f, 0.f, 0.f, 0.f};
    bf16x8 At[4][2], B0[2][2], B1[2][2];
    const char* cA = (const char*)g.A + (size_t)cur.pm * tstep; const char* cB = (const char*)g.Bt + (size_t)cur.pn * tstep;
    const char* const gA0 = (const char*)g.A;
    if constexpr (GATHER) {
#pragma unroll
        for (int h = 0; h < 2; ++h)
#pragma unroll
            for (int i = 0; i < 2; ++i) { gcur[h][i] = (unsigned)g.rows[cur.rb + h * HALF + gR[i]] * (unsigned)(K * 2) + gC2[i]; gnxt[h][i] = gcur[h][i]; } }
    S.a_ready(cur);
    if constexpr (SP2) {
        PG8_STAGE(PG8_SB(0, 0), cB, voffB); PG8_STAGE(PG8_SB(0, 1), cB + hstep, voffB); PG8_STAGE_A(PG8_SA(0, 0), cA, 0, 0, false); PG8_STAGE_A(PG8_SA(0, 1), cA, 0, 1, false);
        if (wr == 1) PG8_BAR;
        PG8_WAIT_V(2); PG8_BAR;
        PG8_STAGE(PG8_SB(1, 0), cB + kstep, voffB); PG8_STAGE_A(PG8_SA(1, 0), cA + kstep, 1, 0, false); PG8_STAGE(PG8_SB(1, 1), cB + hstep + kstep, voffB);
        PG8_WAIT_V(6); PG8_BAR;
    } else {
        PG8_STAGE(PG8_SB(0, 0), cB, voffB); PG8_STAGE(PG8_SA(0, 0), cA, voffA); PG8_STAGE(PG8_SB(0, 1), cB + hstep, voffB); PG8_STAGE(PG8_SA(0, 1), cA + hstep, voffA);
        if (wr == 1) PG8_BAR;
        PG8_WAIT_V(4); PG8_BAR;
        PG8_STAGE(PG8_SB(1, 0), cB + kstep, voffB); PG8_STAGE(PG8_SA(1, 0), cA + kstep, voffA); PG8_STAGE(PG8_SB(1, 1), cB + hstep + kstep, voffB);
        PG8_WAIT_V(6); PG8_BAR;
    }
    for (;;) {
        const bool has_next = S.next(ui + 1, nxt);
        const char* nA = has_next ? (const char*)g.A + (size_t)nxt.pm * tstep : cA; const char* nB = has_next ? (const char*)g.Bt + (size_t)nxt.pn * tstep : cB;
        if constexpr (GATHER) { if (has_next) {
#pragma unroll
            for (int h = 0; h < 2; ++h)
#pragma unroll
                for (int i = 0; i < 2; ++i) asm volatile("global_load_dword %0, %1, off" : "=v"(graw[h * 2 + i]) : "v"(g.rows + (nxt.rb + h * HALF + gR[i])) : "memory"); } }
        for (int t = 0; t < nt; t += 2) {
            const bool last = (t == nt - 2);
            const char* a1 = cA + (size_t)(t + 1) * kstep;
            const char* a2 = last ? nA : cA + (size_t)(t + 2) * kstep; const char* b2 = last ? nB : cB + (size_t)(t + 2) * kstep;
            const char* a3 = a2 + kstep; const char* b3 = b2 + kstep;
            if (last && has_next) S.a_ready(nxt);
            if constexpr (GATHER) { if (last) { if (has_next) { asm volatile("" : "+v"(graw[0]), "+v"(graw[1]), "+v"(graw[2]), "+v"(graw[3]));
#pragma unroll
                    for (int h = 0; h < 2; ++h)
#pragma unroll
                        for (int i = 0; i < 2; ++i) gnxt[h][i] = (unsigned)graw[h * 2 + i] * (unsigned)(K * 2) + gC2[i]; }
                else {
#pragma unroll
                    for (int h = 0; h < 2; ++h)
#pragma unroll
                        for (int i = 0; i < 2; ++i) gnxt[h][i] = gcur[h][i]; } } }
            const int kt2 = last ? 0 : t + 2;
            if constexpr (SP2) {
            PG8_LDB(B0, 0, 0); PG8_LDB(B1, 0, 1); PG8_SCHED; PG8_LDA(At, 0, 0); PG8_STAGE_A(PG8_SA(1, 1), a1, t + 1, 1, false);
            PG8_WAIT_V(8); PG8_WAIT_L(0); PG8_BAR; PG8_MMA(0, 0, At, B0); PG8_MMA(0, 1, At, B1); PG8_BAR; PG8_SCHED;
            PG8_LDA(At, 0, 1); PG8_STAGE(PG8_SB(0, 0), b2, voffB); PG8_STAGE(PG8_SB(0, 1), b2 + hstep, voffB); PG8_STAGE_A(PG8_SA(0, 0), a2, kt2, 0, last);
            PG8_WAIT_V(8); PG8_WAIT_L(0); PG8_BAR; PG8_MMA(1, 0, At, B0); PG8_MMA(1, 1, At, B1); PG8_BAR; PG8_SCHED;
            PG8_LDB(B0, 1, 0); PG8_LDB(B1, 1, 1); PG8_SCHED; PG8_LDA(At, 1, 0); PG8_STAGE_A(PG8_SA(0, 1), a2, kt2, 1, last);
            PG8_WAIT_V(8); PG8_WAIT_L(0); PG8_BAR; PG8_MMA(0, 0, At, B0); PG8_MMA(0, 1, At, B1); PG8_BAR; PG8_SCHED;
            PG8_LDA(At, 1, 1); PG8_STAGE(PG8_SB(1, 0), b3, voffB); PG8_STAGE(PG8_SB(1, 1), b3 + hstep, voffB); PG8_STAGE_A(PG8_SA(1, 0), a3, kt2 + 1, 0, last);
            PG8_WAIT_V(8); PG8_WAIT_L(0); PG8_BAR; PG8_MMA(1, 0, At, B0); PG8_MMA(1, 1, At, B1); PG8_BAR; PG8_SCHED;
            } else {
            PG8_LDB(B0, 0, 0); PG8_SCHED; PG8_LDA(At, 0, 0); PG8_STAGE(PG8_SA(1, 1), a1 + hstep, voffA);
            PG8_WAIT_L(8); PG8_BAR; PG8_WAIT_L(0); PG8_MMA(0, 0, At, B0); PG8_BAR; PG8_SCHED;
            PG8_LDB(B1, 0, 1); PG8_STAGE(PG8_SB(0, 0), b2, voffB);
            PG8_BAR; PG8_WAIT_L(0); PG8_MMA(0, 1, At, B1); PG8_BAR;
            PG8_LDA(At, 0, 1); PG8_STAGE(PG8_SA(0, 0), a2, voffA);
            PG8_BAR; PG8_WAIT_L(0); PG8_MMA(1, 0, At, B0); PG8_BAR; PG8_SCHED;
            PG8_STAGE(PG8_SB(0, 1), b2 + hstep, voffB);
            PG8_WAIT_V(6); PG8_BAR; PG8_MMA(1, 1, At, B1); PG8_BAR;
            PG8_LDB(B0, 1, 0); PG8_SCHED; PG8_LDA(At, 1, 0); PG8_STAGE(PG8_SA(0, 1), a2 + hstep, voffA);
            PG8_WAIT_L(8); PG8_BAR; PG8_WAIT_L(0); PG8_MMA(0, 0, At, B0); PG8_BAR; PG8_SCHED;
            PG8_LDB(B1, 1, 1); PG8_STAGE(PG8_SB(1, 0), b3, voffB);
            PG8_BAR; PG8_WAIT_L(0); PG8_MMA(0, 1, At, B1); PG8_BAR;
            PG8_LDA(At, 1, 1); PG8_STAGE(PG8_SA(1, 0), a3, voffA);
            PG8_BAR; PG8_WAIT_L(0); PG8_MMA(1, 0, At, B0); PG8_BAR; PG8_SCHED;
            PG8_STAGE(PG8_SB(1, 1), b3 + hstep, voffB);
            PG8_WAIT_V(6); PG8_BAR; PG8_MMA(1, 1, At, B1); PG8_BAR;
            }
        }
        if constexpr (ALIGN_EPI) { if (wr == 0) PG8_BAR; }
        if constexpr (!Epi::AFTER_DRAIN) { E(acc, cur, wr, wc, fr, fq); S.done(cur); }
        if (!has_next) break;
        if (!E.keep_acc(cur)) {
#pragma unroll
        for (int a = 0; a < 2; ++a)
#pragma unroll
            for (int b = 0; b < 2; ++b)
#pragma unroll
                for (int m = 0; m < 4; ++m)
#pragma unroll
                    for (int n = 0; n < 2; ++n) acc[a][b][m][n] = (f32x4){0.f, 0.f, 0.f, 0.f};
        }
        cur = nxt; cA = nA; cB = nB; ++ui;
        if constexpr (GATHER) {
#pragma unroll
            for (int h = 0; h < 2; ++h)
#pragma unroll
                for (int i = 0; i < 2; ++i) gcur[h][i] = gnxt[h][i]; }
        if constexpr (ALIGN_EPI) { if (wr == 1) PG8_BAR; }
    }
    PG8_WAIT_V(0);
    if constexpr (!ALIGN_EPI) { if (wr == 0) PG8_BAR; }
    PG8_BAR;
    if constexpr (Epi::AFTER_DRAIN) { E.fused(acc, cur, wr, wc, fr, fq, lds, wid, lane); S.done(cur); }
#undef PG8_SA
#undef PG8_SB
#undef PG8_STAGE
#undef PG8_STAGE_A
#undef PG8_LDA
#undef PG8_LDB
#undef PG8_MMA
#undef PG8_WAIT_V
#undef PG8_WAIT_L
#undef PG8_BAR
#undef PG8_SCHED
}
}
typedef unsigned short bf16;
typedef unsigned v4u __attribute__((ext_vector_type(4)));
typedef unsigned v2u __attribute__((ext_vector_type(2)));
typedef float f32x4 __attribute__((ext_vector_type(4)));
#define LDS_WAIT() asm volatile("s_waitcnt lgkmcnt(0)" ::: "memory")
#define VM_WAIT() asm volatile("s_waitcnt vmcnt(0)" ::: "memory")
typedef float cvt_f32x2 __attribute__((ext_vector_type(2)));
typedef __bf16 cvt_bf16x2 __attribute__((ext_vector_type(2)));
__device__ __forceinline__ unsigned cvt_pk_bf16(float lo, float hi) { const cvt_f32x2 v = {lo, hi}; return __builtin_bit_cast(unsigned, __builtin_convertvector(v, cvt_bf16x2)); }
__device__ __forceinline__ float bf_lo(unsigned u) { return __uint_as_float(u << 16); }
__device__ __forceinline__ float bf_hi(unsigned u) { return __uint_as_float(u & 0xffff0000u); }

template <bool NT = false>
__device__ __forceinline__ void tr_item(const float* __restrict__ src, int ldn, int k0, int nsrc0, bf16* dst, int K, int ndst0, LAS float* scr, int lane) {
    const int c4 = (lane & 15) * 4, kr = lane >> 4;
#pragma unroll 4
    for (int i = 0; i < 16; ++i) { const int kk = 4 * i + kr; const f32x4* gp = (const f32x4*)(src + (size_t)(k0 + kk) * ldn + nsrc0 + c4); const f32x4 v = NT ? __builtin_nontemporal_load(gp) : *gp;
        LAS float* s = scr + kk * 65 + c4; s[0] = v[0]; s[1] = v[1]; s[2] = v[2]; s[3] = v[3]; }
    LDS_WAIT();
    const int kc = lane & 7, nr = lane >> 3;
#pragma unroll
    for (int jj = 0; jj < 8; ++jj) { const int n = 8 * jj + nr; const LAS float* s = scr + (8 * kc) * 65 + n;
        v4u o; o.x = cvt_pk_bf16(s[0], s[65]); o.y = cvt_pk_bf16(s[130], s[195]); o.z = cvt_pk_bf16(s[260], s[325]); o.w = cvt_pk_bf16(s[390], s[455]);
        *(v4u*)(dst + (size_t)(ndst0 + n) * K + k0 + 8 * kc) = o; }
    LDS_WAIT();
}
__device__ __forceinline__ void p_convert_moe(const Ctx& c, const float* w_gate_up, const float* w_down, bf16* Wgu_t, bf16* Wd_t) {
    LAS float* scr = (LAS float*)c.lds + c.wave * (64 * 65);
    constexpr int I_GU = NE * 16 * 32, I_D = NE * 16 * 16;
    for (int it = c.bid * NWAVES + c.wave; it < I_GU + I_D; it += c.nb * NWAVES) {
        if (it < I_GU) { const int e = it >> 9, r = it & 511, kb = r >> 5, nbk = r & 31, R0 = nbk * 64, pn = R0 >> 8, rr = R0 & 255, bj = rr >> 7, j0 = rr & 127;
            tr_item<true>(w_gate_up + (size_t)e * D * 2 * DFF, 2 * DFF, kb * 64, bj * DFF + 128 * pn + j0, Wgu_t + (size_t)e * 2 * DFF * D, D, R0, scr, c.lane); }
        else { const int r2 = it - I_GU, e = r2 >> 8, r = r2 & 255, kb = r >> 4, nbk = r & 15;
            tr_item<true>(w_down + (size_t)e * DFF * D, D, kb * 64, nbk * 64, Wd_t + (size_t)e * D * DFF, DFF, nbk * 64, scr, c.lane); }
    }
}

__device__ __forceinline__ float f4c(const float4& v, int i) { return i == 0 ? v.x : (i == 1 ? v.y : (i == 2 ? v.z : v.w)); }
__device__ __forceinline__ void p_router(const Ctx& c, const float* __restrict__ X1, const float* __restrict__ g2, const float* __restrict__ wr, const float* __restrict__ br, bf16* __restrict__ H2, int* __restrict__ slot_e, int* __restrict__ slot_pos, int* __restrict__ elist, float* __restrict__ ewgt, unsigned* gcnt, int reps = 1) {
    LAS f32x4* WL = (LAS f32x4*)c.lds;
    LAS float* LG = (LAS float*)(c.lds0 + EXTRA_OFF);
    LAS int* HIST = (LAS int*)(c.lds0 + EXTRA_OFF + 8192);
    LAS int* BASE = HIST + 32;
    LAS int* SELE = BASE + 32;
    LAS int* SELR = SELE + 256;
    LAS float* SELW = (LAS float*)(SELR + 256);
    const int lane = c.lane;
    { f32x4 wv[16];
#pragma unroll
      for (int i = 0; i < 16; ++i) wv[i] = ((const f32x4*)wr)[c.tid + NTHR * i];
#pragma unroll
      for (int i = 0; i < 16; ++i) { const int idx = c.tid + NTHR * i, k = idx >> 3, q = idx & 7, l = (k & 255) >> 2, cc = k & 3, j = k >> 8; WL[((j * 4 + cc) * 8 + q) * 64 + l] = wv[i]; } }
    __syncthreads();
    for (int blk = c.bid; blk < NTOK / 64; blk += c.nb) {
        if (c.tid < 32) HIST[c.tid] = 0;
        __syncthreads();
        for (int pp = 0; pp < 4 * reps; ++pp) { const int p = pp & 3;
            const size_t t0 = (size_t)blk * 64 + c.wave * 8 + 2 * p;
            float4 xa[4], xb[4]; float sa = 0.f, sb = 0.f;
#pragma unroll
            for (int j = 0; j < 4; ++j) { xa[j] = ((const float4*)(X1 + t0 * D))[lane + 64 * j]; xb[j] = ((const float4*)(X1 + (t0 + 1) * D))[lane + 64 * j];
                sa += xa[j].x * xa[j].x + xa[j].y * xa[j].y + xa[j].z * xa[j].z + xa[j].w * xa[j].w; sb += xb[j].x * xb[j].x + xb[j].y * xb[j].y + xb[j].z * xb[j].z + xb[j].w * xb[j].w; }
            const float ra = rsqrtf(wave_sum(sa) * (1.f / D) + RMS_EPS), rb = rsqrtf(wave_sum(sb) * (1.f / D) + RMS_EPS);
#pragma unroll
            for (int j = 0; j < 4; ++j) { const float4 g = ((const float4*)g2)[lane + 64 * j];
                xa[j].x *= ra * g.x; xa[j].y *= ra * g.y; xa[j].z *= ra * g.z; xa[j].w *= ra * g.w; xb[j].x *= rb * g.x; xb[j].y *= rb * g.y; xb[j].z *= rb * g.z; xb[j].w *= rb * g.w;
                v2u oa, ob; oa.x = cvt_pk_bf16(xa[j].x, xa[j].y); oa.y = cvt_pk_bf16(xa[j].z, xa[j].w); ob.x = cvt_pk_bf16(xb[j].x, xb[j].y); ob.y = cvt_pk_bf16(xb[j].z, xb[j].w);
                ((v2u*)(H2 + t0 * D))[lane + 64 * j] = oa; ((v2u*)(H2 + (t0 + 1) * D))[lane + 64 * j] = ob; }
            float acc[64];
#pragma unroll
            for (int i = 0; i < 64; ++i) acc[i] = 0.f;
#pragma unroll
            for (int j = 0; j < 4; ++j)
#pragma unroll
                for (int cc = 0; cc < 4; ++cc) { const float ha = f4c(xa[j], cc), hb = f4c(xb[j], cc);
#pragma unroll
                    for (int q = 0; q < 8; ++q) { const f32x4 w = WL[((j * 4 + cc) * 8 + q) * 64 + lane];
                        acc[4 * q + 0] = fmaf(ha, w.x, acc[4 * q + 0]); acc[4 * q + 1] = fmaf(ha, w.y, acc[4 * q + 1]); acc[4 * q + 2] = fmaf(ha, w.z, acc[4 * q + 2]); acc[4 * q + 3] = fmaf(ha, w.w, acc[4 * q + 3]);
                        acc[32 + 4 * q + 0] = fmaf(hb, w.x, acc[32 + 4 * q + 0]); acc[32 + 4 * q + 1] = fmaf(hb, w.y, acc[32 + 4 * q + 1]); acc[32 + 4 * q + 2] = fmaf(hb, w.z, acc[32 + 4 * q + 2]); acc[32 + 4 * q + 3] = fmaf(hb, w.w, acc[32 + 4 * q + 3]); } }
            BFLY_SW32(acc, 64) BFLY_SW16(acc, 32) BFLY_DPP(acc, 16, 8, dpp_ror8) BFLY_DPP(acc, 8, 4, dpp_xor4) BFLY_DPP(acc, 4, 2, dpp_xor2) BFLY_DPP(acc, 2, 1, dpp_xor1)
            LG[(c.wave * 8 + 2 * p + (lane >> 5)) * 32 + (lane & 31)] = acc[0] + br[lane & 31];
        }
        LDS_WAIT();
        if (lane < 8) {
            const int tokl = c.wave * 8 + lane;
            float l[NE];
#pragma unroll
            for (int j = 0; j < NE; ++j) l[j] = LG[tokl * 32 + j];
            int sel[4]; float sv[4];
#pragma unroll
            for (int k = 0; k < 4; ++k) { int bi = 0; float bv = -INFINITY;
#pragma unroll
                for (int j = 0; j < NE; ++j) { const bool better = l[j] > bv; bv = better ? l[j] : bv; bi = better ? j : bi; }
                sel[k] = bi; sv[k] = bv;
#pragma unroll
                for (int j = 0; j < NE; ++j) l[j] = (j == bi) ? -INFINITY : l[j]; }
            float den = 0.f, ex[4];
#pragma unroll
            for (int k = 0; k < 4; ++k) { ex[k] = expf(sv[k] - sv[0]); den += ex[k]; }
            const float inv = 1.f / den;
#pragma unroll
            for (int k = 0; k < 4; ++k) { SELE[tokl * 4 + k] = sel[k]; SELW[tokl * 4 + k] = ex[k] * inv; SELR[tokl * 4 + k] = atomicAdd((int*)(HIST + sel[k]), 1); }
        }
        __syncthreads();
        if (c.tid < 32) BASE[c.tid] = (int)__hip_atomic_fetch_add(gcnt + c.tid, (unsigned)HIST[c.tid], __ATOMIC_RELAXED, __HIP_MEMORY_SCOPE_AGENT);
        __syncthreads();
        if (c.tid < 256) { const int gi = blk * 256 + c.tid, e = SELE[c.tid], pos = BASE[e] + SELR[c.tid]; slot_e[gi] = e; slot_pos[gi] = pos; elist[e * NTOK + pos] = gi >> 2; ewgt[e * NTOK + pos] = SELW[c.tid]; }
    }
}

struct MoeOrder {
    int nM, nN, nwg, G, c; const LAS unsigned char* tile_e; const LAS int* tile_b;
    __device__ __forceinline__ void init(int nM_, int nN_, int G_, int c_, const LAS unsigned char* te, const LAS int* tb) { nM = nM_; nN = nN_; nwg = nM * nN; G = G_; c = c_; tile_e = te; tile_b = tb; }
    __device__ __forceinline__ bool next(int i, pg8::Unit& u) const {
        const long L = (long)i * G + c; if (L >= nwg) return false;
        int wgid = (int)L; { const int q = nwg / pg8::NXCD, r = nwg % pg8::NXCD, xcd = wgid % pg8::NXCD, off = wgid / pg8::NXCD; wgid = (xcd < r ? xcd * (q + 1) : r * (q + 1) + (xcd - r) * q) + off; }
        const int nig = pg8::WGM * nN, gid = wgid / nig, fm = gid * pg8::WGM, gsz = (nM - fm) < pg8::WGM ? (nM - fm) : pg8::WGM;
        const int pm = fm + ((wgid % nig) % gsz), pnl = (wgid % nig) / gsz;
        const int e = __builtin_amdgcn_readfirstlane((int)tile_e[pm]);
        u.pm = pm; u.pn = e * nN + pnl; u.x0 = e; u.x1 = pnl; u.rb = e * NTOK + (pm - __builtin_amdgcn_readfirstlane(tile_b[e])) * 256; return true;
    }
    __device__ __forceinline__ void a_ready(const pg8::Unit&) const {}
    __device__ __forceinline__ void done(const pg8::Unit&) const {}
};
__device__ __forceinline__ void build_tile_table(const Ctx& c, const unsigned* gcnt, LAS unsigned char* tile_e, LAS int* ntiles, LAS int* tile_b) {
    if (c.tid == 0) { int tb = 0; for (int e = 0; e < NE; ++e) { const int nt = ((int)gcnt[e] + 255) >> 8; tile_b[e] = tb; for (int i = 0; i < nt; ++i) tile_e[tb + i] = (unsigned char)e; tb += nt; } tile_b[NE] = tb; ntiles[0] = tb; }
    __syncthreads();
}

struct EpiSwiglu {
    static constexpr bool PERM = true, AFTER_DRAIN = false;
    bf16* O; const float* bias;
    __device__ __forceinline__ bool keep_acc(const pg8::Unit&) const { return false; }
    __device__ __forceinline__ void operator()(const f32x4 (&acc)[2][2][4][2], const pg8::Unit& u, int wr, int wc, int fr, int fq) const {
        const int row0 = u.pm * 256 + wr * 64 + fr, col0 = u.x1 * 128 + wc * 32 + 8 * fq;
        const float* bg = bias + (size_t)u.x0 * 2 * DFF + col0; const float* bl = bg + DFF;
        f32x4 bgv[2], blv[2];
#pragma unroll
        for (int n = 0; n < 2; ++n) { bgv[n] = *(const f32x4*)(bg + 4 * n); blv[n] = *(const f32x4*)(bl + 4 * n); }
#pragma unroll
        for (int ai = 0; ai < 2; ++ai)
#pragma unroll
            for (int m = 0; m < 4; ++m) { bf16* rowp = O + (size_t)(row0 + ai * 128 + m * 16) * DFF + col0; float a[8];
#pragma unroll
                for (int n = 0; n < 2; ++n) { const f32x4 g = acc[ai][0][m][n] + bgv[n], l = acc[ai][1][m][n] + blv[n];
#pragma unroll
                    for (int i = 0; i < 4; ++i) { const float xg = fminf(g[i], 7.f), xl = fminf(fmaxf(l[i], -7.f), 7.f);
                        a[4 * n + i] = xg * __builtin_amdgcn_rcpf(1.f + __expf(-1.702f * xg)) * (xl + 1.f); } }
                v4u w; w.x = cvt_pk_bf16(a[0], a[1]); w.y = cvt_pk_bf16(a[2], a[3]); w.z = cvt_pk_bf16(a[4], a[5]); w.w = cvt_pk_bf16(a[6], a[7]);
                *(v4u*)rowp = w; }
    }
};
struct EpiDown {
    static constexpr bool PERM = true, AFTER_DRAIN = false;
    bf16* O; const float* bias; const float* roww;
    __device__ __forceinline__ bool keep_acc(const pg8::Unit&) const { return false; }
    __device__ __forceinline__ void operator()(const f32x4 (&acc)[2][2][4][2], const pg8::Unit& u, int wr, int wc, int fr, int fq) const {
        const int row0 = u.pm * 256 + wr * 64 + fr, col0 = u.x1 * 256 + wc * 32 + 8 * fq;
        const float* bp = bias + (size_t)u.x0 * D + col0;
        f32x4 bv[2][2];
#pragma unroll
        for (int bj = 0; bj < 2; ++bj)
#pragma unroll
            for (int n = 0; n < 2; ++n) bv[bj][n] = *(const f32x4*)(bp + bj * 128 + 4 * n);
#pragma unroll
        for (int ai = 0; ai < 2; ++ai)
#pragma unroll
            for (int m = 0; m < 4; ++m) { const int rl = wr * 64 + fr + ai * 128 + m * 16, row = u.pm * 256 + rl; const float w = roww[u.rb + rl]; bf16* rowp = O + (size_t)row * D + col0;
#pragma unroll
                for (int bj = 0; bj < 2; ++bj) { const f32x4 v0 = (acc[ai][bj][m][0] + bv[bj][0]) * w, v1 = (acc[ai][bj][m][1] + bv[bj][1]) * w;
                    v4u o; o.x = cvt_pk_bf16(v0[0], v0[1]); o.y = cvt_pk_bf16(v0[2], v0[3]); o.z = cvt_pk_bf16(v1[0], v1[1]); o.w = cvt_pk_bf16(v1[2], v1[3]);
                    *(v4u*)(rowp + bj * 128) = o; } }
    }
};

__device__ __forceinline__ void p_final(const Ctx& c, const float* __restrict__ X1, const bf16* __restrict__ Yb, const int* __restrict__ slot_e, const int* __restrict__ slot_pos, const unsigned* gcnt, const float* __restrict__ g, float* __restrict__ out, float pscale = 1.f) {
    LAS int* POFF = (LAS int*)(c.lds0 + EXTRA_OFF);
    if (c.tid == 0) { int s = 0; for (int e = 0; e < NE; ++e) { POFF[e] = s; s += (((int)gcnt[e] + 255) >> 8) << 8; } }
    __syncthreads();
#pragma unroll 2
    for (int t = c.bid * NWAVES + c.wave; t < NTOK; t += c.nb * NWAVES) {
        const int lane = c.lane; float4 v[4];
#pragma unroll
        for (int j = 0; j < 4; ++j) v[j] = ((const float4*)(X1 + (size_t)t * D))[lane + 64 * j];
#pragma unroll
        for (int k = 0; k < 4; ++k) { const int dst = POFF[slot_e[t * 4 + k]] + slot_pos[t * 4 + k];
#pragma unroll
            for (int j = 0; j < 4; ++j) { const v2u y = ((const v2u*)(Yb + (size_t)dst * D))[lane + 64 * j]; v[j].x += bf_lo(y.x); v[j].y += bf_hi(y.x); v[j].z += bf_lo(y.y); v[j].w += bf_hi(y.y); } }
        float s = 0.f;
#pragma unroll
        for (int j = 0; j < 4; ++j) s += v[j].x * v[j].x + v[j].y * v[j].y + v[j].z * v[j].z + v[j].w * v[j].w;
        const float r = rsqrtf(wave_sum(s) * (1.f / D) + RMS_EPS) * pscale;
#pragma unroll
        for (int j = 0; j < 4; ++j) { const float4 gg = ((const float4*)g)[lane + 64 * j]; ((float4*)(out + (size_t)t * D))[lane + 64 * j] = make_float4(v[j].x * r * gg.x, v[j].y * r * gg.y, v[j].z * r * gg.z, v[j].w * r * gg.w); }
    }
}

constexpr int PJ = 5120;
typedef float f32x2 __attribute__((ext_vector_type(2)));
__device__ __forceinline__ f32x2 gelu_pk(f32x2 v) {
    const f32x2 av = __builtin_elementwise_abs(v), d = av * 0.2316418882f + 1.0f;
    f32x2 t; t.x = __builtin_amdgcn_rcpf(d.x); t.y = __builtin_amdgcn_rcpf(d.y);
    f32x2 q = t * 0.5307027145f + (-0.7265760135f); q = q * t + 0.7107068705f; q = q * t + (-0.142248368f); q = q * t + 0.127414796f; q = q * t;
    const f32x2 s = (v * v) * (-0.72134752044f);
    f32x2 e; e.x = __builtin_amdgcn_exp2f(s.x); e.y = __builtin_amdgcn_exp2f(s.y);
    const f32x2 m = v * (q * e), r = v - m;
    f32x2 o; o.x = v.x < 0.f ? m.x : r.x; o.y = v.y < 0.f ? m.y : r.y; return o;
}
__device__ __forceinline__ float fast_sigmoid(float x) { return __builtin_amdgcn_rcpf(1.f + __expf(-x)); }

__device__ __forceinline__ void p_convert_front(const Ctx& c, const float* w_in, const float* w_o_dn, const float* w_o_sg, const float* w_out, bf16* Win_t, bf16* Wo_t, bf16* Wout_t) {
    LAS float* scr = (LAS float*)c.lds + c.wave * (64 * 65);
    constexpr int I_IN = 16 * 80, I_O = 8 * 16, I_OUT = 16 * 16;
    for (int it = c.bid * NWAVES + c.wave; it < I_IN + 2 * I_O + I_OUT; it += c.nb * NWAVES) {
        int r = it;
        if (r < I_IN) { const int kb = r / 80, nbk = r % 80, n0 = nbk * 64; tr_item(w_in, INC, kb * 64, n0 < 2048 ? n0 : n0 + 8, Win_t, D, n0, scr, c.lane); continue; } r -= I_IN;
        if (r < I_O) { const int kb = r / 16, nbk = r % 16; tr_item(w_o_dn, D, kb * 64, nbk * 64, Wo_t, DNW, nbk * 64, scr, c.lane); continue; } r -= I_O;
        if (r < I_O) { const int kb = r / 16, nbk = r % 16; tr_item(w_o_sg, D, kb * 64, nbk * 64, Wo_t + (size_t)D * DNW, SGW, nbk * 64, scr, c.lane); continue; } r -= I_O;
        { const int kb = r / 16, nbk = r % 16; tr_item(w_out, D, kb * 64, nbk * 64, Wout_t, D, nbk * 64, scr, c.lane); }
    }
}
__device__ __forceinline__ void p_norm1(const Ctx& c, const float* __restrict__ x, const float* __restrict__ g1, const float* __restrict__ w_in, const float* __restrict__ a_log, const float* __restrict__ dt_bias, bf16* __restrict__ Hb, float* __restrict__ BG) {
    LAS f32x4* WB = (LAS f32x4*)c.lds;
    const int lane = c.lane;
    for (int idx = c.tid; idx < 2048; idx += NTHR) { const int k = idx >> 1, q = idx & 1; const f32x4 v = *(const f32x4*)(w_in + (size_t)k * INC + 2048 + 4 * q);
        const int l = (k & 255) >> 2, cc = k & 3, j = k >> 8; WB[((j * 4 + cc) * 2 + q) * 64 + l] = v; }
    __syncthreads();
#pragma unroll 2
    for (int t = c.bid * NWAVES + c.wave; t < NTOK; t += c.nb * NWAVES) {
        float4 xv[4]; float ss = 0.f;
#pragma unroll
        for (int j = 0; j < 4; ++j) { xv[j] = ((const float4*)(x + (size_t)t * D))[lane + 64 * j]; ss += xv[j].x * xv[j].x + xv[j].y * xv[j].y + xv[j].z * xv[j].z + xv[j].w * xv[j].w; }
        const float r = rsqrtf(wave_sum(ss) * (1.f / D) + RMS_EPS);
#pragma unroll
        for (int j = 0; j < 4; ++j) { const float4 g = ((const float4*)g1)[lane + 64 * j]; xv[j].x *= r * g.x; xv[j].y *= r * g.y; xv[j].z *= r * g.z; xv[j].w *= r * g.w;
            v2u o; o.x = cvt_pk_bf16(xv[j].x, xv[j].y); o.y = cvt_pk_bf16(xv[j].z, xv[j].w); ((v2u*)(Hb + (size_t)t * D))[lane + 64 * j] = o; }
        float acc[8];
#pragma unroll
        for (int i = 0; i < 8; ++i) acc[i] = 0.f;
#pragma unroll
        for (int j = 0; j < 4; ++j)
#pragma unroll
            for (int cc = 0; cc < 4; ++cc) { const float h = f4c(xv[j], cc);
#pragma unroll
                for (int q = 0; q < 2; ++q) { const f32x4 w = WB[((j * 4 + cc) * 2 + q) * 64 + lane];
                    acc[4 * q + 0] = fmaf(h, w.x, acc[4 * q + 0]); acc[4 * q + 1] = fmaf(h, w.y, acc[4 * q + 1]); acc[4 * q + 2] = fmaf(h, w.z, acc[4 * q + 2]); acc[4 * q + 3] = fmaf(h, w.w, acc[4 * q + 3]); } }
        BFLY_SW32(acc, 8) BFLY_SW16(acc, 4) BFLY_DPP(acc, 2, 8, dpp_ror8)
        float a0 = acc[0]; a0 += dpp_xor4(a0); a0 += dpp_xor2(a0); a0 += dpp_xor1(a0);
        const int idx = lane >> 3;
        if ((lane & 7) == 0) { float o;
            if (idx < 4) o = 1.f / (1.f + expf(-a0)); else { const int h = idx - 4; o = -expf(a_log[h]) * softplusf_(a0 + dt_bias[h]); }
            BG[(size_t)t * 8 + idx] = o; }
    }
}
struct EpiProj {
    static constexpr bool PERM = true, AFTER_DRAIN = false;
    bf16* O;
    __device__ __forceinline__ bool keep_acc(const pg8::Unit&) const { return false; }
    __device__ __forceinline__ void operator()(const f32x4 (&acc)[2][2][4][2], const pg8::Unit& u, int wr, int wc, int fr, int fq) const {
        const int row0 = u.pm * 256 + wr * 64 + fr, col0 = u.pn * 256 + wc * 32 + 8 * fq;
        const int act = (u.pn < 6) ? 0 : (u.pn < 8 ? 1 : (u.pn < 12 ? 2 : 0));
#pragma unroll
        for (int ai = 0; ai < 2; ++ai)
#pragma unroll
            for (int m = 0; m < 4; ++m) { bf16* rowp = O + (size_t)(row0 + ai * 128 + m * 16) * PJ + col0;
#pragma unroll
                for (int bj = 0; bj < 2; ++bj) { f32x4 v0 = acc[ai][bj][m][0], v1 = acc[ai][bj][m][1];
                    if (act == 1) {
#pragma unroll
                        for (int i = 0; i < 4; ++i) { v0[i] = v0[i] * fast_sigmoid(v0[i]); v1[i] = v1[i] * fast_sigmoid(v1[i]); } }
                    else if (act == 2) { const f32x2 a = gelu_pk((f32x2){v0[0], v0[1]}), b = gelu_pk((f32x2){v0[2], v0[3]}), cc = gelu_pk((f32x2){v1[0], v1[1]}), d = gelu_pk((f32x2){v1[2], v1[3]});
                        v0 = (f32x4){a.x, a.y, b.x, b.y}; v1 = (f32x4){cc.x, cc.y, d.x, d.y}; }
                    v4u w; w.x = cvt_pk_bf16(v0[0], v0[1]); w.y = cvt_pk_bf16(v0[2], v0[3]); w.z = cvt_pk_bf16(v1[0], v1[1]); w.w = cvt_pk_bf16(v1[2], v1[3]);
                    *(v4u*)(rowp + bj * 128) = w; } }
    }
};
struct DualOrder {
    pg8::StaticOrder S0;
    __device__ __forceinline__ void init(int G, int c) { S0.init(NTOK, D, G, c); }
    __device__ __forceinline__ bool next(int i, pg8::Unit& u) const { pg8::Unit t; if (!S0.next(i >> 1, t)) return false; const int which = i & 1; u.pm = t.pm + 64 * which; u.pn = t.pn + 4 * which; u.x0 = which; u.x1 = t.pn; u.rb = 0; return true; }
    __device__ __forceinline__ void a_ready(const pg8::Unit&) const {}
    __device__ __forceinline__ void done(const pg8::Unit&) const {}
};
struct EpiMerge {
    static constexpr bool PERM = true, AFTER_DRAIN = false;
    const bf16* P; bf16* O;
    __device__ __forceinline__ bool keep_acc(const pg8::Unit& u) const { return u.x0 == 0; }
    __device__ __forceinline__ void operator()(f32x4 (&acc)[2][2][4][2], const pg8::Unit& u, int wr, int wc, int fr, int fq) const {
        const int row0 = (u.pm & 63) * 256 + wr * 64 + fr, col0 = u.x1 * 256 + wc * 32 + 8 * fq; const bool first = (u.x0 == 0);
#pragma unroll
        for (int ai = 0; ai < 2; ++ai)
#pragma unroll
            for (int m = 0; m < 4; ++m) { const int row = row0 + ai * 128 + m * 16; const bf16* pr = P + (size_t)row * PJ + col0;
#pragma unroll
                for (int bj = 0; bj < 2; ++bj) { const v4u xb = *(const v4u*)(pr + 4096 + bj * 128); float fb[8];
                    fb[0] = bf_lo(xb.x); fb[1] = bf_hi(xb.x); fb[2] = bf_lo(xb.y); fb[3] = bf_hi(xb.y); fb[4] = bf_lo(xb.z); fb[5] = bf_hi(xb.z); fb[6] = bf_lo(xb.w); fb[7] = bf_hi(xb.w);
#pragma unroll
                    for (int i = 0; i < 8; ++i) fb[i] = 1.f + __expf(-fmaxf(fb[i], -30.f));
                    if (first) { const v4u xa = *(const v4u*)(pr + 3072 + bj * 128); float fa[8];
                        fa[0] = bf_lo(xa.x); fa[1] = bf_hi(xa.x); fa[2] = bf_lo(xa.y); fa[3] = bf_hi(xa.y); fa[4] = bf_lo(xa.z); fa[5] = bf_hi(xa.z); fa[6] = bf_lo(xa.w); fa[7] = bf_hi(xa.w);
#pragma unroll
                        for (int i = 0; i < 4; ++i) { acc[ai][bj][m][0][i] *= fb[i] * fast_sigmoid(fa[i]); acc[ai][bj][m][1][i] *= fb[4 + i] * fast_sigmoid(fa[4 + i]); } }
                    else { f32x4 v0, v1;
#pragma unroll
                        for (int i = 0; i < 4; ++i) { v0[i] = acc[ai][bj][m][0][i] * __builtin_amdgcn_rcpf(fb[i]); v1[i] = acc[ai][bj][m][1][i] * __builtin_amdgcn_rcpf(fb[4 + i]); }
                        v4u w; w.x = cvt_pk_bf16(v0[0], v0[1]); w.y = cvt_pk_bf16(v0[2], v0[3]); w.z = cvt_pk_bf16(v1[0], v1[1]); w.w = cvt_pk_bf16(v1[2], v1[3]);
                        *(v4u*)(O + (size_t)row * D + col0 + bj * 128) = w; } } }
    }
};
struct EpiResid {
    static constexpr bool PERM = false, AFTER_DRAIN = false;
    const float* X; float* O;
    __device__ __forceinline__ bool keep_acc(const pg8::Unit&) const { return false; }
    __device__ __forceinline__ void operator()(const f32x4 (&acc)[2][2][4][2], const pg8::Unit& u, int wr, int wc, int fr, int fq) const {
        const int row0 = u.pm * 256 + wr * 64 + fr, col0 = u.pn * 256 + wc * 32 + 4 * fq;
#pragma unroll
        for (int ai = 0; ai < 2; ++ai)
#pragma unroll
            for (int m = 0; m < 4; ++m) { const size_t off = (size_t)(row0 + ai * 128 + m * 16) * D + col0;
#pragma unroll
                for (int bj = 0; bj < 2; ++bj)
#pragma unroll
                    for (int n = 0; n < 2; ++n) *(f32x4*)(O + off + bj * 128 + n * 16) = *(const f32x4*)(X + off + bj * 128 + n * 16) + acc[ai][bj][m][n]; }
    }
};
__device__ __forceinline__ float ldbf(const bf16* p) { return __uint_as_float((unsigned)(*p) << 16); }
typedef short bf16x8 __attribute__((ext_vector_type(8)));
#define MFMA16(a, b, c) __builtin_amdgcn_mfma_f32_16x16x32_bf16((a), (b), (c), 0, 0, 0)
__device__ __forceinline__ unsigned short f2bf1(float f) { return (unsigned short)(cvt_pk_bf16(f, 0.f) & 0xffffu); }
__device__ __forceinline__ void unpack8(const v4u& x, float (&f)[8]) { f[0] = bf_lo(x.x); f[1] = bf_hi(x.x); f[2] = bf_lo(x.y); f[3] = bf_hi(x.y); f[4] = bf_lo(x.z); f[5] = bf_hi(x.z); f[6] = bf_lo(x.w); f[7] = bf_hi(x.w); }
__device__ __forceinline__ bf16x8 as_frag(const v4u& x) { return __builtin_bit_cast(bf16x8, x); }

constexpr size_t DN_WN = 16384, DN_QD = 16384, DN_KD = 16384, DN_QK = 8192, DN_U = 16384, DN_SST = 32768;
struct DnBufs { unsigned char *WN, *QD, *KD, *QK, *U, *SST; float* EG; };
constexpr int PL_QH = 0, PL_KH = 17408, PL_XVT = 34816, PL_XWT = 53248, PL_KDT = 71680, PL_AL = 90112, PL_TL = 106496, PL_GAM = 115712;
constexpr int RS = 136  , TS = 72  ;

__device__ __forceinline__ void p_dn_prep(const Ctx& c, const bf16* PROJ, const float* cw, const float* BG, const DnBufs& B) {
    LAS unsigned char* L = c.lds;
    LAS unsigned short* QH = (LAS unsigned short*)(L + PL_QH); LAS unsigned short* KH = (LAS unsigned short*)(L + PL_KH);
    LAS unsigned short* XVT = (LAS unsigned short*)(L + PL_XVT); LAS unsigned short* XWT = (LAS unsigned short*)(L + PL_XWT); LAS unsigned short* KDT = (LAS unsigned short*)(L + PL_KDT);
    LAS float* AL = (LAS float*)(L + PL_AL); LAS unsigned short* TL = (LAS unsigned short*)(L + PL_TL);
    LAS float* GAM = (LAS float*)(L + PL_GAM); LAS float* BETA = GAM + 64; LAS float* EGAM = GAM + 128; LAS float* KSC = GAM + 192;
    const int lane = c.lane, w = c.wave, fr = lane & 15, fq = lane >> 4;
    for (int it = c.bid; it < BATCH * DNH * (SEQ / 64); it += c.nb) {
        const int bh = it >> 7, ch = it & 127, b = bh >> 2, h = bh & 3; const size_t row0 = (size_t)b * SEQ + ch * 64;
        if (w == 0) { const float gt = BG[(row0 + lane) * 8 + 4 + h], bt = BG[(row0 + lane) * 8 + h]; float gam = gt;
#pragma unroll
            for (int o = 1; o < 64; o <<= 1) { const float t = __shfl_up(gam, o); if (lane >= o) gam += t; }
            const float gl = __shfl(gam, 63);
            GAM[lane] = gam; BETA[lane] = bt; EGAM[lane] = expf(gam); KSC[lane] = expf(gl - gam);
            if (lane == 0) B.EG[it] = expf(gl); }
        for (int i = c.tid; i < 1024; i += NTHR) ((LAS f32x4*)AL)[i] = (f32x4){0.f, 0.f, 0.f, 0.f};
        __syncthreads();
#pragma unroll 1
        for (int i = 0; i < 6; i += 2) {
            v4u xr[2][4];
#pragma unroll
            for (int u = 0; u < 2; ++u) { const int idx = c.tid + NTHR * (i + u), t = idx / 48, cg = idx % 48, col = (cg >> 4) * 512 + h * 128 + (cg & 15) * 8;
#pragma unroll
                for (int kk = 0; kk < 4; ++kk) { const int tt = ch * 64 + t - 3 + kk; xr[u][kk] = (tt >= 0) ? *(const v4u*)(PROJ + ((size_t)b * SEQ + tt) * PJ + col) : (v4u){0u, 0u, 0u, 0u}; } }
#pragma unroll
            for (int u = 0; u < 2; ++u) {
            const int idx = c.tid + NTHR * (i + u), t = idx / 48, cg = idx % 48, part = cg >> 4, c8 = (cg & 15) * 8, col = part * 512 + h * 128 + c8;
            float a[8];
#pragma unroll
            for (int e = 0; e < 8; ++e) a[e] = 0.f;
#pragma unroll
            for (int kk = 0; kk < 4; ++kk) { float xf[8]; unpack8(xr[u][kk], xf);
                    const float4 w0 = *(const float4*)(cw + kk * 1536 + col), w1 = *(const float4*)(cw + kk * 1536 + col + 4);
                    a[0] = fmaf(w0.x, xf[0], a[0]); a[1] = fmaf(w0.y, xf[1], a[1]); a[2] = fmaf(w0.z, xf[2], a[2]); a[3] = fmaf(w0.w, xf[3], a[3]);
                    a[4] = fmaf(w1.x, xf[4], a[4]); a[5] = fmaf(w1.y, xf[5], a[5]); a[6] = fmaf(w1.z, xf[6], a[6]); a[7] = fmaf(w1.w, xf[7], a[7]); }
            float ss = 0.f;
#pragma unroll
            for (int e = 0; e < 8; ++e) { a[e] = a[e] / (1.f + __expf(-a[e])); ss = fmaf(a[e], a[e], ss); }
            ss = row16_sum(ss);
            const float rs = rsqrtf(ss + L2_EPS);
            if (part == 0) { const float sc = rs * 0.08838834764831845f; v4u o; o.x = cvt_pk_bf16(a[0] * sc, a[1] * sc); o.y = cvt_pk_bf16(a[2] * sc, a[3] * sc); o.z = cvt_pk_bf16(a[4] * sc, a[5] * sc); o.w = cvt_pk_bf16(a[6] * sc, a[7] * sc);
                *(LAS v4u*)(QH + t * RS + c8) = o; }
            else if (part == 1) { v4u o; o.x = cvt_pk_bf16(a[0] * rs, a[1] * rs); o.y = cvt_pk_bf16(a[2] * rs, a[3] * rs); o.z = cvt_pk_bf16(a[4] * rs, a[5] * rs); o.w = cvt_pk_bf16(a[6] * rs, a[7] * rs);
                *(LAS v4u*)(KH + t * RS + c8) = o; const float s1 = rs * BETA[t] * EGAM[t], s2 = rs * KSC[t];
#pragma unroll
                for (int e = 0; e < 8; ++e) { XWT[(c8 + e) * TS + t] = f2bf1(a[e] * s1); KDT[(c8 + e) * TS + t] = f2bf1(a[e] * s2); } }
            else { const float bt = BETA[t];
#pragma unroll
                for (int e = 0; e < 8; ++e) XVT[(c8 + e) * TS + t] = f2bf1(a[e] * bt); }
            }
        }
        __syncthreads();
        { const int rt = w & 3, ksq = w >> 2; v2u half[2];
#pragma unroll
            for (int sub = 0; sub < 2; ++sub) { const int st = 2 * ksq + sub; f32x4 acc = {0.f, 0.f, 0.f, 0.f};
#pragma unroll
                for (int kk = 0; kk < 4; ++kk) { const bf16x8 a = *(const LAS bf16x8*)(KH + (16 * st + fr) * RS + 32 * kk + 8 * fq), bq = *(const LAS bf16x8*)(QH + (16 * rt + fr) * RS + 32 * kk + 8 * fq); acc = MFMA16(a, bq, acc); }
                const int rr = 16 * rt + fr; const float gr = GAM[rr]; float v[4];
#pragma unroll
                for (int r = 0; r < 4; ++r) { const int s2 = 16 * st + 4 * fq + r; v[r] = (s2 <= rr) ? acc[r] * __expf(fminf(gr - GAM[s2], 0.f)) : 0.f; }
                half[sub].x = cvt_pk_bf16(v[0], v[1]); half[sub].y = cvt_pk_bf16(v[2], v[3]); }
            v4u o; o.x = half[0].x; o.y = half[0].y; o.z = half[1].x; o.w = half[1].y;
            *(v4u*)(B.QK + (size_t)it * DN_QK + ((rt * 2 + ksq) * 64 + lane) * 16) = o; }
#pragma unroll 1
        for (int n = w; n < 10; n += 8) { const int rt = (n >= 6) ? 3 : (n >= 3 ? 2 : (n >= 1 ? 1 : 0)), st = n - rt * (rt + 1) / 2; f32x4 acc = {0.f, 0.f, 0.f, 0.f};
#pragma unroll
            for (int kk = 0; kk < 4; ++kk) { const bf16x8 a = *(const LAS bf16x8*)(KH + (16 * rt + fr) * RS + 32 * kk + 8 * fq), bk = *(const LAS bf16x8*)(KH + (16 * st + fr) * RS + 32 * kk + 8 * fq); acc = MFMA16(a, bk, acc); }
            const int s2 = 16 * st + fr; const float gs = GAM[s2];
#pragma unroll
            for (int r = 0; r < 4; ++r) { const int rr = 16 * rt + 4 * fq + r; const float v = (s2 < rr) ? BETA[rr] * acc[r] * __expf(fminf(GAM[rr] - gs, 0.f)) : 0.f; AL[rr * 64 + (s2 & 7) * 8 + (s2 >> 3)] = v; } }
        __syncthreads();
        { const int j = w * 8 + (lane >> 3), p = lane & 7; float tc[8];
#pragma unroll
            for (int i = 0; i < 8; ++i) tc[i] = 0.f;
#pragma unroll
            for (int r = 0; r < 64; ++r) { float s0 = 0.f, s1 = 0.f;
                if (r > 0) { const LAS float* ar = AL + r * 64 + p * 8; const f32x4 a0 = *(const LAS f32x4*)ar; s0 = a0[0] * tc[0];
                    if (r > 8) s1 = a0[1] * tc[1];
                    if (r > 16) s0 = fmaf(a0[2], tc[2], s0);
                    if (r > 24) s1 = fmaf(a0[3], tc[3], s1);
                    if (r > 32) { const f32x4 a1 = *(const LAS f32x4*)(ar + 4); s0 = fmaf(a1[0], tc[4], s0);
                        if (r > 40) s1 = fmaf(a1[1], tc[5], s1);
                        if (r > 48) s0 = fmaf(a1[2], tc[6], s0);
                        if (r > 56) s1 = fmaf(a1[3], tc[7], s1); } }
                float tot = s0 + s1; tot += dpp_xor1(tot); tot += dpp_xor2(tot); tot += dpp_hmir(tot);
                const float tr = ((r == j) ? 1.f : 0.f) - tot;
                if (p == (r & 7)) tc[r >> 3] = tr; }
#pragma unroll
            for (int i = 0; i < 8; ++i) TL[(8 * i + p) * TS + j] = f2bf1(tc[i]); }
        __syncthreads();
        { const int sl = w;
#pragma unroll
            for (int mt = 0; mt < 4; ++mt) { f32x4 acc = {0.f, 0.f, 0.f, 0.f};
#pragma unroll
                for (int kk = 0; kk < 2; ++kk) if (kk == 0 || mt >= 2) { const bf16x8 a = *(const LAS bf16x8*)(TL + (16 * mt + fr) * TS + 32 * kk + 8 * fq), bv = *(const LAS bf16x8*)(XVT + (16 * sl + fr) * TS + 32 * kk + 8 * fq); acc = MFMA16(a, bv, acc); }
                v2u o; o.x = cvt_pk_bf16(acc[0], acc[1]); o.y = cvt_pk_bf16(acc[2], acc[3]);
                *(v2u*)(B.U + (size_t)it * DN_U + ((mt * 8 + sl) * 64 + lane) * 8) = o; }
            const int dt = w;
#pragma unroll
            for (int rt = 0; rt < 4; ++rt) { f32x4 acc = {0.f, 0.f, 0.f, 0.f};
#pragma unroll
                for (int kk = 0; kk < 2; ++kk) if (kk == 0 || rt >= 2) { const bf16x8 a = *(const LAS bf16x8*)(XWT + (16 * dt + fr) * TS + 32 * kk + 8 * fq), bt = *(const LAS bf16x8*)(TL + (16 * rt + fr) * TS + 32 * kk + 8 * fq); acc = MFMA16(a, bt, acc); }
                v2u o; o.x = cvt_pk_bf16(-acc[0], -acc[1]); o.y = cvt_pk_bf16(-acc[2], -acc[3]);
                *(v2u*)(B.WN + (size_t)it * DN_WN + ((rt * 4 + (dt >> 1)) * 64 + lane) * 16 + (dt & 1) * 8) = o; } }
        { const int mt = w & 3;
#pragma unroll
            for (int q2 = 0; q2 < 2; ++q2) { const int ks = 2 * (w >> 2) + q2, rr = 16 * mt + fr; const float sc = EGAM[rr];
                const v2u lo = *(const LAS v2u*)(QH + rr * RS + 32 * ks + 4 * fq), hi = *(const LAS v2u*)(QH + rr * RS + 32 * ks + 16 + 4 * fq);
                v4u o; o.x = cvt_pk_bf16(bf_lo(lo.x) * sc, bf_hi(lo.x) * sc); o.y = cvt_pk_bf16(bf_lo(lo.y) * sc, bf_hi(lo.y) * sc); o.z = cvt_pk_bf16(bf_lo(hi.x) * sc, bf_hi(hi.x) * sc); o.w = cvt_pk_bf16(bf_lo(hi.y) * sc, bf_hi(hi.y) * sc);
                *(v4u*)(B.QD + (size_t)it * DN_QD + ((mt * 4 + ks) * 64 + lane) * 16) = o; }
            const int dt = w;
#pragma unroll
            for (int ks = 0; ks < 2; ++ks) { const v2u lo = *(const LAS v2u*)(KDT + (16 * dt + fr) * TS + 32 * ks + 4 * fq), hi = *(const LAS v2u*)(KDT + (16 * dt + fr) * TS + 32 * ks + 16 + 4 * fq);
                v4u o; o.x = lo.x; o.y = lo.y; o.z = hi.x; o.w = hi.y;
                *(v4u*)(B.KD + (size_t)it * DN_KD + ((dt * 2 + ks) * 64 + lane) * 16) = o; } }
        __syncthreads();
    }
}

constexpr int SCAN_WGS = BATCH * DNH * 2;
__device__ __forceinline__ void u_load_asm(v2u& dst, const unsigned char* p) { asm volatile("global_load_dwordx2 %0, %1, off" : "=v"(dst) : "v"(p) : "memory"); }
template <int STG>
__device__ __forceinline__ void scan_step(const DnBufs& B, LAS unsigned char* L, int lane, int sl, int it, int ch, f32x4 (&S)[8], v2u (&ucur)[4], v2u (&unxt)[4], float egc) {
    if (ch < 126) asm volatile("s_waitcnt vmcnt(8)" ::: "memory"); else asm volatile("s_waitcnt vmcnt(0)" ::: "memory");
    __builtin_amdgcn_s_barrier(); asm volatile("" ::: "memory");
    asm volatile("" : "+v"(ucur[0]), "+v"(ucur[1]), "+v"(ucur[2]), "+v"(ucur[3]));
    bf16x8 sf[4];
#pragma unroll
    for (int ks = 0; ks < 4; ++ks) { v4u o; o.x = cvt_pk_bf16(S[2 * ks][0], S[2 * ks][1]); o.y = cvt_pk_bf16(S[2 * ks][2], S[2 * ks][3]); o.z = cvt_pk_bf16(S[2 * ks + 1][0], S[2 * ks + 1][1]); o.w = cvt_pk_bf16(S[2 * ks + 1][2], S[2 * ks + 1][3]);
        *(v4u*)(B.SST + (size_t)it * DN_SST + ((ks * 8 + sl) * 64 + lane) * 16) = o; sf[ks] = as_frag(o); }
    asm volatile("" ::: "memory");
    if (ch + 3 < 128) {
#pragma unroll
        for (int mt = 0; mt < 4; ++mt) u_load_asm(unxt[mt], B.U + (size_t)(it + 3) * DN_U + ((mt * 8 + sl) * 64 + lane) * 8); }
    const LAS unsigned char* wl = L + STG * 32768 + lane * 16; const LAS unsigned char* kl = wl + 16384;
    f32x4 vn[4];
#pragma unroll
    for (int mt = 0; mt < 4; ++mt) { vn[mt] = (f32x4){bf_lo(ucur[mt].x), bf_hi(ucur[mt].x), bf_lo(ucur[mt].y), bf_hi(ucur[mt].y)};
#pragma unroll
        for (int ks = 0; ks < 4; ++ks) vn[mt] = MFMA16(*(const LAS bf16x8*)(wl + (mt * 4 + ks) * 1024), sf[ks], vn[mt]); }
    bf16x8 vf[2];
#pragma unroll
    for (int ks = 0; ks < 2; ++ks) { v4u o; o.x = cvt_pk_bf16(vn[2 * ks][0], vn[2 * ks][1]); o.y = cvt_pk_bf16(vn[2 * ks][2], vn[2 * ks][3]); o.z = cvt_pk_bf16(vn[2 * ks + 1][0], vn[2 * ks + 1][1]); o.w = cvt_pk_bf16(vn[2 * ks + 1][2], vn[2 * ks + 1][3]); vf[ks] = as_frag(o); }
#pragma unroll
    for (int dt = 0; dt < 8; ++dt) { f32x4 a = S[dt] * egc;
#pragma unroll
        for (int ks = 0; ks < 2; ++ks) a = MFMA16(*(const LAS bf16x8*)(kl + (dt * 2 + ks) * 1024), vf[ks], a);
        S[dt] = a; }
}
__device__ __forceinline__ void p_dn_scan(const Ctx& c, const DnBufs& B) {
    const int lane = c.lane, w = c.wave, bh = c.bid >> 1, half = c.bid & 1; LAS unsigned char* L = c.lds;
    if (w >= 4) {
        const unsigned char* gsrc = (w < 6) ? B.WN : B.KD; const int goff = (w & 1) * 8192 + lane * 16, loff = (w - 4) * 8192;
#define SCAN_DMA(itn, stage) do { _Pragma("unroll") for (int _p = 0; _p < 8; ++_p) \
        __builtin_amdgcn_global_load_lds((const unsigned*)(gsrc + (size_t)(itn) * 16384 + goff + _p * 1024), (LAS unsigned*)(L + (stage) * 32768 + loff + _p * 1024), 16, 0, 0); } while (0)
        const int it0 = bh * 128;
        SCAN_DMA(it0, 0); SCAN_DMA(it0 + 1, 1); SCAN_DMA(it0 + 2, 2);
#pragma unroll 1
        for (int ch = 0; ch < 128; ++ch) {
            if (ch < 126) asm volatile("s_waitcnt vmcnt(16)" ::: "memory"); else asm volatile("s_waitcnt vmcnt(0)" ::: "memory");
            __builtin_amdgcn_s_barrier(); asm volatile("" ::: "memory");
            if (ch + 3 < 128) SCAN_DMA(it0 + ch + 3, (ch + 3) & 3);
        }
#undef SCAN_DMA
    } else {
        __builtin_amdgcn_s_setprio(1);
        const int sl = half * 4 + w;
        f32x4 S[8];
#pragma unroll
        for (int i = 0; i < 8; ++i) S[i] = (f32x4){0.f, 0.f, 0.f, 0.f};
        v2u u0[4], u1[4], u2[4], u3[4];
        const float eglo = B.EG[bh * 128 + lane], eghi = B.EG[bh * 128 + 64 + lane];
        asm volatile("s_waitcnt vmcnt(0)" ::: "memory");
        { const int it = bh * 128;
#pragma unroll
            for (int mt = 0; mt < 4; ++mt) u_load_asm(u0[mt], B.U + (size_t)it * DN_U + ((mt * 8 + sl) * 64 + lane) * 8);
#pragma unroll
            for (int mt = 0; mt < 4; ++mt) u_load_asm(u1[mt], B.U + (size_t)(it + 1) * DN_U + ((mt * 8 + sl) * 64 + lane) * 8);
#pragma unroll
            for (int mt = 0; mt < 4; ++mt) u_load_asm(u2[mt], B.U + (size_t)(it + 2) * DN_U + ((mt * 8 + sl) * 64 + lane) * 8);
#pragma unroll
            for (int mt = 0; mt < 4; ++mt) u3[mt] = (v2u){0u, 0u}; }
#define EGC(chx) __builtin_bit_cast(float, __builtin_amdgcn_readlane(__builtin_bit_cast(int, (chx) < 64 ? eglo : eghi), (chx) & 63))
#pragma unroll 1
        for (int ch = 0; ch < 128; ch += 4) {
            const int it = bh * 128 + ch;
            scan_step<0>(B, L, lane, sl, it, ch, S, u0, u3, EGC(ch));
            scan_step<1>(B, L, lane, sl, it + 1, ch + 1, S, u1, u0, EGC(ch + 1));
            scan_step<2>(B, L, lane, sl, it + 2, ch + 2, S, u2, u1, EGC(ch + 2));
            scan_step<3>(B, L, lane, sl, it + 3, ch + 3, S, u3, u2, EGC(ch + 3));
        }
#undef EGC
        __builtin_amdgcn_s_setprio(0);
    }
    asm volatile("s_waitcnt vmcnt(0)" ::: "memory"); __builtin_amdgcn_s_barrier(); asm volatile("" ::: "memory");
}

__device__ __forceinline__ void p_dn_out(const Ctx& c, const DnBufs& B, const bf16* PROJ, const float* gn, bf16* YA) {
    const int lane = c.lane, sl = c.wave, fr = lane & 15, fq = lane >> 4; LAS float* SSQ = (LAS float*)c.lds;
    LAS unsigned char* IMG = c.lds + 2048;
    for (int it = c.bid; it < BATCH * DNH * (SEQ / 64); it += c.nb) {
        const int bh = it >> 7, ch = it & 127, b = bh >> 2, h = bh & 3; const size_t row0 = (size_t)b * SEQ + ch * 64;
        v4u sfr[4]; v2u ur[4];
#pragma unroll
        for (int ks = 0; ks < 4; ++ks) sfr[ks] = *(const v4u*)(B.SST + (size_t)it * DN_SST + ((ks * 8 + sl) * 64 + lane) * 16);
#pragma unroll
        for (int mt = 0; mt < 4; ++mt) ur[mt] = *(const v2u*)(B.U + (size_t)it * DN_U + ((mt * 8 + sl) * 64 + lane) * 8);
#pragma unroll
        for (int j = 0; j < 5; ++j) { const int p = sl * 5 + j;
            const unsigned char* src = (p < 16) ? B.WN + (size_t)it * DN_WN + p * 1024 : (p < 32 ? B.QD + (size_t)it * DN_QD + (p - 16) * 1024 : B.QK + (size_t)it * DN_QK + (p - 32) * 1024);
            __builtin_amdgcn_global_load_lds((const unsigned*)(src + lane * 16), (LAS unsigned*)(IMG + p * 1024), 16, 0, 0); }
        asm volatile("s_waitcnt vmcnt(0)" ::: "memory"); __syncthreads();
        bf16x8 sf[4];
#pragma unroll
        for (int ks = 0; ks < 4; ++ks) sf[ks] = as_frag(sfr[ks]);
        const LAS unsigned char* wn = IMG + lane * 16; const LAS unsigned char* qd = wn + 16384; const LAS unsigned char* qk = wn + 32768;
        f32x4 vn[4];
#pragma unroll
        for (int mt = 0; mt < 4; ++mt) { vn[mt] = (f32x4){bf_lo(ur[mt].x), bf_hi(ur[mt].x), bf_lo(ur[mt].y), bf_hi(ur[mt].y)};
#pragma unroll
            for (int ks = 0; ks < 4; ++ks) vn[mt] = MFMA16(*(const LAS bf16x8*)(wn + (mt * 4 + ks) * 1024), sf[ks], vn[mt]); }
        bf16x8 vf[2];
#pragma unroll
        for (int ks = 0; ks < 2; ++ks) { v4u o; o.x = cvt_pk_bf16(vn[2 * ks][0], vn[2 * ks][1]); o.y = cvt_pk_bf16(vn[2 * ks][2], vn[2 * ks][3]); o.z = cvt_pk_bf16(vn[2 * ks + 1][0], vn[2 * ks + 1][1]); o.w = cvt_pk_bf16(vn[2 * ks + 1][2], vn[2 * ks + 1][3]); vf[ks] = as_frag(o); }
        f32x4 o[4];
#pragma unroll
        for (int mt = 0; mt < 4; ++mt) { f32x4 a = {0.f, 0.f, 0.f, 0.f};
#pragma unroll
            for (int ks = 0; ks < 4; ++ks) a = MFMA16(*(const LAS bf16x8*)(qd + (mt * 4 + ks) * 1024), sf[ks], a);
#pragma unroll
            for (int ks = 0; ks < 2; ++ks) a = MFMA16(*(const LAS bf16x8*)(qk + (mt * 2 + ks) * 1024), vf[ks], a);
            o[mt] = a;
#pragma unroll
            for (int r = 0; r < 4; ++r) { float q = row16_sum(a[r] * a[r]);
                if (fr == 0) SSQ[(16 * mt + 4 * fq + r) * 8 + sl] = q; } }
        float zv[4][4];
#pragma unroll
        for (int mt = 0; mt < 4; ++mt)
#pragma unroll
            for (int r = 0; r < 4; ++r) zv[mt][r] = ldbf(PROJ + (row0 + 16 * mt + 4 * fq + r) * PJ + 1536 + h * 128 + 16 * sl + fr);
        const float gg = gn[16 * sl + fr];
        __syncthreads();
#pragma unroll
        for (int mt = 0; mt < 4; ++mt)
#pragma unroll
            for (int r = 0; r < 4; ++r) { const int rl = 16 * mt + 4 * fq + r; const f32x4 q0 = *(const LAS f32x4*)(SSQ + rl * 8), q1 = *(const LAS f32x4*)(SSQ + rl * 8 + 4);
                const float rstd = rsqrtf(((q0[0] + q0[1]) + (q0[2] + q0[3]) + (q1[0] + q1[1]) + (q1[2] + q1[3])) * (1.f / 128.f) + RMS_EPS);
                const size_t row = row0 + rl; const int col = h * 128 + 16 * sl + fr;
                YA[row * DNW + col] = f2bf1(o[mt][r] * rstd * gg * zv[mt][r]); }
        __syncthreads();
    }
}

__device__ __forceinline__ void p_sg_item(const Ctx& c, int it, const bf16* PROJ, const float* lg, const float* lb, const float* sw, const float* sb, bf16* YB) {
    LAS unsigned short* VT = (LAS unsigned short*)c.lds;
    LAS float* STAT = (LAS float*)(c.lds + 128 * RS * 2);
    const int lane = c.lane, w = c.wave, fr = lane & 15, fq = lane >> 4, chunk = it >> 2, g = it & 3; const size_t row0 = (size_t)chunk * SGC;
    {
        v4u xr[16];
#pragma unroll
        for (int rr = 0; rr < 16; ++rr) xr[rr] = *(const v4u*)(PROJ + (row0 + 16 * w + rr) * PJ + 2560 + lane * 8);
        float acc[32];
#pragma unroll
        for (int rr = 0; rr < 16; ++rr) { float f[8]; unpack8(xr[rr], f); float s1 = 0.f, s2 = 0.f;
#pragma unroll
            for (int e = 0; e < 8; ++e) { s1 += f[e]; s2 = fmaf(f[e], f[e], s2); }
            acc[rr] = s1; acc[16 + rr] = s2; }
        BFLY_SW32(acc, 32) BFLY_SW16(acc, 16) BFLY_DPP(acc, 8, 8, dpp_ror8) BFLY_DPP(acc, 4, 4, dpp_xor4) BFLY_DPP(acc, 2, 2, dpp_xor2)
        const float tot = acc[0] + dpp_xor1(acc[0]);
        if ((lane & 1) == 0) { const int vi = lane >> 1; STAT[2 * (16 * w + (vi & 15)) + (vi >> 4)] = tot; } }
    __syncthreads();
    { v4u xv[4];
#pragma unroll
        for (int i = 0; i < 4; ++i) { const int idx = c.tid + NTHR * i, s = idx >> 4, c8 = (idx & 15) * 8; xv[i] = *(const v4u*)(PROJ + (row0 + s) * PJ + 2560 + g * 128 + c8); }
        const int c8 = (c.tid & 15) * 8;
        const float4 g0 = *(const float4*)(lg + g * 128 + c8), g1 = *(const float4*)(lg + g * 128 + c8 + 4), b0 = *(const float4*)(lb + g * 128 + c8), b1 = *(const float4*)(lb + g * 128 + c8 + 4);
        const float gv[8] = {g0.x, g0.y, g0.z, g0.w, g1.x, g1.y, g1.z, g1.w}, bv[8] = {b0.x, b0.y, b0.z, b0.w, b1.x, b1.y, b1.z, b1.w};
#pragma unroll
        for (int i = 0; i < 4; ++i) { const int s = (c.tid + NTHR * i) >> 4; float f[8]; unpack8(xv[i], f);
            const float mu = STAT[2 * s] * (1.f / SGW), rstd = rsqrtf(fmaxf(STAT[2 * s + 1] * (1.f / SGW) - mu * mu, 0.f) + LN_EPS);
#pragma unroll
            for (int e = 0; e < 8; ++e) VT[(c8 + e) * RS + s] = f2bf1((f[e] - mu) * rstd * gv[e] + bv[e]); } }
    __syncthreads();
    { f32x4 acc[8];
#pragma unroll
        for (int ct = 0; ct < 8; ++ct) acc[ct] = (f32x4){0.f, 0.f, 0.f, 0.f};
        const int t = 16 * w + fr, nk = (w >> 1) + 1;
        for (int kk = 0; kk < nk; ++kk) { const int s0 = 32 * kk + 8 * fq; const float* wp = sw + ((size_t)g * SGC + t) * SGC + s0;
            const float4 w0 = *(const float4*)wp, w1 = *(const float4*)(wp + 4);
            const float wv[8] = {w0.x, w0.y, w0.z, w0.w, w1.x, w1.y, w1.z, w1.w}; float wm[8];
#pragma unroll
            for (int e = 0; e < 8; ++e) wm[e] = (s0 + e <= t) ? wv[e] : 0.f;
            v4u wb; wb.x = cvt_pk_bf16(wm[0], wm[1]); wb.y = cvt_pk_bf16(wm[2], wm[3]); wb.z = cvt_pk_bf16(wm[4], wm[5]); wb.w = cvt_pk_bf16(wm[6], wm[7]);
            const bf16x8 bfr = as_frag(wb);
#pragma unroll
            for (int ct = 0; ct < 8; ++ct) acc[ct] = MFMA16(*(const LAS bf16x8*)(VT + (16 * ct + fr) * RS + s0), bfr, acc[ct]); }
        const float bias = sb[g * SGC + t]; const size_t row = row0 + t;
#pragma unroll
        for (int ct = 0; ct < 8; ++ct) { const int col = g * 128 + 16 * ct + 4 * fq; const v2u u = *(const v2u*)(PROJ + row * PJ + 2048 + col);
            v2u o; o.x = cvt_pk_bf16(bf_lo(u.x) * (acc[ct][0] + bias), bf_hi(u.x) * (acc[ct][1] + bias)); o.y = cvt_pk_bf16(bf_lo(u.y) * (acc[ct][2] + bias), bf_hi(u.y) * (acc[ct][3] + bias));
            *(v2u*)(YB + row * SGW + col) = o; } }
    __syncthreads();
}

struct Args { const float* in[22]; float* out; unsigned char* ws; int ph_lo, ph_hi; };
__global__ void __launch_bounds__(NTHR, 2) mega(Args args) {
    extern __shared__ __attribute__((aligned(16))) unsigned char lds_raw[];
    Ctx c; c.lds0 = (LAS unsigned char*)lds_raw; c.lds = c.lds0 + RING_OFF; c.tid = threadIdx.x; c.lane = c.tid & 63; c.wave = __builtin_amdgcn_readfirstlane(c.tid >> 6); c.bid = blockIdx.x; c.nb = gridDim.x;
    volatile LAS unsigned* MISC = (volatile LAS unsigned*)(c.lds0 + MISC_OFF);
    for (int u = c.tid; u < RING_OFF / 4; u += NTHR) ((LAS unsigned*)(c.lds0 + LDSCTL_OFF))[u] = 0u;
    __syncthreads();
    unsigned char* ws = args.ws;
    gu32* ctl = (gu32*)(ws + WS_CTL);
    XcdBarrier bar = xcd_barrier_post((unsigned*)(ctl + CW_BAR), MISC + 8);
#define GRID_BAR() xcd_barrier(bar)
    const float* x = args.in[0]; const float* norm1_g = args.in[1]; const float* w_in = args.in[2]; const float* conv_w = args.in[3];
    const float* a_log = args.in[4]; const float* dt_bias = args.in[5]; const float* dn_norm_g = args.in[6]; const float* w_o_dn = args.in[7];
    const float* sg_ln_g = args.in[8]; const float* sg_ln_b = args.in[9]; const float* sg_w = args.in[10]; const float* sg_b = args.in[11];
    const float* w_o_sg = args.in[12]; const float* w_out = args.in[13]; const float* norm2_g = args.in[14]; const float* w_router = args.in[15];
    const float* b_router = args.in[16]; const float* w_gate_up = args.in[17]; const float* b_gate_up = args.in[18]; const float* w_down = args.in[19];
    const float* b_down = args.in[20]; const float* norm_f_g = args.in[21];
    float* out = args.out;
    unsigned char* wb = ws + WS_BASE;
    bf16* Hb = (bf16*)(wb + 0); bf16* H2b = (bf16*)(wb + 0);
    bf16* Win_t = (bf16*)(wb + 32 * MiB); bf16* Wo_t = (bf16*)(wb + 42 * MiB); bf16* Wout_t = (bf16*)(wb + 44 * MiB); float* BG = (float*)(wb + 46 * MiB);
    bf16* PROJb = (bf16*)(wb + 48 * MiB); bf16* ACTb = (bf16*)(wb + 48 * MiB);
    bf16* YAB = (bf16*)(wb + 208 * MiB); bf16* MERGED = (bf16*)(wb + 240 * MiB); float* X1 = (float*)(wb + 272 * MiB);
    float* QKV = (float*)(wb + 336 * MiB); float* O32 = (float*)(wb + 432 * MiB); float* U = (float*)(wb + 464 * MiB); float* VLN = (float*)(wb + 496 * MiB);
    bf16* Wgu_t = (bf16*)(wb + 528 * MiB); bf16* Wd_t = (bf16*)(wb + 656 * MiB); bf16* HS = (bf16*)(wb + 720 * MiB); bf16* Yb = (bf16*)(wb + 864 * MiB);
    unsigned char* small = wb + 1008 * MiB;
    int* slot_e = (int*)(small + 0 * MiB); int* slot_pos = (int*)(small + 1 * MiB); int* elist = (int*)(small + 2 * MiB); float* ewgt = (float*)(small + 4 * MiB);
    unsigned* gcnt = (unsigned*)(ctl + CW_CNT);

#ifndef PROBE_MASK
#define PROBE_MASK 0
#endif
#define REP(bit) for (int _r = 0; _r < ((PROBE_MASK >> (bit)) & 1) + 1; ++_r)
    REP(0) { p_convert_front(c, w_in, w_o_dn, w_o_sg, w_out, Win_t, Wo_t, Wout_t);
    __syncthreads();
    p_norm1(c, x, norm1_g, w_in, a_log, dt_bias, Hb, BG); if (PROBE_MASK & 1) __syncthreads();
    for (int i = c.bid * NTHR + c.tid; i < NE * NTOK / 4; i += c.nb * NTHR) { ((v4u*)elist)[i] = (v4u){0u, 0u, 0u, 0u}; ((v4u*)ewgt)[i] = (v4u){0u, 0u, 0u, 0u}; } }
    GRID_BAR();
    REP(1) { pg8::Gemm g{Hb, Win_t, NTOK, PJ, D}; pg8::StaticOrder S; S.init(NTOK, PJ, c.nb, c.bid); EpiProj E{PROJb};
      pg8::gemm_phase<EpiProj, pg8::StaticOrder, true, true>(c.lds, g, S, E); }
    GRID_BAR();
    DnBufs DB; DB.WN = wb + 336 * MiB; DB.QD = wb + 352 * MiB; DB.KD = wb + 368 * MiB; DB.QK = wb + 384 * MiB; DB.U = wb + 392 * MiB; DB.SST = wb + 408 * MiB; DB.EG = (float*)(wb + 440 * MiB);
    REP(2) { p_dn_prep(c, PROJb, conv_w, BG, DB); }
    GRID_BAR();
    if (c.bid < SCAN_WGS) { REP(3) { p_dn_scan(c, DB); } }
    else { Ctx c2 = c; c2.bid = c.bid - SCAN_WGS; c2.nb = c.nb - SCAN_WGS;
        REP(4) { for (int it = c2.bid; it < (NTOK / SGC) * 4; it += c2.nb) p_sg_item(c, it, PROJb, sg_ln_g, sg_ln_b, sg_w, sg_b, YAB + (size_t)NTOK * DNW); }
        REP(5) { p_convert_moe(c2, w_gate_up, w_down, Wgu_t, Wd_t); } }
    GRID_BAR();
    REP(6) { p_dn_out(c, DB, PROJb, dn_norm_g, YAB); }
    GRID_BAR();
    REP(7) { pg8::Gemm g{YAB, Wo_t, 0, 0, DNW}; DualOrder S; S.init(c.nb, c.bid); EpiMerge E{PROJb, MERGED};
      pg8::gemm_phase<EpiMerge, DualOrder, true, true>(c.lds, g, S, E); }
    GRID_BAR();
    REP(8) { pg8::Gemm g{MERGED, Wout_t, NTOK, D, D}; pg8::StaticOrder S; S.init(NTOK, D, c.nb, c.bid); EpiResid E{x, X1};
      pg8::gemm_phase<EpiResid, pg8::StaticOrder, true, true>(c.lds, g, S, E); }
    GRID_BAR();
    p_router(c, X1, norm2_g, w_router, b_router, H2b, slot_e, slot_pos, elist, ewgt, gcnt, (PROBE_MASK & 16384) ? 2 : 1);
    GRID_BAR();
    LAS unsigned char* tile_e = c.lds0 + EXTRA_OFF + 512; LAS int* ntl = (LAS int*)(c.lds0 + EXTRA_OFF + 1024); LAS int* tile_b = (LAS int*)(c.lds0 + EXTRA_OFF + 1088);
    build_tile_table(c, gcnt, tile_e, ntl, tile_b);
    const int NTL = __builtin_amdgcn_readfirstlane(ntl[0]);
    REP(10) { pg8::Gemm g{H2b, Wgu_t, 0, 0, D, elist}; MoeOrder S; S.init(NTL, 8, c.nb, c.bid, tile_e, tile_b); EpiSwiglu E{ACTb, b_gate_up};
      pg8::gemm_phase<EpiSwiglu, MoeOrder, true, true, true>(c.lds, g, S, E); }
    GRID_BAR();
    REP(11) { pg8::Gemm g{ACTb, Wd_t, 0, 0, DFF}; MoeOrder S; S.init(NTL, 4, c.nb, c.bid, tile_e, tile_b); EpiDown E{Yb, b_down, ewgt};
      pg8::gemm_phase<EpiDown, MoeOrder, true, true>(c.lds, g, S, E); }
    GRID_BAR();
    REP(12) { p_final(c, X1, Yb, slot_e, slot_pos, gcnt, norm_f_g, out); }
    if (PROBE_MASK & 8192) { for (int k = 0; k < 10; ++k) GRID_BAR(); }
}

extern "C" void kernel_launch(void* const* d_in, const int* in_sizes, int n_in, void* d_out, int out_size, void* d_ws, size_t ws_size, hipStream_t stream) {
    static int grid = 0;
    if (grid == 0) {
        if (n_in != 22 || in_sizes[0] != NTOK * D || out_size != NTOK * D || ws_size < WS_NEED) { fprintf(stderr, "kernel_launch: unexpected shapes (n_in %d, ws %zu)\n", n_in, ws_size); grid = -1; return; }
        int dev = 0, cus = 0, per_cu = 0;
        if (hipGetDevice(&dev) != hipSuccess || hipDeviceGetAttribute(&cus, hipDeviceAttributeMultiprocessorCount, dev) != hipSuccess) { grid = -1; return; }
        if (hipFuncSetAttribute((const void*)mega, hipFuncAttributeMaxDynamicSharedMemorySize, LDS_BYTES) != hipSuccess) { fprintf(stderr, "kernel_launch: hipFuncSetAttribute failed\n"); grid = -1; return; }
        if (hipOccupancyMaxActiveBlocksPerMultiprocessor(&per_cu, (const void*)mega, NTHR, LDS_BYTES) != hipSuccess || per_cu < 1) fprintf(stderr, "kernel_launch: occupancy query reports %d\n", per_cu);
        (void)hipGetLastError();
        grid = cus;
    }
    if (grid < 0) return;
    if (hipMemsetAsync((char*)d_ws + WS_CTL, 0, CTL_ZERO_BYTES, stream) != hipSuccess) { fprintf(stderr, "kernel_launch: memset failed\n"); return; }
    Args a{};
    for (int i = 0; i < 22; ++i) a.in[i] = (const float*)d_in[i];
    a.out = (float*)d_out; a.ws = (unsigned char*)d_ws; a.ph_lo = 0; a.ph_hi = 100;
    hipLaunchKernelGGL(mega, dim3(grid), dim3(NTHR), LDS_BYTES, stream, a);
#if PROBE_MASK & 131072
    (void)hipMemsetAsync((char*)d_ws + WS_CTL, 0, CTL_ZERO_BYTES, stream); hipLaunchKernelGGL(mega, dim3(grid), dim3(NTHR), LDS_BYTES, stream, a);
#endif
    const hipError_t le = hipPeekAtLastError();
    if (le != hipSuccess) fprintf(stderr, "kernel_launch: launch failed: %s\n", hipGetErrorName(le));
}
```

```cpp
#include <hip/hip_runtime.h>
#include <cstdio>
#include <cstdint>
#include <cmath>

#define GAS __attribute__((address_space(1)))
#define LAS __attribute__((address_space(3)))
typedef GAS unsigned gu32;
#define RLX_AGENT __ATOMIC_RELAXED, __HIP_MEMORY_SCOPE_AGENT

constexpr int NWAVES = 8, NTHR = 512;
constexpr int D = 1024, BATCH = 2, SEQ = 8192, NTOK = BATCH * SEQ;
constexpr int DNH = 4, DNW = 512;
constexpr int SGD = 128, SGW = 512, SGC = 128;
constexpr int NE = 32, TOPK = 4, DFF = 1024;
constexpr int OFF_Z = 1536, OFF_BETA = 2048, OFF_A = 2052, OFF_U = 2056, OFF_V = 2568, OFF_GA = 3080, OFF_GB = 4104, INC = 5128;
constexpr float RMS_EPS = 1e-6f, LN_EPS = 1e-5f, L2_EPS = 1e-6f;

constexpr size_t MiB = 1u << 20;
constexpr size_t WS_CTL = 0, CTL_ZERO_BYTES = 1 * MiB;
constexpr int CW_BAR = 4096;
constexpr int CW_CNT = 16384;
constexpr size_t WS_BASE = 2 * MiB;
constexpr size_t WS_NEED = 1020 * MiB;
constexpr int LDSCTL_OFF = 0, MISC_OFF = 320, RING_OFF = 1024, RING_BYTES = 131072, EXTRA_OFF = RING_OFF + RING_BYTES, LDS_BYTES = 147456;

#define XB_TMO      128
#define XB_XCNT(j)  (256  + 64 * (j))
#define XB_XSUB(j)  (1280 + 64 * (j))
#define XB_XGEN(j)  (2304 + 64 * (j))
#define XB_TOP      3328
#define XB_TOPGEN   3392
#define XCD_BAR_WORDS 3456
#define XB_SPIN_CAP (1u << 22)
__device__ __forceinline__ unsigned xb_ld(unsigned* p)              { return __hip_atomic_load(p, __ATOMIC_RELAXED, __HIP_MEMORY_SCOPE_AGENT); }
__device__ __forceinline__ unsigned xb_add(unsigned* p, unsigned v) { return __hip_atomic_fetch_add(p, v, __ATOMIC_RELAXED, __HIP_MEMORY_SCOPE_AGENT); }
__device__ __forceinline__ unsigned xb_xcc_id() { return (unsigned)__builtin_amdgcn_s_getreg((3 << 11) | 20) & 0xFu; }
#define XB_SPIN(cond, bar) do { unsigned _sp = 0; while (cond) { __builtin_amdgcn_s_sleep(1); \
    if ((++_sp & 255u) == 0u) { if (xb_ld(&(bar)[XB_TMO])) break; if (_sp > XB_SPIN_CAP) { atomicAdd(&(bar)[XB_TMO], 1u); break; } } } } while (0)
struct XcdBarrier { unsigned* bar; unsigned x; volatile LAS unsigned* st; };
__device__ __forceinline__ XcdBarrier xcd_barrier_post(unsigned* bar, volatile LAS unsigned* st) {
    XcdBarrier b; b.bar = bar; b.x = xb_xcc_id(); b.st = st;
    if (threadIdx.x == 0) (void)xb_add(&bar[XB_XCNT(b.x)], 1u);
    return b;
}
__device__ __forceinline__ void xcd_barrier_complete(unsigned* bar, unsigned x, unsigned& nloc, unsigned& nx) {
    const unsigned G = gridDim.x * gridDim.y * gridDim.z;
    unsigned sum, cnt, mine, sp = 0u;
    for (;;) {
        sum = 0u; cnt = 0u; mine = 0u;
#pragma unroll
        for (unsigned j = 0; j < 16; ++j) { const unsigned c = xb_ld(&bar[XB_XCNT(j)]); sum += c; cnt += (c > 0u) ? 1u : 0u; mine = (j == x) ? c : mine; }
        if (sum == G) break;
        __builtin_amdgcn_s_sleep(1);
        if ((++sp & 255u) == 0u) { if (xb_ld(&bar[XB_TMO])) break; if (sp > XB_SPIN_CAP) { atomicAdd(&bar[XB_TMO], 1u); break; } }
    }
    nloc = mine > 0u ? mine : 1u; nx = cnt > 0u ? cnt : 1u;
}
__device__ __forceinline__ void xcd_barrier(const XcdBarrier& b) {
    asm volatile("s_waitcnt vmcnt(0)" ::: "memory");
    __syncthreads();
    if (threadIdx.x == 0) {
        unsigned* bar = b.bar;
        __builtin_amdgcn_s_waitcnt(0);
        unsigned nloc = b.st[0], nx = b.st[1];
        if (nloc == 0u) { xcd_barrier_complete(bar, b.x, nloc, nx); b.st[0] = nloc; b.st[1] = nx; }
        const unsigned old = xb_add(&bar[XB_XSUB(b.x)], 1u);
        const unsigned gen = old / nloc;
        if (old + 1u == (gen + 1u) * nloc) {
            __builtin_amdgcn_fence(__ATOMIC_RELEASE, "agent");
            asm volatile("s_waitcnt vmcnt(0)" ::: "memory");
            const unsigned og = xb_add(&bar[XB_TOP], 1u);
            const unsigned tg = og / nx;
            if (og + 1u == (tg + 1u) * nx) xb_add(&bar[XB_TOPGEN], 1u);
            else XB_SPIN(xb_ld(&bar[XB_TOPGEN]) == tg, bar);
            __builtin_amdgcn_fence(__ATOMIC_ACQUIRE, "agent");
            xb_add(&bar[XB_XGEN(b.x)], 1u);
            asm volatile("s_waitcnt vmcnt(0)" ::: "memory");
        } else {
            XB_SPIN(xb_ld(&bar[XB_XGEN(b.x)]) == gen, bar);
            __builtin_amdgcn_fence(__ATOMIC_ACQUIRE, "agent");
            asm volatile("s_waitcnt vmcnt(0)" ::: "memory");
        }
    }
    __syncthreads();
}

__device__ __forceinline__ float dpp_xor1(float v) { return __builtin_bit_cast(float, __builtin_amdgcn_update_dpp(0, __builtin_bit_cast(int, v), 0xB1, 0xF, 0xF, true)); }
__device__ __forceinline__ float dpp_xor2(float v) { return __builtin_bit_cast(float, __builtin_amdgcn_update_dpp(0, __builtin_bit_cast(int, v), 0x4E, 0xF, 0xF, true)); }
__device__ __forceinline__ float dpp_qrev(float v) { return __builtin_bit_cast(float, __builtin_amdgcn_update_dpp(0, __builtin_bit_cast(int, v), 0x1B, 0xF, 0xF, true)); }
__device__ __forceinline__ float dpp_hmir(float v) { return __builtin_bit_cast(float, __builtin_amdgcn_update_dpp(0, __builtin_bit_cast(int, v), 0x141, 0xF, 0xF, true)); }
__device__ __forceinline__ float dpp_rmir(float v) { return __builtin_bit_cast(float, __builtin_amdgcn_update_dpp(0, __builtin_bit_cast(int, v), 0x140, 0xF, 0xF, true)); }
__device__ __forceinline__ float dpp_ror8(float v) { return __builtin_bit_cast(float, __builtin_amdgcn_update_dpp(0, __builtin_bit_cast(int, v), 0x128, 0xF, 0xF, true)); }
__device__ __forceinline__ float dpp_xor4(float v) { return dpp_qrev(dpp_hmir(v)); }
__device__ __forceinline__ float row16_sum(float v) { v += dpp_xor1(v); v += dpp_xor2(v); v += dpp_hmir(v); v += dpp_rmir(v); return v; }
__device__ __forceinline__ float rdlane(float v, int l) { return __builtin_bit_cast(float, __builtin_amdgcn_readlane(__builtin_bit_cast(int, v), l)); }
__device__ __forceinline__ float wave_sum(float v) { v = row16_sum(v); return (rdlane(v, 0) + rdlane(v, 16)) + (rdlane(v, 32) + rdlane(v, 48)); }
__device__ __forceinline__ void swap32(float& a, float& b) { asm volatile("s_nop 1\n\tv_permlane32_swap_b32 %0, %1" : "+v"(a), "+v"(b)); }
__device__ __forceinline__ void swap16(float& a, float& b) { asm volatile("s_nop 1\n\tv_permlane16_swap_b32 %0, %1" : "+v"(a), "+v"(b)); }
#define BFLY_SW32(acc, n) _Pragma("unroll") for (int i_ = 0; i_ < (n) / 2; ++i_) { float x_ = acc[i_], y_ = acc[i_ + (n) / 2]; swap32(x_, y_); acc[i_] = x_ + y_; }
#define BFLY_SW16(acc, n) _Pragma("unroll") for (int i_ = 0; i_ < (n) / 2; ++i_) { float x_ = acc[i_], y_ = acc[i_ + (n) / 2]; swap16(x_, y_); acc[i_] = x_ + y_; }
#define BFLY_DPP(acc, n, m, PERM) _Pragma("unroll") for (int i_ = 0; i_ < (n) / 2; ++i_) { const bool up_ = (lane & (m)) != 0; const float send_ = up_ ? acc[i_] : acc[i_ + (n) / 2]; const float keep_ = up_ ? acc[i_ + (n) / 2] : acc[i_]; acc[i_] = keep_ + PERM(send_); }
__device__ __forceinline__ float sigmoidf_(float x) { return 1.f / (1.f + expf(-x)); }
__device__ __forceinline__ float siluf_(float x) { return x / (1.f + expf(-x)); }
__device__ __forceinline__ float geluf_(float x) { return 0.5f * x * (1.f + erff(x * 0.70710678118654752f)); }
__device__ __forceinline__ float softplusf_(float x) { return x > 20.f ? x : log1pf(expf(x)); }

struct Ctx { int bid, nb, tid, lane, wave; LAS unsigned char* lds; LAS unsigned char* lds0; };

namespace pg8 {
#define PG8_LAS __attribute__((address_space(3)))
typedef unsigned short bf16_t;
typedef short bf16x8 __attribute__((ext_vector_type(8)));
typedef float f32x4 __attribute__((ext_vector_type(4)));
typedef unsigned u32x4 __attribute__((ext_vector_type(4)));
constexpr int BM = 256, BK = 64, HALF = 128, HTB = HALF * BK * 2  , STAGE_BYTES = 8 * HTB, NXCD = 8, WGM = 8;

__host__ __device__ __forceinline__ int lds_byte(int r, int c) { const int st = (r >> 4) * 2 + (c >> 5), rr = r & 15, cc = c & 31, ob = rr * 64 + cc * 2; return st * 1024 + (ob ^ (((ob >> 9) & 1) << 5)); }
__host__ __device__ __forceinline__ void stage_rc(int b, int& R, int& C) { const int st = b / 1024, sb = b % 1024, swz = sb ^ (((sb >> 9) & 1) << 5); R = (st >> 1) * 16 + swz / 64; C = (st & 1) * 32 + (swz % 64) / 2; }
__host__ __device__ __forceinline__ int perm32(int rho) { const int n = rho >> 4, i = rho & 15; return 8 * (i >> 2) + 4 * n + (i & 3); }

struct Unit { int pm, pn, x0, x1, rb; };
struct Gemm { const bf16_t* A; const bf16_t* Bt; int M, N, K; const int* rows; };

struct StaticOrder {
    int nM, nN, nwg, G, c;
    __host__ __device__ void init(int M, int N, int G_, int c_) { nM = M / BM; nN = N / BM; nwg = nM * nN; G = G_; c = c_; }
    __host__ __device__ bool next(int i, Unit& u) const {
        const long L = (long)i * G + c; if (L >= nwg) return false;
        int wgid = (int)L; { const int q = nwg / NXCD, r = nwg % NXCD, xcd = wgid % NXCD, off = wgid / NXCD; wgid = (xcd < r ? xcd * (q + 1) : r * (q + 1) + (xcd - r) * q) + off; }
        const int nig = WGM * nN, gid = wgid / nig, fm = gid * WGM, gsz = (nM - fm) < WGM ? (nM - fm) : WGM;
        u.pm = fm + ((wgid % nig) % gsz); u.pn = (wgid % nig) / gsz; u.x0 = 0; u.x1 = u.pn; u.rb = 0; return true;
    }
    __device__ __forceinline__ void a_ready(const Unit&) const {}
    __device__ __forceinline__ void done(const Unit&) const {}
};


template <class Epi, class Sched, bool ALIGN_EPI = false, bool SP2 = false, bool GATHER = false>
__device__ __forceinline__ void gemm_phase(PG8_LAS unsigned char* lds, const Gemm g, const Sched& S, const Epi& E) {
    int tid_ = threadIdx.x; asm volatile("" : "+v"(tid_));
    const int tid = tid_, wid = __builtin_amdgcn_readfirstlane(tid >> 6), lane = tid & 63, wr = wid >> 2, wc = wid & 3, fr = lane & 15, fq = lane >> 4;
    const int K = g.K, nt = K / BK;
    unsigned voffA[2], voffB[2]; int gR[2]; unsigned gC2[2];
#pragma unroll
    for (int i = 0; i < 2; ++i) { int R, C; stage_rc(tid * 16 + i * 8192, R, C); const int Rb = Epi::PERM ? ((R & ~31) + perm32(R & 31)) : R;
        voffA[i] = (unsigned)(R * K + C) * 2u; voffB[i] = (unsigned)(Rb * K + C) * 2u; gR[i] = R; gC2[i] = (unsigned)C * 2u; }
    static_assert(!GATHER || SP2, "GATHER is implemented for the SP2 loop only");
    unsigned gcur[2][2], gnxt[2][2]; int graw[4];
#define PG8_STAGE_A(bufoff, kptr, ktile, h, use_next) do { if constexpr (GATHER) { const unsigned sv_[2] = {(use_next) ? gnxt[h][0] : gcur[h][0], (use_next) ? gnxt[h][1] : gcur[h][1]}; \
        PG8_STAGE(bufoff, gA0 + (size_t)(ktile) * kstep, sv_); } else { PG8_STAGE(bufoff, (kptr) + ((h) ? hstep : 0), voffA); } } while (0)
    const size_t kstep = (size_t)(BK * 2);
    const size_t hstep = (size_t)HALF * K * 2;
    const size_t tstep = 2 * hstep;
    const unsigned ldsw = (unsigned)wid * 1024u;
    const int aoff = lds_byte(wr * 64 + fr, fq * 8), boff = lds_byte(wc * 32 + fr, fq * 8);
#define PG8_SA(b, h) (((b) * 2 + (h)) * HTB)
#define PG8_SB(b, h) ((4 + (b) * 2 + (h)) * HTB)
#define PG8_STAGE(bufoff, gbase, voff) do { _Pragma("unroll") for (int _i = 0; _i < 2; ++_i) \
        __builtin_amdgcn_global_load_lds((const unsigned*)((const char*)(gbase) + (voff)[_i]), (PG8_LAS unsigned*)(lds + (bufoff) + ldsw + _i * 8192), 16, 0, 0); } while (0)
#define PG8_LDA(dst, b, h) do { _Pragma("unroll") for (int m = 0; m < 4; ++m) _Pragma("unroll") for (int k = 0; k < 2; ++k) dst[m][k] = *(const PG8_LAS bf16x8*)(lds + PG8_SA(b, h) + aoff + m * 2048 + k * 1024); } while (0)
#define PG8_LDB(dst, b, h) do { _Pragma("unroll") for (int n = 0; n < 2; ++n) _Pragma("unroll") for (int k = 0; k < 2; ++k) dst[n][k] = *(const PG8_LAS bf16x8*)(lds + PG8_SB(b, h) + boff + n * 2048 + k * 1024); } while (0)
#define PG8_MMA(ai, bj, At, Bt) do { __builtin_amdgcn_s_setprio(1); _Pragma("unroll") for (int m = 0; m < 4; ++m) _Pragma("unroll") for (int n = 0; n < 2; ++n) _Pragma("unroll") for (int k = 0; k < 2; ++k) \
        acc[ai][bj][m][n] = __builtin_amdgcn_mfma_f32_16x16x32_bf16(Bt[n][k], At[m][k], acc[ai][bj][m][n], 0, 0, 0); __builtin_amdgcn_s_setprio(0); } while (0)
#define PG8_WAIT_V(n) asm volatile("s_waitcnt vmcnt(" #n ")" ::: "memory")
#define PG8_WAIT_L(n) asm volatile("s_waitcnt lgkmcnt(" #n ")" ::: "memory")
#define PG8_BAR __builtin_amdgcn_s_barrier()
#define PG8_SCHED __builtin_amdgcn_sched_barrier(0)
    Unit cur, nxt; int ui = 0;
    if (!S.next(0, cur)) return;
    f32x4 acc[2][2][4][2];
#pragma unroll
    for (int a = 0; a < 2; ++a)
#pragma unroll
        for (int b = 0; b < 2; ++b)
#pragma unroll
            for (int m = 0; m < 4; ++m)
#pragma unroll
                for (int n = 0; n < 2; ++n) acc[a][b][m][n] = (f32x4){0.f, 0.f, 0.f, 0.f};
    bf16x8 At[4][2], B0[2][2], B1[2][2];
    const char* cA = (const char*)g.A + (size_t)cur.pm * tstep; const char* cB = (const char*)g.Bt + (size_t)cur.pn * tstep;
    const char* const gA0 = (const char*)g.A;
    if constexpr (GATHER) {
#pragma unroll
        for (int h = 0; h < 2; ++h)
#pragma unroll
            for (int i = 0; i < 2; ++i) { gcur[h][i] = (unsigned)g.rows[cur.rb + h * HALF + gR[i]] * (unsigned)(K * 2) + gC2[i]; gnxt[h][i] = gcur[h][i]; } }
    S.a_ready(cur);
    if constexpr (SP2) {
        PG8_STAGE(PG8_SB(0, 0), cB, voffB); PG8_STAGE(PG8_SB(0, 1), cB + hstep, voffB); PG8_STAGE_A(PG8_SA(0, 0), cA, 0, 0, false); PG8_STAGE_A(PG8_SA(0, 1), cA, 0, 1, false);
        if (wr == 1) PG8_BAR;
        PG8_WAIT_V(2); PG8_BAR;
        PG8_STAGE(PG8_SB(1, 0), cB + kstep, voffB); PG8_STAGE_A(PG8_SA(1, 0), cA + kstep, 1, 0, false); PG8_STAGE(PG8_SB(1, 1), cB + hstep + kstep, voffB);
        PG8_WAIT_V(6); PG8_BAR;
    } else {
        PG8_STAGE(PG8_SB(0, 0), cB, voffB); PG8_STAGE(PG8_SA(0, 0), cA, voffA); PG8_STAGE(PG8_SB(0, 1), cB + hstep, voffB); PG8_STAGE(PG8_SA(0, 1), cA + hstep, voffA);
        if (wr == 1) PG8_BAR;
        PG8_WAIT_V(4); PG8_BAR;
        PG8_STAGE(PG8_SB(1, 0), cB + kstep, voffB); PG8_STAGE(PG8_SA(1, 0), cA + kstep, voffA); PG8_STAGE(PG8_SB(1, 1), cB + hstep + kstep, voffB);
        PG8_WAIT_V(6); PG8_BAR;
    }
    for (;;) {
        const bool has_next = S.next(ui + 1, nxt);
        const char* nA = has_next ? (const char*)g.A + (size_t)nxt.pm * tstep : cA; const char* nB = has_next ? (const char*)g.Bt + (size_t)nxt.pn * tstep : cB;
        if constexpr (GATHER) { if (has_next) {
#pragma unroll
            for (int h = 0; h < 2; ++h)
#pragma unroll
                for (int i = 0; i < 2; ++i) asm volatile("global_load_dword %0, %1, off" : "=v"(graw[h * 2 + i]) : "v"(g.rows + (nxt.rb + h * HALF + gR[i])) : "memory"); } }
        for (int t = 0; t < nt; t += 2) {
            const bool last = (t == nt - 2);
            const char* a1 = cA + (size_t)(t + 1) * kstep;
            const char* a2 = last ? nA : cA + (size_t)(t + 2) * kstep; const char* b2 = last ? nB : cB + (size_t)(t + 2) * kstep;
            const char* a3 = a2 + kstep; const char* b3 = b2 + kstep;
            if (last && has_next) S.a_ready(nxt);
            if constexpr (GATHER) { if (last) { if (has_next) { asm volatile("" : "+v"(graw[0]), "+v"(graw[1]), "+v"(graw[2]), "+v"(graw[3]));
#pragma unroll
                    for (int h = 0; h < 2; ++h)
#pragma unroll
                        for (int i = 0; i < 2; ++i) gnxt[h][i] = (unsigned)graw[h * 2 + i] * (unsigned)(K * 2) + gC2[i]; }
                else {
#pragma unroll
                    for (int h = 0; h < 2; ++h)
#pragma unroll
                        for (int i = 0; i < 2; ++i) gnxt[h][i] = gcur[h][i]; } } }
            const int kt2 = last ? 0 : t + 2;
            if constexpr (SP2) {
            PG8_LDB(B0, 0, 0); PG8_LDB(B1, 0, 1); PG8_SCHED; PG8_LDA(At, 0, 0); PG8_STAGE_A(PG8_SA(1, 1), a1, t + 1, 1, false);
            PG8_WAIT_V(8); PG8_WAIT_L(0); PG8_BAR; PG8_MMA(0, 0, At, B0); PG8_MMA(0, 1, At, B1); PG8_BAR; PG8_SCHED;
            PG8_LDA(At, 0, 1); PG8_STAGE(PG8_SB(0, 0), b2, voffB); PG8_STAGE(PG8_SB(0, 1), b2 + hstep, voffB); PG8_STAGE_A(PG8_SA(0, 0), a2, kt2, 0, last);
            PG8_WAIT_V(8); PG8_WAIT_L(0); PG8_BAR; PG8_MMA(1, 0, At, B0); PG8_MMA(1, 1, At, B1); PG8_BAR; PG8_SCHED;
            PG8_LDB(B0, 1, 0); PG8_LDB(B1, 1, 1); PG8_SCHED; PG8_LDA(At, 1, 0); PG8_STAGE_A(PG8_SA(0, 1), a2, kt2, 1, last);
            PG8_WAIT_V(8); PG8_WAIT_L(0); PG8_BAR; PG8_MMA(0, 0, At, B0); PG8_MMA(0, 1, At, B1); PG8_BAR; PG8_SCHED;
            PG8_LDA(At, 1, 1); PG8_STAGE(PG8_SB(1, 0), b3, voffB); PG8_STAGE(PG8_SB(1, 1), b3 + hstep, voffB); PG8_STAGE_A(PG8_SA(1, 0), a3, kt2 + 1, 0, last);
            PG8_WAIT_V(8); PG8_WAIT_L(0); PG8_BAR; PG8_MMA(1, 0, At, B0); PG8_MMA(1, 1, At, B1); PG8_BAR; PG8_SCHED;
            } else {
            PG8_LDB(B0, 0, 0); PG8_SCHED; PG8_LDA(At, 0, 0); PG8_STAGE(PG8_SA(1, 1), a1 + hstep, voffA);
            PG8_WAIT_L(8); PG8_BAR; PG8_WAIT_L(0); PG8_MMA(0, 0, At, B0); PG8_BAR; PG8_SCHED;
            PG8_LDB(B1, 0, 1); PG8_STAGE(PG8_SB(0, 0), b2, voffB);
            PG8_BAR; PG8_WAIT_L(0); PG8_MMA(0, 1, At, B1); PG8_BAR;
            PG8_LDA(At, 0, 1); PG8_STAGE(PG8_SA(0, 0), a2, voffA);
            PG8_BAR; PG8_WAIT_L(0); PG8_MMA(1, 0, At, B0); PG8_BAR; PG8_SCHED;
            PG8_STAGE(PG8_SB(0, 1), b2 + hstep, voffB);
            PG8_WAIT_V(6); PG8_BAR; PG8_MMA(1, 1, At, B1); PG8_BAR;
            PG8_LDB(B0, 1, 0); PG8_SCHED; PG8_LDA(At, 1, 0); PG8_STAGE(PG8_SA(0, 1), a2 + hstep, voffA);
            PG8_WAIT_L(8); PG8_BAR; PG8_WAIT_L(0); PG8_MMA(0, 0, At, B0); PG8_BAR; PG8_SCHED;
            PG8_LDB(B1, 1, 1); PG8_STAGE(PG8_SB(1, 0), b3, voffB);
            PG8_BAR; PG8_WAIT_L(0); PG8_MMA(0, 1, At, B1); PG8_BAR;
            PG8_LDA(At, 1, 1); PG8_STAGE(PG8_SA(1, 0), a3, voffA);
            PG8_BAR; PG8_WAIT_L(0); PG8_MMA(1, 0, At, B0); PG8_BAR; PG8_SCHED;
            PG8_STAGE(PG8_SB(1, 1), b3 + hstep, voffB);
            PG8_WAIT_V(6); PG8_BAR; PG8_MMA(1, 1, At, B1); PG8_BAR;
            }
        }
        if constexpr (ALIGN_EPI) { if (wr == 0) PG8_BAR; }
        if constexpr (!Epi::AFTER_DRAIN) { E(acc, cur, wr, wc, fr, fq); S.done(cur); }
        if (!has_next) break;
        if (!E.keep_acc(cur)) {
#pragma unroll
        for (int a = 0; a < 2; ++a)
#pragma unroll
            for (int b = 0; b < 2; ++b)
#pragma unroll
                for (int m = 0; m < 4; ++m)
#pragma unroll
                    for (int n = 0; n < 2; ++n) acc[a][b][m][n] = (f32x4){0.f, 0.f, 0.f, 0.f};
        }
        cur = nxt; cA = nA; cB = nB; ++ui;
        if constexpr (GATHER) {
#pragma unroll
            for (int h = 0; h < 2; ++h)
#pragma unroll
                for (int i = 0; i < 2; ++i) gcur[h][i] = gnxt[h][i]; }
        if constexpr (ALIGN_EPI) { if (wr == 1) PG8_BAR; }
    }
    PG8_WAIT_V(0);
    if constexpr (!ALIGN_EPI) { if (wr == 0) PG8_BAR; }
    PG8_BAR;
    if constexpr (Epi::AFTER_DRAIN) { E.fused(acc, cur, wr, wc, fr, fq, lds, wid, lane); S.done(cur); }
#undef PG8_SA
#undef PG8_SB
#undef PG8_STAGE
#undef PG8_STAGE_A
#undef PG8_LDA
#undef PG8_LDB
#undef PG8_MMA
#undef PG8_WAIT_V
#undef PG8_WAIT_L
#undef PG8_BAR
#undef PG8_SCHED
}
}
typedef unsigned short bf16;
typedef unsigned v4u __attribute__((ext_vector_type(4)));
typedef unsigned v2u __attribute__((ext_vector_type(2)));
typedef float f32x4 __attribute__((ext_vector_type(4)));
#define LDS_WAIT() asm volatile("s_waitcnt lgkmcnt(0)" ::: "memory")
#define VM_WAIT() asm volatile("s_waitcnt vmcnt(0)" ::: "memory")
typedef float cvt_f32x2 __attribute__((ext_vector_type(2)));
typedef __bf16 cvt_bf16x2 __attribute__((ext_vector_type(2)));
__device__ __forceinline__ unsigned cvt_pk_bf16(float lo, float hi) { const cvt_f32x2 v = {lo, hi}; return __builtin_bit_cast(unsigned, __builtin_convertvector(v, cvt_bf16x2)); }
__device__ __forceinline__ v4u ldnt4(const void* p) { return __builtin_nontemporal_load((const v4u*)p); }
__device__ __forceinline__ v2u ldnt2(const void* p) { return __builtin_nontemporal_load((const v2u*)p); }
__device__ __forceinline__ float bf_lo(unsigned u) { return __uint_as_float(u << 16); }
__device__ __forceinline__ float bf_hi(unsigned u) { return __uint_as_float(u & 0xffff0000u); }

template <bool NT = false>
__device__ __forceinline__ void tr_item(const float* __restrict__ src, int ldn, int k0, int nsrc0, bf16* dst, int K, int ndst0, LAS float* scr, int lane) {
    const int c4 = (lane & 15) * 4, kr = lane >> 4;
#pragma unroll 4
    for (int i = 0; i < 16; ++i) { const int kk = 4 * i + kr; const f32x4* gp = (const f32x4*)(src + (size_t)(k0 + kk) * ldn + nsrc0 + c4); const f32x4 v = NT ? __builtin_nontemporal_load(gp) : *gp;
        LAS float* s = scr + kk * 65 + c4; s[0] = v[0]; s[1] = v[1]; s[2] = v[2]; s[3] = v[3]; }
    LDS_WAIT();
    const int kc = lane & 7, nr = lane >> 3;
#pragma unroll
    for (int jj = 0; jj < 8; ++jj) { const int n = 8 * jj + nr; const LAS float* s = scr + (8 * kc) * 65 + n;
        v4u o; o.x = cvt_pk_bf16(s[0], s[65]); o.y = cvt_pk_bf16(s[130], s[195]); o.z = cvt_pk_bf16(s[260], s[325]); o.w = cvt_pk_bf16(s[390], s[455]);
        v4u* dp = (v4u*)(dst + (size_t)(ndst0 + n) * K + k0 + 8 * kc); if (NT) __builtin_nontemporal_store(o, dp); else *dp = o; }
    LDS_WAIT();
}
__device__ __forceinline__ void p_convert_moe(const Ctx& c, const float* w_gate_up, const float* w_down, bf16* Wgu_t, bf16* Wd_t) {
    LAS float* scr = (LAS float*)c.lds + c.wave * (64 * 65);
    constexpr int I_GU = NE * 16 * 32, I_D = NE * 16 * 16;
    for (int it = c.bid * NWAVES + c.wave; it < I_GU + I_D; it += c.nb * NWAVES) {
        if (it < I_GU) { const int e = it >> 9, r = it & 511, kb = r >> 5, nbk = r & 31, R0 = nbk * 64, pn = R0 >> 8, rr = R0 & 255, bj = rr >> 7, j0 = rr & 127;
            tr_item<true>(w_gate_up + (size_t)e * D * 2 * DFF, 2 * DFF, kb * 64, bj * DFF + 128 * pn + j0, Wgu_t + (size_t)e * 2 * DFF * D, D, R0, scr, c.lane); }
        else { const int r2 = it - I_GU, e = r2 >> 8, r = r2 & 255, kb = r >> 4, nbk = r & 15;
            tr_item<true>(w_down + (size_t)e * DFF * D, D, kb * 64, nbk * 64, Wd_t + (size_t)e * D * DFF, DFF, nbk * 64, scr, c.lane); }
    }
}

__device__ __forceinline__ float f4c(const float4& v, int i) { return i == 0 ? v.x : (i == 1 ? v.y : (i == 2 ? v.z : v.w)); }
__device__ __forceinline__ void p_router(const Ctx& c, const float* __restrict__ X1, const float* __restrict__ g2, const float* __restrict__ wr, const float* __restrict__ br, bf16* __restrict__ H2, int* __restrict__ slot_e, int* __restrict__ slot_pos, int* __restrict__ elist, float* __restrict__ ewgt, unsigned* gcnt, int reps = 1) {
    LAS f32x4* WL = (LAS f32x4*)c.lds;
    LAS float* LG = (LAS float*)(c.lds0 + EXTRA_OFF);
    LAS int* HIST = (LAS int*)(c.lds0 + EXTRA_OFF + 8192);
    LAS int* BASE = HIST + 32;
    LAS int* SELE = BASE + 32;
    LAS int* SELR = SELE + 256;
    LAS float* SELW = (LAS float*)(SELR + 256);
    const int lane = c.lane;
    { f32x4 wv[16];
#pragma unroll
      for (int i = 0; i < 16; ++i) wv[i] = ((const f32x4*)wr)[c.tid + NTHR * i];
#pragma unroll
      for (int i = 0; i < 16; ++i) { const int idx = c.tid + NTHR * i, k = idx >> 3, q = idx & 7, l = (k & 255) >> 2, cc = k & 3, j = k >> 8; WL[((j * 4 + cc) * 8 + q) * 64 + l] = wv[i]; } }
    __syncthreads();
    for (int blk = c.bid; blk < NTOK / 64; blk += c.nb) {
        if (c.tid < 32) HIST[c.tid] = 0;
        __syncthreads();
        for (int pp = 0; pp < 4 * reps; ++pp) { const int p = pp & 3;
            const size_t t0 = (size_t)blk * 64 + c.wave * 8 + 2 * p;
            float4 xa[4], xb[4]; float sa = 0.f, sb = 0.f;
#pragma unroll
            for (int j = 0; j < 4; ++j) { xa[j] = ((const float4*)(X1 + t0 * D))[lane + 64 * j]; xb[j] = ((const float4*)(X1 + (t0 + 1) * D))[lane + 64 * j];
                sa += xa[j].x * xa[j].x + xa[j].y * xa[j].y + xa[j].z * xa[j].z + xa[j].w * xa[j].w; sb += xb[j].x * xb[j].x + xb[j].y * xb[j].y + xb[j].z * xb[j].z + xb[j].w * xb[j].w; }
            const float ra = rsqrtf(wave_sum(sa) * (1.f / D) + RMS_EPS), rb = rsqrtf(wave_sum(sb) * (1.f / D) + RMS_EPS);
#pragma unroll
            for (int j = 0; j < 4; ++j) { const float4 g = ((const float4*)g2)[lane + 64 * j];
                xa[j].x *= ra * g.x; xa[j].y *= ra * g.y; xa[j].z *= ra * g.z; xa[j].w *= ra * g.w; xb[j].x *= rb * g.x; xb[j].y *= rb * g.y; xb[j].z *= rb * g.z; xb[j].w *= rb * g.w;
                v2u oa, ob; oa.x = cvt_pk_bf16(xa[j].x, xa[j].y); oa.y = cvt_pk_bf16(xa[j].z, xa[j].w); ob.x = cvt_pk_bf16(xb[j].x, xb[j].y); ob.y = cvt_pk_bf16(xb[j].z, xb[j].w);
                ((v2u*)(H2 + t0 * D))[lane + 64 * j] = oa; ((v2u*)(H2 + (t0 + 1) * D))[lane + 64 * j] = ob; }
            float acc[64];
#pragma unroll
            for (int i = 0; i < 64; ++i) acc[i] = 0.f;
#pragma unroll
            for (int j = 0; j < 4; ++j)
#pragma unroll
                for (int cc = 0; cc < 4; ++cc) { const float ha = f4c(xa[j], cc), hb = f4c(xb[j], cc);
#pragma unroll
                    for (int q = 0; q < 8; ++q) { const f32x4 w = WL[((j * 4 + cc) * 8 + q) * 64 + lane];
                        acc[4 * q + 0] = fmaf(ha, w.x, acc[4 * q + 0]); acc[4 * q + 1] = fmaf(ha, w.y, acc[4 * q + 1]); acc[4 * q + 2] = fmaf(ha, w.z, acc[4 * q + 2]); acc[4 * q + 3] = fmaf(ha, w.w, acc[4 * q + 3]);
                        acc[32 + 4 * q + 0] = fmaf(hb, w.x, acc[32 + 4 * q + 0]); acc[32 + 4 * q + 1] = fmaf(hb, w.y, acc[32 + 4 * q + 1]); acc[32 + 4 * q + 2] = fmaf(hb, w.z, acc[32 + 4 * q + 2]); acc[32 + 4 * q + 3] = fmaf(hb, w.w, acc[32 + 4 * q + 3]); } }
            BFLY_SW32(acc, 64) BFLY_SW16(acc, 32) BFLY_DPP(acc, 16, 8, dpp_ror8) BFLY_DPP(acc, 8, 4, dpp_xor4) BFLY_DPP(acc, 4, 2, dpp_xor2) BFLY_DPP(acc, 2, 1, dpp_xor1)
            LG[(c.wave * 8 + 2 * p + (lane >> 5)) * 32 + (lane & 31)] = acc[0] + br[lane & 31];
        }
        LDS_WAIT();
        if (lane < 8) {
            const int tokl = c.wave * 8 + lane;
            float l[NE];
#pragma unroll
            for (int j = 0; j < NE; ++j) l[j] = LG[tokl * 32 + j];
            int sel[4]; float sv[4];
#pragma unroll
            for (int k = 0; k < 4; ++k) { int bi = 0; float bv = -INFINITY;
#pragma unroll
                for (int j = 0; j < NE; ++j) { const bool better = l[j] > bv; bv = better ? l[j] : bv; bi = better ? j : bi; }
                sel[k] = bi; sv[k] = bv;
#pragma unroll
                for (int j = 0; j < NE; ++j) l[j] = (j == bi) ? -INFINITY : l[j]; }
            float den = 0.f, ex[4];
#pragma unroll
            for (int k = 0; k < 4; ++k) { ex[k] = expf(sv[k] - sv[0]); den += ex[k]; }
            const float inv = 1.f / den;
#pragma unroll
            for (int k = 0; k < 4; ++k) { SELE[tokl * 4 + k] = sel[k]; SELW[tokl * 4 + k] = ex[k] * inv; SELR[tokl * 4 + k] = atomicAdd((int*)(HIST + sel[k]), 1); }
        }
        __syncthreads();
        if (c.tid < 32) BASE[c.tid] = (int)__hip_atomic_fetch_add(gcnt + c.tid, (unsigned)HIST[c.tid], __ATOMIC_RELAXED, __HIP_MEMORY_SCOPE_AGENT);
        __syncthreads();
        if (c.tid < 256) { const int gi = blk * 256 + c.tid, e = SELE[c.tid], pos = BASE[e] + SELR[c.tid]; slot_e[gi] = e; slot_pos[gi] = pos; elist[e * NTOK + pos] = gi >> 2; ewgt[e * NTOK + pos] = SELW[c.tid]; }
    }
}

struct MoeOrder {
    int nM, nN, nwg, G, c; const LAS unsigned char* tile_e; const LAS int* tile_b;
    __device__ __forceinline__ void init(int nM_, int nN_, int G_, int c_, const LAS unsigned char* te, const LAS int* tb) { nM = nM_; nN = nN_; nwg = nM * nN; G = G_; c = c_; tile_e = te; tile_b = tb; }
    __device__ __forceinline__ bool next(int i, pg8::Unit& u) const {
        const long L = (long)i * G + c; if (L >= nwg) return false;
        int wgid = (int)L; { const int q = nwg / pg8::NXCD, r = nwg % pg8::NXCD, xcd = wgid % pg8::NXCD, off = wgid / pg8::NXCD; wgid = (xcd < r ? xcd * (q + 1) : r * (q + 1) + (xcd - r) * q) + off; }
        const int nig = pg8::WGM * nN, gid = wgid / nig, fm = gid * pg8::WGM, gsz = (nM - fm) < pg8::WGM ? (nM - fm) : pg8::WGM;
        const int pm = fm + ((wgid % nig) % gsz), pnl = (wgid % nig) / gsz;
        const int e = __builtin_amdgcn_readfirstlane((int)tile_e[pm]);
        u.pm = pm; u.pn = e * nN + pnl; u.x0 = e; u.x1 = pnl; u.rb = e * NTOK + (pm - __builtin_amdgcn_readfirstlane(tile_b[e])) * 256; return true;
    }
    __device__ __forceinline__ void a_ready(const pg8::Unit&) const {}
    __device__ __forceinline__ void done(const pg8::Unit&) const {}
};
__device__ __forceinline__ void build_tile_table(const Ctx& c, const unsigned* gcnt, LAS unsigned char* tile_e, LAS int* ntiles, LAS int* tile_b) {
    if (c.tid == 0) { int tb = 0; for (int e = 0; e < NE; ++e) { const int nt = ((int)gcnt[e] + 255) >> 8; tile_b[e] = tb; for (int i = 0; i < nt; ++i) tile_e[tb + i] = (unsigned char)e; tb += nt; } tile_b[NE] = tb; ntiles[0] = tb; }
    __syncthreads();
}

struct EpiSwiglu {
    static constexpr bool PERM = true, AFTER_DRAIN = false;
    bf16* O; const float* bias;
    __device__ __forceinline__ bool keep_acc(const pg8::Unit&) const { return false; }
    __device__ __forceinline__ void operator()(const f32x4 (&acc)[2][2][4][2], const pg8::Unit& u, int wr, int wc, int fr, int fq) const {
        const int row0 = u.pm * 256 + wr * 64 + fr, col0 = u.x1 * 128 + wc * 32 + 8 * fq;
        const float* bg = bias + (size_t)u.x0 * 2 * DFF + col0; const float* bl = bg + DFF;
        f32x4 bgv[2], blv[2];
#pragma unroll
        for (int n = 0; n < 2; ++n) { bgv[n] = *(const f32x4*)(bg + 4 * n); blv[n] = *(const f32x4*)(bl + 4 * n); }
#pragma unroll
        for (int ai = 0; ai < 2; ++ai)
#pragma unroll
            for (int m = 0; m < 4; ++m) { bf16* rowp = O + (size_t)(row0 + ai * 128 + m * 16) * DFF + col0; float a[8];
#pragma unroll
                for (int n = 0; n < 2; ++n) { const f32x4 g = acc[ai][0][m][n] + bgv[n], l = acc[ai][1][m][n] + blv[n];
#pragma unroll
                    for (int i = 0; i < 4; ++i) { const float xg = fminf(g[i], 7.f), xl = fminf(fmaxf(l[i], -7.f), 7.f);
                        a[4 * n + i] = xg * __builtin_amdgcn_rcpf(1.f + __expf(-1.702f * xg)) * (xl + 1.f); } }
                v4u w; w.x = cvt_pk_bf16(a[0], a[1]); w.y = cvt_pk_bf16(a[2], a[3]); w.z = cvt_pk_bf16(a[4], a[5]); w.w = cvt_pk_bf16(a[6], a[7]);
                *(v4u*)rowp = w; }
    }
};
struct EpiDown {
    static constexpr bool PERM = true, AFTER_DRAIN = false;
    bf16* O; const float* bias; const float* roww;
    __device__ __forceinline__ bool keep_acc(const pg8::Unit&) const { return false; }
    __device__ __forceinline__ void operator()(const f32x4 (&acc)[2][2][4][2], const pg8::Unit& u, int wr, int wc, int fr, int fq) const {
        const int row0 = u.pm * 256 + wr * 64 + fr, col0 = u.x1 * 256 + wc * 32 + 8 * fq;
        const float* bp = bias + (size_t)u.x0 * D + col0;
        f32x4 bv[2][2];
#pragma unroll
        for (int bj = 0; bj < 2; ++bj)
#pragma unroll
            for (int n = 0; n < 2; ++n) bv[bj][n] = *(const f32x4*)(bp + bj * 128 + 4 * n);
#pragma unroll
        for (int ai = 0; ai < 2; ++ai)
#pragma unroll
            for (int m = 0; m < 4; ++m) { const int rl = wr * 64 + fr + ai * 128 + m * 16, row = u.pm * 256 + rl; const float w = roww[u.rb + rl]; bf16* rowp = O + (size_t)row * D + col0;
#pragma unroll
                for (int bj = 0; bj < 2; ++bj) { const f32x4 v0 = (acc[ai][bj][m][0] + bv[bj][0]) * w, v1 = (acc[ai][bj][m][1] + bv[bj][1]) * w;
                    v4u o; o.x = cvt_pk_bf16(v0[0], v0[1]); o.y = cvt_pk_bf16(v0[2], v0[3]); o.z = cvt_pk_bf16(v1[0], v1[1]); o.w = cvt_pk_bf16(v1[2], v1[3]);
                    *(v4u*)(rowp + bj * 128) = o; } }
    }
};

__device__ __forceinline__ void p_final(const Ctx& c, const float* __restrict__ X1, const bf16* __restrict__ Yb, const int* __restrict__ slot_e, const int* __restrict__ slot_pos, const unsigned* gcnt, const float* __restrict__ g, float* __restrict__ out, float pscale = 1.f) {
    LAS int* POFF = (LAS int*)(c.lds0 + EXTRA_OFF);
    if (c.tid == 0) { int s = 0; for (int e = 0; e < NE; ++e) { POFF[e] = s; s += (((int)gcnt[e] + 255) >> 8) << 8; } }
    __syncthreads();
#pragma unroll 2
    for (int t = c.bid * NWAVES + c.wave; t < NTOK; t += c.nb * NWAVES) {
        const int lane = c.lane; float4 v[4];
#pragma unroll
        for (int j = 0; j < 4; ++j) { const v4u xr = ldnt4((const v4u*)(X1 + (size_t)t * D) + lane + 64 * j); v[j] = make_float4(__uint_as_float(xr.x), __uint_as_float(xr.y), __uint_as_float(xr.z), __uint_as_float(xr.w)); }
#pragma unroll
        for (int k = 0; k < 4; ++k) { const int dst = POFF[slot_e[t * 4 + k]] + slot_pos[t * 4 + k];
#pragma unroll
            for (int j = 0; j < 4; ++j) { const v2u y = ldnt2((const v2u*)(Yb + (size_t)dst * D) + lane + 64 * j); v[j].x += bf_lo(y.x); v[j].y += bf_hi(y.x); v[j].z += bf_lo(y.y); v[j].w += bf_hi(y.y); } }
        float s = 0.f;
#pragma unroll
        for (int j = 0; j < 4; ++j) s += v[j].x * v[j].x + v[j].y * v[j].y + v[j].z * v[j].z + v[j].w * v[j].w;
        const float r = rsqrtf(wave_sum(s) * (1.f / D) + RMS_EPS) * pscale;
#pragma unroll
        for (int j = 0; j < 4; ++j) { const float4 gg = ((const float4*)g)[lane + 64 * j]; const f32x4 ov = {v[j].x * r * gg.x, v[j].y * r * gg.y, v[j].z * r * gg.z, v[j].w * r * gg.w}; __builtin_nontemporal_store(ov, (f32x4*)(out + (size_t)t * D) + lane + 64 * j); }
    }
}

constexpr int PJ = 5120;
typedef float f32x2 __attribute__((ext_vector_type(2)));
__device__ __forceinline__ f32x2 gelu_pk(f32x2 v) {
    const f32x2 av = __builtin_elementwise_abs(v), d = av * 0.2316418882f + 1.0f;
    f32x2 t; t.x = __builtin_amdgcn_rcpf(d.x); t.y = __builtin_amdgcn_rcpf(d.y);
    f32x2 q = t * 0.5307027145f + (-0.7265760135f); q = q * t + 0.7107068705f; q = q * t + (-0.142248368f); q = q * t + 0.127414796f; q = q * t;
    const f32x2 s = (v * v) * (-0.72134752044f);
    f32x2 e; e.x = __builtin_amdgcn_exp2f(s.x); e.y = __builtin_amdgcn_exp2f(s.y);
    const f32x2 m = v * (q * e), r = v - m;
    f32x2 o; o.x = v.x < 0.f ? m.x : r.x; o.y = v.y < 0.f ? m.y : r.y; return o;
}
__device__ __forceinline__ float fast_sigmoid(float x) { return __builtin_amdgcn_rcpf(1.f + __expf(-x)); }

__device__ __forceinline__ void p_convert_front(const Ctx& c, const float* w_in, const float* w_o_dn, const float* w_o_sg, const float* w_out, bf16* Win_t, bf16* Wo_t, bf16* Wout_t) {
    LAS float* scr = (LAS float*)c.lds + c.wave * (64 * 65);
    constexpr int I_IN = 16 * 80, I_O = 8 * 16, I_OUT = 16 * 16;
    for (int it = c.bid * NWAVES + c.wave; it < I_IN + 2 * I_O + I_OUT; it += c.nb * NWAVES) {
        int r = it;
        if (r < I_IN) { const int kb = r / 80, nbk = r % 80, n0 = nbk * 64; tr_item<true>(w_in, INC, kb * 64, n0 < 2048 ? n0 : n0 + 8, Win_t, D, n0, scr, c.lane); continue; } r -= I_IN;
        if (r < I_O) { const int kb = r / 16, nbk = r % 16; tr_item<true>(w_o_dn, D, kb * 64, nbk * 64, Wo_t, DNW, nbk * 64, scr, c.lane); continue; } r -= I_O;
        if (r < I_O) { const int kb = r / 16, nbk = r % 16; tr_item<true>(w_o_sg, D, kb * 64, nbk * 64, Wo_t + (size_t)D * DNW, SGW, nbk * 64, scr, c.lane); continue; } r -= I_O;
        { const int kb = r / 16, nbk = r % 16; tr_item<true>(w_out, D, kb * 64, nbk * 64, Wout_t, D, nbk * 64, scr, c.lane); }
    }
}
__device__ __forceinline__ void p_norm1(const Ctx& c, const float* __restrict__ x, const float* __restrict__ g1, const float* __restrict__ w_in, const float* __restrict__ a_log, const float* __restrict__ dt_bias, bf16* __restrict__ Hb, float* __restrict__ BG) {
    LAS f32x4* WB = (LAS f32x4*)c.lds;
    const int lane = c.lane;
    for (int idx = c.tid; idx < 2048; idx += NTHR) { const int k = idx >> 1, q = idx & 1; const f32x4 v = *(const f32x4*)(w_in + (size_t)k * INC + 2048 + 4 * q);
        const int l = (k & 255) >> 2, cc = k & 3, j = k >> 8; WB[((j * 4 + cc) * 2 + q) * 64 + l] = v; }
    __syncthreads();
#pragma unroll 2
    for (int t = c.bid * NWAVES + c.wave; t < NTOK; t += c.nb * NWAVES) {
        float4 xv[4]; float ss = 0.f;
#pragma unroll
        for (int j = 0; j < 4; ++j) { xv[j] = ((const float4*)(x + (size_t)t * D))[lane + 64 * j]; ss += xv[j].x * xv[j].x + xv[j].y * xv[j].y + xv[j].z * xv[j].z + xv[j].w * xv[j].w; }
        const float r = rsqrtf(wave_sum(ss) * (1.f / D) + RMS_EPS);
#pragma unroll
        for (int j = 0; j < 4; ++j) { const float4 g = ((const float4*)g1)[lane + 64 * j]; xv[j].x *= r * g.x; xv[j].y *= r * g.y; xv[j].z *= r * g.z; xv[j].w *= r * g.w;
            v2u o; o.x = cvt_pk_bf16(xv[j].x, xv[j].y); o.y = cvt_pk_bf16(xv[j].z, xv[j].w); ((v2u*)(Hb + (size_t)t * D))[lane + 64 * j] = o; }
        float acc[8];
#pragma unroll
        for (int i = 0; i < 8; ++i) acc[i] = 0.f;
#pragma unroll
        for (int j = 0; j < 4; ++j)
#pragma unroll
            for (int cc = 0; cc < 4; ++cc) { const float h = f4c(xv[j], cc);
#pragma unroll
                for (int q = 0; q < 2; ++q) { const f32x4 w = WB[((j * 4 + cc) * 2 + q) * 64 + lane];
                    acc[4 * q + 0] = fmaf(h, w.x, acc[4 * q + 0]); acc[4 * q + 1] = fmaf(h, w.y, acc[4 * q + 1]); acc[4 * q + 2] = fmaf(h, w.z, acc[4 * q + 2]); acc[4 * q + 3] = fmaf(h, w.w, acc[4 * q + 3]); } }
        BFLY_SW32(acc, 8) BFLY_SW16(acc, 4) BFLY_DPP(acc, 2, 8, dpp_ror8)
        float a0 = acc[0]; a0 += dpp_xor4(a0); a0 += dpp_xor2(a0); a0 += dpp_xor1(a0);
        const int idx = lane >> 3;
        if ((lane & 7) == 0) { float o;
            if (idx < 4) o = 1.f / (1.f + expf(-a0)); else { const int h = idx - 4; o = -expf(a_log[h]) * softplusf_(a0 + dt_bias[h]); }
            BG[(size_t)t * 8 + idx] = o; }
    }
}
struct EpiProj {
    static constexpr bool PERM = true, AFTER_DRAIN = false;
    bf16* O;
    __device__ __forceinline__ bool keep_acc(const pg8::Unit&) const { return false; }
    __device__ __forceinline__ void operator()(const f32x4 (&acc)[2][2][4][2], const pg8::Unit& u, int wr, int wc, int fr, int fq) const {
        const int row0 = u.pm * 256 + wr * 64 + fr, col0 = u.pn * 256 + wc * 32 + 8 * fq;
        const int act = (u.pn < 6) ? 0 : (u.pn < 8 ? 1 : (u.pn < 12 ? 2 : 0));
#pragma unroll
        for (int ai = 0; ai < 2; ++ai)
#pragma unroll
            for (int m = 0; m < 4; ++m) { bf16* rowp = O + (size_t)(row0 + ai * 128 + m * 16) * PJ + col0;
#pragma unroll
                for (int bj = 0; bj < 2; ++bj) { f32x4 v0 = acc[ai][bj][m][0], v1 = acc[ai][bj][m][1];
                    if (act == 1) {
#pragma unroll
                        for (int i = 0; i < 4; ++i) { v0[i] = v0[i] * fast_sigmoid(v0[i]); v1[i] = v1[i] * fast_sigmoid(v1[i]); } }
                    else if (act == 2) { const f32x2 a = gelu_pk((f32x2){v0[0], v0[1]}), b = gelu_pk((f32x2){v0[2], v0[3]}), cc = gelu_pk((f32x2){v1[0], v1[1]}), d = gelu_pk((f32x2){v1[2], v1[3]});
                        v0 = (f32x4){a.x, a.y, b.x, b.y}; v1 = (f32x4){cc.x, cc.y, d.x, d.y}; }
                    v4u w; w.x = cvt_pk_bf16(v0[0], v0[1]); w.y = cvt_pk_bf16(v0[2], v0[3]); w.z = cvt_pk_bf16(v1[0], v1[1]); w.w = cvt_pk_bf16(v1[2], v1[3]);
                    *(v4u*)(rowp + bj * 128) = w; } }
    }
};
struct DualOrder {
    pg8::StaticOrder S0;
    __device__ __forceinline__ void init(int G, int c) { S0.init(NTOK, D, G, c); }
    __device__ __forceinline__ bool next(int i, pg8::Unit& u) const { pg8::Unit t; if (!S0.next(i >> 1, t)) return false; const int which = i & 1; u.pm = t.pm + 64 * which; u.pn = t.pn + 4 * which; u.x0 = which; u.x1 = t.pn; u.rb = 0; return true; }
    __device__ __forceinline__ void a_ready(const pg8::Unit&) const {}
    __device__ __forceinline__ void done(const pg8::Unit&) const {}
};
struct EpiMerge {
    static constexpr bool PERM = true, AFTER_DRAIN = false;
    const bf16* P; bf16* O;
    __device__ __forceinline__ bool keep_acc(const pg8::Unit& u) const { return u.x0 == 0; }
    __device__ __forceinline__ void operator()(f32x4 (&acc)[2][2][4][2], const pg8::Unit& u, int wr, int wc, int fr, int fq) const {
        const int row0 = (u.pm & 63) * 256 + wr * 64 + fr, col0 = u.x1 * 256 + wc * 32 + 8 * fq; const bool first = (u.x0 == 0);
#pragma unroll
        for (int ai = 0; ai < 2; ++ai)
#pragma unroll
            for (int m = 0; m < 4; ++m) { const int row = row0 + ai * 128 + m * 16; const bf16* pr = P + (size_t)row * PJ + col0;
#pragma unroll
                for (int bj = 0; bj < 2; ++bj) { const v4u xb = *(const v4u*)(pr + 4096 + bj * 128); float fb[8];
                    fb[0] = bf_lo(xb.x); fb[1] = bf_hi(xb.x); fb[2] = bf_lo(xb.y); fb[3] = bf_hi(xb.y); fb[4] = bf_lo(xb.z); fb[5] = bf_hi(xb.z); fb[6] = bf_lo(xb.w); fb[7] = bf_hi(xb.w);
#pragma unroll
                    for (int i = 0; i < 8; ++i) fb[i] = 1.f + __expf(-fmaxf(fb[i], -30.f));
                    if (first) { const v4u xa = *(const v4u*)(pr + 3072 + bj * 128); float fa[8];
                        fa[0] = bf_lo(xa.x); fa[1] = bf_hi(xa.x); fa[2] = bf_lo(xa.y); fa[3] = bf_hi(xa.y); fa[4] = bf_lo(xa.z); fa[5] = bf_hi(xa.z); fa[6] = bf_lo(xa.w); fa[7] = bf_hi(xa.w);
#pragma unroll
                        for (int i = 0; i < 4; ++i) { acc[ai][bj][m][0][i] *= fb[i] * fast_sigmoid(fa[i]); acc[ai][bj][m][1][i] *= fb[4 + i] * fast_sigmoid(fa[4 + i]); } }
                    else { f32x4 v0, v1;
#pragma unroll
                        for (int i = 0; i < 4; ++i) { v0[i] = acc[ai][bj][m][0][i] * __builtin_amdgcn_rcpf(fb[i]); v1[i] = acc[ai][bj][m][1][i] * __builtin_amdgcn_rcpf(fb[4 + i]); }
                        v4u w; w.x = cvt_pk_bf16(v0[0], v0[1]); w.y = cvt_pk_bf16(v0[2], v0[3]); w.z = cvt_pk_bf16(v1[0], v1[1]); w.w = cvt_pk_bf16(v1[2], v1[3]);
                        *(v4u*)(O + (size_t)row * D + col0 + bj * 128) = w; } } }
    }
};
struct EpiResid {
    static constexpr bool PERM = false, AFTER_DRAIN = false;
    const float* X; float* O;
    __device__ __forceinline__ bool keep_acc(const pg8::Unit&) const { return false; }
    __device__ __forceinline__ void operator()(const f32x4 (&acc)[2][2][4][2], const pg8::Unit& u, int wr, int wc, int fr, int fq) const {
        const int row0 = u.pm * 256 + wr * 64 + fr, col0 = u.pn * 256 + wc * 32 + 4 * fq;
#pragma unroll
        for (int ai = 0; ai < 2; ++ai)
#pragma unroll
            for (int m = 0; m < 4; ++m) { const size_t off = (size_t)(row0 + ai * 128 + m * 16) * D + col0;
#pragma unroll
                for (int bj = 0; bj < 2; ++bj)
#pragma unroll
                    for (int n = 0; n < 2; ++n) *(f32x4*)(O + off + bj * 128 + n * 16) = *(const f32x4*)(X + off + bj * 128 + n * 16) + acc[ai][bj][m][n]; }
    }
};
__device__ __forceinline__ float ldbf(const bf16* p) { return __uint_as_float((unsigned)(*p) << 16); }
typedef short bf16x8 __attribute__((ext_vector_type(8)));
#define MFMA16(a, b, c) __builtin_amdgcn_mfma_f32_16x16x32_bf16((a), (b), (c), 0, 0, 0)
__device__ __forceinline__ unsigned short f2bf1(float f) { return (unsigned short)(cvt_pk_bf16(f, 0.f) & 0xffffu); }
__device__ __forceinline__ void unpack8(const v4u& x, float (&f)[8]) { f[0] = bf_lo(x.x); f[1] = bf_hi(x.x); f[2] = bf_lo(x.y); f[3] = bf_hi(x.y); f[4] = bf_lo(x.z); f[5] = bf_hi(x.z); f[6] = bf_lo(x.w); f[7] = bf_hi(x.w); }
__device__ __forceinline__ bf16x8 as_frag(const v4u& x) { return __builtin_bit_cast(bf16x8, x); }

constexpr size_t DN_WN = 16384, DN_QD = 16384, DN_KD = 16384, DN_QK = 8192, DN_U = 16384, DN_SST = 32768;
struct DnBufs { unsigned char *WN, *QD, *KD, *QK, *U, *SST; float* EG; };
constexpr int PL_QH = 0, PL_KH = 17408, PL_XVT = 34816, PL_XWT = 53248, PL_KDT = 71680, PL_AL = 90112, PL_TL = 106496, PL_GAM = 115712;
constexpr int RS = 136  , TS = 72  ;

__device__ __forceinline__ void p_dn_prep(const Ctx& c, const bf16* PROJ, const float* cw, const float* BG, const DnBufs& B) {
    LAS unsigned char* L = c.lds;
    LAS unsigned short* QH = (LAS unsigned short*)(L + PL_QH); LAS unsigned short* KH = (LAS unsigned short*)(L + PL_KH);
    LAS unsigned short* XVT = (LAS unsigned short*)(L + PL_XVT); LAS unsigned short* XWT = (LAS unsigned short*)(L + PL_XWT); LAS unsigned short* KDT = (LAS unsigned short*)(L + PL_KDT);
    LAS float* AL = (LAS float*)(L + PL_AL); LAS unsigned short* TL = (LAS unsigned short*)(L + PL_TL);
    LAS float* GAM = (LAS float*)(L + PL_GAM); LAS float* BETA = GAM + 64; LAS float* EGAM = GAM + 128; LAS float* KSC = GAM + 192;
    const int lane = c.lane, w = c.wave, fr = lane & 15, fq = lane >> 4;
    for (int it = c.bid; it < BATCH * DNH * (SEQ / 64); it += c.nb) {
        const int bh = it >> 7, ch = it & 127, b = bh >> 2, h = bh & 3; const size_t row0 = (size_t)b * SEQ + ch * 64;
        if (w == 0) { const float gt = BG[(row0 + lane) * 8 + 4 + h], bt = BG[(row0 + lane) * 8 + h]; float gam = gt;
#pragma unroll
            for (int o = 1; o < 64; o <<= 1) { const float t = __shfl_up(gam, o); if (lane >= o) gam += t; }
            const float gl = __shfl(gam, 63);
            GAM[lane] = gam; BETA[lane] = bt; EGAM[lane] = expf(gam); KSC[lane] = expf(gl - gam);
            if (lane == 0) B.EG[it] = expf(gl); }
        for (int i = c.tid; i < 1024; i += NTHR) ((LAS f32x4*)AL)[i] = (f32x4){0.f, 0.f, 0.f, 0.f};
        __syncthreads();
#pragma unroll 1
        for (int i = 0; i < 6; i += 2) {
            v4u xr[2][4];
#pragma unroll
            for (int u = 0; u < 2; ++u) { const int idx = c.tid + NTHR * (i + u), t = idx / 48, cg = idx % 48, col = (cg >> 4) * 512 + h * 128 + (cg & 15) * 8;
#pragma unroll
                for (int kk = 0; kk < 4; ++kk) { const int tt = ch * 64 + t - 3 + kk; xr[u][kk] = (tt >= 0) ? *(const v4u*)(PROJ + ((size_t)b * SEQ + tt) * PJ + col) : (v4u){0u, 0u, 0u, 0u}; } }
#pragma unroll
            for (int u = 0; u < 2; ++u) {
            const int idx = c.tid + NTHR * (i + u), t = idx / 48, cg = idx % 48, part = cg >> 4, c8 = (cg & 15) * 8, col = part * 512 + h * 128 + c8;
            float a[8];
#pragma unroll
            for (int e = 0; e < 8; ++e) a[e] = 0.f;
#pragma unroll
            for (int kk = 0; kk < 4; ++kk) { float xf[8]; unpack8(xr[u][kk], xf);
                    const float4 w0 = *(const float4*)(cw + kk * 1536 + col), w1 = *(const float4*)(cw + kk * 1536 + col + 4);
                    a[0] = fmaf(w0.x, xf[0], a[0]); a[1] = fmaf(w0.y, xf[1], a[1]); a[2] = fmaf(w0.z, xf[2], a[2]); a[3] = fmaf(w0.w, xf[3], a[3]);
                    a[4] = fmaf(w1.x, xf[4], a[4]); a[5] = fmaf(w1.y, xf[5], a[5]); a[6] = fmaf(w1.z, xf[6], a[6]); a[7] = fmaf(w1.w, xf[7], a[7]); }
            float ss = 0.f;
#pragma unroll
            for (int e = 0; e < 8; ++e) { a[e] = a[e] / (1.f + __expf(-a[e])); ss = fmaf(a[e], a[e], ss); }
            ss = row16_sum(ss);
            const float rs = rsqrtf(ss + L2_EPS);
            if (part == 0) { const float sc = rs * 0.08838834764831845f; v4u o; o.x = cvt_pk_bf16(a[0] * sc, a[1] * sc); o.y = cvt_pk_bf16(a[2] * sc, a[3] * sc); o.z = cvt_pk_bf16(a[4] * sc, a[5] * sc); o.w = cvt_pk_bf16(a[6] * sc, a[7] * sc);
                *(LAS v4u*)(QH + t * RS + c8) = o; }
            else if (part == 1) { v4u o; o.x = cvt_pk_bf16(a[0] * rs, a[1] * rs); o.y = cvt_pk_bf16(a[2] * rs, a[3] * rs); o.z = cvt_pk_bf16(a[4] * rs, a[5] * rs); o.w = cvt_pk_bf16(a[6] * rs, a[7] * rs);
                *(LAS v4u*)(KH + t * RS + c8) = o; const float s1 = rs * BETA[t] * EGAM[t], s2 = rs * KSC[t];
#pragma unroll
                for (int e = 0; e < 8; ++e) { XWT[(c8 + e) * TS + t] = f2bf1(a[e] * s1); KDT[(c8 + e) * TS + t] = f2bf1(a[e] * s2); } }
            else { const float bt = BETA[t];
#pragma unroll
                for (int e = 0; e < 8; ++e) XVT[(c8 + e) * TS + t] = f2bf1(a[e] * bt); }
            }
        }
        __syncthreads();
        { const int rt = w & 3, ksq = w >> 2; v2u half[2];
#pragma unroll
            for (int sub = 0; sub < 2; ++sub) { const int st = 2 * ksq + sub; f32x4 acc = {0.f, 0.f, 0.f, 0.f};
#pragma unroll
                for (int kk = 0; kk < 4; ++kk) { const bf16x8 a = *(const LAS bf16x8*)(KH + (16 * st + fr) * RS + 32 * kk + 8 * fq), bq = *(const LAS bf16x8*)(QH + (16 * rt + fr) * RS + 32 * kk + 8 * fq); acc = MFMA16(a, bq, acc); }
                const int rr = 16 * rt + fr; const float gr = GAM[rr]; float v[4];
#pragma unroll
                for (int r = 0; r < 4; ++r) { const int s2 = 16 * st + 4 * fq + r; v[r] = (s2 <= rr) ? acc[r] * __expf(fminf(gr - GAM[s2], 0.f)) : 0.f; }
                half[sub].x = cvt_pk_bf16(v[0], v[1]); half[sub].y = cvt_pk_bf16(v[2], v[3]); }
            v4u o; o.x = half[0].x; o.y = half[0].y; o.z = half[1].x; o.w = half[1].y;
            *(v4u*)(B.QK + (size_t)it * DN_QK + ((rt * 2 + ksq) * 64 + lane) * 16) = o; }
#pragma unroll 1
        for (int n = w; n < 10; n += 8) { const int rt = (n >= 6) ? 3 : (n >= 3 ? 2 : (n >= 1 ? 1 : 0)), st = n - rt * (rt + 1) / 2; f32x4 acc = {0.f, 0.f, 0.f, 0.f};
#pragma unroll
            for (int kk = 0; kk < 4; ++kk) { const bf16x8 a = *(const LAS bf16x8*)(KH + (16 * rt + fr) * RS + 32 * kk + 8 * fq), bk = *(const LAS bf16x8*)(KH + (16 * st + fr) * RS + 32 * kk + 8 * fq); acc = MFMA16(a, bk, acc); }
            const int s2 = 16 * st + fr; const float gs = GAM[s2];
#pragma unroll
            for (int r = 0; r < 4; ++r) { const int rr = 16 * rt + 4 * fq + r; const float v = (s2 < rr) ? BETA[rr] * acc[r] * __expf(fminf(GAM[rr] - gs, 0.f)) : 0.f; AL[rr * 64 + (s2 & 7) * 8 + (s2 >> 3)] = v; } }
        __syncthreads();
        { const int j = w * 8 + (lane >> 3), p = lane & 7; float tc[8];
#pragma unroll
            for (int i = 0; i < 8; ++i) tc[i] = 0.f;
#pragma unroll
            for (int r = 0; r < 64; ++r) { float s0 = 0.f, s1 = 0.f;
                if (r > 0) { const LAS float* ar = AL + r * 64 + p * 8; const f32x4 a0 = *(const LAS f32x4*)ar; s0 = a0[0] * tc[0];
                    if (r > 8) s1 = a0[1] * tc[1];
                    if (r > 16) s0 = fmaf(a0[2], tc[2], s0);
                    if (r > 24) s1 = fmaf(a0[3], tc[3], s1);
                    if (r > 32) { const f32x4 a1 = *(const LAS f32x4*)(ar + 4); s0 = fmaf(a1[0], tc[4], s0);
                        if (r > 40) s1 = fmaf(a1[1], tc[5], s1);
                        if (r > 48) s0 = fmaf(a1[2], tc[6], s0);
                        if (r > 56) s1 = fmaf(a1[3], tc[7], s1); } }
                float tot = s0 + s1; tot += dpp_xor1(tot); tot += dpp_xor2(tot); tot += dpp_hmir(tot);
                const float tr = ((r == j) ? 1.f : 0.f) - tot;
                if (p == (r & 7)) tc[r >> 3] = tr; }
#pragma unroll
            for (int i = 0; i < 8; ++i) TL[(8 * i + p) * TS + j] = f2bf1(tc[i]); }
        __syncthreads();
        { const int sl = w;
#pragma unroll
            for (int mt = 0; mt < 4; ++mt) { f32x4 acc = {0.f, 0.f, 0.f, 0.f};
#pragma unroll
                for (int kk = 0; kk < 2; ++kk) if (kk == 0 || mt >= 2) { const bf16x8 a = *(const LAS bf16x8*)(TL + (16 * mt + fr) * TS + 32 * kk + 8 * fq), bv = *(const LAS bf16x8*)(XVT + (16 * sl + fr) * TS + 32 * kk + 8 * fq); acc = MFMA16(a, bv, acc); }
                v2u o; o.x = cvt_pk_bf16(acc[0], acc[1]); o.y = cvt_pk_bf16(acc[2], acc[3]);
                *(v2u*)(B.U + (size_t)it * DN_U + ((mt * 8 + sl) * 64 + lane) * 8) = o; }
            const int dt = w;
#pragma unroll
            for (int rt = 0; rt < 4; ++rt) { f32x4 acc = {0.f, 0.f, 0.f, 0.f};
#pragma unroll
                for (int kk = 0; kk < 2; ++kk) if (kk == 0 || rt >= 2) { const bf16x8 a = *(const LAS bf16x8*)(XWT + (16 * dt + fr) * TS + 32 * kk + 8 * fq), bt = *(const LAS bf16x8*)(TL + (16 * rt + fr) * TS + 32 * kk + 8 * fq); acc = MFMA16(a, bt, acc); }
                v2u o; o.x = cvt_pk_bf16(-acc[0], -acc[1]); o.y = cvt_pk_bf16(-acc[2], -acc[3]);
                *(v2u*)(B.WN + (size_t)it * DN_WN + ((rt * 4 + (dt >> 1)) * 64 + lane) * 16 + (dt & 1) * 8) = o; } }
        { const int mt = w & 3;
#pragma unroll
            for (int q2 = 0; q2 < 2; ++q2) { const int ks = 2 * (w >> 2) + q2, rr = 16 * mt + fr; const float sc = EGAM[rr];
                const v2u lo = *(const LAS v2u*)(QH + rr * RS + 32 * ks + 4 * fq), hi = *(const LAS v2u*)(QH + rr * RS + 32 * ks + 16 + 4 * fq);
                v4u o; o.x = cvt_pk_bf16(bf_lo(lo.x) * sc, bf_hi(lo.x) * sc); o.y = cvt_pk_bf16(bf_lo(lo.y) * sc, bf_hi(lo.y) * sc); o.z = cvt_pk_bf16(bf_lo(hi.x) * sc, bf_hi(hi.x) * sc); o.w = cvt_pk_bf16(bf_lo(hi.y) * sc, bf_hi(hi.y) * sc);
                *(v4u*)(B.QD + (size_t)it * DN_QD + ((mt * 4 + ks) * 64 + lane) * 16) = o; }
            const int dt = w;
#pragma unroll
            for (int ks = 0; ks < 2; ++ks) { const v2u lo = *(const LAS v2u*)(KDT + (16 * dt + fr) * TS + 32 * ks + 4 * fq), hi = *(const LAS v2u*)(KDT + (16 * dt + fr) * TS + 32 * ks + 16 + 4 * fq);
                v4u o; o.x = lo.x; o.y = lo.y; o.z = hi.x; o.w = hi.y;
                *(v4u*)(B.KD + (size_t)it * DN_KD + ((dt * 2 + ks) * 64 + lane) * 16) = o; } }
        __syncthreads();
    }
}

constexpr int SCAN_WGS = BATCH * DNH * 2;
__device__ __forceinline__ void u_load_asm(v2u& dst, const unsigned char* p) { asm volatile("global_load_dwordx2 %0, %1, off" : "=v"(dst) : "v"(p) : "memory"); }
template <int STG>
__device__ __forceinline__ void scan_step(const DnBufs& B, LAS unsigned char* L, int lane, int sl, int it, int ch, f32x4 (&S)[8], v2u (&ucur)[4], v2u (&unxt)[4], float egc) {
    if (ch < 126) asm volatile("s_waitcnt vmcnt(8)" ::: "memory"); else asm volatile("s_waitcnt vmcnt(0)" ::: "memory");
    __builtin_amdgcn_s_barrier(); asm volatile("" ::: "memory");
    asm volatile("" : "+v"(ucur[0]), "+v"(ucur[1]), "+v"(ucur[2]), "+v"(ucur[3]));
    bf16x8 sf[4];
#pragma unroll
    for (int ks = 0; ks < 4; ++ks) { v4u o; o.x = cvt_pk_bf16(S[2 * ks][0], S[2 * ks][1]); o.y = cvt_pk_bf16(S[2 * ks][2], S[2 * ks][3]); o.z = cvt_pk_bf16(S[2 * ks + 1][0], S[2 * ks + 1][1]); o.w = cvt_pk_bf16(S[2 * ks + 1][2], S[2 * ks + 1][3]);
        *(v4u*)(B.SST + (size_t)it * DN_SST + ((ks * 8 + sl) * 64 + lane) * 16) = o; sf[ks] = as_frag(o); }
    asm volatile("" ::: "memory");
    if (ch + 3 < 128) {
#pragma unroll
        for (int mt = 0; mt < 4; ++mt) u_load_asm(unxt[mt], B.U + (size_t)(it + 3) * DN_U + ((mt * 8 + sl) * 64 + lane) * 8); }
    const LAS unsigned char* wl = L + STG * 32768 + lane * 16; const LAS unsigned char* kl = wl + 16384;
    f32x4 vn[4];
#pragma unroll
    for (int mt = 0; mt < 4; ++mt) { vn[mt] = (f32x4){bf_lo(ucur[mt].x), bf_hi(ucur[mt].x), bf_lo(ucur[mt].y), bf_hi(ucur[mt].y)};
#pragma unroll
        for (int ks = 0; ks < 4; ++ks) vn[mt] = MFMA16(*(const LAS bf16x8*)(wl + (mt * 4 + ks) * 1024), sf[ks], vn[mt]); }
    bf16x8 vf[2];
#pragma unroll
    for (int ks = 0; ks < 2; ++ks) { v4u o; o.x = cvt_pk_bf16(vn[2 * ks][0], vn[2 * ks][1]); o.y = cvt_pk_bf16(vn[2 * ks][2], vn[2 * ks][3]); o.z = cvt_pk_bf16(vn[2 * ks + 1][0], vn[2 * ks + 1][1]); o.w = cvt_pk_bf16(vn[2 * ks + 1][2], vn[2 * ks + 1][3]); vf[ks] = as_frag(o); }
#pragma unroll
    for (int dt = 0; dt < 8; ++dt) { f32x4 a = S[dt] * egc;
#pragma unroll
        for (int ks = 0; ks < 2; ++ks) a = MFMA16(*(const LAS bf16x8*)(kl + (dt * 2 + ks) * 1024), vf[ks], a);
        S[dt] = a; }
}
__device__ __forceinline__ void p_dn_scan(const Ctx& c, const DnBufs& B) {
    const int lane = c.lane, w = c.wave, bh = c.bid >> 1, half = c.bid & 1; LAS unsigned char* L = c.lds;
    if (w >= 4) {
        const unsigned char* gsrc = (w < 6) ? B.WN : B.KD; const int goff = (w & 1) * 8192 + lane * 16, loff = (w - 4) * 8192;
#define SCAN_DMA(itn, stage) do { _Pragma("unroll") for (int _p = 0; _p < 8; ++_p) \
        __builtin_amdgcn_global_load_lds((const unsigned*)(gsrc + (size_t)(itn) * 16384 + goff + _p * 1024), (LAS unsigned*)(L + (stage) * 32768 + loff + _p * 1024), 16, 0, 0); } while (0)
        const int it0 = bh * 128;
        SCAN_DMA(it0, 0); SCAN_DMA(it0 + 1, 1); SCAN_DMA(it0 + 2, 2);
#pragma unroll 1
        for (int ch = 0; ch < 128; ++ch) {
            if (ch < 126) asm volatile("s_waitcnt vmcnt(16)" ::: "memory"); else asm volatile("s_waitcnt vmcnt(0)" ::: "memory");
            __builtin_amdgcn_s_barrier(); asm volatile("" ::: "memory");
            if (ch + 3 < 128) SCAN_DMA(it0 + ch + 3, (ch + 3) & 3);
        }
#undef SCAN_DMA
    } else {
        __builtin_amdgcn_s_setprio(1);
        const int sl = half * 4 + w;
        f32x4 S[8];
#pragma unroll
        for (int i = 0; i < 8; ++i) S[i] = (f32x4){0.f, 0.f, 0.f, 0.f};
        v2u u0[4], u1[4], u2[4], u3[4];
        const float eglo = B.EG[bh * 128 + lane], eghi = B.EG[bh * 128 + 64 + lane];
        asm volatile("s_waitcnt vmcnt(0)" ::: "memory");
        { const int it = bh * 128;
#pragma unroll
            for (int mt = 0; mt < 4; ++mt) u_load_asm(u0[mt], B.U + (size_t)it * DN_U + ((mt * 8 + sl) * 64 + lane) * 8);
#pragma unroll
            for (int mt = 0; mt < 4; ++mt) u_load_asm(u1[mt], B.U + (size_t)(it + 1) * DN_U + ((mt * 8 + sl) * 64 + lane) * 8);
#pragma unroll
            for (int mt = 0; mt < 4; ++mt) u_load_asm(u2[mt], B.U + (size_t)(it + 2) * DN_U + ((mt * 8 + sl) * 64 + lane) * 8);
#pragma unroll
            for (int mt = 0; mt < 4; ++mt) u3[mt] = (v2u){0u, 0u}; }
#define EGC(chx) __builtin_bit_cast(float, __builtin_amdgcn_readlane(__builtin_bit_cast(int, (chx) < 64 ? eglo : eghi), (chx) & 63))
#pragma unroll 1
        for (int ch = 0; ch < 128; ch += 4) {
            const int it = bh * 128 + ch;
            scan_step<0>(B, L, lane, sl, it, ch, S, u0, u3, EGC(ch));
            scan_step<1>(B, L, lane, sl, it + 1, ch + 1, S, u1, u0, EGC(ch + 1));
            scan_step<2>(B, L, lane, sl, it + 2, ch + 2, S, u2, u1, EGC(ch + 2));
            scan_step<3>(B, L, lane, sl, it + 3, ch + 3, S, u3, u2, EGC(ch + 3));
        }
#undef EGC
        __builtin_amdgcn_s_setprio(0);
    }
    asm volatile("s_waitcnt vmcnt(0)" ::: "memory"); __builtin_amdgcn_s_barrier(); asm volatile("" ::: "memory");
}

__device__ __forceinline__ void p_dn_out(const Ctx& c, const DnBufs& B, const bf16* PROJ, const float* gn, bf16* YA) {
    const int lane = c.lane, sl = c.wave, fr = lane & 15, fq = lane >> 4; LAS float* SSQ = (LAS float*)c.lds;
    LAS unsigned char* IMG = c.lds + 2048;
    for (int it = c.bid; it < BATCH * DNH * (SEQ / 64); it += c.nb) {
        const int bh = it >> 7, ch = it & 127, b = bh >> 2, h = bh & 3; const size_t row0 = (size_t)b * SEQ + ch * 64;
        v4u sfr[4]; v2u ur[4];
#pragma unroll
        for (int ks = 0; ks < 4; ++ks) sfr[ks] = *(const v4u*)(B.SST + (size_t)it * DN_SST + ((ks * 8 + sl) * 64 + lane) * 16);
#pragma unroll
        for (int mt = 0; mt < 4; ++mt) ur[mt] = *(const v2u*)(B.U + (size_t)it * DN_U + ((mt * 8 + sl) * 64 + lane) * 8);
#pragma unroll
        for (int j = 0; j < 5; ++j) { const int p = sl * 5 + j;
            const unsigned char* src = (p < 16) ? B.WN + (size_t)it * DN_WN + p * 1024 : (p < 32 ? B.QD + (size_t)it * DN_QD + (p - 16) * 1024 : B.QK + (size_t)it * DN_QK + (p - 32) * 1024);
            __builtin_amdgcn_global_load_lds((const unsigned*)(src + lane * 16), (LAS unsigned*)(IMG + p * 1024), 16, 0, 0); }
        asm volatile("s_waitcnt vmcnt(0)" ::: "memory"); __syncthreads();
        bf16x8 sf[4];
#pragma unroll
        for (int ks = 0; ks < 4; ++ks) sf[ks] = as_frag(sfr[ks]);
        const LAS unsigned char* wn = IMG + lane * 16; const LAS unsigned char* qd = wn + 16384; const LAS unsigned char* qk = wn + 32768;
        f32x4 vn[4];
#pragma unroll
        for (int mt = 0; mt < 4; ++mt) { vn[mt] = (f32x4){bf_lo(ur[mt].x), bf_hi(ur[mt].x), bf_lo(ur[mt].y), bf_hi(ur[mt].y)};
#pragma unroll
            for (int ks = 0; ks < 4; ++ks) vn[mt] = MFMA16(*(const LAS bf16x8*)(wn + (mt * 4 + ks) * 1024), sf[ks], vn[mt]); }
        bf16x8 vf[2];
#pragma unroll
        for (int ks = 0; ks < 2; ++ks) { v4u o; o.x = cvt_pk_bf16(vn[2 * ks][0], vn[2 * ks][1]); o.y = cvt_pk_bf16(vn[2 * ks][2], vn[2 * ks][3]); o.z = cvt_pk_bf16(vn[2 * ks + 1][0], vn[2 * ks + 1][1]); o.w = cvt_pk_bf16(vn[2 * ks + 1][2], vn[2 * ks + 1][3]); vf[ks] = as_frag(o); }
        f32x4 o[4];
#pragma unroll
        for (int mt = 0; mt < 4; ++mt) { f32x4 a = {0.f, 0.f, 0.f, 0.f};
#pragma unroll
            for (int ks = 0; ks < 4; ++ks) a = MFMA16(*(const LAS bf16x8*)(qd + (mt * 4 + ks) * 1024), sf[ks], a);
#pragma unroll
            for (int ks = 0; ks < 2; ++ks) a = MFMA16(*(const LAS bf16x8*)(qk + (mt * 2 + ks) * 1024), vf[ks], a);
            o[mt] = a;
#pragma unroll
            for (int r = 0; r < 4; ++r) { float q = row16_sum(a[r] * a[r]);
                if (fr == 0) SSQ[(16 * mt + 4 * fq + r) * 8 + sl] = q; } }
        float zv[4][4];
#pragma unroll
        for (int mt = 0; mt < 4; ++mt)
#pragma unroll
            for (int r = 0; r < 4; ++r) zv[mt][r] = ldbf(PROJ + (row0 + 16 * mt + 4 * fq + r) * PJ + 1536 + h * 128 + 16 * sl + fr);
        const float gg = gn[16 * sl + fr];
        __syncthreads();
#pragma unroll
        for (int mt = 0; mt < 4; ++mt)
#pragma unroll
            for (int r = 0; r < 4; ++r) { const int rl = 16 * mt + 4 * fq + r; const f32x4 q0 = *(const LAS f32x4*)(SSQ + rl * 8), q1 = *(const LAS f32x4*)(SSQ + rl * 8 + 4);
                const float rstd = rsqrtf(((q0[0] + q0[1]) + (q0[2] + q0[3]) + (q1[0] + q1[1]) + (q1[2] + q1[3])) * (1.f / 128.f) + RMS_EPS);
                const size_t row = row0 + rl; const int col = h * 128 + 16 * sl + fr;
                YA[row * DNW + col] = f2bf1(o[mt][r] * rstd * gg * zv[mt][r]); }
        __syncthreads();
    }
}

__device__ __forceinline__ void p_sg_item(const Ctx& c, int it, const bf16* PROJ, const float* lg, const float* lb, const float* sw, const float* sb, bf16* YB) {
    LAS unsigned short* VT = (LAS unsigned short*)c.lds;
    LAS float* STAT = (LAS float*)(c.lds + 128 * RS * 2);
    const int lane = c.lane, w = c.wave, fr = lane & 15, fq = lane >> 4, chunk = it >> 2, g = it & 3; const size_t row0 = (size_t)chunk * SGC;
    {
        v4u xr[16];
#pragma unroll
        for (int rr = 0; rr < 16; ++rr) xr[rr] = *(const v4u*)(PROJ + (row0 + 16 * w + rr) * PJ + 2560 + lane * 8);
        float acc[32];
#pragma unroll
        for (int rr = 0; rr < 16; ++rr) { float f[8]; unpack8(xr[rr], f); float s1 = 0.f, s2 = 0.f;
#pragma unroll
            for (int e = 0; e < 8; ++e) { s1 += f[e]; s2 = fmaf(f[e], f[e], s2); }
            acc[rr] = s1; acc[16 + rr] = s2; }
        BFLY_SW32(acc, 32) BFLY_SW16(acc, 16) BFLY_DPP(acc, 8, 8, dpp_ror8) BFLY_DPP(acc, 4, 4, dpp_xor4) BFLY_DPP(acc, 2, 2, dpp_xor2)
        const float tot = acc[0] + dpp_xor1(acc[0]);
        if ((lane & 1) == 0) { const int vi = lane >> 1; STAT[2 * (16 * w + (vi & 15)) + (vi >> 4)] = tot; } }
    __syncthreads();
    { v4u xv[4];
#pragma unroll
        for (int i = 0; i < 4; ++i) { const int idx = c.tid + NTHR * i, s = idx >> 4, c8 = (idx & 15) * 8; xv[i] = *(const v4u*)(PROJ + (row0 + s) * PJ + 2560 + g * 128 + c8); }
        const int c8 = (c.tid & 15) * 8;
        const float4 g0 = *(const float4*)(lg + g * 128 + c8), g1 = *(const float4*)(lg + g * 128 + c8 + 4), b0 = *(const float4*)(lb + g * 128 + c8), b1 = *(const float4*)(lb + g * 128 + c8 + 4);
        const float gv[8] = {g0.x, g0.y, g0.z, g0.w, g1.x, g1.y, g1.z, g1.w}, bv[8] = {b0.x, b0.y, b0.z, b0.w, b1.x, b1.y, b1.z, b1.w};
#pragma unroll
        for (int i = 0; i < 4; ++i) { const int s = (c.tid + NTHR * i) >> 4; float f[8]; unpack8(xv[i], f);
            const float mu = STAT[2 * s] * (1.f / SGW), rstd = rsqrtf(fmaxf(STAT[2 * s + 1] * (1.f / SGW) - mu * mu, 0.f) + LN_EPS);
#pragma unroll
            for (int e = 0; e < 8; ++e) VT[(c8 + e) * RS + s] = f2bf1((f[e] - mu) * rstd * gv[e] + bv[e]); } }
    __syncthreads();
    { f32x4 acc[8];
#pragma unroll
        for (int ct = 0; ct < 8; ++ct) acc[ct] = (f32x4){0.f, 0.f, 0.f, 0.f};
        const int t = 16 * w + fr, nk = (w >> 1) + 1;
        for (int kk = 0; kk < nk; ++kk) { const int s0 = 32 * kk + 8 * fq; const float* wp = sw + ((size_t)g * SGC + t) * SGC + s0;
            const float4 w0 = *(const float4*)wp, w1 = *(const float4*)(wp + 4);
            const float wv[8] = {w0.x, w0.y, w0.z, w0.w, w1.x, w1.y, w1.z, w1.w}; float wm[8];
#pragma unroll
            for (int e = 0; e < 8; ++e) wm[e] = (s0 + e <= t) ? wv[e] : 0.f;
            v4u wb; wb.x = cvt_pk_bf16(wm[0], wm[1]); wb.y = cvt_pk_bf16(wm[2], wm[3]); wb.z = cvt_pk_bf16(wm[4], wm[5]); wb.w = cvt_pk_bf16(wm[6], wm[7]);
            const bf16x8 bfr = as_frag(wb);
#pragma unroll
            for (int ct = 0; ct < 8; ++ct) acc[ct] = MFMA16(*(const LAS bf16x8*)(VT + (16 * ct + fr) * RS + s0), bfr, acc[ct]); }
        const float bias = sb[g * SGC + t]; const size_t row = row0 + t;
#pragma unroll
        for (int ct = 0; ct < 8; ++ct) { const int col = g * 128 + 16 * ct + 4 * fq; const v2u u = *(const v2u*)(PROJ + row * PJ + 2048 + col);
            v2u o; o.x = cvt_pk_bf16(bf_lo(u.x) * (acc[ct][0] + bias), bf_hi(u.x) * (acc[ct][1] + bias)); o.y = cvt_pk_bf16(bf_lo(u.y) * (acc[ct][2] + bias), bf_hi(u.y) * (acc[ct][3] + bias));
            *(v2u*)(YB + row * SGW + col) = o; } }
    __syncthreads();
}

struct Args { const float* in[22]; float* out; unsigned char* ws; int ph_lo, ph_hi; };
__global__ void __launch_bounds__(NTHR, 2) mega(Args args) {
    extern __shared__ __attribute__((aligned(16))) unsigned char lds_raw[];
    Ctx c; c.lds0 = (LAS unsigned char*)lds_raw; c.lds = c.lds0 + RING_OFF; c.tid = threadIdx.x; c.lane = c.tid & 63; c.wave = __builtin_amdgcn_readfirstlane(c.tid >> 6); c.bid = blockIdx.x; c.nb = gridDim.x;
    volatile LAS unsigned* MISC = (volatile LAS unsigned*)(c.lds0 + MISC_OFF);
    for (int u = c.tid; u < RING_OFF / 4; u += NTHR) ((LAS unsigned*)(c.lds0 + LDSCTL_OFF))[u] = 0u;
    __syncthreads();
    unsigned char* ws = args.ws;
    gu32* ctl = (gu32*)(ws + WS_CTL);
    XcdBarrier bar = xcd_barrier_post((unsigned*)(ctl + CW_BAR), MISC + 8);
#define GRID_BAR() xcd_barrier(bar)
    const float* x = args.in[0]; const float* norm1_g = args.in[1]; const float* w_in = args.in[2]; const float* conv_w = args.in[3];
    const float* a_log = args.in[4]; const float* dt_bias = args.in[5]; const float* dn_norm_g = args.in[6]; const float* w_o_dn = args.in[7];
    const float* sg_ln_g = args.in[8]; const float* sg_ln_b = args.in[9]; const float* sg_w = args.in[10]; const float* sg_b = args.in[11];
    const float* w_o_sg = args.in[12]; const float* w_out = args.in[13]; const float* norm2_g = args.in[14]; const float* w_router = args.in[15];
    const float* b_router = args.in[16]; const float* w_gate_up = args.in[17]; const float* b_gate_up = args.in[18]; const float* w_down = args.in[19];
    const float* b_down = args.in[20]; const float* norm_f_g = args.in[21];
    float* out = args.out;
    unsigned char* wb = ws + WS_BASE;
    bf16* Hb = (bf16*)(wb + 0); bf16* H2b = (bf16*)(wb + 0);
    bf16* Win_t = (bf16*)(wb + 32 * MiB); bf16* Wo_t = (bf16*)(wb + 42 * MiB); bf16* Wout_t = (bf16*)(wb + 44 * MiB); float* BG = (float*)(wb + 46 * MiB);
    bf16* PROJb = (bf16*)(wb + 48 * MiB); bf16* ACTb = (bf16*)(wb + 48 * MiB);
    bf16* YAB = (bf16*)(wb + 208 * MiB); bf16* MERGED = (bf16*)(wb + 240 * MiB); float* X1 = (float*)(wb + 272 * MiB);
    float* QKV = (float*)(wb + 336 * MiB); float* O32 = (float*)(wb + 432 * MiB); float* U = (float*)(wb + 464 * MiB); float* VLN = (float*)(wb + 496 * MiB);
    bf16* Wgu_t = (bf16*)(wb + 528 * MiB); bf16* Wd_t = (bf16*)(wb + 656 * MiB); bf16* HS = (bf16*)(wb + 720 * MiB); bf16* Yb = (bf16*)(wb + 864 * MiB);
    unsigned char* small = wb + 1008 * MiB;
    int* slot_e = (int*)(small + 0 * MiB); int* slot_pos = (int*)(small + 1 * MiB); int* elist = (int*)(small + 2 * MiB); float* ewgt = (float*)(small + 4 * MiB);
    unsigned* gcnt = (unsigned*)(ctl + CW_CNT);

#ifndef PROBE_MASK
#define PROBE_MASK 0
#endif
#define REP(bit) for (int _r = 0; _r < ((PROBE_MASK >> (bit)) & 1) + 1; ++_r)
    REP(0) { p_convert_front(c, w_in, w_o_dn, w_o_sg, w_out, Win_t, Wo_t, Wout_t);
    __syncthreads();
    p_norm1(c, x, norm1_g, w_in, a_log, dt_bias, Hb, BG); if (PROBE_MASK & 1) __syncthreads();
    for (int i = c.bid * NTHR + c.tid; i < NE * NTOK / 4; i += c.nb * NTHR) { ((v4u*)elist)[i] = (v4u){0u, 0u, 0u, 0u}; ((v4u*)ewgt)[i] = (v4u){0u, 0u, 0u, 0u}; } }
    GRID_BAR();
    REP(1) { pg8::Gemm g{Hb, Win_t, NTOK, PJ, D}; pg8::StaticOrder S; S.init(NTOK, PJ, c.nb, c.bid); EpiProj E{PROJb};
      pg8::gemm_phase<EpiProj, pg8::StaticOrder, true, true>(c.lds, g, S, E); }
    GRID_BAR();
    DnBufs DB; DB.WN = wb + 336 * MiB; DB.QD = wb + 352 * MiB; DB.KD = wb + 368 * MiB; DB.QK = wb + 384 * MiB; DB.U = wb + 392 * MiB; DB.SST = wb + 408 * MiB; DB.EG = (float*)(wb + 440 * MiB);
    REP(2) { p_dn_prep(c, PROJb, conv_w, BG, DB); }
    GRID_BAR();
    if (c.bid < SCAN_WGS) { REP(3) { p_dn_scan(c, DB); } }
    else { Ctx c2 = c; c2.bid = c.bid - SCAN_WGS; c2.nb = c.nb - SCAN_WGS;
        REP(4) { for (int it = c2.bid; it < (NTOK / SGC) * 4; it += c2.nb) p_sg_item(c, it, PROJb, sg_ln_g, sg_ln_b, sg_w, sg_b, YAB + (size_t)NTOK * DNW); }
        REP(5) { p_convert_moe(c2, w_gate_up, w_down, Wgu_t, Wd_t); } }
    GRID_BAR();
    REP(6) { p_dn_out(c, DB, PROJb, dn_norm_g, YAB); }
    GRID_BAR();
    REP(7) { pg8::Gemm g{YAB, Wo_t, 0, 0, DNW}; DualOrder S; S.init(c.nb, c.bid); EpiMerge E{PROJb, MERGED};
      pg8::gemm_phase<EpiMerge, DualOrder, true, true>(c.lds, g, S, E); }
    GRID_BAR();
    REP(8) { pg8::Gemm g{MERGED, Wout_t, NTOK, D, D}; pg8::StaticOrder S; S.init(NTOK, D, c.nb, c.bid); EpiResid E{x, X1};
      pg8::gemm_phase<EpiResid, pg8::StaticOrder, true, true>(c.lds, g, S, E); }
    GRID_BAR();
    p_router(c, X1, norm2_g, w_router, b_router, H2b, slot_e, slot_pos, elist, ewgt, gcnt, (PROBE_MASK & 16384) ? 2 : 1);
    GRID_BAR();
    LAS unsigned char* tile_e = c.lds0 + EXTRA_OFF + 512; LAS int* ntl = (LAS int*)(c.lds0 + EXTRA_OFF + 1024); LAS int* tile_b = (LAS int*)(c.lds0 + EXTRA_OFF + 1088);
    build_tile_table(c, gcnt, tile_e, ntl, tile_b);
    const int NTL = __builtin_amdgcn_readfirstlane(ntl[0]);
    REP(10) { pg8::Gemm g{H2b, Wgu_t, 0, 0, D, elist}; MoeOrder S; S.init(NTL, 8, c.nb, c.bid, tile_e, tile_b); EpiSwiglu E{ACTb, b_gate_up};
      pg8::gemm_phase<EpiSwiglu, MoeOrder, true, true, true>(c.lds, g, S, E); }
    GRID_BAR();
    REP(11) { pg8::Gemm g{ACTb, Wd_t, 0, 0, DFF}; MoeOrder S; S.init(NTL, 4, c.nb, c.bid, tile_e, tile_b); EpiDown E{Yb, b_down, ewgt};
      pg8::gemm_phase<EpiDown, MoeOrder, true, true>(c.lds, g, S, E); }
    GRID_BAR();
    REP(12) { p_final(c, X1, Yb, slot_e, slot_pos, gcnt, norm_f_g, out); }
    if (PROBE_MASK & 8192) { for (int k = 0; k < 10; ++k) GRID_BAR(); }
}

extern "C" void kernel_launch(void* const* d_in, const int* in_sizes, int n_in, void* d_out, int out_size, void* d_ws, size_t ws_size, hipStream_t stream) {
    static int grid = 0;
    if (grid == 0) {
        if (n_in != 22 || in_sizes[0] != NTOK * D || out_size != NTOK * D || ws_size < WS_NEED) { fprintf(stderr, "kernel_launch: unexpected shapes (n_in %d, ws %zu)\n", n_in, ws_size); grid = -1; return; }
        int dev = 0, cus = 0, per_cu = 0;
        if (hipGetDevice(&dev) != hipSuccess || hipDeviceGetAttribute(&cus, hipDeviceAttributeMultiprocessorCount, dev) != hipSuccess) { grid = -1; return; }
        if (hipFuncSetAttribute((const void*)mega, hipFuncAttributeMaxDynamicSharedMemorySize, LDS_BYTES) != hipSuccess) { fprintf(stderr, "kernel_launch: hipFuncSetAttribute failed\n"); grid = -1; return; }
        if (hipOccupancyMaxActiveBlocksPerMultiprocessor(&per_cu, (const void*)mega, NTHR, LDS_BYTES) != hipSuccess || per_cu < 1) fprintf(stderr, "kernel_launch: occupancy query reports %d\n", per_cu);
        (void)hipGetLastError();
        grid = cus;
    }
    if (grid < 0) return;
    if (hipMemsetAsync((char*)d_ws + WS_CTL, 0, CTL_ZERO_BYTES, stream) != hipSuccess) { fprintf(stderr, "kernel_launch: memset failed\n"); return; }
    Args a{};
    for (int i = 0; i < 22; ++i) a.in[i] = (const float*)d_in[i];
    a.out = (float*)d_out; a.ws = (unsigned char*)d_ws; a.ph_lo = 0; a.ph_hi = 100;
    hipLaunchKernelGGL(mega, dim3(grid), dim3(NTHR), LDS_BYTES, stream, a);
#if PROBE_MASK & 131072
    (void)hipMemsetAsync((char*)d_ws + WS_CTL, 0, CTL_ZERO_BYTES, stream); hipLaunchKernelGGL(mega, dim3(grid), dim3(NTHR), LDS_BYTES, stream, a);
#endif
    const hipError_t le = hipPeekAtLastError();
    if (le != hipSuccess) fprintf(stderr, "kernel_launch: launch failed: %s\n", hipGetErrorName(le));
}
```

```cpp
#include <hip/hip_runtime.h>
#include <cstdio>
#include <cstdint>
#include <cmath>

#define GAS __attribute__((address_space(1)))
#define LAS __attribute__((address_space(3)))
typedef GAS unsigned gu32;
#define RLX_AGENT __ATOMIC_RELAXED, __HIP_MEMORY_SCOPE_AGENT

constexpr int NWAVES = 8, NTHR = 512;
constexpr int D = 1024, BATCH = 2, SEQ = 8192, NTOK = BATCH * SEQ;
constexpr int DNH = 4, DNW = 512;
constexpr int SGD = 128, SGW = 512, SGC = 128;
constexpr int NE = 32, TOPK = 4, DFF = 1024;
constexpr int OFF_Z = 1536, OFF_BETA = 2048, OFF_A = 2052, OFF_U = 2056, OFF_V = 2568, OFF_GA = 3080, OFF_GB = 4104, INC = 5128;
constexpr float RMS_EPS = 1e-6f, LN_EPS = 1e-5f, L2_EPS = 1e-6f;

constexpr size_t MiB = 1u << 20;
constexpr size_t WS_CTL = 0, CTL_ZERO_BYTES = 1 * MiB;
constexpr int CW_BAR = 4096;
constexpr int CW_CNT = 16384;
constexpr size_t WS_BASE = 2 * MiB;
constexpr size_t WS_NEED = 1020 * MiB;
constexpr int LDSCTL_OFF = 0, MISC_OFF = 320, RING_OFF = 1024, RING_BYTES = 131072, EXTRA_OFF = RING_OFF + RING_BYTES, LDS_BYTES = 147456;

#define XB_TMO      128
#define XB_XCNT(j)  (256  + 64 * (j))
#define XB_XSUB(j)  (1280 + 64 * (j))
#define XB_XGEN(j)  (2304 + 64 * (j))
#define XB_TOP      3328
#define XB_TOPGEN   3392
#define XCD_BAR_WORDS 3456
#define XB_SPIN_CAP (1u << 22)
__device__ __forceinline__ unsigned xb_ld(unsigned* p)              { return __hip_atomic_load(p, __ATOMIC_RELAXED, __HIP_MEMORY_SCOPE_AGENT); }
__device__ __forceinline__ unsigned xb_add(unsigned* p, unsigned v) { return __hip_atomic_fetch_add(p, v, __ATOMIC_RELAXED, __HIP_MEMORY_SCOPE_AGENT); }
__device__ __forceinline__ unsigned xb_xcc_id() { return (unsigned)__builtin_amdgcn_s_getreg((3 << 11) | 20) & 0xFu; }
#define XB_SPIN(cond, bar) do { unsigned _sp = 0; while (cond) { __builtin_amdgcn_s_sleep(1); \
    if ((++_sp & 255u) == 0u) { if (xb_ld(&(bar)[XB_TMO])) break; if (_sp > XB_SPIN_CAP) { atomicAdd(&(bar)[XB_TMO], 1u); break; } } } } while (0)
struct XcdBarrier { unsigned* bar; unsigned x; volatile LAS unsigned* st; };
__device__ __forceinline__ XcdBarrier xcd_barrier_post(unsigned* bar, volatile LAS unsigned* st) {
    XcdBarrier b; b.bar = bar; b.x = xb_xcc_id(); b.st = st;
    if (threadIdx.x == 0) (void)xb_add(&bar[XB_XCNT(b.x)], 1u);
    return b;
}
__device__ __forceinline__ void xcd_barrier_complete(unsigned* bar, unsigned x, unsigned& nloc, unsigned& nx) {
    const unsigned G = gridDim.x * gridDim.y * gridDim.z;
    unsigned sum, cnt, mine, sp = 0u;
    for (;;) {
        sum = 0u; cnt = 0u; mine = 0u;
#pragma unroll
        for (unsigned j = 0; j < 16; ++j) { const unsigned c = xb_ld(&bar[XB_XCNT(j)]); sum += c; cnt += (c > 0u) ? 1u : 0u; mine = (j == x) ? c : mine; }
        if (sum == G) break;
        __builtin_amdgcn_s_sleep(1);
        if ((++sp & 255u) == 0u) { if (xb_ld(&bar[XB_TMO])) break; if (sp > XB_SPIN_CAP) { atomicAdd(&bar[XB_TMO], 1u); break; } }
    }
    nloc = mine > 0u ? mine : 1u; nx = cnt > 0u ? cnt : 1u;
}
__device__ __forceinline__ void xcd_barrier(const XcdBarrier& b) {
    asm volatile("s_waitcnt vmcnt(0)" ::: "memory");
    __syncthreads();
    if (threadIdx.x == 0) {
        unsigned* bar = b.bar;
        __builtin_amdgcn_s_waitcnt(0);
        unsigned nloc = b.st[0], nx = b.st[1];
        if (nloc == 0u) { xcd_barrier_complete(bar, b.x, nloc, nx); b.st[0] = nloc; b.st[1] = nx; }
        const unsigned old = xb_add(&bar[XB_XSUB(b.x)], 1u);
        const unsigned gen = old / nloc;
        if (old + 1u == (gen + 1u) * nloc) {
            __builtin_amdgcn_fence(__ATOMIC_RELEASE, "agent");
            asm volatile("s_waitcnt vmcnt(0)" ::: "memory");
            const unsigned og = xb_add(&bar[XB_TOP], 1u);
            const unsigned tg = og / nx;
            if (og + 1u == (tg + 1u) * nx) xb_add(&bar[XB_TOPGEN], 1u);
            else XB_SPIN(xb_ld(&bar[XB_TOPGEN]) == tg, bar);
            __builtin_amdgcn_fence(__ATOMIC_ACQUIRE, "agent");
            xb_add(&bar[XB_XGEN(b.x)], 1u);
            asm volatile("s_waitcnt vmcnt(0)" ::: "memory");
        } else {
            XB_SPIN(xb_ld(&bar[XB_XGEN(b.x)]) == gen, bar);
            __builtin_amdgcn_fence(__ATOMIC_ACQUIRE, "agent");
            asm volatile("s_waitcnt vmcnt(0)" ::: "memory");
        }
    }
    __syncthreads();
}

__device__ __forceinline__ float dpp_xor1(float v) { return __builtin_bit_cast(float, __builtin_amdgcn_update_dpp(0, __builtin_bit_cast(int, v), 0xB1, 0xF, 0xF, true)); }
__device__ __forceinline__ float dpp_xor2(float v) { return __builtin_bit_cast(float, __builtin_amdgcn_update_dpp(0, __builtin_bit_cast(int, v), 0x4E, 0xF, 0xF, true)); }
__device__ __forceinline__ float dpp_qrev(float v) { return __builtin_bit_cast(float, __builtin_amdgcn_update_dpp(0, __builtin_bit_cast(int, v), 0x1B, 0xF, 0xF, true)); }
__device__ __forceinline__ float dpp_hmir(float v) { return __builtin_bit_cast(float, __builtin_amdgcn_update_dpp(0, __builtin_bit_cast(int, v), 0x141, 0xF, 0xF, true)); }
__device__ __forceinline__ float dpp_rmir(float v) { return __builtin_bit_cast(float, __builtin_amdgcn_update_dpp(0, __builtin_bit_cast(int, v), 0x140, 0xF, 0xF, true)); }
__device__ __forceinline__ float dpp_ror8(float v) { return __builtin_bit_cast(float, __builtin_amdgcn_update_dpp(0, __builtin_bit_cast(int, v), 0x128, 0xF, 0xF, true)); }
__device__ __forceinline__ float dpp_xor4(float v) { return dpp_qrev(dpp_hmir(v)); }
__device__ __forceinline__ float row16_sum(float v) { v += dpp_xor1(v); v += dpp_xor2(v); v += dpp_hmir(v); v += dpp_rmir(v); return v; }
__device__ __forceinline__ float rdlane(float v, int l) { return __builtin_bit_cast(float, __builtin_amdgcn_readlane(__builtin_bit_cast(int, v), l)); }
__device__ __forceinline__ float wave_sum(float v) { v = row16_sum(v); return (rdlane(v, 0) + rdlane(v, 16)) + (rdlane(v, 32) + rdlane(v, 48)); }
__device__ __forceinline__ void swap32(float& a, float& b) { asm volatile("s_nop 1\n\tv_permlane32_swap_b32 %0, %1" : "+v"(a), "+v"(b)); }
__device__ __forceinline__ void swap16(float& a, float& b) { asm volatile("s_nop 1\n\tv_permlane16_swap_b32 %0, %1" : "+v"(a), "+v"(b)); }
#define BFLY_SW32(acc, n) _Pragma("unroll") for (int i_ = 0; i_ < (n) / 2; ++i_) { float x_ = acc[i_], y_ = acc[i_ + (n) / 2]; swap32(x_, y_); acc[i_] = x_ + y_; }
#define BFLY_SW16(acc, n) _Pragma("unroll") for (int i_ = 0; i_ < (n) / 2; ++i_) { float x_ = acc[i_], y_ = acc[i_ + (n) / 2]; swap16(x_, y_); acc[i_] = x_ + y_; }
#define BFLY_DPP(acc, n, m, PERM) _Pragma("unroll") for (int i_ = 0; i_ < (n) / 2; ++i_) { const bool up_ = (lane & (m)) != 0; const float send_ = up_ ? acc[i_] : acc[i_ + (n) / 2]; const float keep_ = up_ ? acc[i_ + (n) / 2] : acc[i_]; acc[i_] = keep_ + PERM(send_); }
__device__ __forceinline__ float sigmoidf_(float x) { return 1.f / (1.f + expf(-x)); }
__device__ __forceinline__ float siluf_(float x) { return x / (1.f + expf(-x)); }
__device__ __forceinline__ float geluf_(float x) { return 0.5f * x * (1.f + erff(x * 0.70710678118654752f)); }
__device__ __forceinline__ float softplusf_(float x) { return x > 20.f ? x : log1pf(expf(x)); }

struct Ctx { int bid, nb, tid, lane, wave; LAS unsigned char* lds; LAS unsigned char* lds0; };

namespace pg8 {
#define PG8_LAS __attribute__((address_space(3)))
typedef unsigned short bf16_t;
typedef short bf16x8 __attribute__((ext_vector_type(8)));
typedef float f32x4 __attribute__((ext_vector_type(4)));
typedef unsigned u32x4 __attribute__((ext_vector_type(4)));
constexpr int BM = 256, BK = 64, HALF = 128, HTB = HALF * BK * 2  , STAGE_BYTES = 8 * HTB, NXCD = 8, WGM = 8;

__host__ __device__ __forceinline__ int lds_byte(int r, int c) { const int st = (r >> 4) * 2 + (c >> 5), rr = r & 15, cc = c & 31, ob = rr * 64 + cc * 2; return st * 1024 + (ob ^ (((ob >> 9) & 1) << 5)); }
__host__ __device__ __forceinline__ void stage_rc(int b, int& R, int& C) { const int st = b / 1024, sb = b % 1024, swz = sb ^ (((sb >> 9) & 1) << 5); R = (st >> 1) * 16 + swz / 64; C = (st & 1) * 32 + (swz % 64) / 2; }
__host__ __device__ __forceinline__ int perm32(int rho) { const int n = rho >> 4, i = rho & 15; return 8 * (i >> 2) + 4 * n + (i & 3); }

struct Unit { int pm, pn, x0, x1, rb; };
struct Gemm { const bf16_t* A; const bf16_t* Bt; int M, N, K; const int* rows; };

struct StaticOrder {
    int nM, nN, nwg, G, c;
    __host__ __device__ void init(int M, int N, int G_, int c_) { nM = M / BM; nN = N / BM; nwg = nM * nN; G = G_; c = c_; }
    __host__ __device__ bool next(int i, Unit& u) const {
        const long L = (long)i * G + c; if (L >= nwg) return false;
        int wgid = (int)L; { const int q = nwg / NXCD, r = nwg % NXCD, xcd = wgid % NXCD, off = wgid / NXCD; wgid = (xcd < r ? xcd * (q + 1) : r * (q + 1) + (xcd - r) * q) + off; }
        const int nig = WGM * nN, gid = wgid / nig, fm = gid * WGM, gsz = (nM - fm) < WGM ? (nM - fm) : WGM;
        u.pm = fm + ((wgid % nig) % gsz); u.pn = (wgid % nig) / gsz; u.x0 = 0; u.x1 = u.pn; u.rb = 0; return true;
    }
    __device__ __forceinline__ void a_ready(const Unit&) const {}
    __device__ __forceinline__ void done(const Unit&) const {}
};


template <class Epi, class Sched, bool ALIGN_EPI = false, bool SP2 = false, bool GATHER = false, int BAUX = 0>
__device__ __forceinline__ void gemm_phase(PG8_LAS unsigned char* lds, const Gemm g, const Sched& S, const Epi& E) {
    int tid_ = threadIdx.x; asm volatile("" : "+v"(tid_));
    const int tid = tid_, wid = __builtin_amdgcn_readfirstlane(tid >> 6), lane = tid & 63, wr = wid >> 2, wc = wid & 3, fr = lane & 15, fq = lane >> 4;
    const int K = g.K, nt = K / BK;
    unsigned voffA[2], voffB[2]; int gR[2]; unsigned gC2[2];
#pragma unroll
    for (int i = 0; i < 2; ++i) { int R, C; stage_rc(tid * 16 + i * 8192, R, C); const int Rb = Epi::PERM ? ((R & ~31) + perm32(R & 31)) : R;
        voffA[i] = (unsigned)(R * K + C) * 2u; voffB[i] = (unsigned)(Rb * K + C) * 2u; gR[i] = R; gC2[i] = (unsigned)C * 2u; }
    static_assert(!GATHER || SP2, "GATHER is implemented for the SP2 loop only");
    unsigned gcur[2][2], gnxt[2][2]; int graw[4];
#define PG8_STAGE_A(bufoff, kptr, ktile, h, use_next) do { if constexpr (GATHER) { const unsigned sv_[2] = {(use_next) ? gnxt[h][0] : gcur[h][0], (use_next) ? gnxt[h][1] : gcur[h][1]}; \
        PG8_STAGE(bufoff, gA0 + (size_t)(ktile) * kstep, sv_); } else { PG8_STAGE(bufoff, (kptr) + ((h) ? hstep : 0), voffA); } } while (0)
    const size_t kstep = (size_t)(BK * 2);
    const size_t hstep = (size_t)HALF * K * 2;
    const size_t tstep = 2 * hstep;
    const unsigned ldsw = (unsigned)wid * 1024u;
    const int aoff = lds_byte(wr * 64 + fr, fq * 8), boff = lds_byte(wc * 32 + fr, fq * 8);
#define PG8_SA(b, h) (((b) * 2 + (h)) * HTB)
#define PG8_SB(b, h) ((4 + (b) * 2 + (h)) * HTB)
#define PG8_STAGE(bufoff, gbase, voff) do { _Pragma("unroll") for (int _i = 0; _i < 2; ++_i) \
        __builtin_amdgcn_global_load_lds((const unsigned*)((const char*)(gbase) + (voff)[_i]), (PG8_LAS unsigned*)(lds + (bufoff) + ldsw + _i * 8192), 16, 0, 0); } while (0)
#define PG8_STAGE_B(bufoff, gbase, voff) do { _Pragma("unroll") for (int _i = 0; _i < 2; ++_i) \
        __builtin_amdgcn_global_load_lds((const unsigned*)((const char*)(gbase) + (voff)[_i]), (PG8_LAS unsigned*)(lds + (bufoff) + ldsw + _i * 8192), 16, 0, BAUX); } while (0)
#define PG8_LDA(dst, b, h) do { _Pragma("unroll") for (int m = 0; m < 4; ++m) _Pragma("unroll") for (int k = 0; k < 2; ++k) dst[m][k] = *(const PG8_LAS bf16x8*)(lds + PG8_SA(b, h) + aoff + m * 2048 + k * 1024); } while (0)
#define PG8_LDB(dst, b, h) do { _Pragma("unroll") for (int n = 0; n < 2; ++n) _Pragma("unroll") for (int k = 0; k < 2; ++k) dst[n][k] = *(const PG8_LAS bf16x8*)(lds + PG8_SB(b, h) + boff + n * 2048 + k * 1024); } while (0)
#define PG8_MMA(ai, bj, At, Bt) do { __builtin_amdgcn_s_setprio(1); _Pragma("unroll") for (int m = 0; m < 4; ++m) _Pragma("unroll") for (int n = 0; n < 2; ++n) _Pragma("unroll") for (int k = 0; k < 2; ++k) \
        acc[ai][bj][m][n] = __builtin_amdgcn_mfma_f32_16x16x32_bf16(Bt[n][k], At[m][k], acc[ai][bj][m][n], 0, 0, 0); __builtin_amdgcn_s_setprio(0); } while (0)
#define PG8_WAIT_V(n) asm volatile("s_waitcnt vmcnt(" #n ")" ::: "memory")
#define PG8_WAIT_L(n) asm volatile("s_waitcnt lgkmcnt(" #n ")" ::: "memory")
#define PG8_BAR __builtin_amdgcn_s_barrier()
#define PG8_SCHED __builtin_amdgcn_sched_barrier(0)
    Unit cur, nxt; int ui = 0;
    if (!S.next(0, cur)) return;
    f32x4 acc[2][2][4][2];
#pragma unroll
    for (int a = 0; a < 2; ++a)
#pragma unroll
        for (int b = 0; b < 2; ++b)
#pragma unroll
            for (int m = 0; m < 4; ++m)
#pragma unroll
                for (int n = 0; n < 2; ++n) acc[a][b][m][n] = (f32x4){0.f, 0.f, 0.f, 0.f};
    bf16x8 At[4][2], B0[2][2], B1[2][2];
    const char* cA = (const char*)g.A + (size_t)cur.pm * tstep; const char* cB = (const char*)g.Bt + (size_t)cur.pn * tstep;
    const char* const gA0 = (const char*)g.A;
    if constexpr (GATHER) {
#pragma unroll
        for (int h = 0; h < 2; ++h)
#pragma unroll
            for (int i = 0; i < 2; ++i) { gcur[h][i] = (unsigned)g.rows[cur.rb + h * HALF + gR[i]] * (unsigned)(K * 2) + gC2[i]; gnxt[h][i] = gcur[h][i]; } }
    S.a_ready(cur);
    if constexpr (SP2) {
        PG8_STAGE_B(PG8_SB(0, 0), cB, voffB); PG8_STAGE_B(PG8_SB(0, 1), cB + hstep, voffB); PG8_STAGE_A(PG8_SA(0, 0), cA, 0, 0, false); PG8_STAGE_A(PG8_SA(0, 1), cA, 0, 1, false);
        if (wr == 1) PG8_BAR;
        PG8_WAIT_V(2); PG8_BAR;
        PG8_STAGE_B(PG8_SB(1, 0), cB + kstep, voffB); PG8_STAGE_A(PG8_SA(1, 0), cA + kstep, 1, 0, false); PG8_STAGE_B(PG8_SB(1, 1), cB + hstep + kstep, voffB);
        PG8_WAIT_V(6); PG8_BAR;
    } else {
        PG8_STAGE_B(PG8_SB(0, 0), cB, voffB); PG8_STAGE(PG8_SA(0, 0), cA, voffA); PG8_STAGE_B(PG8_SB(0, 1), cB + hstep, voffB); PG8_STAGE(PG8_SA(0, 1), cA + hstep, voffA);
        if (wr == 1) PG8_BAR;
        PG8_WAIT_V(4); PG8_BAR;
        PG8_STAGE_B(PG8_SB(1, 0), cB + kstep, voffB); PG8_STAGE(PG8_SA(1, 0), cA + kstep, voffA); PG8_STAGE_B(PG8_SB(1, 1), cB + hstep + kstep, voffB);
        PG8_WAIT_V(6); PG8_BAR;
    }
    for (;;) {
        const bool has_next = S.next(ui + 1, nxt);
        const char* nA = has_next ? (const char*)g.A + (size_t)nxt.pm * tstep : cA; const char* nB = has_next ? (const char*)g.Bt + (size_t)nxt.pn * tstep : cB;
        if constexpr (GATHER) { if (has_next) {
#pragma unroll
            for (int h = 0; h < 2; ++h)
#pragma unroll
                for (int i = 0; i < 2; ++i) asm volatile("global_load_dword %0, %1, off" : "=v"(graw[h * 2 + i]) : "v"(g.rows + (nxt.rb + h * HALF + gR[i])) : "memory"); } }
        for (int t = 0; t < nt; t += 2) {
            const bool last = (t == nt - 2);
            const char* a1 = cA + (size_t)(t + 1) * kstep;
            const char* a2 = last ? nA : cA + (size_t)(t + 2) * kstep; const char* b2 = last ? nB : cB + (size_t)(t + 2) * kstep;
            const char* a3 = a2 + kstep; const char* b3 = b2 + kstep;
            if (last && has_next) S.a_ready(nxt);
            if constexpr (GATHER) { if (last) { if (has_next) { asm volatile("" : "+v"(graw[0]), "+v"(graw[1]), "+v"(graw[2]), "+v"(graw[3]));
#pragma unroll
                    for (int h = 0; h < 2; ++h)
#pragma unroll
                        for (int i = 0; i < 2; ++i) gnxt[h][i] = (unsigned)graw[h * 2 + i] * (unsigned)(K * 2) + gC2[i]; }
                else {
#pragma unroll
                    for (int h = 0; h < 2; ++h)
#pragma unroll
                        for (int i = 0; i < 2; ++i) gnxt[h][i] = gcur[h][i]; } } }
            const int kt2 = last ? 0 : t + 2;
            if constexpr (SP2) {
            PG8_LDB(B0, 0, 0); PG8_LDB(B1, 0, 1); PG8_SCHED; PG8_LDA(At, 0, 0); PG8_STAGE_A(PG8_SA(1, 1), a1, t + 1, 1, false);
            PG8_WAIT_V(8); PG8_WAIT_L(0); PG8_BAR; PG8_MMA(0, 0, At, B0); PG8_MMA(0, 1, At, B1); PG8_BAR; PG8_SCHED;
            PG8_LDA(At, 0, 1); PG8_STAGE_B(PG8_SB(0, 0), b2, voffB); PG8_STAGE_B(PG8_SB(0, 1), b2 + hstep, voffB); PG8_STAGE_A(PG8_SA(0, 0), a2, kt2, 0, last);
            PG8_WAIT_V(8); PG8_WAIT_L(0); PG8_BAR; PG8_MMA(1, 0, At, B0); PG8_MMA(1, 1, At, B1); PG8_BAR; PG8_SCHED;
            PG8_LDB(B0, 1, 0); PG8_LDB(B1, 1, 1); PG8_SCHED; PG8_LDA(At, 1, 0); PG8_STAGE_A(PG8_SA(0, 1), a2, kt2, 1, last);
            PG8_WAIT_V(8); PG8_WAIT_L(0); PG8_BAR; PG8_MMA(0, 0, At, B0); PG8_MMA(0, 1, At, B1); PG8_BAR; PG8_SCHED;
            PG8_LDA(At, 1, 1); PG8_STAGE_B(PG8_SB(1, 0), b3, voffB); PG8_STAGE_B(PG8_SB(1, 1), b3 + hstep, voffB); PG8_STAGE_A(PG8_SA(1, 0), a3, kt2 + 1, 0, last);
            PG8_WAIT_V(8); PG8_WAIT_L(0); PG8_BAR; PG8_MMA(1, 0, At, B0); PG8_MMA(1, 1, At, B1); PG8_BAR; PG8_SCHED;
            } else {
            PG8_LDB(B0, 0, 0); PG8_SCHED; PG8_LDA(At, 0, 0); PG8_STAGE(PG8_SA(1, 1), a1 + hstep, voffA);
            PG8_WAIT_L(8); PG8_BAR; PG8_WAIT_L(0); PG8_MMA(0, 0, At, B0); PG8_BAR; PG8_SCHED;
            PG8_LDB(B1, 0, 1); PG8_STAGE_B(PG8_SB(0, 0), b2, voffB);
            PG8_BAR; PG8_WAIT_L(0); PG8_MMA(0, 1, At, B1); PG8_BAR;
            PG8_LDA(At, 0, 1); PG8_STAGE(PG8_SA(0, 0), a2, voffA);
            PG8_BAR; PG8_WAIT_L(0); PG8_MMA(1, 0, At, B0); PG8_BAR; PG8_SCHED;
            PG8_STAGE_B(PG8_SB(0, 1), b2 + hstep, voffB);
            PG8_WAIT_V(6); PG8_BAR; PG8_MMA(1, 1, At, B1); PG8_BAR;
            PG8_LDB(B0, 1, 0); PG8_SCHED; PG8_LDA(At, 1, 0); PG8_STAGE(PG8_SA(0, 1), a2 + hstep, voffA);
            PG8_WAIT_L(8); PG8_BAR; PG8_WAIT_L(0); PG8_MMA(0, 0, At, B0); PG8_BAR; PG8_SCHED;
            PG8_LDB(B1, 1, 1); PG8_STAGE_B(PG8_SB(1, 0), b3, voffB);
            PG8_BAR; PG8_WAIT_L(0); PG8_MMA(0, 1, At, B1); PG8_BAR;
            PG8_LDA(At, 1, 1); PG8_STAGE(PG8_SA(1, 0), a3, voffA);
            PG8_BAR; PG8_WAIT_L(0); PG8_MMA(1, 0, At, B0); PG8_BAR; PG8_SCHED;
            PG8_STAGE_B(PG8_SB(1, 1), b3 + hstep, voffB);
            PG8_WAIT_V(6); PG8_BAR; PG8_MMA(1, 1, At, B1); PG8_BAR;
            }
        }
        if constexpr (ALIGN_EPI) { if (wr == 0) PG8_BAR; }
        if constexpr (!Epi::AFTER_DRAIN) { E(acc, cur, wr, wc, fr, fq); S.done(cur); }
        if (!has_next) break;
        if (!E.keep_acc(cur)) {
#pragma unroll
        for (int a = 0; a < 2; ++a)
#pragma unroll
            for (int b = 0; b < 2; ++b)
#pragma unroll
                for (int m = 0; m < 4; ++m)
#pragma unroll
                    for (int n = 0; n < 2; ++n) acc[a][b][m][n] = (f32x4){0.f, 0.f, 0.f, 0.f};
        }
        cur = nxt; cA = nA; cB = nB; ++ui;
        if constexpr (GATHER) {
#pragma unroll
            for (int h = 0; h < 2; ++h)
#pragma unroll
                for (int i = 0; i < 2; ++i) gcur[h][i] = gnxt[h][i]; }
        if constexpr (ALIGN_EPI) { if (wr == 1) PG8_BAR; }
    }
    PG8_WAIT_V(0);
    if constexpr (!ALIGN_EPI) { if (wr == 0) PG8_BAR; }
    PG8_BAR;
    if constexpr (Epi::AFTER_DRAIN) { E.fused(acc, cur, wr, wc, fr, fq, lds, wid, lane); S.done(cur); }
#undef PG8_SA
#undef PG8_SB
#undef PG8_STAGE
#undef PG8_STAGE_B
#undef PG8_STAGE_A
#undef PG8_LDA
#undef PG8_LDB
#undef PG8_MMA
#undef PG8_WAIT_V
#undef PG8_WAIT_L
#undef PG8_BAR
#undef PG8_SCHED
}
}
typedef unsigned short bf16;
typedef unsigned v4u __attribute__((ext_vector_type(4)));
typedef unsigned v2u __attribute__((ext_vector_type(2)));
typedef float f32x4 __attribute__((ext_vector_type(4)));
typedef short bf16x8 __attribute__((ext_vector_type(8)));
#define MFMA16(a, b, c) __builtin_amdgcn_mfma_f32_16x16x32_bf16((a), (b), (c), 0, 0, 0)
__device__ __forceinline__ bf16x8 as_frag(const v4u& x) { return __builtin_bit_cast(bf16x8, x); }
#define LDS_WAIT() asm volatile("s_waitcnt lgkmcnt(0)" ::: "memory")
#define VM_WAIT() asm volatile("s_waitcnt vmcnt(0)" ::: "memory")
typedef float cvt_f32x2 __attribute__((ext_vector_type(2)));
typedef __bf16 cvt_bf16x2 __attribute__((ext_vector_type(2)));
__device__ __forceinline__ unsigned cvt_pk_bf16(float lo, float hi) { const cvt_f32x2 v = {lo, hi}; return __builtin_bit_cast(unsigned, __builtin_convertvector(v, cvt_bf16x2)); }
__device__ __forceinline__ v4u ldnt4(const void* p) { return __builtin_nontemporal_load((const v4u*)p); }
__device__ __forceinline__ v2u ldnt2(const void* p) { return __builtin_nontemporal_load((const v2u*)p); }
__device__ __forceinline__ float bf_lo(unsigned u) { return __uint_as_float(u << 16); }
__device__ __forceinline__ float bf_hi(unsigned u) { return __uint_as_float(u & 0xffff0000u); }

template <bool NT = false>
__device__ __forceinline__ void tr_item(const float* __restrict__ src, int ldn, int k0, int nsrc0, bf16* dst, int K, int ndst0, LAS float* scr, int lane) {
    const int c4 = (lane & 15) * 4, kr = lane >> 4;
#pragma unroll 4
    for (int i = 0; i < 16; ++i) { const int kk = 4 * i + kr; const f32x4* gp = (const f32x4*)(src + (size_t)(k0 + kk) * ldn + nsrc0 + c4); const f32x4 v = NT ? __builtin_nontemporal_load(gp) : *gp;
        LAS float* s = scr + kk * 65 + c4; s[0] = v[0]; s[1] = v[1]; s[2] = v[2]; s[3] = v[3]; }
    LDS_WAIT();
    const int kc = lane & 7, nr = lane >> 3;
#pragma unroll
    for (int jj = 0; jj < 8; ++jj) { const int n = 8 * jj + nr; const LAS float* s = scr + (8 * kc) * 65 + n;
        v4u o; o.x = cvt_pk_bf16(s[0], s[65]); o.y = cvt_pk_bf16(s[130], s[195]); o.z = cvt_pk_bf16(s[260], s[325]); o.w = cvt_pk_bf16(s[390], s[455]);
        v4u* dp = (v4u*)(dst + (size_t)(ndst0 + n) * K + k0 + 8 * kc); if (NT) __builtin_nontemporal_store(o, dp); else *dp = o; }
    LDS_WAIT();
}
__device__ __forceinline__ void p_convert_moe(const Ctx& c, const float* w_gate_up, const float* w_down, bf16* Wgu_t, bf16* Wd_t) {
    LAS float* scr = (LAS float*)c.lds + c.wave * (64 * 65);
    constexpr int I_GU = NE * 16 * 32, I_D = NE * 16 * 16;
    for (int it = c.bid * NWAVES + c.wave; it < I_GU + I_D; it += c.nb * NWAVES) {
        if (it < I_GU) { const int e = it >> 9, r = it & 511, kb = r >> 5, nbk = r & 31, R0 = nbk * 64, pn = R0 >> 8, rr = R0 & 255, bj = rr >> 7, j0 = rr & 127;
            tr_item<true>(w_gate_up + (size_t)e * D * 2 * DFF, 2 * DFF, kb * 64, bj * DFF + 128 * pn + j0, Wgu_t + (size_t)e * 2 * DFF * D, D, R0, scr, c.lane); }
        else { const int r2 = it - I_GU, e = r2 >> 8, r = r2 & 255, kb = r >> 4, nbk = r & 15;
            tr_item<true>(w_down + (size_t)e * DFF * D, D, kb * 64, nbk * 64, Wd_t + (size_t)e * D * DFF, DFF, nbk * 64, scr, c.lane); }
    }
}

__device__ __forceinline__ float f4c(const float4& v, int i) { return i == 0 ? v.x : (i == 1 ? v.y : (i == 2 ? v.z : v.w)); }
__device__ __forceinline__ void p_router(const Ctx& c, const float* __restrict__ X1, const float* __restrict__ g2, const float* __restrict__ wr, const float* __restrict__ br, bf16* __restrict__ H2, int* __restrict__ slot_e, int* __restrict__ slot_pos, int* __restrict__ elist, float* __restrict__ ewgt, unsigned* gcnt, int reps = 1) {
    LAS f32x4* WL = (LAS f32x4*)c.lds;
    LAS float* LG = (LAS float*)(c.lds0 + EXTRA_OFF);
    LAS int* HIST = (LAS int*)(c.lds0 + EXTRA_OFF + 8192);
    LAS int* BASE = HIST + 32;
    LAS int* SELE = BASE + 32;
    LAS int* SELR = SELE + 256;
    LAS float* SELW = (LAS float*)(SELR + 256);
    const int lane = c.lane;
    { f32x4 wv[16];
#pragma unroll
      for (int i = 0; i < 16; ++i) wv[i] = ((const f32x4*)wr)[c.tid + NTHR * i];
#pragma unroll
      for (int i = 0; i < 16; ++i) { const int idx = c.tid + NTHR * i, k = idx >> 3, q = idx & 7, l = (k & 255) >> 2, cc = k & 3, j = k >> 8; WL[((j * 4 + cc) * 8 + q) * 64 + l] = wv[i]; } }
    __syncthreads();
    for (int blk = c.bid; blk < NTOK / 64; blk += c.nb) {
        if (c.tid < 32) HIST[c.tid] = 0;
        __syncthreads();
        for (int pp = 0; pp < 4 * reps; ++pp) { const int p = pp & 3;
            const size_t t0 = (size_t)blk * 64 + c.wave * 8 + 2 * p;
            float4 xa[4], xb[4]; float sa = 0.f, sb = 0.f;
#pragma unroll
            for (int j = 0; j < 4; ++j) { xa[j] = ((const float4*)(X1 + t0 * D))[lane + 64 * j]; xb[j] = ((const float4*)(X1 + (t0 + 1) * D))[lane + 64 * j];
                sa += xa[j].x * xa[j].x + xa[j].y * xa[j].y + xa[j].z * xa[j].z + xa[j].w * xa[j].w; sb += xb[j].x * xb[j].x + xb[j].y * xb[j].y + xb[j].z * xb[j].z + xb[j].w * xb[j].w; }
            const float ra = rsqrtf(wave_sum(sa) * (1.f / D) + RMS_EPS), rb = rsqrtf(wave_sum(sb) * (1.f / D) + RMS_EPS);
#pragma unroll
            for (int j = 0; j < 4; ++j) { const float4 g = ((const float4*)g2)[lane + 64 * j];
                xa[j].x *= ra * g.x; xa[j].y *= ra * g.y; xa[j].z *= ra * g.z; xa[j].w *= ra * g.w; xb[j].x *= rb * g.x; xb[j].y *= rb * g.y; xb[j].z *= rb * g.z; xb[j].w *= rb * g.w;
                v2u oa, ob; oa.x = cvt_pk_bf16(xa[j].x, xa[j].y); oa.y = cvt_pk_bf16(xa[j].z, xa[j].w); ob.x = cvt_pk_bf16(xb[j].x, xb[j].y); ob.y = cvt_pk_bf16(xb[j].z, xb[j].w);
                ((v2u*)(H2 + t0 * D))[lane + 64 * j] = oa; ((v2u*)(H2 + (t0 + 1) * D))[lane + 64 * j] = ob; }
            float acc[64];
#pragma unroll
            for (int i = 0; i < 64; ++i) acc[i] = 0.f;
#pragma unroll
            for (int j = 0; j < 4; ++j)
#pragma unroll
                for (int cc = 0; cc < 4; ++cc) { const float ha = f4c(xa[j], cc), hb = f4c(xb[j], cc);
#pragma unroll
                    for (int q = 0; q < 8; ++q) { const f32x4 w = WL[((j * 4 + cc) * 8 + q) * 64 + lane];
                        acc[4 * q + 0] = fmaf(ha, w.x, acc[4 * q + 0]); acc[4 * q + 1] = fmaf(ha, w.y, acc[4 * q + 1]); acc[4 * q + 2] = fmaf(ha, w.z, acc[4 * q + 2]); acc[4 * q + 3] = fmaf(ha, w.w, acc[4 * q + 3]);
                        acc[32 + 4 * q + 0] = fmaf(hb, w.x, acc[32 + 4 * q + 0]); acc[32 + 4 * q + 1] = fmaf(hb, w.y, acc[32 + 4 * q + 1]); acc[32 + 4 * q + 2] = fmaf(hb, w.z, acc[32 + 4 * q + 2]); acc[32 + 4 * q + 3] = fmaf(hb, w.w, acc[32 + 4 * q + 3]); } }
            BFLY_SW32(acc, 64) BFLY_SW16(acc, 32) BFLY_DPP(acc, 16, 8, dpp_ror8) BFLY_DPP(acc, 8, 4, dpp_xor4) BFLY_DPP(acc, 4, 2, dpp_xor2) BFLY_DPP(acc, 2, 1, dpp_xor1)
            LG[(c.wave * 8 + 2 * p + (lane >> 5)) * 32 + (lane & 31)] = acc[0] + br[lane & 31];
        }
        LDS_WAIT();
        if (lane < 8) {
            const int tokl = c.wave * 8 + lane;
            float l[NE];
#pragma unroll
            for (int j = 0; j < NE; ++j) l[j] = LG[tokl * 32 + j];
            int sel[4]; float sv[4];
#pragma unroll
            for (int k = 0; k < 4; ++k) { int bi = 0; float bv = -INFINITY;
#pragma unroll
                for (int j = 0; j < NE; ++j) { const bool better = l[j] > bv; bv = better ? l[j] : bv; bi = better ? j : bi; }
                sel[k] = bi; sv[k] = bv;
#pragma unroll
                for (int j = 0; j < NE; ++j) l[j] = (j == bi) ? -INFINITY : l[j]; }
            float den = 0.f, ex[4];
#pragma unroll
            for (int k = 0; k < 4; ++k) { ex[k] = expf(sv[k] - sv[0]); den += ex[k]; }
            const float inv = 1.f / den;
#pragma unroll
            for (int k = 0; k < 4; ++k) { SELE[tokl * 4 + k] = sel[k]; SELW[tokl * 4 + k] = ex[k] * inv; SELR[tokl * 4 + k] = atomicAdd((int*)(HIST + sel[k]), 1); }
        }
        __syncthreads();
        if (c.tid < 32) BASE[c.tid] = (int)__hip_atomic_fetch_add(gcnt + c.tid, (unsigned)HIST[c.tid], __ATOMIC_RELAXED, __HIP_MEMORY_SCOPE_AGENT);
        __syncthreads();
        if (c.tid < 256) { const int gi = blk * 256 + c.tid, e = SELE[c.tid], pos = BASE[e] + SELR[c.tid]; slot_e[gi] = e; slot_pos[gi] = pos; elist[e * NTOK + pos] = gi >> 2; ewgt[e * NTOK + pos] = SELW[c.tid]; }
    }
}

__device__ __forceinline__ void p_build_wrt(const Ctx& c, const float* __restrict__ wr, bf16* __restrict__ WrT) {
    for (int i = c.bid * NTHR + c.tid; i < NE * D; i += c.nb * NTHR) { const int e = i >> 10, k = i & 1023; const float w = wr[k * NE + e];
        const unsigned hi = cvt_pk_bf16(w, 0.f) & 0xffffu; const float rem = w - __uint_as_float(hi << 16);
        WrT[e * D + k] = (bf16)hi; WrT[NE * D + e * D + k] = (bf16)(cvt_pk_bf16(rem, 0.f) & 0xffffu); }
}
__device__ __forceinline__ void p_router2(const Ctx& c, const float* __restrict__ X1, const float* __restrict__ g2, const bf16* __restrict__ WrT, const float* __restrict__ br, bf16* __restrict__ H2,
                                          int* __restrict__ slot_e, int* __restrict__ slot_pos, int* __restrict__ elist, float* __restrict__ ewgt, unsigned* gcnt) {
    LAS unsigned char* HH = c.lds; LAS unsigned char* HL = c.lds + 65536;
    LAS float* LG = (LAS float*)(c.lds0 + EXTRA_OFF);
    LAS float* PART = LG + 1024;
    LAS int* HIST = (LAS int*)(PART + 1024);
    LAS int* BASE = HIST + 32; LAS int* SELE = BASE + 32; LAS int* SELR = SELE + 128; LAS float* SELW = (LAS float*)(SELR + 128);
    const int lane = c.lane, w = c.wave, fr = lane & 15, fq = lane >> 4;
    for (int blk = c.bid; blk < NTOK / 32; blk += c.nb) {
        if (c.tid < 32) HIST[c.tid] = 0;
#pragma unroll 1
        for (int p = 0; p < 2; ++p) {
            const int tl = w * 4 + 2 * p; const size_t t0 = (size_t)blk * 32 + tl;
            float4 xa[4], xb[4]; float sa = 0.f, sb = 0.f;
#pragma unroll
            for (int j = 0; j < 4; ++j) { xa[j] = ((const float4*)(X1 + t0 * D))[lane + 64 * j]; xb[j] = ((const float4*)(X1 + (t0 + 1) * D))[lane + 64 * j];
                sa += xa[j].x * xa[j].x + xa[j].y * xa[j].y + xa[j].z * xa[j].z + xa[j].w * xa[j].w; sb += xb[j].x * xb[j].x + xb[j].y * xb[j].y + xb[j].z * xb[j].z + xb[j].w * xb[j].w; }
            const float ra = rsqrtf(wave_sum(sa) * (1.f / D) + RMS_EPS), rb = rsqrtf(wave_sum(sb) * (1.f / D) + RMS_EPS);
#pragma unroll
            for (int j = 0; j < 4; ++j) { const float4 g = ((const float4*)g2)[lane + 64 * j];
                const float ha[4] = {xa[j].x * ra * g.x, xa[j].y * ra * g.y, xa[j].z * ra * g.z, xa[j].w * ra * g.w}, hb[4] = {xb[j].x * rb * g.x, xb[j].y * rb * g.y, xb[j].z * rb * g.z, xb[j].w * rb * g.w};
                v2u ah, al, bh, bl;
                ah.x = cvt_pk_bf16(ha[0], ha[1]); ah.y = cvt_pk_bf16(ha[2], ha[3]); bh.x = cvt_pk_bf16(hb[0], hb[1]); bh.y = cvt_pk_bf16(hb[2], hb[3]);
                al.x = cvt_pk_bf16(ha[0] - bf_lo(ah.x), ha[1] - bf_hi(ah.x)); al.y = cvt_pk_bf16(ha[2] - bf_lo(ah.y), ha[3] - bf_hi(ah.y));
                bl.x = cvt_pk_bf16(hb[0] - bf_lo(bh.x), hb[1] - bf_hi(bh.x)); bl.y = cvt_pk_bf16(hb[2] - bf_lo(bh.y), hb[3] - bf_hi(bh.y));
                ((v2u*)(H2 + t0 * D))[lane + 64 * j] = ah; ((v2u*)(H2 + (t0 + 1) * D))[lane + 64 * j] = bh;
                const int ch = (lane >> 1) + 32 * j, h8 = 8 * (lane & 1);
                const int oa = tl * 2048 + 16 * (ch ^ (tl & 15)) + h8, ob = (tl + 1) * 2048 + 16 * (ch ^ ((tl + 1) & 15)) + h8;
                *(LAS v2u*)(HH + oa) = ah; *(LAS v2u*)(HL + oa) = al; *(LAS v2u*)(HH + ob) = bh; *(LAS v2u*)(HL + ob) = bl; }
        }
        __syncthreads();
        { const int mt = w & 1, nt = (w >> 1) & 1, kh = w >> 2, tok = 16 * mt + fr; f32x4 acc = {0.f, 0.f, 0.f, 0.f};
            const bf16* wh = WrT + (size_t)(16 * nt + fr) * D + 8 * fq; const bf16* wl = wh + NE * D;
#pragma unroll 4
            for (int kk = 16 * kh; kk < 16 * kh + 16; ++kk) { const int off = tok * 2048 + 16 * ((4 * kk + fq) ^ (tok & 15));
                const bf16x8 ahi = *(const LAS bf16x8*)(HH + off), alo = *(const LAS bf16x8*)(HL + off);
                const bf16x8 bhi = as_frag(*(const v4u*)(wh + 32 * kk)), blo = as_frag(*(const v4u*)(wl + 32 * kk));
                acc = MFMA16(ahi, bhi, acc); acc = MFMA16(ahi, blo, acc); acc = MFMA16(alo, bhi, acc); }
            if (kh == 1) *(LAS f32x4*)(PART + ((mt * 2 + nt) * 64 + lane) * 4) = acc;
            __syncthreads();
            if (kh == 0) { const f32x4 pr = *(const LAS f32x4*)(PART + ((mt * 2 + nt) * 64 + lane) * 4); const float bb = br[16 * nt + fr];
#pragma unroll
                for (int r = 0; r < 4; ++r) LG[(16 * mt + 4 * fq + r) * 32 + 16 * nt + fr] = acc[r] + pr[r] + bb; } }
        __syncthreads();
        if (c.tid < 32) {
            const int tokl = c.tid;
            float l[NE];
#pragma unroll
            for (int j = 0; j < NE; ++j) l[j] = LG[tokl * 32 + j];
            int sel[4]; float sv[4];
#pragma unroll
            for (int k = 0; k < 4; ++k) { int bi = 0; float bv = -INFINITY;
#pragma unroll
                for (int j = 0; j < NE; ++j) { const bool better = l[j] > bv; bv = better ? l[j] : bv; bi = better ? j : bi; }
                sel[k] = bi; sv[k] = bv;
#pragma unroll
                for (int j = 0; j < NE; ++j) l[j] = (j == bi) ? -INFINITY : l[j]; }
            float den = 0.f, ex[4];
#pragma unroll
            for (int k = 0; k < 4; ++k) { ex[k] = expf(sv[k] - sv[0]); den += ex[k]; }
            const float inv = 1.f / den;
#pragma unroll
            for (int k = 0; k < 4; ++k) { SELE[tokl * 4 + k] = sel[k]; SELW[tokl * 4 + k] = ex[k] * inv; SELR[tokl * 4 + k] = atomicAdd((int*)(HIST + sel[k]), 1); }
        }
        __syncthreads();
        if (c.tid < 32) BASE[c.tid] = (int)__hip_atomic_fetch_add(gcnt + c.tid, (unsigned)HIST[c.tid], __ATOMIC_RELAXED, __HIP_MEMORY_SCOPE_AGENT);
        __syncthreads();
        if (c.tid < 128) { const int gi = blk * 128 + c.tid, e = SELE[c.tid], pos = BASE[e] + SELR[c.tid]; slot_e[gi] = e; slot_pos[gi] = pos; elist[e * NTOK + pos] = gi >> 2; ewgt[e * NTOK + pos] = SELW[c.tid]; }
        __syncthreads();
    }
}

struct MoeOrder {
    int nM, nN, nwg, G, c; const LAS unsigned char* tile_e; const LAS int* tile_b;
    __device__ __forceinline__ void init(int nM_, int nN_, int G_, int c_, const LAS unsigned char* te, const LAS int* tb) { nM = nM_; nN = nN_; nwg = nM * nN; G = G_; c = c_; tile_e = te; tile_b = tb; }
    __device__ __forceinline__ bool next(int i, pg8::Unit& u) const {
        const long L = (long)i * G + c; if (L >= nwg) return false;
        int wgid = (int)L; { const int q = nwg / pg8::NXCD, r = nwg % pg8::NXCD, xcd = wgid % pg8::NXCD, off = wgid / pg8::NXCD; wgid = (xcd < r ? xcd * (q + 1) : r * (q + 1) + (xcd - r) * q) + off; }
        const int nig = pg8::WGM * nN, gid = wgid / nig, fm = gid * pg8::WGM, gsz = (nM - fm) < pg8::WGM ? (nM - fm) : pg8::WGM;
        const int pm = fm + ((wgid % nig) % gsz), pnl = (wgid % nig) / gsz;
        const int e = __builtin_amdgcn_readfirstlane((int)tile_e[pm]);
        u.pm = pm; u.pn = e * nN + pnl; u.x0 = e; u.x1 = pnl; u.rb = e * NTOK + (pm - __builtin_amdgcn_readfirstlane(tile_b[e])) * 256; return true;
    }
    __device__ __forceinline__ void a_ready(const pg8::Unit&) const {}
    __device__ __forceinline__ void done(const pg8::Unit&) const {}
};
__device__ __forceinline__ void build_tile_table(const Ctx& c, const unsigned* gcnt, LAS unsigned char* tile_e, LAS int* ntiles, LAS int* tile_b) {
    if (c.tid == 0) { int tb = 0; for (int e = 0; e < NE; ++e) { const int nt = ((int)gcnt[e] + 255) >> 8; tile_b[e] = tb; for (int i = 0; i < nt; ++i) tile_e[tb + i] = (unsigned char)e; tb += nt; } tile_b[NE] = tb; ntiles[0] = tb; }
    __syncthreads();
}

struct EpiSwiglu {
    static constexpr bool PERM = true, AFTER_DRAIN = false;
    bf16* O; const float* bias;
    __device__ __forceinline__ bool keep_acc(const pg8::Unit&) const { return false; }
    __device__ __forceinline__ void operator()(const f32x4 (&acc)[2][2][4][2], const pg8::Unit& u, int wr, int wc, int fr, int fq) const {
        const int row0 = u.pm * 256 + wr * 64 + fr, col0 = u.x1 * 128 + wc * 32 + 8 * fq;
        const float* bg = bias + (size_t)u.x0 * 2 * DFF + col0; const float* bl = bg + DFF;
        f32x4 bgv[2], blv[2];
#pragma unroll
        for (int n = 0; n < 2; ++n) { bgv[n] = *(const f32x4*)(bg + 4 * n); blv[n] = *(const f32x4*)(bl + 4 * n); }
#pragma unroll
        for (int ai = 0; ai < 2; ++ai)
#pragma unroll
            for (int m = 0; m < 4; ++m) { bf16* rowp = O + (size_t)(row0 + ai * 128 + m * 16) * DFF + col0; float a[8];
#pragma unroll
                for (int n = 0; n < 2; ++n) { const f32x4 g = acc[ai][0][m][n] + bgv[n], l = acc[ai][1][m][n] + blv[n];
#pragma unroll
                    for (int i = 0; i < 4; ++i) { const float xg = fminf(g[i], 7.f), xl = fminf(fmaxf(l[i], -7.f), 7.f);
                        a[4 * n + i] = xg * __builtin_amdgcn_rcpf(1.f + __expf(-1.702f * xg)) * (xl + 1.f); } }
                v4u w; w.x = cvt_pk_bf16(a[0], a[1]); w.y = cvt_pk_bf16(a[2], a[3]); w.z = cvt_pk_bf16(a[4], a[5]); w.w = cvt_pk_bf16(a[6], a[7]);
                *(v4u*)rowp = w; }
    }
};
struct EpiDown {
    static constexpr bool PERM = true, AFTER_DRAIN = false;
    bf16* O; const float* bias; const float* roww;
    __device__ __forceinline__ bool keep_acc(const pg8::Unit&) const { return false; }
    __device__ __forceinline__ void operator()(const f32x4 (&acc)[2][2][4][2], const pg8::Unit& u, int wr, int wc, int fr, int fq) const {
        const int row0 = u.pm * 256 + wr * 64 + fr, col0 = u.x1 * 256 + wc * 32 + 8 * fq;
        const float* bp = bias + (size_t)u.x0 * D + col0;
        f32x4 bv[2][2];
#pragma unroll
        for (int bj = 0; bj < 2; ++bj)
#pragma unroll
            for (int n = 0; n < 2; ++n) bv[bj][n] = *(const f32x4*)(bp + bj * 128 + 4 * n);
#pragma unroll
        for (int ai = 0; ai < 2; ++ai)
#pragma unroll
            for (int m = 0; m < 4; ++m) { const int rl = wr * 64 + fr + ai * 128 + m * 16, row = u.pm * 256 + rl; const float w = roww[u.rb + rl]; bf16* rowp = O + (size_t)row * D + col0;
#pragma unroll
                for (int bj = 0; bj < 2; ++bj) { const f32x4 v0 = (acc[ai][bj][m][0] + bv[bj][0]) * w, v1 = (acc[ai][bj][m][1] + bv[bj][1]) * w;
                    v4u o; o.x = cvt_pk_bf16(v0[0], v0[1]); o.y = cvt_pk_bf16(v0[2], v0[3]); o.z = cvt_pk_bf16(v1[0], v1[1]); o.w = cvt_pk_bf16(v1[2], v1[3]);
                    *(v4u*)(rowp + bj * 128) = o; } }
    }
};

__device__ __forceinline__ void p_final(const Ctx& c, const float* __restrict__ X1, const bf16* __restrict__ Yb, const int* __restrict__ slot_e, const int* __restrict__ slot_pos, const unsigned* gcnt, const float* __restrict__ g, float* __restrict__ out, float pscale = 1.f) {
    LAS int* POFF = (LAS int*)(c.lds0 + EXTRA_OFF);
    if (c.tid == 0) { int s = 0; for (int e = 0; e < NE; ++e) { POFF[e] = s; s += (((int)gcnt[e] + 255) >> 8) << 8; } }
    __syncthreads();
#pragma unroll 2
    for (int t = c.bid * NWAVES + c.wave; t < NTOK; t += c.nb * NWAVES) {
        const int lane = c.lane; float4 v[4];
#pragma unroll
        for (int j = 0; j < 4; ++j) { const v4u xr = ldnt4((const v4u*)(X1 + (size_t)t * D) + lane + 64 * j); v[j] = make_float4(__uint_as_float(xr.x), __uint_as_float(xr.y), __uint_as_float(xr.z), __uint_as_float(xr.w)); }
#pragma unroll
        for (int k = 0; k < 4; ++k) { const int dst = POFF[slot_e[t * 4 + k]] + slot_pos[t * 4 + k];
#pragma unroll
            for (int j = 0; j < 4; ++j) { const v2u y = ldnt2((const v2u*)(Yb + (size_t)dst * D) + lane + 64 * j); v[j].x += bf_lo(y.x); v[j].y += bf_hi(y.x); v[j].z += bf_lo(y.y); v[j].w += bf_hi(y.y); } }
        float s = 0.f;
#pragma unroll
        for (int j = 0; j < 4; ++j) s += v[j].x * v[j].x + v[j].y * v[j].y + v[j].z * v[j].z + v[j].w * v[j].w;
        const float r = rsqrtf(wave_sum(s) * (1.f / D) + RMS_EPS) * pscale;
#pragma unroll
        for (int j = 0; j < 4; ++j) { const float4 gg = ((const float4*)g)[lane + 64 * j]; const f32x4 ov = {v[j].x * r * gg.x, v[j].y * r * gg.y, v[j].z * r * gg.z, v[j].w * r * gg.w}; __builtin_nontemporal_store(ov, (f32x4*)(out + (size_t)t * D) + lane + 64 * j); }
    }
}

constexpr int PJ = 5120;
typedef float f32x2 __attribute__((ext_vector_type(2)));
__device__ __forceinline__ f32x2 gelu_pk(f32x2 v) {
    const f32x2 av = __builtin_elementwise_abs(v), d = av * 0.2316418882f + 1.0f;
    f32x2 t; t.x = __builtin_amdgcn_rcpf(d.x); t.y = __builtin_amdgcn_rcpf(d.y);
    f32x2 q = t * 0.5307027145f + (-0.7265760135f); q = q * t + 0.7107068705f; q = q * t + (-0.142248368f); q = q * t + 0.127414796f; q = q * t;
    const f32x2 s = (v * v) * (-0.72134752044f);
    f32x2 e; e.x = __builtin_amdgcn_exp2f(s.x); e.y = __builtin_amdgcn_exp2f(s.y);
    const f32x2 m = v * (q * e), r = v - m;
    f32x2 o; o.x = v.x < 0.f ? m.x : r.x; o.y = v.y < 0.f ? m.y : r.y; return o;
}
__device__ __forceinline__ float fast_sigmoid(float x) { return __builtin_amdgcn_rcpf(1.f + __expf(-x)); }

__device__ __forceinline__ void p_convert_front(const Ctx& c, const float* w_in, const float* w_o_dn, const float* w_o_sg, const float* w_out, bf16* Win_t, bf16* Wo_t, bf16* Wout_t) {
    LAS float* scr = (LAS float*)c.lds + c.wave * (64 * 65);
    constexpr int I_IN = 16 * 80, I_O = 8 * 16, I_OUT = 16 * 16;
    for (int it = c.bid * NWAVES + c.wave; it < I_IN + 2 * I_O + I_OUT; it += c.nb * NWAVES) {
        int r = it;
        if (r < I_IN) { const int kb = r / 80, nbk = r % 80, n0 = nbk * 64; tr_item<true>(w_in, INC, kb * 64, n0 < 2048 ? n0 : n0 + 8, Win_t, D, n0, scr, c.lane); continue; } r -= I_IN;
        if (r < I_O) { const int kb = r / 16, nbk = r % 16; tr_item<true>(w_o_dn, D, kb * 64, nbk * 64, Wo_t, DNW, nbk * 64, scr, c.lane); continue; } r -= I_O;
        if (r < I_O) { const int kb = r / 16, nbk = r % 16; tr_item<true>(w_o_sg, D, kb * 64, nbk * 64, Wo_t + (size_t)D * DNW, SGW, nbk * 64, scr, c.lane); continue; } r -= I_O;
        { const int kb = r / 16, nbk = r % 16; tr_item<true>(w_out, D, kb * 64, nbk * 64, Wout_t, D, nbk * 64, scr, c.lane); }
    }
}
__device__ __forceinline__ void p_norm1(const Ctx& c, const float* __restrict__ x, const float* __restrict__ g1, const float* __restrict__ w_in, const float* __restrict__ a_log, const float* __restrict__ dt_bias, bf16* __restrict__ Hb, float* __restrict__ BG) {
    LAS f32x4* WB = (LAS f32x4*)c.lds;
    const int lane = c.lane;
    for (int idx = c.tid; idx < 2048; idx += NTHR) { const int k = idx >> 1, q = idx & 1; const f32x4 v = *(const f32x4*)(w_in + (size_t)k * INC + 2048 + 4 * q);
        const int l = (k & 255) >> 2, cc = k & 3, j = k >> 8; WB[((j * 4 + cc) * 2 + q) * 64 + l] = v; }
    __syncthreads();
#pragma unroll 2
    for (int t = c.bid * NWAVES + c.wave; t < NTOK; t += c.nb * NWAVES) {
        float4 xv[4]; float ss = 0.f;
#pragma unroll
        for (int j = 0; j < 4; ++j) { xv[j] = ((const float4*)(x + (size_t)t * D))[lane + 64 * j]; ss += xv[j].x * xv[j].x + xv[j].y * xv[j].y + xv[j].z * xv[j].z + xv[j].w * xv[j].w; }
        const float r = rsqrtf(wave_sum(ss) * (1.f / D) + RMS_EPS);
#pragma unroll
        for (int j = 0; j < 4; ++j) { const float4 g = ((const float4*)g1)[lane + 64 * j]; xv[j].x *= r * g.x; xv[j].y *= r * g.y; xv[j].z *= r * g.z; xv[j].w *= r * g.w;
            v2u o; o.x = cvt_pk_bf16(xv[j].x, xv[j].y); o.y = cvt_pk_bf16(xv[j].z, xv[j].w); ((v2u*)(Hb + (size_t)t * D))[lane + 64 * j] = o; }
        float acc[8];
#pragma unroll
        for (int i = 0; i < 8; ++i) acc[i] = 0.f;
#pragma unroll
        for (int j = 0; j < 4; ++j)
#pragma unroll
            for (int cc = 0; cc < 4; ++cc) { const float h = f4c(xv[j], cc);
#pragma unroll
                for (int q = 0; q < 2; ++q) { const f32x4 w = WB[((j * 4 + cc) * 2 + q) * 64 + lane];
                    acc[4 * q + 0] = fmaf(h, w.x, acc[4 * q + 0]); acc[4 * q + 1] = fmaf(h, w.y, acc[4 * q + 1]); acc[4 * q + 2] = fmaf(h, w.z, acc[4 * q + 2]); acc[4 * q + 3] = fmaf(h, w.w, acc[4 * q + 3]); } }
        BFLY_SW32(acc, 8) BFLY_SW16(acc, 4) BFLY_DPP(acc, 2, 8, dpp_ror8)
        float a0 = acc[0]; a0 += dpp_xor4(a0); a0 += dpp_xor2(a0); a0 += dpp_xor1(a0);
        const int idx = lane >> 3;
        if ((lane & 7) == 0) { float o;
            if (idx < 4) o = 1.f / (1.f + expf(-a0)); else { const int h = idx - 4; o = -expf(a_log[h]) * softplusf_(a0 + dt_bias[h]); }
            BG[(size_t)t * 8 + idx] = o; }
    }
}
struct EpiProj {
    static constexpr bool PERM = true, AFTER_DRAIN = false;
    bf16* O;
    __device__ __forceinline__ bool keep_acc(const pg8::Unit&) const { return false; }
    __device__ __forceinline__ void operator()(const f32x4 (&acc)[2][2][4][2], const pg8::Unit& u, int wr, int wc, int fr, int fq) const {
        const int row0 = u.pm * 256 + wr * 64 + fr, col0 = u.pn * 256 + wc * 32 + 8 * fq;
        const int act = (u.pn < 6) ? 0 : (u.pn < 8 ? 1 : (u.pn < 12 ? 2 : 0));
#pragma unroll
        for (int ai = 0; ai < 2; ++ai)
#pragma unroll
            for (int m = 0; m < 4; ++m) { bf16* rowp = O + (size_t)(row0 + ai * 128 + m * 16) * PJ + col0;
#pragma unroll
                for (int bj = 0; bj < 2; ++bj) { f32x4 v0 = acc[ai][bj][m][0], v1 = acc[ai][bj][m][1];
                    if (act == 1) {
#pragma unroll
                        for (int i = 0; i < 4; ++i) { v0[i] = v0[i] * fast_sigmoid(v0[i]); v1[i] = v1[i] * fast_sigmoid(v1[i]); } }
                    else if (act == 2) { const f32x2 a = gelu_pk((f32x2){v0[0], v0[1]}), b = gelu_pk((f32x2){v0[2], v0[3]}), cc = gelu_pk((f32x2){v1[0], v1[1]}), d = gelu_pk((f32x2){v1[2], v1[3]});
                        v0 = (f32x4){a.x, a.y, b.x, b.y}; v1 = (f32x4){cc.x, cc.y, d.x, d.y}; }
                    v4u w; w.x = cvt_pk_bf16(v0[0], v0[1]); w.y = cvt_pk_bf16(v0[2], v0[3]); w.z = cvt_pk_bf16(v1[0], v1[1]); w.w = cvt_pk_bf16(v1[2], v1[3]);
                    *(v4u*)(rowp + bj * 128) = w; } }
    }
};
struct DualOrder {
    pg8::StaticOrder S0;
    __device__ __forceinline__ void init(int G, int c) { S0.init(NTOK, D, G, c); }
    __device__ __forceinline__ bool next(int i, pg8::Unit& u) const { pg8::Unit t; if (!S0.next(i >> 1, t)) return false; const int which = i & 1; u.pm = t.pm + 64 * which; u.pn = t.pn + 4 * which; u.x0 = which; u.x1 = t.pn; u.rb = 0; return true; }
    __device__ __forceinline__ void a_ready(const pg8::Unit&) const {}
    __device__ __forceinline__ void done(const pg8::Unit&) const {}
};
struct EpiMerge {
    static constexpr bool PERM = true, AFTER_DRAIN = false;
    const bf16* P; bf16* O;
    __device__ __forceinline__ bool keep_acc(const pg8::Unit& u) const { return u.x0 == 0; }
    __device__ __forceinline__ void operator()(f32x4 (&acc)[2][2][4][2], const pg8::Unit& u, int wr, int wc, int fr, int fq) const {
        const int row0 = (u.pm & 63) * 256 + wr * 64 + fr, col0 = u.x1 * 256 + wc * 32 + 8 * fq; const bool first = (u.x0 == 0);
#pragma unroll
        for (int ai = 0; ai < 2; ++ai)
#pragma unroll
            for (int m = 0; m < 4; ++m) { const int row = row0 + ai * 128 + m * 16; const bf16* pr = P + (size_t)row * PJ + col0;
#pragma unroll
                for (int bj = 0; bj < 2; ++bj) { const v4u xb = *(const v4u*)(pr + 4096 + bj * 128); float fb[8];
                    fb[0] = bf_lo(xb.x); fb[1] = bf_hi(xb.x); fb[2] = bf_lo(xb.y); fb[3] = bf_hi(xb.y); fb[4] = bf_lo(xb.z); fb[5] = bf_hi(xb.z); fb[6] = bf_lo(xb.w); fb[7] = bf_hi(xb.w);
#pragma unroll
                    for (int i = 0; i < 8; ++i) fb[i] = 1.f + __expf(-fmaxf(fb[i], -30.f));
                    if (first) { const v4u xa = *(const v4u*)(pr + 3072 + bj * 128); float fa[8];
                        fa[0] = bf_lo(xa.x); fa[1] = bf_hi(xa.x); fa[2] = bf_lo(xa.y); fa[3] = bf_hi(xa.y); fa[4] = bf_lo(xa.z); fa[5] = bf_hi(xa.z); fa[6] = bf_lo(xa.w); fa[7] = bf_hi(xa.w);
#pragma unroll
                        for (int i = 0; i < 4; ++i) { acc[ai][bj][m][0][i] *= fb[i] * fast_sigmoid(fa[i]); acc[ai][bj][m][1][i] *= fb[4 + i] * fast_sigmoid(fa[4 + i]); } }
                    else { f32x4 v0, v1;
#pragma unroll
                        for (int i = 0; i < 4; ++i) { v0[i] = acc[ai][bj][m][0][i] * __builtin_amdgcn_rcpf(fb[i]); v1[i] = acc[ai][bj][m][1][i] * __builtin_amdgcn_rcpf(fb[4 + i]); }
                        v4u w; w.x = cvt_pk_bf16(v0[0], v0[1]); w.y = cvt_pk_bf16(v0[2], v0[3]); w.z = cvt_pk_bf16(v1[0], v1[1]); w.w = cvt_pk_bf16(v1[2], v1[3]);
                        *(v4u*)(O + (size_t)row * D + col0 + bj * 128) = w; } } }
    }
};
struct EpiResid {
    static constexpr bool PERM = false, AFTER_DRAIN = false;
    const float* X; float* O;
    __device__ __forceinline__ bool keep_acc(const pg8::Unit&) const { return false; }
    __device__ __forceinline__ void operator()(const f32x4 (&acc)[2][2][4][2], const pg8::Unit& u, int wr, int wc, int fr, int fq) const {
        const int row0 = u.pm * 256 + wr * 64 + fr, col0 = u.pn * 256 + wc * 32 + 4 * fq;
#pragma unroll
        for (int ai = 0; ai < 2; ++ai)
#pragma unroll
            for (int m = 0; m < 4; ++m) { const size_t off = (size_t)(row0 + ai * 128 + m * 16) * D + col0;
#pragma unroll
                for (int bj = 0; bj < 2; ++bj)
#pragma unroll
                    for (int n = 0; n < 2; ++n) *(f32x4*)(O + off + bj * 128 + n * 16) = *(const f32x4*)(X + off + bj * 128 + n * 16) + acc[ai][bj][m][n]; }
    }
};
__device__ __forceinline__ float ldbf(const bf16* p) { return __uint_as_float((unsigned)(*p) << 16); }
__device__ __forceinline__ unsigned short f2bf1(float f) { return (unsigned short)(cvt_pk_bf16(f, 0.f) & 0xffffu); }
__device__ __forceinline__ void unpack8(const v4u& x, float (&f)[8]) { f[0] = bf_lo(x.x); f[1] = bf_hi(x.x); f[2] = bf_lo(x.y); f[3] = bf_hi(x.y); f[4] = bf_lo(x.z); f[5] = bf_hi(x.z); f[6] = bf_lo(x.w); f[7] = bf_hi(x.w); }

constexpr size_t DN_WN = 16384, DN_QD = 16384, DN_KD = 16384, DN_QK = 8192, DN_U = 16384, DN_SST = 32768;
struct DnBufs { unsigned char *WN, *QD, *KD, *QK, *U, *SST; float* EG; };
constexpr int PL_QH = 0, PL_KH = 17408, PL_XVT = 34816, PL_XWT = 53248, PL_KDT = 71680, PL_AL = 90112, PL_TL = 106496, PL_GAM = 115712;
constexpr int RS = 136  , TS = 72  ;

__device__ __forceinline__ void p_dn_prep(const Ctx& c, const bf16* PROJ, const float* cw, const float* BG, const DnBufs& B) {
    LAS unsigned char* L = c.lds;
    LAS unsigned short* QH = (LAS unsigned short*)(L + PL_QH); LAS unsigned short* KH = (LAS unsigned short*)(L + PL_KH);
    LAS unsigned short* XVT = (LAS unsigned short*)(L + PL_XVT); LAS unsigned short* XWT = (LAS unsigned short*)(L + PL_XWT); LAS unsigned short* KDT = (LAS unsigned short*)(L + PL_KDT);
    LAS float* AL = (LAS float*)(L + PL_AL); LAS unsigned short* TL = (LAS unsigned short*)(L + PL_TL);
    LAS float* GAM = (LAS float*)(L + PL_GAM); LAS float* BETA = GAM + 64; LAS float* EGAM = GAM + 128; LAS float* KSC = GAM + 192;
    const int lane = c.lane, w = c.wave, fr = lane & 15, fq = lane >> 4;
    for (int it = c.bid; it < BATCH * DNH * (SEQ / 64); it += c.nb) {
        const int bh = it >> 7, ch = it & 127, b = bh >> 2, h = bh & 3; const size_t row0 = (size_t)b * SEQ + ch * 64;
        if (w == 0) { const float gt = BG[(row0 + lane) * 8 + 4 + h], bt = BG[(row0 + lane) * 8 + h]; float gam = gt;
#pragma unroll
            for (int o = 1; o < 64; o <<= 1) { const float t = __shfl_up(gam, o); if (lane >= o) gam += t; }
            const float gl = __shfl(gam, 63);
            GAM[lane] = gam; BETA[lane] = bt; EGAM[lane] = expf(gam); KSC[lane] = expf(gl - gam);
            if (lane == 0) B.EG[it] = expf(gl); }
        for (int i = c.tid; i < 1024; i += NTHR) ((LAS f32x4*)AL)[i] = (f32x4){0.f, 0.f, 0.f, 0.f};
        __syncthreads();
#pragma unroll 1
        for (int i = 0; i < 6; i += 2) {
            v4u xr[2][4];
#pragma unroll
            for (int u = 0; u < 2; ++u) { const int idx = c.tid + NTHR * (i + u), t = idx / 48, cg = idx % 48, col = (cg >> 4) * 512 + h * 128 + (cg & 15) * 8;
#pragma unroll
                for (int kk = 0; kk < 4; ++kk) { const int tt = ch * 64 + t - 3 + kk; xr[u][kk] = (tt >= 0) ? *(const v4u*)(PROJ + ((size_t)b * SEQ + tt) * PJ + col) : (v4u){0u, 0u, 0u, 0u}; } }
#pragma unroll
            for (int u = 0; u < 2; ++u) {
            const int idx = c.tid + NTHR * (i + u), t = idx / 48, cg = idx % 48, part = cg >> 4, c8 = (cg & 15) * 8, col = part * 512 + h * 128 + c8;
            float a[8];
#pragma unroll
            for (int e = 0; e < 8; ++e) a[e] = 0.f;
#pragma unroll
            for (int kk = 0; kk < 4; ++kk) { float xf[8]; unpack8(xr[u][kk], xf);
                    const float4 w0 = *(const float4*)(cw + kk * 1536 + col), w1 = *(const float4*)(cw + kk * 1536 + col + 4);
                    a[0] = fmaf(w0.x, xf[0], a[0]); a[1] = fmaf(w0.y, xf[1], a[1]); a[2] = fmaf(w0.z, xf[2], a[2]); a[3] = fmaf(w0.w, xf[3], a[3]);
                    a[4] = fmaf(w1.x, xf[4], a[4]); a[5] = fmaf(w1.y, xf[5], a[5]); a[6] = fmaf(w1.z, xf[6], a[6]); a[7] = fmaf(w1.w, xf[7], a[7]); }
            float ss = 0.f;
#pragma unroll
            for (int e = 0; e < 8; ++e) { a[e] = a[e] / (1.f + __expf(-a[e])); ss = fmaf(a[e], a[e], ss); }
            ss = row16_sum(ss);
            const float rs = rsqrtf(ss + L2_EPS);
            if (part == 0) { const float sc = rs * 0.08838834764831845f; v4u o; o.x = cvt_pk_bf16(a[0] * sc, a[1] * sc); o.y = cvt_pk_bf16(a[2] * sc, a[3] * sc); o.z = cvt_pk_bf16(a[4] * sc, a[5] * sc); o.w = cvt_pk_bf16(a[6] * sc, a[7] * sc);
                *(LAS v4u*)(QH + t * RS + c8) = o; }
            else if (part == 1) { v4u o; o.x = cvt_pk_bf16(a[0] * rs, a[1] * rs); o.y = cvt_pk_bf16(a[2] * rs, a[3] * rs); o.z = cvt_pk_bf16(a[4] * rs, a[5] * rs); o.w = cvt_pk_bf16(a[6] * rs, a[7] * rs);
                *(LAS v4u*)(KH + t * RS + c8) = o; const float s1 = rs * BETA[t] * EGAM[t], s2 = rs * KSC[t];
#pragma unroll
                for (int e = 0; e < 8; ++e) { XWT[(c8 + e) * TS + t] = f2bf1(a[e] * s1); KDT[(c8 + e) * TS + t] = f2bf1(a[e] * s2); } }
            else { const float bt = BETA[t];
#pragma unroll
                for (int e = 0; e < 8; ++e) XVT[(c8 + e) * TS + t] = f2bf1(a[e] * bt); }
            }
        }
        __syncthreads();
        { const int rt = w & 3, ksq = w >> 2; v2u half[2];
#pragma unroll
            for (int sub = 0; sub < 2; ++sub) { const int st = 2 * ksq + sub; f32x4 acc = {0.f, 0.f, 0.f, 0.f};
#pragma unroll
                for (int kk = 0; kk < 4; ++kk) { const bf16x8 a = *(const LAS bf16x8*)(KH + (16 * st + fr) * RS + 32 * kk + 8 * fq), bq = *(const LAS bf16x8*)(QH + (16 * rt + fr) * RS + 32 * kk + 8 * fq); acc = MFMA16(a, bq, acc); }
                const int rr = 16 * rt + fr; const float gr = GAM[rr]; float v[4];
#pragma unroll
                for (int r = 0; r < 4; ++r) { const int s2 = 16 * st + 4 * fq + r; v[r] = (s2 <= rr) ? acc[r] * __expf(fminf(gr - GAM[s2], 0.f)) : 0.f; }
                half[sub].x = cvt_pk_bf16(v[0], v[1]); half[sub].y = cvt_pk_bf16(v[2], v[3]); }
            v4u o; o.x = half[0].x; o.y = half[0].y; o.z = half[1].x; o.w = half[1].y;
            *(v4u*)(B.QK + (size_t)it * DN_QK + ((rt * 2 + ksq) * 64 + lane) * 16) = o; }
#pragma unroll 1
        for (int n = w; n < 10; n += 8) { const int rt = (n >= 6) ? 3 : (n >= 3 ? 2 : (n >= 1 ? 1 : 0)), st = n - rt * (rt + 1) / 2; f32x4 acc = {0.f, 0.f, 0.f, 0.f};
#pragma unroll
            for (int kk = 0; kk < 4; ++kk) { const bf16x8 a = *(const LAS bf16x8*)(KH + (16 * rt + fr) * RS + 32 * kk + 8 * fq), bk = *(const LAS bf16x8*)(KH + (16 * st + fr) * RS + 32 * kk + 8 * fq); acc = MFMA16(a, bk, acc); }
            const int s2 = 16 * st + fr; const float gs = GAM[s2];
#pragma unroll
            for (int r = 0; r < 4; ++r) { const int rr = 16 * rt + 4 * fq + r; const float v = (s2 < rr) ? BETA[rr] * acc[r] * __expf(fminf(GAM[rr] - gs, 0.f)) : 0.f; AL[rr * 64 + (s2 & 7) * 8 + (s2 >> 3)] = v; } }
        __syncthreads();
        { const int j = w * 8 + (lane >> 3), p = lane & 7; float tc[8];
#pragma unroll
            for (int i = 0; i < 8; ++i) tc[i] = 0.f;
#pragma unroll
            for (int r = 0; r < 64; ++r) { float s0 = 0.f, s1 = 0.f;
                if (r > 0) { const LAS float* ar = AL + r * 64 + p * 8; const f32x4 a0 = *(const LAS f32x4*)ar; s0 = a0[0] * tc[0];
                    if (r > 8) s1 = a0[1] * tc[1];
                    if (r > 16) s0 = fmaf(a0[2], tc[2], s0);
                    if (r > 24) s1 = fmaf(a0[3], tc[3], s1);
                    if (r > 32) { const f32x4 a1 = *(const LAS f32x4*)(ar + 4); s0 = fmaf(a1[0], tc[4], s0);
                        if (r > 40) s1 = fmaf(a1[1], tc[5], s1);
                        if (r > 48) s0 = fmaf(a1[2], tc[6], s0);
                        if (r > 56) s1 = fmaf(a1[3], tc[7], s1); } }
                float tot = s0 + s1; tot += dpp_xor1(tot); tot += dpp_xor2(tot); tot += dpp_hmir(tot);
                const float tr = ((r == j) ? 1.f : 0.f) - tot;
                if (p == (r & 7)) tc[r >> 3] = tr; }
#pragma unroll
            for (int i = 0; i < 8; ++i) TL[(8 * i + p) * TS + j] = f2bf1(tc[i]); }
        __syncthreads();
        { const int sl = w;
#pragma unroll
            for (int mt = 0; mt < 4; ++mt) { f32x4 acc = {0.f, 0.f, 0.f, 0.f};
#pragma unroll
                for (int kk = 0; kk < 2; ++kk) if (kk == 0 || mt >= 2) { const bf16x8 a = *(const LAS bf16x8*)(TL + (16 * mt + fr) * TS + 32 * kk + 8 * fq), bv = *(const LAS bf16x8*)(XVT + (16 * sl + fr) * TS + 32 * kk + 8 * fq); acc = MFMA16(a, bv, acc); }
                v2u o; o.x = cvt_pk_bf16(acc[0], acc[1]); o.y = cvt_pk_bf16(acc[2], acc[3]);
                *(v2u*)(B.U + (size_t)it * DN_U + ((mt * 8 + sl) * 64 + lane) * 8) = o; }
            const int dt = w;
#pragma unroll
            for (int rt = 0; rt < 4; ++rt) { f32x4 acc = {0.f, 0.f, 0.f, 0.f};
#pragma unroll
                for (int kk = 0; kk < 2; ++kk) if (kk == 0 || rt >= 2) { const bf16x8 a = *(const LAS bf16x8*)(XWT + (16 * dt + fr) * TS + 32 * kk + 8 * fq), bt = *(const LAS bf16x8*)(TL + (16 * rt + fr) * TS + 32 * kk + 8 * fq); acc = MFMA16(a, bt, acc); }
                v2u o; o.x = cvt_pk_bf16(-acc[0], -acc[1]); o.y = cvt_pk_bf16(-acc[2], -acc[3]);
                *(v2u*)(B.WN + (size_t)it * DN_WN + ((rt * 4 + (dt >> 1)) * 64 + lane) * 16 + (dt & 1) * 8) = o; } }
        { const int mt = w & 3;
#pragma unroll
            for (int q2 = 0; q2 < 2; ++q2) { const int ks = 2 * (w >> 2) + q2, rr = 16 * mt + fr; const float sc = EGAM[rr];
                const v2u lo = *(const LAS v2u*)(QH + rr * RS + 32 * ks + 4 * fq), hi = *(const LAS v2u*)(QH + rr * RS + 32 * ks + 16 + 4 * fq);
                v4u o; o.x = cvt_pk_bf16(bf_lo(lo.x) * sc, bf_hi(lo.x) * sc); o.y = cvt_pk_bf16(bf_lo(lo.y) * sc, bf_hi(lo.y) * sc); o.z = cvt_pk_bf16(bf_lo(hi.x) * sc, bf_hi(hi.x) * sc); o.w = cvt_pk_bf16(bf_lo(hi.y) * sc, bf_hi(hi.y) * sc);
                *(v4u*)(B.QD + (size_t)it * DN_QD + ((mt * 4 + ks) * 64 + lane) * 16) = o; }
            const int dt = w;
#pragma unroll
            for (int ks = 0; ks < 2; ++ks) { const v2u lo = *(const LAS v2u*)(KDT + (16 * dt + fr) * TS + 32 * ks + 4 * fq), hi = *(const LAS v2u*)(KDT + (16 * dt + fr) * TS + 32 * ks + 16 + 4 * fq);
                v4u o; o.x = lo.x; o.y = lo.y; o.z = hi.x; o.w = hi.y;
                *(v4u*)(B.KD + (size_t)it * DN_KD + ((dt * 2 + ks) * 64 + lane) * 16) = o; } }
        __syncthreads();
    }
}

constexpr int SCAN_WGS = BATCH * DNH * 2;
__device__ __forceinline__ void u_load_asm(v2u& dst, const unsigned char* p) { asm volatile("global_load_dwordx2 %0, %1, off" : "=v"(dst) : "v"(p) : "memory"); }
template <int STG>
__device__ __forceinline__ void scan_step(const DnBufs& B, LAS unsigned char* L, int lane, int sl, int it, int ch, f32x4 (&S)[8], v2u (&ucur)[4], v2u (&unxt)[4], float egc) {
    if (ch < 126) asm volatile("s_waitcnt vmcnt(8)" ::: "memory"); else asm volatile("s_waitcnt vmcnt(0)" ::: "memory");
    __builtin_amdgcn_s_barrier(); asm volatile("" ::: "memory");
    asm volatile("" : "+v"(ucur[0]), "+v"(ucur[1]), "+v"(ucur[2]), "+v"(ucur[3]));
    bf16x8 sf[4];
#pragma unroll
    for (int ks = 0; ks < 4; ++ks) { v4u o; o.x = cvt_pk_bf16(S[2 * ks][0], S[2 * ks][1]); o.y = cvt_pk_bf16(S[2 * ks][2], S[2 * ks][3]); o.z = cvt_pk_bf16(S[2 * ks + 1][0], S[2 * ks + 1][1]); o.w = cvt_pk_bf16(S[2 * ks + 1][2], S[2 * ks + 1][3]);
        *(v4u*)(B.SST + (size_t)it * DN_SST + ((ks * 8 + sl) * 64 + lane) * 16) = o; sf[ks] = as_frag(o); }
    asm volatile("" ::: "memory");
    if (ch + 3 < 128) {
#pragma unroll
        for (int mt = 0; mt < 4; ++mt) u_load_asm(unxt[mt], B.U + (size_t)(it + 3) * DN_U + ((mt * 8 + sl) * 64 + lane) * 8); }
    const LAS unsigned char* wl = L + STG * 32768 + lane * 16; const LAS unsigned char* kl = wl + 16384;
    f32x4 vn[4];
#pragma unroll
    for (int mt = 0; mt < 4; ++mt) { vn[mt] = (f32x4){bf_lo(ucur[mt].x), bf_hi(ucur[mt].x), bf_lo(ucur[mt].y), bf_hi(ucur[mt].y)};
#pragma unroll
        for (int ks = 0; ks < 4; ++ks) vn[mt] = MFMA16(*(const LAS bf16x8*)(wl + (mt * 4 + ks) * 1024), sf[ks], vn[mt]); }
    bf16x8 vf[2];
#pragma unroll
    for (int ks = 0; ks < 2; ++ks) { v4u o; o.x = cvt_pk_bf16(vn[2 * ks][0], vn[2 * ks][1]); o.y = cvt_pk_bf16(vn[2 * ks][2], vn[2 * ks][3]); o.z = cvt_pk_bf16(vn[2 * ks + 1][0], vn[2 * ks + 1][1]); o.w = cvt_pk_bf16(vn[2 * ks + 1][2], vn[2 * ks + 1][3]); vf[ks] = as_frag(o); }
#pragma unroll
    for (int dt = 0; dt < 8; ++dt) { f32x4 a = S[dt] * egc;
#pragma unroll
        for (int ks = 0; ks < 2; ++ks) a = MFMA16(*(const LAS bf16x8*)(kl + (dt * 2 + ks) * 1024), vf[ks], a);
        S[dt] = a; }
}
__device__ __forceinline__ void p_dn_scan(const Ctx& c, const DnBufs& B) {
    const int lane = c.lane, w = c.wave, bh = c.bid >> 1, half = c.bid & 1; LAS unsigned char* L = c.lds;
    if (w >= 4) {
        const unsigned char* gsrc = (w < 6) ? B.WN : B.KD; const int goff = (w & 1) * 8192 + lane * 16, loff = (w - 4) * 8192;
#define SCAN_DMA(itn, stage) do { _Pragma("unroll") for (int _p = 0; _p < 8; ++_p) \
        __builtin_amdgcn_global_load_lds((const unsigned*)(gsrc + (size_t)(itn) * 16384 + goff + _p * 1024), (LAS unsigned*)(L + (stage) * 32768 + loff + _p * 1024), 16, 0, 0); } while (0)
        const int it0 = bh * 128;
        SCAN_DMA(it0, 0); SCAN_DMA(it0 + 1, 1); SCAN_DMA(it0 + 2, 2);
#pragma unroll 1
        for (int ch = 0; ch < 128; ++ch) {
            if (ch < 126) asm volatile("s_waitcnt vmcnt(16)" ::: "memory"); else asm volatile("s_waitcnt vmcnt(0)" ::: "memory");
            __builtin_amdgcn_s_barrier(); asm volatile("" ::: "memory");
            if (ch + 3 < 128) SCAN_DMA(it0 + ch + 3, (ch + 3) & 3);
        }
#undef SCAN_DMA
    } else {
        __builtin_amdgcn_s_setprio(1);
        const int sl = half * 4 + w;
        f32x4 S[8];
#pragma unroll
        for (int i = 0; i < 8; ++i) S[i] = (f32x4){0.f, 0.f, 0.f, 0.f};
        v2u u0[4], u1[4], u2[4], u3[4];
        const float eglo = B.EG[bh * 128 + lane], eghi = B.EG[bh * 128 + 64 + lane];
        asm volatile("s_waitcnt vmcnt(0)" ::: "memory");
        { const int it = bh * 128;
#pragma unroll
            for (int mt = 0; mt < 4; ++mt) u_load_asm(u0[mt], B.U + (size_t)it * DN_U + ((mt * 8 + sl) * 64 + lane) * 8);
#pragma unroll
            for (int mt = 0; mt < 4; ++mt) u_load_asm(u1[mt], B.U + (size_t)(it + 1) * DN_U + ((mt * 8 + sl) * 64 + lane) * 8);
#pragma unroll
            for (int mt = 0; mt < 4; ++mt) u_load_asm(u2[mt], B.U + (size_t)(it + 2) * DN_U + ((mt * 8 + sl) * 64 + lane) * 8);
#pragma unroll
            for (int mt = 0; mt < 4; ++mt) u3[mt] = (v2u){0u, 0u}; }
#define EGC(chx) __builtin_bit_cast(float, __builtin_amdgcn_readlane(__builtin_bit_cast(int, (chx) < 64 ? eglo : eghi), (chx) & 63))
#pragma unroll 1
        for (int ch = 0; ch < 128; ch += 4) {
            const int it = bh * 128 + ch;
            scan_step<0>(B, L, lane, sl, it, ch, S, u0, u3, EGC(ch));
            scan_step<1>(B, L, lane, sl, it + 1, ch + 1, S, u1, u0, EGC(ch + 1));
            scan_step<2>(B, L, lane, sl, it + 2, ch + 2, S, u2, u1, EGC(ch + 2));
            scan_step<3>(B, L, lane, sl, it + 3, ch + 3, S, u3, u2, EGC(ch + 3));
        }
#undef EGC
        __builtin_amdgcn_s_setprio(0);
    }
    asm volatile("s_waitcnt vmcnt(0)" ::: "memory"); __builtin_amdgcn_s_barrier(); asm volatile("" ::: "memory");
}

__device__ __forceinline__ void p_dn_out(const Ctx& c, const DnBufs& B, const bf16* PROJ, const float* gn, bf16* YA) {
    const int lane = c.lane, sl = c.wave, fr = lane & 15, fq = lane >> 4; LAS float* SSQ = (LAS float*)c.lds;
    LAS unsigned char* IMG = c.lds + 2048;
    for (int it = c.bid; it < BATCH * DNH * (SEQ / 64); it += c.nb) {
        const int bh = it >> 7, ch = it & 127, b = bh >> 2, h = bh & 3; const size_t row0 = (size_t)b * SEQ + ch * 64;
        v4u sfr[4]; v2u ur[4];
#pragma unroll
        for (int ks = 0; ks < 4; ++ks) sfr[ks] = *(const v4u*)(B.SST + (size_t)it * DN_SST + ((ks * 8 + sl) * 64 + lane) * 16);
#pragma unroll
        for (int mt = 0; mt < 4; ++mt) ur[mt] = *(const v2u*)(B.U + (size_t)it * DN_U + ((mt * 8 + sl) * 64 + lane) * 8);
#pragma unroll
        for (int j = 0; j < 5; ++j) { const int p = sl * 5 + j;
            const unsigned char* src = (p < 16) ? B.WN + (size_t)it * DN_WN + p * 1024 : (p < 32 ? B.QD + (size_t)it * DN_QD + (p - 16) * 1024 : B.QK + (size_t)it * DN_QK + (p - 32) * 1024);
            __builtin_amdgcn_global_load_lds((const unsigned*)(src + lane * 16), (LAS unsigned*)(IMG + p * 1024), 16, 0, 0); }
        asm volatile("s_waitcnt vmcnt(0)" ::: "memory"); __syncthreads();
        bf16x8 sf[4];
#pragma unroll
        for (int ks = 0; ks < 4; ++ks) sf[ks] = as_frag(sfr[ks]);
        const LAS unsigned char* wn = IMG + lane * 16; const LAS unsigned char* qd = wn + 16384; const LAS unsigned char* qk = wn + 32768;
        f32x4 vn[4];
#pragma unroll
        for (int mt = 0; mt < 4; ++mt) { vn[mt] = (f32x4){bf_lo(ur[mt].x), bf_hi(ur[mt].x), bf_lo(ur[mt].y), bf_hi(ur[mt].y)};
#pragma unroll
            for (int ks = 0; ks < 4; ++ks) vn[mt] = MFMA16(*(const LAS bf16x8*)(wn + (mt * 4 + ks) * 1024), sf[ks], vn[mt]); }
        bf16x8 vf[2];
#pragma unroll
        for (int ks = 0; ks < 2; ++ks) { v4u o; o.x = cvt_pk_bf16(vn[2 * ks][0], vn[2 * ks][1]); o.y = cvt_pk_bf16(vn[2 * ks][2], vn[2 * ks][3]); o.z = cvt_pk_bf16(vn[2 * ks + 1][0], vn[2 * ks + 1][1]); o.w = cvt_pk_bf16(vn[2 * ks + 1][2], vn[2 * ks + 1][3]); vf[ks] = as_frag(o); }
        f32x4 o[4];
#pragma unroll
        for (int mt = 0; mt < 4; ++mt) { f32x4 a = {0.f, 0.f, 0.f, 0.f};
#pragma unroll
            for (int ks = 0; ks < 4; ++ks) a = MFMA16(*(const LAS bf16x8*)(qd + (mt * 4 + ks) * 1024), sf[ks], a);
#pragma unroll
            for (int ks = 0; ks < 2; ++ks) a = MFMA16(*(const LAS bf16x8*)(qk + (mt * 2 + ks) * 1024), vf[ks], a);
            o[mt] = a;
#pragma unroll
            for (int r = 0; r < 4; ++r) { float q = row16_sum(a[r] * a[r]);
                if (fr == 0) SSQ[(16 * mt + 4 * fq + r) * 8 + sl] = q; } }
        float zv[4][4];
#pragma unroll
        for (int mt = 0; mt < 4; ++mt)
#pragma unroll
            for (int r = 0; r < 4; ++r) zv[mt][r] = ldbf(PROJ + (row0 + 16 * mt + 4 * fq + r) * PJ + 1536 + h * 128 + 16 * sl + fr);
        const float gg = gn[16 * sl + fr];
        __syncthreads();
#pragma unroll
        for (int mt = 0; mt < 4; ++mt)
#pragma unroll
            for (int r = 0; r < 4; ++r) { const int rl = 16 * mt + 4 * fq + r; const f32x4 q0 = *(const LAS f32x4*)(SSQ + rl * 8), q1 = *(const LAS f32x4*)(SSQ + rl * 8 + 4);
                const float rstd = rsqrtf(((q0[0] + q0[1]) + (q0[2] + q0[3]) + (q1[0] + q1[1]) + (q1[2] + q1[3])) * (1.f / 128.f) + RMS_EPS);
                const size_t row = row0 + rl; const int col = h * 128 + 16 * sl + fr;
                YA[row * DNW + col] = f2bf1(o[mt][r] * rstd * gg * zv[mt][r]); }
        __syncthreads();
    }
}

__device__ __forceinline__ void p_sg_item(const Ctx& c, int it, const bf16* PROJ, const float* lg, const float* lb, const float* sw, const float* sb, bf16* YB) {
    LAS unsigned short* VT = (LAS unsigned short*)c.lds;
    LAS float* STAT = (LAS float*)(c.lds + 128 * RS * 2);
    const int lane = c.lane, w = c.wave, fr = lane & 15, fq = lane >> 4, chunk = it >> 2, g = it & 3; const size_t row0 = (size_t)chunk * SGC;
    {
        v4u xr[16];
#pragma unroll
        for (int rr = 0; rr < 16; ++rr) xr[rr] = *(const v4u*)(PROJ + (row0 + 16 * w + rr) * PJ + 2560 + lane * 8);
        float acc[32];
#pragma unroll
        for (int rr = 0; rr < 16; ++rr) { float f[8]; unpack8(xr[rr], f); float s1 = 0.f, s2 = 0.f;
#pragma unroll
            for (int e = 0; e < 8; ++e) { s1 += f[e]; s2 = fmaf(f[e], f[e], s2); }
            acc[rr] = s1; acc[16 + rr] = s2; }
        BFLY_SW32(acc, 32) BFLY_SW16(acc, 16) BFLY_DPP(acc, 8, 8, dpp_ror8) BFLY_DPP(acc, 4, 4, dpp_xor4) BFLY_DPP(acc, 2, 2, dpp_xor2)
        const float tot = acc[0] + dpp_xor1(acc[0]);
        if ((lane & 1) == 0) { const int vi = lane >> 1; STAT[2 * (16 * w + (vi & 15)) + (vi >> 4)] = tot; } }
    __syncthreads();
    { v4u xv[4];
#pragma unroll
        for (int i = 0; i < 4; ++i) { const int idx = c.tid + NTHR * i, s = idx >> 4, c8 = (idx & 15) * 8; xv[i] = *(const v4u*)(PROJ + (row0 + s) * PJ + 2560 + g * 128 + c8); }
        const int c8 = (c.tid & 15) * 8;
        const float4 g0 = *(const float4*)(lg + g * 128 + c8), g1 = *(const float4*)(lg + g * 128 + c8 + 4), b0 = *(const float4*)(lb + g * 128 + c8), b1 = *(const float4*)(lb + g * 128 + c8 + 4);
        const float gv[8] = {g0.x, g0.y, g0.z, g0.w, g1.x, g1.y, g1.z, g1.w}, bv[8] = {b0.x, b0.y, b0.z, b0.w, b1.x, b1.y, b1.z, b1.w};
#pragma unroll
        for (int i = 0; i < 4; ++i) { const int s = (c.tid + NTHR * i) >> 4; float f[8]; unpack8(xv[i], f);
            const float mu = STAT[2 * s] * (1.f / SGW), rstd = rsqrtf(fmaxf(STAT[2 * s + 1] * (1.f / SGW) - mu * mu, 0.f) + LN_EPS);
#pragma unroll
            for (int e = 0; e < 8; ++e) VT[(c8 + e) * RS + s] = f2bf1((f[e] - mu) * rstd * gv[e] + bv[e]); } }
    __syncthreads();
    { f32x4 acc[8];
#pragma unroll
        for (int ct = 0; ct < 8; ++ct) acc[ct] = (f32x4){0.f, 0.f, 0.f, 0.f};
        const int t = 16 * w + fr, nk = (w >> 1) + 1;
        for (int kk = 0; kk < nk; ++kk) { const int s0 = 32 * kk + 8 * fq; const float* wp = sw + ((size_t)g * SGC + t) * SGC + s0;
            const float4 w0 = *(const float4*)wp, w1 = *(const float4*)(wp + 4);
            const float wv[8] = {w0.x, w0.y, w0.z, w0.w, w1.x, w1.y, w1.z, w1.w}; float wm[8];
#pragma unroll
            for (int e = 0; e < 8; ++e) wm[e] = (s0 + e <= t) ? wv[e] : 0.f;
            v4u wb; wb.x = cvt_pk_bf16(wm[0], wm[1]); wb.y = cvt_pk_bf16(wm[2], wm[3]); wb.z = cvt_pk_bf16(wm[4], wm[5]); wb.w = cvt_pk_bf16(wm[6], wm[7]);
            const bf16x8 bfr = as_frag(wb);
#pragma unroll
            for (int ct = 0; ct < 8; ++ct) acc[ct] = MFMA16(*(const LAS bf16x8*)(VT + (16 * ct + fr) * RS + s0), bfr, acc[ct]); }
        const float bias = sb[g * SGC + t]; const size_t row = row0 + t;
#pragma unroll
        for (int ct = 0; ct < 8; ++ct) { const int col = g * 128 + 16 * ct + 4 * fq; const v2u u = *(const v2u*)(PROJ + row * PJ + 2048 + col);
            v2u o; o.x = cvt_pk_bf16(bf_lo(u.x) * (acc[ct][0] + bias), bf_hi(u.x) * (acc[ct][1] + bias)); o.y = cvt_pk_bf16(bf_lo(u.y) * (acc[ct][2] + bias), bf_hi(u.y) * (acc[ct][3] + bias));
            *(v2u*)(YB + row * SGW + col) = o; } }
    __syncthreads();
}

struct Args { const float* in[22]; float* out; unsigned char* ws; int ph_lo, ph_hi; };
__global__ void __launch_bounds__(NTHR, 2) mega(Args args) {
    extern __shared__ __attribute__((aligned(16))) unsigned char lds_raw[];
    Ctx c; c.lds0 = (LAS unsigned char*)lds_raw; c.lds = c.lds0 + RING_OFF; c.tid = threadIdx.x; c.lane = c.tid & 63; c.wave = __builtin_amdgcn_readfirstlane(c.tid >> 6); c.bid = blockIdx.x; c.nb = gridDim.x;
    volatile LAS unsigned* MISC = (volatile LAS unsigned*)(c.lds0 + MISC_OFF);
    for (int u = c.tid; u < RING_OFF / 4; u += NTHR) ((LAS unsigned*)(c.lds0 + LDSCTL_OFF))[u] = 0u;
    __syncthreads();
    unsigned char* ws = args.ws;
    gu32* ctl = (gu32*)(ws + WS_CTL);
    XcdBarrier bar = xcd_barrier_post((unsigned*)(ctl + CW_BAR), MISC + 8);
#define GRID_BAR() xcd_barrier(bar)
    const float* x = args.in[0]; const float* norm1_g = args.in[1]; const float* w_in = args.in[2]; const float* conv_w = args.in[3];
    const float* a_log = args.in[4]; const float* dt_bias = args.in[5]; const float* dn_norm_g = args.in[6]; const float* w_o_dn = args.in[7];
    const float* sg_ln_g = args.in[8]; const float* sg_ln_b = args.in[9]; const float* sg_w = args.in[10]; const float* sg_b = args.in[11];
    const float* w_o_sg = args.in[12]; const float* w_out = args.in[13]; const float* norm2_g = args.in[14]; const float* w_router = args.in[15];
    const float* b_router = args.in[16]; const float* w_gate_up = args.in[17]; const float* b_gate_up = args.in[18]; const float* w_down = args.in[19];
    const float* b_down = args.in[20]; const float* norm_f_g = args.in[21];
    float* out = args.out;
    unsigned char* wb = ws + WS_BASE;
    bf16* Hb = (bf16*)(wb + 0); bf16* H2b = (bf16*)(wb + 0);
    bf16* Win_t = (bf16*)(wb + 32 * MiB); bf16* Wo_t = (bf16*)(wb + 42 * MiB); bf16* Wout_t = (bf16*)(wb + 44 * MiB); float* BG = (float*)(wb + 46 * MiB);
    bf16* PROJb = (bf16*)(wb + 48 * MiB); bf16* ACTb = (bf16*)(wb + 48 * MiB);
    bf16* YAB = (bf16*)(wb + 208 * MiB); bf16* MERGED = (bf16*)(wb + 240 * MiB); float* X1 = (float*)(wb + 272 * MiB);
    float* QKV = (float*)(wb + 336 * MiB); float* O32 = (float*)(wb + 432 * MiB); float* U = (float*)(wb + 464 * MiB); float* VLN = (float*)(wb + 496 * MiB);
    bf16* Wgu_t = (bf16*)(wb + 528 * MiB); bf16* Wd_t = (bf16*)(wb + 656 * MiB); bf16* HS = (bf16*)(wb + 720 * MiB); bf16* Yb = (bf16*)(wb + 864 * MiB);
    unsigned char* small = wb + 1008 * MiB;
    int* slot_e = (int*)(small + 0 * MiB); int* slot_pos = (int*)(small + 1 * MiB); int* elist = (int*)(small + 2 * MiB); float* ewgt = (float*)(small + 4 * MiB); bf16* WrT = (bf16*)(small + 6 * MiB);
    unsigned* gcnt = (unsigned*)(ctl + CW_CNT);

#ifndef PROBE_MASK
#define PROBE_MASK 0
#endif
#define REP(bit) for (int _r = 0; _r < ((PROBE_MASK >> (bit)) & 1) + 1; ++_r)
    REP(0) { p_convert_front(c, w_in, w_o_dn, w_o_sg, w_out, Win_t, Wo_t, Wout_t);
    __syncthreads();
    p_norm1(c, x, norm1_g, w_in, a_log, dt_bias, Hb, BG); if (PROBE_MASK & 1) __syncthreads();
    p_build_wrt(c, w_router, WrT);
    for (int i = c.bid * NTHR + c.tid; i < NE * NTOK / 4; i += c.nb * NTHR) { ((v4u*)elist)[i] = (v4u){0u, 0u, 0u, 0u}; ((v4u*)ewgt)[i] = (v4u){0u, 0u, 0u, 0u}; } }
    GRID_BAR();
    REP(1) { pg8::Gemm g{Hb, Win_t, NTOK, PJ, D}; pg8::StaticOrder S; S.init(NTOK, PJ, c.nb, c.bid); EpiProj E{PROJb};
      pg8::gemm_phase<EpiProj, pg8::StaticOrder, true, true>(c.lds, g, S, E); }
    GRID_BAR();
    DnBufs DB; DB.WN = wb + 336 * MiB; DB.QD = wb + 352 * MiB; DB.KD = wb + 368 * MiB; DB.QK = wb + 384 * MiB; DB.U = wb + 392 * MiB; DB.SST = wb + 408 * MiB; DB.EG = (float*)(wb + 440 * MiB);
    REP(2) { p_dn_prep(c, PROJb, conv_w, BG, DB); }
    GRID_BAR();
    if (c.bid < SCAN_WGS) { REP(3) { p_dn_scan(c, DB); } }
    else { Ctx c2 = c; c2.bid = c.bid - SCAN_WGS; c2.nb = c.nb - SCAN_WGS;
        REP(4) { for (int it = c2.bid; it < (NTOK / SGC) * 4; it += c2.nb) p_sg_item(c, it, PROJb, sg_ln_g, sg_ln_b, sg_w, sg_b, YAB + (size_t)NTOK * DNW); }
        REP(5) { p_convert_moe(c2, w_gate_up, w_down, Wgu_t, Wd_t); } }
    GRID_BAR();
    REP(6) { p_dn_out(c, DB, PROJb, dn_norm_g, YAB); }
    GRID_BAR();
    REP(7) { pg8::Gemm g{YAB, Wo_t, 0, 0, DNW}; DualOrder S; S.init(c.nb, c.bid); EpiMerge E{PROJb, MERGED};
      pg8::gemm_phase<EpiMerge, DualOrder, true, true>(c.lds, g, S, E); }
    GRID_BAR();
    REP(8) { pg8::Gemm g{MERGED, Wout_t, NTOK, D, D}; pg8::StaticOrder S; S.init(NTOK, D, c.nb, c.bid); EpiResid E{x, X1};
      pg8::gemm_phase<EpiResid, pg8::StaticOrder, true, true>(c.lds, g, S, E); }
    GRID_BAR();
    p_router2(c, X1, norm2_g, WrT, b_router, H2b, slot_e, slot_pos, elist, ewgt, gcnt);
    GRID_BAR();
    LAS unsigned char* tile_e = c.lds0 + EXTRA_OFF + 512; LAS int* ntl = (LAS int*)(c.lds0 + EXTRA_OFF + 1024); LAS int* tile_b = (LAS int*)(c.lds0 + EXTRA_OFF + 1088);
    build_tile_table(c, gcnt, tile_e, ntl, tile_b);
    const int NTL = __builtin_amdgcn_readfirstlane(ntl[0]);
    REP(10) { pg8::Gemm g{H2b, Wgu_t, 0, 0, D, elist}; MoeOrder S; S.init(NTL, 8, c.nb, c.bid, tile_e, tile_b); EpiSwiglu E{ACTb, b_gate_up};
      pg8::gemm_phase<EpiSwiglu, MoeOrder, true, true, true>(c.lds, g, S, E); }
    GRID_BAR();
    REP(11) { pg8::Gemm g{ACTb, Wd_t, 0, 0, DFF}; MoeOrder S; S.init(NTL, 4, c.nb, c.bid, tile_e, tile_b); EpiDown E{Yb, b_down, ewgt};
      pg8::gemm_phase<EpiDown, MoeOrder, true, true>(c.lds, g, S, E); }
    GRID_BAR();
    REP(12) { p_final(c, X1, Yb, slot_e, slot_pos, gcnt, norm_f_g, out); }
    if (PROBE_MASK & 8192) { for (int k = 0; k < 10; ++k) GRID_BAR(); }
}

extern "C" void kernel_launch(void* const* d_in, const int* in_sizes, int n_in, void* d_out, int out_size, void* d_ws, size_t ws_size, hipStream_t stream) {
    static int grid = 0;
    if (grid == 0) {
        if (n_in != 22 || in_sizes[0] != NTOK * D || out_size != NTOK * D || ws_size < WS_NEED) { fprintf(stderr, "kernel_launch: unexpected shapes (n_in %d, ws %zu)\n", n_in, ws_size); grid = -1; return; }
        int dev = 0, cus = 0, per_cu = 0;
        if (hipGetDevice(&dev) != hipSuccess || hipDeviceGetAttribute(&cus, hipDeviceAttributeMultiprocessorCount, dev) != hipSuccess) { grid = -1; return; }
        if (hipFuncSetAttribute((const void*)mega, hipFuncAttributeMaxDynamicSharedMemorySize, LDS_BYTES) != hipSuccess) { fprintf(stderr, "kernel_launch: hipFuncSetAttribute failed\n"); grid = -1; return; }
        if (hipOccupancyMaxActiveBlocksPerMultiprocessor(&per_cu, (const void*)mega, NTHR, LDS_BYTES) != hipSuccess || per_cu < 1) fprintf(stderr, "kernel_launch: occupancy query reports %d\n", per_cu);
        (void)hipGetLastError();
        grid = cus;
    }
    if (grid < 0) return;
    if (hipMemsetAsync((char*)d_ws + WS_CTL, 0, CTL_ZERO_BYTES, stream) != hipSuccess) { fprintf(stderr, "kernel_launch: memset failed\n"); return; }
    Args a{};
    for (int i = 0; i < 22; ++i) a.in[i] = (const float*)d_in[i];
    a.out = (float*)d_out; a.ws = (unsigned char*)d_ws; a.ph_lo = 0; a.ph_hi = 100;
    hipLaunchKernelGGL(mega, dim3(grid), dim3(NTHR), LDS_BYTES, stream, a);
#if PROBE_MASK & 131072
    (void)hipMemsetAsync((char*)d_ws + WS_CTL, 0, CTL_ZERO_BYTES, stream); hipLaunchKernelGGL(mega, dim3(grid), dim3(NTHR), LDS_BYTES, stream, a);
#endif
    const hipError_t le = hipPeekAtLastError();
    if (le != hipSuccess) fprintf(stderr, "kernel_launch: launch failed: %s\n", hipGetErrorName(le));
}
```

```cpp
#include <hip/hip_runtime.h>
#include <cstdio>
#include <cstdint>
#include <cmath>

#define GAS __attribute__((address_space(1)))
#define LAS __attribute__((address_space(3)))
typedef GAS unsigned gu32;
#define RLX_AGENT __ATOMIC_RELAXED, __HIP_MEMORY_SCOPE_AGENT

constexpr int NWAVES = 8, NTHR = 512;
constexpr int D = 1024, BATCH = 2, SEQ = 8192, NTOK = BATCH * SEQ;
constexpr int DNH = 4, DNW = 512;
constexpr int SGD = 128, SGW = 512, SGC = 128;
constexpr int NE = 32, TOPK = 4, DFF = 1024;
constexpr int OFF_Z = 1536, OFF_BETA = 2048, OFF_A = 2052, OFF_U = 2056, OFF_V = 2568, OFF_GA = 3080, OFF_GB = 4104, INC = 5128;
constexpr float RMS_EPS = 1e-6f, LN_EPS = 1e-5f, L2_EPS = 1e-6f;

constexpr size_t MiB = 1u << 20;
constexpr size_t WS_CTL = 0, CTL_ZERO_BYTES = 1 * MiB;
constexpr int CW_BAR = 4096;
constexpr int CW_CNT = 16384;
constexpr size_t WS_BASE = 2 * MiB;
constexpr size_t WS_NEED = 1020 * MiB;
constexpr int LDSCTL_OFF = 0, MISC_OFF = 320, RING_OFF = 1024, RING_BYTES = 131072, EXTRA_OFF = RING_OFF + RING_BYTES, LDS_BYTES = 147456;

#define XB_TMO      128
#define XB_XCNT(j)  (256  + 64 * (j))
#define XB_XSUB(j)  (1280 + 64 * (j))
#define XB_XGEN(j)  (2304 + 64 * (j))
#define XB_TOP      3328
#define XB_TOPGEN   3392
#define XCD_BAR_WORDS 3456
#define XB_SPIN_CAP (1u << 22)
__device__ __forceinline__ unsigned xb_ld(unsigned* p)              { return __hip_atomic_load(p, __ATOMIC_RELAXED, __HIP_MEMORY_SCOPE_AGENT); }
__device__ __forceinline__ unsigned xb_add(unsigned* p, unsigned v) { return __hip_atomic_fetch_add(p, v, __ATOMIC_RELAXED, __HIP_MEMORY_SCOPE_AGENT); }
__device__ __forceinline__ unsigned xb_xcc_id() { return (unsigned)__builtin_amdgcn_s_getreg((3 << 11) | 20) & 0xFu; }
#define XB_SPIN(cond, bar) do { unsigned _sp = 0; while (cond) { __builtin_amdgcn_s_sleep(1); \
    if ((++_sp & 255u) == 0u) { if (xb_ld(&(bar)[XB_TMO])) break; if (_sp > XB_SPIN_CAP) { atomicAdd(&(bar)[XB_TMO], 1u); break; } } } } while (0)
struct XcdBarrier { unsigned* bar; unsigned x; volatile LAS unsigned* st; };
__device__ __forceinline__ XcdBarrier xcd_barrier_post(unsigned* bar, volatile LAS unsigned* st) {
    XcdBarrier b; b.bar = bar; b.x = xb_xcc_id(); b.st = st;
    if (threadIdx.x == 0) (void)xb_add(&bar[XB_XCNT(b.x)], 1u);
    return b;
}
__device__ __forceinline__ void xcd_barrier_complete(unsigned* bar, unsigned x, unsigned& nloc, unsigned& nx) {
    const unsigned G = gridDim.x * gridDim.y * gridDim.z;
    unsigned sum, cnt, mine, sp = 0u;
    for (;;) {
        sum = 0u; cnt = 0u; mine = 0u;
#pragma unroll
        for (unsigned j = 0; j < 16; ++j) { const unsigned c = xb_ld(&bar[XB_XCNT(j)]); sum += c; cnt += (c > 0u) ? 1u : 0u; mine = (j == x) ? c : mine; }
        if (sum == G) break;
        __builtin_amdgcn_s_sleep(1);
        if ((++sp & 255u) == 0u) { if (xb_ld(&bar[XB_TMO])) break; if (sp > XB_SPIN_CAP) { atomicAdd(&bar[XB_TMO], 1u); break; } }
    }
    nloc = mine > 0u ? mine : 1u; nx = cnt > 0u ? cnt : 1u;
}
__device__ __forceinline__ void xcd_barrier(const XcdBarrier& b) {
    asm volatile("s_waitcnt vmcnt(0)" ::: "memory");
    __syncthreads();
    if (threadIdx.x == 0) {
        unsigned* bar = b.bar;
        __builtin_amdgcn_s_waitcnt(0);
        unsigned nloc = b.st[0], nx = b.st[1];
        if (nloc == 0u) { xcd_barrier_complete(bar, b.x, nloc, nx); b.st[0] = nloc; b.st[1] = nx; }
        const unsigned old = xb_add(&bar[XB_XSUB(b.x)], 1u);
        const unsigned gen = old / nloc;
        if (old + 1u == (gen + 1u) * nloc) {
            __builtin_amdgcn_fence(__ATOMIC_RELEASE, "agent");
            asm volatile("s_waitcnt vmcnt(0)" ::: "memory");
            const unsigned og = xb_add(&bar[XB_TOP], 1u);
            const unsigned tg = og / nx;
            if (og + 1u == (tg + 1u) * nx) xb_add(&bar[XB_TOPGEN], 1u);
            else XB_SPIN(xb_ld(&bar[XB_TOPGEN]) == tg, bar);
            __builtin_amdgcn_fence(__ATOMIC_ACQUIRE, "agent");
            xb_add(&bar[XB_XGEN(b.x)], 1u);
            asm volatile("s_waitcnt vmcnt(0)" ::: "memory");
        } else {
            XB_SPIN(xb_ld(&bar[XB_XGEN(b.x)]) == gen, bar);
            __builtin_amdgcn_fence(__ATOMIC_ACQUIRE, "agent");
            asm volatile("s_waitcnt vmcnt(0)" ::: "memory");
        }
    }
    __syncthreads();
}

__device__ __forceinline__ float dpp_xor1(float v) { return __builtin_bit_cast(float, __builtin_amdgcn_update_dpp(0, __builtin_bit_cast(int, v), 0xB1, 0xF, 0xF, true)); }
__device__ __forceinline__ float dpp_xor2(float v) { return __builtin_bit_cast(float, __builtin_amdgcn_update_dpp(0, __builtin_bit_cast(int, v), 0x4E, 0xF, 0xF, true)); }
__device__ __forceinline__ float dpp_qrev(float v) { return __builtin_bit_cast(float, __builtin_amdgcn_update_dpp(0, __builtin_bit_cast(int, v), 0x1B, 0xF, 0xF, true)); }
__device__ __forceinline__ float dpp_hmir(float v) { return __builtin_bit_cast(float, __builtin_amdgcn_update_dpp(0, __builtin_bit_cast(int, v), 0x141, 0xF, 0xF, true)); }
__device__ __forceinline__ float dpp_rmir(float v) { return __builtin_bit_cast(float, __builtin_amdgcn_update_dpp(0, __builtin_bit_cast(int, v), 0x140, 0xF, 0xF, true)); }
__device__ __forceinline__ float dpp_ror8(float v) { return __builtin_bit_cast(float, __builtin_amdgcn_update_dpp(0, __builtin_bit_cast(int, v), 0x128, 0xF, 0xF, true)); }
__device__ __forceinline__ float dpp_xor4(float v) { return dpp_qrev(dpp_hmir(v)); }
__device__ __forceinline__ float row16_sum(float v) { v += dpp_xor1(v); v += dpp_xor2(v); v += dpp_hmir(v); v += dpp_rmir(v); return v; }
__device__ __forceinline__ float rdlane(float v, int l) { return __builtin_bit_cast(float, __builtin_amdgcn_readlane(__builtin_bit_cast(int, v), l)); }
__device__ __forceinline__ float wave_sum(float v) { v = row16_sum(v); return (rdlane(v, 0) + rdlane(v, 16)) + (rdlane(v, 32) + rdlane(v, 48)); }
__device__ __forceinline__ void swap32(float& a, float& b) { asm volatile("s_nop 1\n\tv_permlane32_swap_b32 %0, %1" : "+v"(a), "+v"(b)); }
__device__ __forceinline__ void swap16(float& a, float& b) { asm volatile("s_nop 1\n\tv_permlane16_swap_b32 %0, %1" : "+v"(a), "+v"(b)); }
#define BFLY_SW32(acc, n) _Pragma("unroll") for (int i_ = 0; i_ < (n) / 2; ++i_) { float x_ = acc[i_], y_ = acc[i_ + (n) / 2]; swap32(x_, y_); acc[i_] = x_ + y_; }
#define BFLY_SW16(acc, n) _Pragma("unroll") for (int i_ = 0; i_ < (n) / 2; ++i_) { float x_ = acc[i_], y_ = acc[i_ + (n) / 2]; swap16(x_, y_); acc[i_] = x_ + y_; }
#define BFLY_DPP(acc, n, m, PERM) _Pragma("unroll") for (int i_ = 0; i_ < (n) / 2; ++i_) { const bool up_ = (lane & (m)) != 0; const float send_ = up_ ? acc[i_] : acc[i_ + (n) / 2]; const float keep_ = up_ ? acc[i_ + (n) / 2] : acc[i_]; acc[i_] = keep_ + PERM(send_); }
__device__ __forceinline__ float sigmoidf_(float x) { return 1.f / (1.f + expf(-x)); }
__device__ __forceinline__ float siluf_(float x) { return x / (1.f + expf(-x)); }
__device__ __forceinline__ float geluf_(float x) { return 0.5f * x * (1.f + erff(x * 0.70710678118654752f)); }
__device__ __forceinline__ float softplusf_(float x) { return x > 20.f ? x : log1pf(expf(x)); }

__device__ __forceinline__ void lds_barrier() { asm volatile("s_waitcnt lgkmcnt(0)" ::: "memory"); __builtin_amdgcn_s_barrier(); asm volatile("" ::: "memory"); }
struct Ctx { int bid, nb, tid, lane, wave; LAS unsigned char* lds; LAS unsigned char* lds0; };

namespace pg8 {
#define PG8_LAS __attribute__((address_space(3)))
typedef unsigned short bf16_t;
typedef short bf16x8 __attribute__((ext_vector_type(8)));
typedef float f32x4 __attribute__((ext_vector_type(4)));
typedef unsigned u32x4 __attribute__((ext_vector_type(4)));
constexpr int BM = 256, BK = 64, HALF = 128, HTB = HALF * BK * 2  , STAGE_BYTES = 8 * HTB, NXCD = 8, WGM = 8;

__host__ __device__ __forceinline__ int lds_byte(int r, int c) { const int st = (r >> 4) * 2 + (c >> 5), rr = r & 15, cc = c & 31, ob = rr * 64 + cc * 2; return st * 1024 + (ob ^ (((ob >> 9) & 1) << 5)); }
__host__ __device__ __forceinline__ void stage_rc(int b, int& R, int& C) { const int st = b / 1024, sb = b % 1024, swz = sb ^ (((sb >> 9) & 1) << 5); R = (st >> 1) * 16 + swz / 64; C = (st & 1) * 32 + (swz % 64) / 2; }
__host__ __device__ __forceinline__ int perm32(int rho) { const int n = rho >> 4, i = rho & 15; return 8 * (i >> 2) + 4 * n + (i & 3); }

struct Unit { int pm, pn, x0, x1, rb; };
struct Gemm { const bf16_t* A; const bf16_t* Bt; int M, N, K; const int* rows; };

struct StaticOrder {
    int nM, nN, nwg, G, c;
    __host__ __device__ void init(int M, int N, int G_, int c_) { nM = M / BM; nN = N / BM; nwg = nM * nN; G = G_; c = c_; }
    __host__ __device__ bool next(int i, Unit& u) const {
        const long L = (long)i * G + c; if (L >= nwg) return false;
        int wgid = (int)L; { const int q = nwg / NXCD, r = nwg % NXCD, xcd = wgid % NXCD, off = wgid / NXCD; wgid = (xcd < r ? xcd * (q + 1) : r * (q + 1) + (xcd - r) * q) + off; }
        const int nig = WGM * nN, gid = wgid / nig, fm = gid * WGM, gsz = (nM - fm) < WGM ? (nM - fm) : WGM;
        u.pm = fm + ((wgid % nig) % gsz); u.pn = (wgid % nig) / gsz; u.x0 = 0; u.x1 = u.pn; u.rb = 0; return true;
    }
    __device__ __forceinline__ void a_ready(const Unit&) const {}
    __device__ __forceinline__ void done(const Unit&) const {}
};


template <class Epi, class Sched, bool ALIGN_EPI = false, bool SP2 = false, bool GATHER = false, int BAUX = 0>
__device__ __forceinline__ void gemm_phase(PG8_LAS unsigned char* lds, const Gemm g, const Sched& S, const Epi& E) {
    int tid_ = threadIdx.x; asm volatile("" : "+v"(tid_));
    const int tid = tid_, wid = __builtin_amdgcn_readfirstlane(tid >> 6), lane = tid & 63, wr = wid >> 2, wc = wid & 3, fr = lane & 15, fq = lane >> 4;
    const int K = g.K, nt = K / BK;
    unsigned voffA[2], voffB[2]; int gR[2]; unsigned gC2[2];
#pragma unroll
    for (int i = 0; i < 2; ++i) { int R, C; stage_rc(tid * 16 + i * 8192, R, C); const int Rb = Epi::PERM ? ((R & ~31) + perm32(R & 31)) : R;
        voffA[i] = (unsigned)(R * K + C) * 2u; voffB[i] = (unsigned)(Rb * K + C) * 2u; gR[i] = R; gC2[i] = (unsigned)C * 2u; }
    static_assert(!GATHER || SP2, "GATHER is implemented for the SP2 loop only");
    unsigned gcur[2][2], gnxt[2][2]; int graw[4];
#define PG8_STAGE_A(bufoff, kptr, ktile, h, use_next) do { if constexpr (GATHER) { const unsigned sv_[2] = {(use_next) ? gnxt[h][0] : gcur[h][0], (use_next) ? gnxt[h][1] : gcur[h][1]}; \
        PG8_STAGE(bufoff, gA0 + (size_t)(ktile) * kstep, sv_); } else { PG8_STAGE(bufoff, (kptr) + ((h) ? hstep : 0), voffA); } } while (0)
    const size_t kstep = (size_t)(BK * 2);
    const size_t hstep = (size_t)HALF * K * 2;
    const size_t tstep = 2 * hstep;
    const unsigned ldsw = (unsigned)wid * 1024u;
    const int aoff = lds_byte(wr * 64 + fr, fq * 8), boff = lds_byte(wc * 32 + fr, fq * 8);
#define PG8_SA(b, h) (((b) * 2 + (h)) * HTB)
#define PG8_SB(b, h) ((4 + (b) * 2 + (h)) * HTB)
#define PG8_STAGE(bufoff, gbase, voff) do { _Pragma("unroll") for (int _i = 0; _i < 2; ++_i) \
        __builtin_amdgcn_global_load_lds((const unsigned*)((const char*)(gbase) + (voff)[_i]), (PG8_LAS unsigned*)(lds + (bufoff) + ldsw + _i * 8192), 16, 0, 0); } while (0)
#define PG8_STAGE_B(bufoff, gbase, voff) do { _Pragma("unroll") for (int _i = 0; _i < 2; ++_i) \
        __builtin_amdgcn_global_load_lds((const unsigned*)((const char*)(gbase) + (voff)[_i]), (PG8_LAS unsigned*)(lds + (bufoff) + ldsw + _i * 8192), 16, 0, BAUX); } while (0)
#define PG8_LDA(dst, b, h) do { _Pragma("unroll") for (int m = 0; m < 4; ++m) _Pragma("unroll") for (int k = 0; k < 2; ++k) dst[m][k] = *(const PG8_LAS bf16x8*)(lds + PG8_SA(b, h) + aoff + m * 2048 + k * 1024); } while (0)
#define PG8_LDB(dst, b, h) do { _Pragma("unroll") for (int n = 0; n < 2; ++n) _Pragma("unroll") for (int k = 0; k < 2; ++k) dst[n][k] = *(const PG8_LAS bf16x8*)(lds + PG8_SB(b, h) + boff + n * 2048 + k * 1024); } while (0)
#define PG8_MMA(ai, bj, At, Bt) do { __builtin_amdgcn_s_setprio(1); _Pragma("unroll") for (int m = 0; m < 4; ++m) _Pragma("unroll") for (int n = 0; n < 2; ++n) _Pragma("unroll") for (int k = 0; k < 2; ++k) \
        acc[ai][bj][m][n] = __builtin_amdgcn_mfma_f32_16x16x32_bf16(Bt[n][k], At[m][k], acc[ai][bj][m][n], 0, 0, 0); __builtin_amdgcn_s_setprio(0); } while (0)
#define PG8_WAIT_V(n) asm volatile("s_waitcnt vmcnt(" #n ")" ::: "memory")
#define PG8_WAIT_L(n) asm volatile("s_waitcnt lgkmcnt(" #n ")" ::: "memory")
#define PG8_BAR __builtin_amdgcn_s_barrier()
#define PG8_SCHED __builtin_amdgcn_sched_barrier(0)
    Unit cur, nxt; int ui = 0;
    if (!S.next(0, cur)) return;
    f32x4 acc[2][2][4][2];
#pragma unroll
    for (int a = 0; a < 2; ++a)
#pragma unroll
        for (int b = 0; b < 2; ++b)
#pragma unroll
            for (int m = 0; m < 4; ++m)
#pragma unroll
                for (int n = 0; n < 2; ++n) acc[a][b][m][n] = (f32x4){0.f, 0.f, 0.f, 0.f};
    bf16x8 At[4][2], B0[2][2], B1[2][2];
    const char* cA = (const char*)g.A + (size_t)cur.pm * tstep; const char* cB = (const char*)g.Bt + (size_t)cur.pn * tstep;
    const char* const gA0 = (const char*)g.A;
    if constexpr (GATHER) {
#pragma unroll
        for (int h = 0; h < 2; ++h)
#pragma unroll
            for (int i = 0; i < 2; ++i) { gcur[h][i] = (unsigned)g.rows[cur.rb + h * HALF + gR[i]] * (unsigned)(K * 2) + gC2[i]; gnxt[h][i] = gcur[h][i]; } }
    S.a_ready(cur);
    if constexpr (SP2) {
        PG8_STAGE_B(PG8_SB(0, 0), cB, voffB); PG8_STAGE_B(PG8_SB(0, 1), cB + hstep, voffB); PG8_STAGE_A(PG8_SA(0, 0), cA, 0, 0, false); PG8_STAGE_A(PG8_SA(0, 1), cA, 0, 1, false);
        if (wr == 1) PG8_BAR;
        PG8_WAIT_V(2); PG8_BAR;
        PG8_STAGE_B(PG8_SB(1, 0), cB + kstep, voffB); PG8_STAGE_A(PG8_SA(1, 0), cA + kstep, 1, 0, false); PG8_STAGE_B(PG8_SB(1, 1), cB + hstep + kstep, voffB);
        PG8_WAIT_V(6); PG8_BAR;
    } else {
        PG8_STAGE_B(PG8_SB(0, 0), cB, voffB); PG8_STAGE(PG8_SA(0, 0), cA, voffA); PG8_STAGE_B(PG8_SB(0, 1), cB + hstep, voffB); PG8_STAGE(PG8_SA(0, 1), cA + hstep, voffA);
        if (wr == 1) PG8_BAR;
        PG8_WAIT_V(4); PG8_BAR;
        PG8_STAGE_B(PG8_SB(1, 0), cB + kstep, voffB); PG8_STAGE(PG8_SA(1, 0), cA + kstep, voffA); PG8_STAGE_B(PG8_SB(1, 1), cB + hstep + kstep, voffB);
        PG8_WAIT_V(6); PG8_BAR;
    }
    for (;;) {
        const bool has_next = S.next(ui + 1, nxt);
        const char* nA = has_next ? (const char*)g.A + (size_t)nxt.pm * tstep : cA; const char* nB = has_next ? (const char*)g.Bt + (size_t)nxt.pn * tstep : cB;
        if constexpr (GATHER) { if (has_next) {
#pragma unroll
            for (int h = 0; h < 2; ++h)
#pragma unroll
                for (int i = 0; i < 2; ++i) asm volatile("global_load_dword %0, %1, off" : "=v"(graw[h * 2 + i]) : "v"(g.rows + (nxt.rb + h * HALF + gR[i])) : "memory"); } }
        for (int t = 0; t < nt; t += 2) {
            const bool last = (t == nt - 2);
            const char* a1 = cA + (size_t)(t + 1) * kstep;
            const char* a2 = last ? nA : cA + (size_t)(t + 2) * kstep; const char* b2 = last ? nB : cB + (size_t)(t + 2) * kstep;
            const char* a3 = a2 + kstep; const char* b3 = b2 + kstep;
            if (last && has_next) S.a_ready(nxt);
            if constexpr (GATHER) { if (last) { if (has_next) { asm volatile("" : "+v"(graw[0]), "+v"(graw[1]), "+v"(graw[2]), "+v"(graw[3]));
#pragma unroll
                    for (int h = 0; h < 2; ++h)
#pragma unroll
                        for (int i = 0; i < 2; ++i) gnxt[h][i] = (unsigned)graw[h * 2 + i] * (unsigned)(K * 2) + gC2[i]; }
                else {
#pragma unroll
                    for (int h = 0; h < 2; ++h)
#pragma unroll
                        for (int i = 0; i < 2; ++i) gnxt[h][i] = gcur[h][i]; } } }
            const int kt2 = last ? 0 : t + 2;
            if constexpr (SP2) {
            PG8_LDB(B0, 0, 0); PG8_LDB(B1, 0, 1); PG8_SCHED; PG8_LDA(At, 0, 0); PG8_STAGE_A(PG8_SA(1, 1), a1, t + 1, 1, false);
            PG8_WAIT_V(8); PG8_WAIT_L(0); PG8_BAR; PG8_MMA(0, 0, At, B0); PG8_MMA(0, 1, At, B1); PG8_BAR; PG8_SCHED;
            PG8_LDA(At, 0, 1); PG8_STAGE_B(PG8_SB(0, 0), b2, voffB); PG8_STAGE_B(PG8_SB(0, 1), b2 + hstep, voffB); PG8_STAGE_A(PG8_SA(0, 0), a2, kt2, 0, last);
            PG8_WAIT_V(8); PG8_WAIT_L(0); PG8_BAR; PG8_MMA(1, 0, At, B0); PG8_MMA(1, 1, At, B1); PG8_BAR; PG8_SCHED;
            PG8_LDB(B0, 1, 0); PG8_LDB(B1, 1, 1); PG8_SCHED; PG8_LDA(At, 1, 0); PG8_STAGE_A(PG8_SA(0, 1), a2, kt2, 1, last);
            PG8_WAIT_V(8); PG8_WAIT_L(0); PG8_BAR; PG8_MMA(0, 0, At, B0); PG8_MMA(0, 1, At, B1); PG8_BAR; PG8_SCHED;
            PG8_LDA(At, 1, 1); PG8_STAGE_B(PG8_SB(1, 0), b3, voffB); PG8_STAGE_B(PG8_SB(1, 1), b3 + hstep, voffB); PG8_STAGE_A(PG8_SA(1, 0), a3, kt2 + 1, 0, last);
            PG8_WAIT_V(8); PG8_WAIT_L(0); PG8_BAR; PG8_MMA(1, 0, At, B0); PG8_MMA(1, 1, At, B1); PG8_BAR; PG8_SCHED;
            } else {
            PG8_LDB(B0, 0, 0); PG8_SCHED; PG8_LDA(At, 0, 0); PG8_STAGE(PG8_SA(1, 1), a1 + hstep, voffA);
            PG8_WAIT_L(8); PG8_BAR; PG8_WAIT_L(0); PG8_MMA(0, 0, At, B0); PG8_BAR; PG8_SCHED;
            PG8_LDB(B1, 0, 1); PG8_STAGE_B(PG8_SB(0, 0), b2, voffB);
            PG8_BAR; PG8_WAIT_L(0); PG8_MMA(0, 1, At, B1); PG8_BAR;
            PG8_LDA(At, 0, 1); PG8_STAGE(PG8_SA(0, 0), a2, voffA);
            PG8_BAR; PG8_WAIT_L(0); PG8_MMA(1, 0, At, B0); PG8_BAR; PG8_SCHED;
            PG8_STAGE_B(PG8_SB(0, 1), b2 + hstep, voffB);
            PG8_WAIT_V(6); PG8_BAR; PG8_MMA(1, 1, At, B1); PG8_BAR;
            PG8_LDB(B0, 1, 0); PG8_SCHED; PG8_LDA(At, 1, 0); PG8_STAGE(PG8_SA(0, 1), a2 + hstep, voffA);
            PG8_WAIT_L(8); PG8_BAR; PG8_WAIT_L(0); PG8_MMA(0, 0, At, B0); PG8_BAR; PG8_SCHED;
            PG8_LDB(B1, 1, 1); PG8_STAGE_B(PG8_SB(1, 0), b3, voffB);
            PG8_BAR; PG8_WAIT_L(0); PG8_MMA(0, 1, At, B1); PG8_BAR;
            PG8_LDA(At, 1, 1); PG8_STAGE(PG8_SA(1, 0), a3, voffA);
            PG8_BAR; PG8_WAIT_L(0); PG8_MMA(1, 0, At, B0); PG8_BAR; PG8_SCHED;
            PG8_STAGE_B(PG8_SB(1, 1), b3 + hstep, voffB);
            PG8_WAIT_V(6); PG8_BAR; PG8_MMA(1, 1, At, B1); PG8_BAR;
            }
        }
        if constexpr (ALIGN_EPI) { if (wr == 0) PG8_BAR; }
        if constexpr (!Epi::AFTER_DRAIN) { E(acc, cur, wr, wc, fr, fq); S.done(cur); }
        if (!has_next) break;
        if (!E.keep_acc(cur)) {
#pragma unroll
        for (int a = 0; a < 2; ++a)
#pragma unroll
            for (int b = 0; b < 2; ++b)
#pragma unroll
                for (int m = 0; m < 4; ++m)
#pragma unroll
                    for (int n = 0; n < 2; ++n) acc[a][b][m][n] = (f32x4){0.f, 0.f, 0.f, 0.f};
        }
        cur = nxt; cA = nA; cB = nB; ++ui;
        if constexpr (GATHER) {
#pragma unroll
            for (int h = 0; h < 2; ++h)
#pragma unroll
                for (int i = 0; i < 2; ++i) gcur[h][i] = gnxt[h][i]; }
        if constexpr (ALIGN_EPI) { if (wr == 1) PG8_BAR; }
    }
    PG8_WAIT_V(0);
    if constexpr (!ALIGN_EPI) { if (wr == 0) PG8_BAR; }
    PG8_BAR;
    if constexpr (Epi::AFTER_DRAIN) { E.fused(acc, cur, wr, wc, fr, fq, lds, wid, lane); S.done(cur); }
#undef PG8_SA
#undef PG8_SB
#undef PG8_STAGE
#undef PG8_STAGE_B
#undef PG8_STAGE_A
#undef PG8_LDA
#undef PG8_LDB
#undef PG8_MMA
#undef PG8_WAIT_V
#undef PG8_WAIT_L
#undef PG8_BAR
#undef PG8_SCHED
}
}
typedef unsigned short bf16;
typedef unsigned v4u __attribute__((ext_vector_type(4)));
typedef unsigned v2u __attribute__((ext_vector_type(2)));
typedef float f32x4 __attribute__((ext_vector_type(4)));
typedef short bf16x8 __attribute__((ext_vector_type(8)));
#define MFMA16(a, b, c) __builtin_amdgcn_mfma_f32_16x16x32_bf16((a), (b), (c), 0, 0, 0)
__device__ __forceinline__ bf16x8 as_frag(const v4u& x) { return __builtin_bit_cast(bf16x8, x); }
#define LDS_WAIT() asm volatile("s_waitcnt lgkmcnt(0)" ::: "memory")
#define VM_WAIT() asm volatile("s_waitcnt vmcnt(0)" ::: "memory")
typedef float cvt_f32x2 __attribute__((ext_vector_type(2)));
typedef __bf16 cvt_bf16x2 __attribute__((ext_vector_type(2)));
__device__ __forceinline__ unsigned cvt_pk_bf16(float lo, float hi) { const cvt_f32x2 v = {lo, hi}; return __builtin_bit_cast(unsigned, __builtin_convertvector(v, cvt_bf16x2)); }
__device__ __forceinline__ v4u ldnt4(const void* p) { return __builtin_nontemporal_load((const v4u*)p); }
__device__ __forceinline__ v2u ldnt2(const void* p) { return __builtin_nontemporal_load((const v2u*)p); }
__device__ __forceinline__ float bf_lo(unsigned u) { return __uint_as_float(u << 16); }
__device__ __forceinline__ float bf_hi(unsigned u) { return __uint_as_float(u & 0xffff0000u); }

template <bool NT = false>
__device__ __forceinline__ void tr_item(const float* __restrict__ src, int ldn, int k0, int nsrc0, bf16* dst, int K, int ndst0, LAS float* scr, int lane) {
    const int c4 = (lane & 15) * 4, kr = lane >> 4;
#pragma unroll 4
    for (int i = 0; i < 16; ++i) { const int kk = 4 * i + kr; const f32x4* gp = (const f32x4*)(src + (size_t)(k0 + kk) * ldn + nsrc0 + c4); const f32x4 v = NT ? __builtin_nontemporal_load(gp) : *gp;
        LAS float* s = scr + kk * 65 + c4; s[0] = v[0]; s[1] = v[1]; s[2] = v[2]; s[3] = v[3]; }
    LDS_WAIT();
    const int kc = lane & 7, nr = lane >> 3;
#pragma unroll
    for (int jj = 0; jj < 8; ++jj) { const int n = 8 * jj + nr; const LAS float* s = scr + (8 * kc) * 65 + n;
        v4u o; o.x = cvt_pk_bf16(s[0], s[65]); o.y = cvt_pk_bf16(s[130], s[195]); o.z = cvt_pk_bf16(s[260], s[325]); o.w = cvt_pk_bf16(s[390], s[455]);
        v4u* dp = (v4u*)(dst + (size_t)(ndst0 + n) * K + k0 + 8 * kc); if (NT) __builtin_nontemporal_store(o, dp); else *dp = o; }
    LDS_WAIT();
}
__device__ __forceinline__ void p_convert_moe(const Ctx& c, const float* w_gate_up, const float* w_down, bf16* Wgu_t, bf16* Wd_t) {
    LAS float* scr = (LAS float*)c.lds + c.wave * (64 * 65);
    constexpr int I_GU = NE * 16 * 32, I_D = NE * 16 * 16;
    for (int it = c.bid * NWAVES + c.wave; it < I_GU + I_D; it += c.nb * NWAVES) {
        if (it < I_GU) { const int e = it >> 9, r = it & 511, kb = r >> 5, nbk = r & 31, R0 = nbk * 64, pn = R0 >> 8, rr = R0 & 255, bj = rr >> 7, j0 = rr & 127;
            tr_item<true>(w_gate_up + (size_t)e * D * 2 * DFF, 2 * DFF, kb * 64, bj * DFF + 128 * pn + j0, Wgu_t + (size_t)e * 2 * DFF * D, D, R0, scr, c.lane); }
        else { const int r2 = it - I_GU, e = r2 >> 8, r = r2 & 255, kb = r >> 4, nbk = r & 15;
            tr_item<true>(w_down + (size_t)e * DFF * D, D, kb * 64, nbk * 64, Wd_t + (size_t)e * D * DFF, DFF, nbk * 64, scr, c.lane); }
    }
}

__device__ __forceinline__ float f4c(const float4& v, int i) { return i == 0 ? v.x : (i == 1 ? v.y : (i == 2 ? v.z : v.w)); }
__device__ __forceinline__ void p_router(const Ctx& c, const float* __restrict__ X1, const float* __restrict__ g2, const float* __restrict__ wr, const float* __restrict__ br, bf16* __restrict__ H2, int* __restrict__ slot_e, int* __restrict__ slot_pos, int* __restrict__ elist, float* __restrict__ ewgt, unsigned* gcnt, int reps = 1) {
    LAS f32x4* WL = (LAS f32x4*)c.lds;
    LAS float* LG = (LAS float*)(c.lds0 + EXTRA_OFF);
    LAS int* HIST = (LAS int*)(c.lds0 + EXTRA_OFF + 8192);
    LAS int* BASE = HIST + 32;
    LAS int* SELE = BASE + 32;
    LAS int* SELR = SELE + 256;
    LAS float* SELW = (LAS float*)(SELR + 256);
    const int lane = c.lane;
    { f32x4 wv[16];
#pragma unroll
      for (int i = 0; i < 16; ++i) wv[i] = ((const f32x4*)wr)[c.tid + NTHR * i];
#pragma unroll
      for (int i = 0; i < 16; ++i) { const int idx = c.tid + NTHR * i, k = idx >> 3, q = idx & 7, l = (k & 255) >> 2, cc = k & 3, j = k >> 8; WL[((j * 4 + cc) * 8 + q) * 64 + l] = wv[i]; } }
    lds_barrier();
    for (int blk = c.bid; blk < NTOK / 64; blk += c.nb) {
        if (c.tid < 32) HIST[c.tid] = 0;
        lds_barrier();
        for (int pp = 0; pp < 4 * reps; ++pp) { const int p = pp & 3;
            const size_t t0 = (size_t)blk * 64 + c.wave * 8 + 2 * p;
            float4 xa[4], xb[4]; float sa = 0.f, sb = 0.f;
#pragma unroll
            for (int j = 0; j < 4; ++j) { xa[j] = ((const float4*)(X1 + t0 * D))[lane + 64 * j]; xb[j] = ((const float4*)(X1 + (t0 + 1) * D))[lane + 64 * j];
                sa += xa[j].x * xa[j].x + xa[j].y * xa[j].y + xa[j].z * xa[j].z + xa[j].w * xa[j].w; sb += xb[j].x * xb[j].x + xb[j].y * xb[j].y + xb[j].z * xb[j].z + xb[j].w * xb[j].w; }
            const float ra = rsqrtf(wave_sum(sa) * (1.f / D) + RMS_EPS), rb = rsqrtf(wave_sum(sb) * (1.f / D) + RMS_EPS);
#pragma unroll
            for (int j = 0; j < 4; ++j) { const float4 g = ((const float4*)g2)[lane + 64 * j];
                xa[j].x *= ra * g.x; xa[j].y *= ra * g.y; xa[j].z *= ra * g.z; xa[j].w *= ra * g.w; xb[j].x *= rb * g.x; xb[j].y *= rb * g.y; xb[j].z *= rb * g.z; xb[j].w *= rb * g.w;
                v2u oa, ob; oa.x = cvt_pk_bf16(xa[j].x, xa[j].y); oa.y = cvt_pk_bf16(xa[j].z, xa[j].w); ob.x = cvt_pk_bf16(xb[j].x, xb[j].y); ob.y = cvt_pk_bf16(xb[j].z, xb[j].w);
                ((v2u*)(H2 + t0 * D))[lane + 64 * j] = oa; ((v2u*)(H2 + (t0 + 1) * D))[lane + 64 * j] = ob; }
            float acc[64];
#pragma unroll
            for (int i = 0; i < 64; ++i) acc[i] = 0.f;
#pragma unroll
            for (int j = 0; j < 4; ++j)
#pragma unroll
                for (int cc = 0; cc < 4; ++cc) { const float ha = f4c(xa[j], cc), hb = f4c(xb[j], cc);
#pragma unroll
                    for (int q = 0; q < 8; ++q) { const f32x4 w = WL[((j * 4 + cc) * 8 + q) * 64 + lane];
                        acc[4 * q + 0] = fmaf(ha, w.x, acc[4 * q + 0]); acc[4 * q + 1] = fmaf(ha, w.y, acc[4 * q + 1]); acc[4 * q + 2] = fmaf(ha, w.z, acc[4 * q + 2]); acc[4 * q + 3] = fmaf(ha, w.w, acc[4 * q + 3]);
                        acc[32 + 4 * q + 0] = fmaf(hb, w.x, acc[32 + 4 * q + 0]); acc[32 + 4 * q + 1] = fmaf(hb, w.y, acc[32 + 4 * q + 1]); acc[32 + 4 * q + 2] = fmaf(hb, w.z, acc[32 + 4 * q + 2]); acc[32 + 4 * q + 3] = fmaf(hb, w.w, acc[32 + 4 * q + 3]); } }
            BFLY_SW32(acc, 64) BFLY_SW16(acc, 32) BFLY_DPP(acc, 16, 8, dpp_ror8) BFLY_DPP(acc, 8, 4, dpp_xor4) BFLY_DPP(acc, 4, 2, dpp_xor2) BFLY_DPP(acc, 2, 1, dpp_xor1)
            LG[(c.wave * 8 + 2 * p + (lane >> 5)) * 32 + (lane & 31)] = acc[0] + br[lane & 31];
        }
        LDS_WAIT();
        if (lane < 8) {
            const int tokl = c.wave * 8 + lane;
            float l[NE];
#pragma unroll
            for (int j = 0; j < NE; ++j) l[j] = LG[tokl * 32 + j];
            int sel[4]; float sv[4];
#pragma unroll
            for (int k = 0; k < 4; ++k) { int bi = 0; float bv = -INFINITY;
#pragma unroll
                for (int j = 0; j < NE; ++j) { const bool better = l[j] > bv; bv = better ? l[j] : bv; bi = better ? j : bi; }
                sel[k] = bi; sv[k] = bv;
#pragma unroll
                for (int j = 0; j < NE; ++j) l[j] = (j == bi) ? -INFINITY : l[j]; }
            float den = 0.f, ex[4];
#pragma unroll
            for (int k = 0; k < 4; ++k) { ex[k] = expf(sv[k] - sv[0]); den += ex[k]; }
            const float inv = 1.f / den;
#pragma unroll
            for (int k = 0; k < 4; ++k) { SELE[tokl * 4 + k] = sel[k]; SELW[tokl * 4 + k] = ex[k] * inv; SELR[tokl * 4 + k] = atomicAdd((int*)(HIST + sel[k]), 1); }
        }
        lds_barrier();
        if (c.tid < 32) BASE[c.tid] = (int)__hip_atomic_fetch_add(gcnt + c.tid, (unsigned)HIST[c.tid], __ATOMIC_RELAXED, __HIP_MEMORY_SCOPE_AGENT);
        lds_barrier();
        if (c.tid < 256) { const int gi = blk * 256 + c.tid, e = SELE[c.tid], pos = BASE[e] + SELR[c.tid]; slot_e[gi] = e; slot_pos[gi] = pos; elist[e * NTOK + pos] = gi >> 2; ewgt[e * NTOK + pos] = SELW[c.tid]; }
    }
}

__device__ __forceinline__ void p_build_wrt(const Ctx& c, const float* __restrict__ wr, bf16* __restrict__ WrT) {
    for (int i = c.bid * NTHR + c.tid; i < NE * D; i += c.nb * NTHR) { const int e = i >> 10, k = i & 1023; const float w = wr[k * NE + e];
        const unsigned hi = cvt_pk_bf16(w, 0.f) & 0xffffu; const float rem = w - __uint_as_float(hi << 16);
        WrT[e * D + k] = (bf16)hi; WrT[NE * D + e * D + k] = (bf16)(cvt_pk_bf16(rem, 0.f) & 0xffffu); }
}
__device__ __forceinline__ void p_router2(const Ctx& c, const float* __restrict__ X1, const float* __restrict__ g2, const bf16* __restrict__ WrT, const float* __restrict__ br, bf16* __restrict__ H2,
                                          int* __restrict__ slot_e, int* __restrict__ slot_pos, int* __restrict__ elist, float* __restrict__ ewgt, unsigned* gcnt) {
    LAS unsigned char* HH = c.lds; LAS unsigned char* HL = c.lds + 65536;
    LAS float* LG = (LAS float*)(c.lds0 + EXTRA_OFF);
    LAS float* PART = LG + 1024;
    LAS int* HIST = (LAS int*)(PART + 1024);
    LAS int* BASE = HIST + 32; LAS int* SELE = BASE + 32; LAS int* SELR = SELE + 128; LAS float* SELW = (LAS float*)(SELR + 128);
    const int lane = c.lane, w = c.wave, fr = lane & 15, fq = lane >> 4;
    for (int blk = c.bid; blk < NTOK / 32; blk += c.nb) {
        if (c.tid < 32) HIST[c.tid] = 0;
#pragma unroll 1
        for (int p = 0; p < 2; ++p) {
            const int tl = w * 4 + 2 * p; const size_t t0 = (size_t)blk * 32 + tl;
            float4 xa[4], xb[4]; float sa = 0.f, sb = 0.f;
#pragma unroll
            for (int j = 0; j < 4; ++j) { xa[j] = ((const float4*)(X1 + t0 * D))[lane + 64 * j]; xb[j] = ((const float4*)(X1 + (t0 + 1) * D))[lane + 64 * j];
                sa += xa[j].x * xa[j].x + xa[j].y * xa[j].y + xa[j].z * xa[j].z + xa[j].w * xa[j].w; sb += xb[j].x * xb[j].x + xb[j].y * xb[j].y + xb[j].z * xb[j].z + xb[j].w * xb[j].w; }
            const float ra = rsqrtf(wave_sum(sa) * (1.f / D) + RMS_EPS), rb = rsqrtf(wave_sum(sb) * (1.f / D) + RMS_EPS);
#pragma unroll
            for (int j = 0; j < 4; ++j) { const float4 g = ((const float4*)g2)[lane + 64 * j];
                const float ha[4] = {xa[j].x * ra * g.x, xa[j].y * ra * g.y, xa[j].z * ra * g.z, xa[j].w * ra * g.w}, hb[4] = {xb[j].x * rb * g.x, xb[j].y * rb * g.y, xb[j].z * rb * g.z, xb[j].w * rb * g.w};
                v2u ah, al, bh, bl;
                ah.x = cvt_pk_bf16(ha[0], ha[1]); ah.y = cvt_pk_bf16(ha[2], ha[3]); bh.x = cvt_pk_bf16(hb[0], hb[1]); bh.y = cvt_pk_bf16(hb[2], hb[3]);
                al.x = cvt_pk_bf16(ha[0] - bf_lo(ah.x), ha[1] - bf_hi(ah.x)); al.y = cvt_pk_bf16(ha[2] - bf_lo(ah.y), ha[3] - bf_hi(ah.y));
                bl.x = cvt_pk_bf16(hb[0] - bf_lo(bh.x), hb[1] - bf_hi(bh.x)); bl.y = cvt_pk_bf16(hb[2] - bf_lo(bh.y), hb[3] - bf_hi(bh.y));
                ((v2u*)(H2 + t0 * D))[lane + 64 * j] = ah; ((v2u*)(H2 + (t0 + 1) * D))[lane + 64 * j] = bh;
                const int ch = (lane >> 1) + 32 * j, h8 = 8 * (lane & 1);
                const int oa = tl * 2048 + 16 * (ch ^ (tl & 15)) + h8, ob = (tl + 1) * 2048 + 16 * (ch ^ ((tl + 1) & 15)) + h8;
                *(LAS v2u*)(HH + oa) = ah; *(LAS v2u*)(HL + oa) = al; *(LAS v2u*)(HH + ob) = bh; *(LAS v2u*)(HL + ob) = bl; }
        }
        lds_barrier();
        { const int mt = w & 1, nt = (w >> 1) & 1, kh = w >> 2, tok = 16 * mt + fr; f32x4 acc = {0.f, 0.f, 0.f, 0.f};
            const bf16* wh = WrT + (size_t)(16 * nt + fr) * D + 8 * fq; const bf16* wl = wh + NE * D;
#pragma unroll 4
            for (int kk = 16 * kh; kk < 16 * kh + 16; ++kk) { const int off = tok * 2048 + 16 * ((4 * kk + fq) ^ (tok & 15));
                const bf16x8 ahi = *(const LAS bf16x8*)(HH + off), alo = *(const LAS bf16x8*)(HL + off);
                const bf16x8 bhi = as_frag(*(const v4u*)(wh + 32 * kk)), blo = as_frag(*(const v4u*)(wl + 32 * kk));
                acc = MFMA16(ahi, bhi, acc); acc = MFMA16(ahi, blo, acc); acc = MFMA16(alo, bhi, acc); }
            if (kh == 1) *(LAS f32x4*)(PART + ((mt * 2 + nt) * 64 + lane) * 4) = acc;
            lds_barrier();
            if (kh == 0) { const f32x4 pr = *(const LAS f32x4*)(PART + ((mt * 2 + nt) * 64 + lane) * 4); const float bb = br[16 * nt + fr];
#pragma unroll
                for (int r = 0; r < 4; ++r) LG[(16 * mt + 4 * fq + r) * 32 + 16 * nt + fr] = acc[r] + pr[r] + bb; } }
        lds_barrier();
        if (c.tid < 32) {
            const int tokl = c.tid;
            float l[NE];
#pragma unroll
            for (int j = 0; j < NE; ++j) l[j] = LG[tokl * 32 + j];
            int sel[4]; float sv[4];
#pragma unroll
            for (int k = 0; k < 4; ++k) { int bi = 0; float bv = -INFINITY;
#pragma unroll
                for (int j = 0; j < NE; ++j) { const bool better = l[j] > bv; bv = better ? l[j] : bv; bi = better ? j : bi; }
                sel[k] = bi; sv[k] = bv;
#pragma unroll
                for (int j = 0; j < NE; ++j) l[j] = (j == bi) ? -INFINITY : l[j]; }
            float den = 0.f, ex[4];
#pragma unroll
            for (int k = 0; k < 4; ++k) { ex[k] = expf(sv[k] - sv[0]); den += ex[k]; }
            const float inv = 1.f / den;
#pragma unroll
            for (int k = 0; k < 4; ++k) { SELE[tokl * 4 + k] = sel[k]; SELW[tokl * 4 + k] = ex[k] * inv; SELR[tokl * 4 + k] = atomicAdd((int*)(HIST + sel[k]), 1); }
        }
        lds_barrier();
        if (c.tid < 32) BASE[c.tid] = (int)__hip_atomic_fetch_add(gcnt + c.tid, (unsigned)HIST[c.tid], __ATOMIC_RELAXED, __HIP_MEMORY_SCOPE_AGENT);
        lds_barrier();
        if (c.tid < 128) { const int gi = blk * 128 + c.tid, e = SELE[c.tid], pos = BASE[e] + SELR[c.tid]; slot_e[gi] = e; slot_pos[gi] = pos; elist[e * NTOK + pos] = gi >> 2; ewgt[e * NTOK + pos] = SELW[c.tid]; }
        lds_barrier();
    }
}

struct MoeOrder {
    int nM, nN, nwg, G, c; const LAS unsigned char* tile_e; const LAS int* tile_b;
    __device__ __forceinline__ void init(int nM_, int nN_, int G_, int c_, const LAS unsigned char* te, const LAS int* tb) { nM = nM_; nN = nN_; nwg = nM * nN; G = G_; c = c_; tile_e = te; tile_b = tb; }
    __device__ __forceinline__ bool next(int i, pg8::Unit& u) const {
        const long L = (long)i * G + c; if (L >= nwg) return false;
        int wgid = (int)L; { const int q = nwg / pg8::NXCD, r = nwg % pg8::NXCD, xcd = wgid % pg8::NXCD, off = wgid / pg8::NXCD; wgid = (xcd < r ? xcd * (q + 1) : r * (q + 1) + (xcd - r) * q) + off; }
        const int nig = pg8::WGM * nN, gid = wgid / nig, fm = gid * pg8::WGM, gsz = (nM - fm) < pg8::WGM ? (nM - fm) : pg8::WGM;
        const int pm = fm + ((wgid % nig) % gsz), pnl = (wgid % nig) / gsz;
        const int e = __builtin_amdgcn_readfirstlane((int)tile_e[pm]);
        u.pm = pm; u.pn = e * nN + pnl; u.x0 = e; u.x1 = pnl; u.rb = e * NTOK + (pm - __builtin_amdgcn_readfirstlane(tile_b[e])) * 256; return true;
    }
    __device__ __forceinline__ void a_ready(const pg8::Unit&) const {}
    __device__ __forceinline__ void done(const pg8::Unit&) const {}
};
__device__ __forceinline__ void build_tile_table(const Ctx& c, const unsigned* gcnt, LAS unsigned char* tile_e, LAS int* ntiles, LAS int* tile_b) {
    if (c.tid == 0) { int tb = 0; for (int e = 0; e < NE; ++e) { const int nt = ((int)gcnt[e] + 255) >> 8; tile_b[e] = tb; for (int i = 0; i < nt; ++i) tile_e[tb + i] = (unsigned char)e; tb += nt; } tile_b[NE] = tb; ntiles[0] = tb; }
    lds_barrier();
}

struct EpiSwiglu {
    static constexpr bool PERM = true, AFTER_DRAIN = false;
    bf16* O; const float* bias;
    __device__ __forceinline__ bool keep_acc(const pg8::Unit&) const { return false; }
    __device__ __forceinline__ void operator()(const f32x4 (&acc)[2][2][4][2], const pg8::Unit& u, int wr, int wc, int fr, int fq) const {
        const int row0 = u.pm * 256 + wr * 64 + fr, col0 = u.x1 * 128 + wc * 32 + 8 * fq;
        const float* bg = bias + (size_t)u.x0 * 2 * DFF + col0; const float* bl = bg + DFF;
        f32x4 bgv[2], blv[2];
#pragma unroll
        for (int n = 0; n < 2; ++n) { bgv[n] = *(const f32x4*)(bg + 4 * n); blv[n] = *(const f32x4*)(bl + 4 * n); }
#pragma unroll
        for (int ai = 0; ai < 2; ++ai)
#pragma unroll
            for (int m = 0; m < 4; ++m) { bf16* rowp = O + (size_t)(row0 + ai * 128 + m * 16) * DFF + col0; float a[8];
#pragma unroll
                for (int n = 0; n < 2; ++n) { const f32x4 g = acc[ai][0][m][n] + bgv[n], l = acc[ai][1][m][n] + blv[n];
#pragma unroll
                    for (int i = 0; i < 4; ++i) { const float xg = fminf(g[i], 7.f), xl = fminf(fmaxf(l[i], -7.f), 7.f);
                        a[4 * n + i] = xg * __builtin_amdgcn_rcpf(1.f + __expf(-1.702f * xg)) * (xl + 1.f); } }
                v4u w; w.x = cvt_pk_bf16(a[0], a[1]); w.y = cvt_pk_bf16(a[2], a[3]); w.z = cvt_pk_bf16(a[4], a[5]); w.w = cvt_pk_bf16(a[6], a[7]);
                *(v4u*)rowp = w; }
    }
};
struct EpiDown {
    static constexpr bool PERM = true, AFTER_DRAIN = false;
    bf16* O; const float* bias; const float* roww;
    __device__ __forceinline__ bool keep_acc(const pg8::Unit&) const { return false; }
    __device__ __forceinline__ void operator()(const f32x4 (&acc)[2][2][4][2], const pg8::Unit& u, int wr, int wc, int fr, int fq) const {
        const int row0 = u.pm * 256 + wr * 64 + fr, col0 = u.x1 * 256 + wc * 32 + 8 * fq;
        const float* bp = bias + (size_t)u.x0 * D + col0;
        f32x4 bv[2][2];
#pragma unroll
        for (int bj = 0; bj < 2; ++bj)
#pragma unroll
            for (int n = 0; n < 2; ++n) bv[bj][n] = *(const f32x4*)(bp + bj * 128 + 4 * n);
#pragma unroll
        for (int ai = 0; ai < 2; ++ai)
#pragma unroll
            for (int m = 0; m < 4; ++m) { const int rl = wr * 64 + fr + ai * 128 + m * 16, row = u.pm * 256 + rl; const float w = roww[u.rb + rl]; bf16* rowp = O + (size_t)row * D + col0;
#pragma unroll
                for (int bj = 0; bj < 2; ++bj) { const f32x4 v0 = (acc[ai][bj][m][0] + bv[bj][0]) * w, v1 = (acc[ai][bj][m][1] + bv[bj][1]) * w;
                    v4u o; o.x = cvt_pk_bf16(v0[0], v0[1]); o.y = cvt_pk_bf16(v0[2], v0[3]); o.z = cvt_pk_bf16(v1[0], v1[1]); o.w = cvt_pk_bf16(v1[2], v1[3]);
                    *(v4u*)(rowp + bj * 128) = o; } }
    }
};

__device__ __forceinline__ void p_final(const Ctx& c, const float* __restrict__ X1, const bf16* __restrict__ Yb, const int* __restrict__ slot_e, const int* __restrict__ slot_pos, const unsigned* gcnt, const float* __restrict__ g, float* __restrict__ out, float pscale = 1.f) {
    LAS int* POFF = (LAS int*)(c.lds0 + EXTRA_OFF);
    if (c.tid == 0) { int s = 0; for (int e = 0; e < NE; ++e) { POFF[e] = s; s += (((int)gcnt[e] + 255) >> 8) << 8; } }
    lds_barrier();
#pragma unroll 2
    for (int t = c.bid * NWAVES + c.wave; t < NTOK; t += c.nb * NWAVES) {
        const int lane = c.lane; float4 v[4];
#pragma unroll
        for (int j = 0; j < 4; ++j) { const v4u xr = ldnt4((const v4u*)(X1 + (size_t)t * D) + lane + 64 * j); v[j] = make_float4(__uint_as_float(xr.x), __uint_as_float(xr.y), __uint_as_float(xr.z), __uint_as_float(xr.w)); }
#pragma unroll
        for (int k = 0; k < 4; ++k) { const int dst = POFF[slot_e[t * 4 + k]] + slot_pos[t * 4 + k];
#pragma unroll
            for (int j = 0; j < 4; ++j) { const v2u y = ldnt2((const v2u*)(Yb + (size_t)dst * D) + lane + 64 * j); v[j].x += bf_lo(y.x); v[j].y += bf_hi(y.x); v[j].z += bf_lo(y.y); v[j].w += bf_hi(y.y); } }
        float s = 0.f;
#pragma unroll
        for (int j = 0; j < 4; ++j) s += v[j].x * v[j].x + v[j].y * v[j].y + v[j].z * v[j].z + v[j].w * v[j].w;
        const float r = rsqrtf(wave_sum(s) * (1.f / D) + RMS_EPS) * pscale;
#pragma unroll
        for (int j = 0; j < 4; ++j) { const float4 gg = ((const float4*)g)[lane + 64 * j]; const f32x4 ov = {v[j].x * r * gg.x, v[j].y * r * gg.y, v[j].z * r * gg.z, v[j].w * r * gg.w}; __builtin_nontemporal_store(ov, (f32x4*)(out + (size_t)t * D) + lane + 64 * j); }
    }
}

constexpr int PJ = 5120;
typedef float f32x2 __attribute__((ext_vector_type(2)));
__device__ __forceinline__ f32x2 gelu_pk(f32x2 v) {
    const f32x2 av = __builtin_elementwise_abs(v), d = av * 0.2316418882f + 1.0f;
    f32x2 t; t.x = __builtin_amdgcn_rcpf(d.x); t.y = __builtin_amdgcn_rcpf(d.y);
    f32x2 q = t * 0.5307027145f + (-0.7265760135f); q = q * t + 0.7107068705f; q = q * t + (-0.142248368f); q = q * t + 0.127414796f; q = q * t;
    const f32x2 s = (v * v) * (-0.72134752044f);
    f32x2 e; e.x = __builtin_amdgcn_exp2f(s.x); e.y = __builtin_amdgcn_exp2f(s.y);
    const f32x2 m = v * (q * e), r = v - m;
    f32x2 o; o.x = v.x < 0.f ? m.x : r.x; o.y = v.y < 0.f ? m.y : r.y; return o;
}
__device__ __forceinline__ float fast_sigmoid(float x) { return __builtin_amdgcn_rcpf(1.f + __expf(-x)); }

__device__ __forceinline__ void p_convert_front(const Ctx& c, const float* w_in, const float* w_o_dn, const float* w_o_sg, const float* w_out, bf16* Win_t, bf16* Wo_t, bf16* Wout_t) {
    LAS float* scr = (LAS float*)c.lds + c.wave * (64 * 65);
    constexpr int I_IN = 16 * 80, I_O = 8 * 16, I_OUT = 16 * 16;
    for (int it = c.bid * NWAVES + c.wave; it < I_IN + 2 * I_O + I_OUT; it += c.nb * NWAVES) {
        int r = it;
        if (r < I_IN) { const int kb = r / 80, nbk = r % 80, n0 = nbk * 64; tr_item<true>(w_in, INC, kb * 64, n0 < 2048 ? n0 : n0 + 8, Win_t, D, n0, scr, c.lane); continue; } r -= I_IN;
        if (r < I_O) { const int kb = r / 16, nbk = r % 16; tr_item<true>(w_o_dn, D, kb * 64, nbk * 64, Wo_t, DNW, nbk * 64, scr, c.lane); continue; } r -= I_O;
        if (r < I_O) { const int kb = r / 16, nbk = r % 16; tr_item<true>(w_o_sg, D, kb * 64, nbk * 64, Wo_t + (size_t)D * DNW, SGW, nbk * 64, scr, c.lane); continue; } r -= I_O;
        { const int kb = r / 16, nbk = r % 16; tr_item<true>(w_out, D, kb * 64, nbk * 64, Wout_t, D, nbk * 64, scr, c.lane); }
    }
}
__device__ __forceinline__ void p_norm1(const Ctx& c, const float* __restrict__ x, const float* __restrict__ g1, const float* __restrict__ w_in, const float* __restrict__ a_log, const float* __restrict__ dt_bias, bf16* __restrict__ Hb, float* __restrict__ BG) {
    LAS f32x4* WB = (LAS f32x4*)c.lds;
    const int lane = c.lane;
    for (int idx = c.tid; idx < 2048; idx += NTHR) { const int k = idx >> 1, q = idx & 1; const f32x4 v = *(const f32x4*)(w_in + (size_t)k * INC + 2048 + 4 * q);
        const int l = (k & 255) >> 2, cc = k & 3, j = k >> 8; WB[((j * 4 + cc) * 2 + q) * 64 + l] = v; }
    lds_barrier();
#pragma unroll 2
    for (int t = c.bid * NWAVES + c.wave; t < NTOK; t += c.nb * NWAVES) {
        float4 xv[4]; float ss = 0.f;
#pragma unroll
        for (int j = 0; j < 4; ++j) { xv[j] = ((const float4*)(x + (size_t)t * D))[lane + 64 * j]; ss += xv[j].x * xv[j].x + xv[j].y * xv[j].y + xv[j].z * xv[j].z + xv[j].w * xv[j].w; }
        const float r = rsqrtf(wave_sum(ss) * (1.f / D) + RMS_EPS);
#pragma unroll
        for (int j = 0; j < 4; ++j) { const float4 g = ((const float4*)g1)[lane + 64 * j]; xv[j].x *= r * g.x; xv[j].y *= r * g.y; xv[j].z *= r * g.z; xv[j].w *= r * g.w;
            v2u o; o.x = cvt_pk_bf16(xv[j].x, xv[j].y); o.y = cvt_pk_bf16(xv[j].z, xv[j].w); ((v2u*)(Hb + (size_t)t * D))[lane + 64 * j] = o; }
        float acc[8];
#pragma unroll
        for (int i = 0; i < 8; ++i) acc[i] = 0.f;
#pragma unroll
        for (int j = 0; j < 4; ++j)
#pragma unroll
            for (int cc = 0; cc < 4; ++cc) { const float h = f4c(xv[j], cc);
#pragma unroll
                for (int q = 0; q < 2; ++q) { const f32x4 w = WB[((j * 4 + cc) * 2 + q) * 64 + lane];
                    acc[4 * q + 0] = fmaf(h, w.x, acc[4 * q + 0]); acc[4 * q + 1] = fmaf(h, w.y, acc[4 * q + 1]); acc[4 * q + 2] = fmaf(h, w.z, acc[4 * q + 2]); acc[4 * q + 3] = fmaf(h, w.w, acc[4 * q + 3]); } }
        BFLY_SW32(acc, 8) BFLY_SW16(acc, 4) BFLY_DPP(acc, 2, 8, dpp_ror8)
        float a0 = acc[0]; a0 += dpp_xor4(a0); a0 += dpp_xor2(a0); a0 += dpp_xor1(a0);
        const int idx = lane >> 3;
        if ((lane & 7) == 0) { float o;
            if (idx < 4) o = 1.f / (1.f + expf(-a0)); else { const int h = idx - 4; o = -expf(a_log[h]) * softplusf_(a0 + dt_bias[h]); }
            BG[(size_t)t * 8 + idx] = o; }
    }
}
struct EpiProj {
    static constexpr bool PERM = true, AFTER_DRAIN = false;
    bf16* O;
    __device__ __forceinline__ bool keep_acc(const pg8::Unit&) const { return false; }
    __device__ __forceinline__ void operator()(const f32x4 (&acc)[2][2][4][2], const pg8::Unit& u, int wr, int wc, int fr, int fq) const {
        const int row0 = u.pm * 256 + wr * 64 + fr, col0 = u.pn * 256 + wc * 32 + 8 * fq;
        const int act = (u.pn < 6) ? 0 : (u.pn < 8 ? 1 : (u.pn < 12 ? 2 : 0));
#pragma unroll
        for (int ai = 0; ai < 2; ++ai)
#pragma unroll
            for (int m = 0; m < 4; ++m) { bf16* rowp = O + (size_t)(row0 + ai * 128 + m * 16) * PJ + col0;
#pragma unroll
                for (int bj = 0; bj < 2; ++bj) { f32x4 v0 = acc[ai][bj][m][0], v1 = acc[ai][bj][m][1];
                    if (act == 1) {
#pragma unroll
                        for (int i = 0; i < 4; ++i) { v0[i] = v0[i] * fast_sigmoid(v0[i]); v1[i] = v1[i] * fast_sigmoid(v1[i]); } }
                    else if (act == 2) { const f32x2 a = gelu_pk((f32x2){v0[0], v0[1]}), b = gelu_pk((f32x2){v0[2], v0[3]}), cc = gelu_pk((f32x2){v1[0], v1[1]}), d = gelu_pk((f32x2){v1[2], v1[3]});
                        v0 = (f32x4){a.x, a.y, b.x, b.y}; v1 = (f32x4){cc.x, cc.y, d.x, d.y}; }
                    v4u w; w.x = cvt_pk_bf16(v0[0], v0[1]); w.y = cvt_pk_bf16(v0[2], v0[3]); w.z = cvt_pk_bf16(v1[0], v1[1]); w.w = cvt_pk_bf16(v1[2], v1[3]);
                    *(v4u*)(rowp + bj * 128) = w; } }
    }
};
struct DualOrder {
    pg8::StaticOrder S0;
    __device__ __forceinline__ void init(int G, int c) { S0.init(NTOK, D, G, c); }
    __device__ __forceinline__ bool next(int i, pg8::Unit& u) const { pg8::Unit t; if (!S0.next(i >> 1, t)) return false; const int which = i & 1; u.pm = t.pm + 64 * which; u.pn = t.pn + 4 * which; u.x0 = which; u.x1 = t.pn; u.rb = 0; return true; }
    __device__ __forceinline__ void a_ready(const pg8::Unit&) const {}
    __device__ __forceinline__ void done(const pg8::Unit&) const {}
};
struct EpiMerge {
    static constexpr bool PERM = true, AFTER_DRAIN = false;
    const bf16* P; bf16* O;
    __device__ __forceinline__ bool keep_acc(const pg8::Unit& u) const { return u.x0 == 0; }
    __device__ __forceinline__ void operator()(f32x4 (&acc)[2][2][4][2], const pg8::Unit& u, int wr, int wc, int fr, int fq) const {
        const int row0 = (u.pm & 63) * 256 + wr * 64 + fr, col0 = u.x1 * 256 + wc * 32 + 8 * fq; const bool first = (u.x0 == 0);
#pragma unroll
        for (int ai = 0; ai < 2; ++ai)
#pragma unroll
            for (int m = 0; m < 4; ++m) { const int row = row0 + ai * 128 + m * 16; const bf16* pr = P + (size_t)row * PJ + col0;
#pragma unroll
                for (int bj = 0; bj < 2; ++bj) { const v4u xb = *(const v4u*)(pr + 4096 + bj * 128); float fb[8];
                    fb[0] = bf_lo(xb.x); fb[1] = bf_hi(xb.x); fb[2] = bf_lo(xb.y); fb[3] = bf_hi(xb.y); fb[4] = bf_lo(xb.z); fb[5] = bf_hi(xb.z); fb[6] = bf_lo(xb.w); fb[7] = bf_hi(xb.w);
#pragma unroll
                    for (int i = 0; i < 8; ++i) fb[i] = 1.f + __expf(-fmaxf(fb[i], -30.f));
                    if (first) { const v4u xa = *(const v4u*)(pr + 3072 + bj * 128); float fa[8];
                        fa[0] = bf_lo(xa.x); fa[1] = bf_hi(xa.x); fa[2] = bf_lo(xa.y); fa[3] = bf_hi(xa.y); fa[4] = bf_lo(xa.z); fa[5] = bf_hi(xa.z); fa[6] = bf_lo(xa.w); fa[7] = bf_hi(xa.w);
#pragma unroll
                        for (int i = 0; i < 4; ++i) { acc[ai][bj][m][0][i] *= fb[i] * fast_sigmoid(fa[i]); acc[ai][bj][m][1][i] *= fb[4 + i] * fast_sigmoid(fa[4 + i]); } }
                    else { f32x4 v0, v1;
#pragma unroll
                        for (int i = 0; i < 4; ++i) { v0[i] = acc[ai][bj][m][0][i] * __builtin_amdgcn_rcpf(fb[i]); v1[i] = acc[ai][bj][m][1][i] * __builtin_amdgcn_rcpf(fb[4 + i]); }
                        v4u w; w.x = cvt_pk_bf16(v0[0], v0[1]); w.y = cvt_pk_bf16(v0[2], v0[3]); w.z = cvt_pk_bf16(v1[0], v1[1]); w.w = cvt_pk_bf16(v1[2], v1[3]);
                        *(v4u*)(O + (size_t)row * D + col0 + bj * 128) = w; } } }
    }
};
struct EpiResid {
    static constexpr bool PERM = false, AFTER_DRAIN = false;
    const float* X; float* O;
    __device__ __forceinline__ bool keep_acc(const pg8::Unit&) const { return false; }
    __device__ __forceinline__ void operator()(const f32x4 (&acc)[2][2][4][2], const pg8::Unit& u, int wr, int wc, int fr, int fq) const {
        const int row0 = u.pm * 256 + wr * 64 + fr, col0 = u.pn * 256 + wc * 32 + 4 * fq;
#pragma unroll
        for (int ai = 0; ai < 2; ++ai)
#pragma unroll
            for (int m = 0; m < 4; ++m) { const size_t off = (size_t)(row0 + ai * 128 + m * 16) * D + col0;
#pragma unroll
                for (int bj = 0; bj < 2; ++bj)
#pragma unroll
                    for (int n = 0; n < 2; ++n) *(f32x4*)(O + off + bj * 128 + n * 16) = *(const f32x4*)(X + off + bj * 128 + n * 16) + acc[ai][bj][m][n]; }
    }
};
__device__ __forceinline__ float ldbf(const bf16* p) { return __uint_as_float((unsigned)(*p) << 16); }
__device__ __forceinline__ unsigned short f2bf1(float f) { return (unsigned short)(cvt_pk_bf16(f, 0.f) & 0xffffu); }
__device__ __forceinline__ void unpack8(const v4u& x, float (&f)[8]) { f[0] = bf_lo(x.x); f[1] = bf_hi(x.x); f[2] = bf_lo(x.y); f[3] = bf_hi(x.y); f[4] = bf_lo(x.z); f[5] = bf_hi(x.z); f[6] = bf_lo(x.w); f[7] = bf_hi(x.w); }

constexpr size_t DN_WN = 16384, DN_QD = 16384, DN_KD = 16384, DN_QK = 8192, DN_U = 16384, DN_SST = 32768;
struct DnBufs { unsigned char *WN, *QD, *KD, *QK, *U, *SST; float* EG; };
constexpr int PL_QH = 0, PL_KH = 17408, PL_XVT = 34816, PL_XWT = 53248, PL_KDT = 71680, PL_AL = 90112, PL_TL = 106496, PL_GAM = 115712;
constexpr int RS = 136  , TS = 72  ;

__device__ __forceinline__ void p_dn_prep(const Ctx& c, const bf16* PROJ, const float* cw, const float* BG, const DnBufs& B) {
    LAS unsigned char* L = c.lds;
    LAS unsigned short* QH = (LAS unsigned short*)(L + PL_QH); LAS unsigned short* KH = (LAS unsigned short*)(L + PL_KH);
    LAS unsigned short* XVT = (LAS unsigned short*)(L + PL_XVT); LAS unsigned short* XWT = (LAS unsigned short*)(L + PL_XWT); LAS unsigned short* KDT = (LAS unsigned short*)(L + PL_KDT);
    LAS float* AL = (LAS float*)(L + PL_AL); LAS unsigned short* TL = (LAS unsigned short*)(L + PL_TL);
    LAS float* GAM = (LAS float*)(L + PL_GAM); LAS float* BETA = GAM + 64; LAS float* EGAM = GAM + 128; LAS float* KSC = GAM + 192;
    const int w = c.wave;
    LAS float* CWL = (LAS float*)(L + PL_GAM + 1024);
    constexpr int NITEMS = BATCH * DNH * (SEQ / 64);
    v4u xr[2][7];
#define DN_LOAD_ROWS(itx) do { const int bh_ = (itx) >> 7, ch_ = (itx) & 127, b_ = bh_ >> 2, h_ = bh_ & 3; int tid_ = c.tid; asm volatile("" : "+v"(tid_));     \
        _Pragma("unroll") for (int u_ = 0; u_ < 2; ++u_) { const int idx_ = tid_ + NTHR * u_; if (idx_ < 768) { const int tq_ = idx_ / 48, cg_ = idx_ % 48, col_ = (cg_ >> 4) * 512 + h_ * 128 + (cg_ & 15) * 8; \
            _Pragma("unroll") for (int r_ = 0; r_ < 7; ++r_) { const int tt_ = ch_ * 64 + 4 * tq_ - 3 + r_; \
                xr[u_][r_] = (tt_ >= 0) ? *(const v4u*)(PROJ + ((size_t)b_ * SEQ + tt_) * PJ + col_) : (v4u){0u, 0u, 0u, 0u}; } } } } while (0)
    float gpre = 0.f, bpre = 0.f, cwpre[4] = {0.f, 0.f, 0.f, 0.f};
#define DN_LOAD_SMALL(itx) do { const int bh_ = (itx) >> 7, ch_ = (itx) & 127, b_ = bh_ >> 2, h_ = bh_ & 3; const size_t r0_ = (size_t)b_ * SEQ + ch_ * 64; \
        if (w == 0) { gpre = BG[(r0_ + (c.tid & 63)) * 8 + 4 + h_]; bpre = BG[(r0_ + (c.tid & 63)) * 8 + h_]; } \
        if (c.tid < 384) { _Pragma("unroll") for (int kk_ = 0; kk_ < 4; ++kk_) cwpre[kk_] = cw[kk_ * 1536 + (c.tid >> 7) * 512 + h_ * 128 + (c.tid & 127)]; } } while (0)
    if (c.bid < NITEMS) { DN_LOAD_ROWS(c.bid); DN_LOAD_SMALL(c.bid); }
    for (int it = c.bid; it < NITEMS; it += c.nb) {
        int tl_ = c.tid; asm volatile("" : "+v"(tl_));
        const int lane = tl_ & 63, fr = lane & 15, fq = lane >> 4;
        const int bh = it >> 7, ch = it & 127, b = bh >> 2, h = bh & 3; const size_t row0 = (size_t)b * SEQ + ch * 64;
        if (c.tid < 384) {
#pragma unroll
            for (int kk = 0; kk < 4; ++kk) CWL[kk * 384 + c.tid] = cwpre[kk]; }
        if (w == 0) { const float gt = gpre, bt = bpre; float gam = gt;
#pragma unroll
            for (int o = 1; o < 64; o <<= 1) { const float t = __shfl_up(gam, o); if (lane >= o) gam += t; }
            const float gl = __shfl(gam, 63);
            GAM[lane] = gam; BETA[lane] = bt; EGAM[lane] = expf(gam); KSC[lane] = expf(gl - gam);
            if (lane == 0) B.EG[it] = expf(gl); }
        for (int i = c.tid; i < 1024; i += NTHR) ((LAS f32x4*)AL)[i] = (f32x4){0.f, 0.f, 0.f, 0.f};
        lds_barrier();
        int tidb = c.tid; asm volatile("" : "+v"(tidb));
#pragma unroll
        for (int u = 0; u < 2; ++u) { const int idx = tidb + NTHR * u; if (idx < 768) {
            const int tq = idx / 48, cg = idx % 48, part = cg >> 4, c8 = (cg & 15) * 8;
            f32x4 wt[4][2];
#pragma unroll
            for (int kk = 0; kk < 4; ++kk) { wt[kk][0] = *(const LAS f32x4*)(CWL + kk * 384 + part * 128 + c8); wt[kk][1] = *(const LAS f32x4*)(CWL + kk * 384 + part * 128 + c8 + 4); }
            float av[4][8];
            float s1v[4], s2v[4];
#pragma unroll
            for (int q = 0; q < 4; ++q) { const int t = 4 * tq + q;
                float a[8];
#pragma unroll
                for (int e = 0; e < 8; ++e) a[e] = 0.f;
#pragma unroll
                for (int kk = 0; kk < 4; ++kk) { float xf[8]; unpack8(xr[u][q + kk], xf);
#pragma unroll
                    for (int e = 0; e < 4; ++e) { a[e] = fmaf(wt[kk][0][e], xf[e], a[e]); a[4 + e] = fmaf(wt[kk][1][e], xf[4 + e], a[4 + e]); } }
                float ss = 0.f;
#pragma unroll
                for (int e = 0; e < 8; ++e) { a[e] = a[e] / (1.f + __expf(-a[e])); ss = fmaf(a[e], a[e], ss); }
                ss = row16_sum(ss);
                const float rs = rsqrtf(ss + L2_EPS);
                if (part == 0) { const float sc = rs * 0.08838834764831845f; v4u o; o.x = cvt_pk_bf16(a[0] * sc, a[1] * sc); o.y = cvt_pk_bf16(a[2] * sc, a[3] * sc); o.z = cvt_pk_bf16(a[4] * sc, a[5] * sc); o.w = cvt_pk_bf16(a[6] * sc, a[7] * sc);
                    *(LAS v4u*)(QH + t * RS + c8) = o; }
                else if (part == 1) { v4u o; o.x = cvt_pk_bf16(a[0] * rs, a[1] * rs); o.y = cvt_pk_bf16(a[2] * rs, a[3] * rs); o.z = cvt_pk_bf16(a[4] * rs, a[5] * rs); o.w = cvt_pk_bf16(a[6] * rs, a[7] * rs);
                    *(LAS v4u*)(KH + t * RS + c8) = o; s1v[q] = rs * BETA[t] * EGAM[t]; s2v[q] = rs * KSC[t]; }
                else { s1v[q] = BETA[t]; s2v[q] = 0.f; }
#pragma unroll
                for (int e = 0; e < 8; ++e) av[q][e] = a[e];
            }
            if (part == 1) {
#pragma unroll
                for (int e = 0; e < 8; ++e) { v2u o1, o2; o1.x = cvt_pk_bf16(av[0][e] * s1v[0], av[1][e] * s1v[1]); o1.y = cvt_pk_bf16(av[2][e] * s1v[2], av[3][e] * s1v[3]);
                    o2.x = cvt_pk_bf16(av[0][e] * s2v[0], av[1][e] * s2v[1]); o2.y = cvt_pk_bf16(av[2][e] * s2v[2], av[3][e] * s2v[3]);
                    *(LAS v2u*)(XWT + (c8 + e) * TS + 4 * tq) = o1; *(LAS v2u*)(KDT + (c8 + e) * TS + 4 * tq) = o2; } }
            else if (part == 2) {
#pragma unroll
                for (int e = 0; e < 8; ++e) { v2u o1; o1.x = cvt_pk_bf16(av[0][e] * s1v[0], av[1][e] * s1v[1]); o1.y = cvt_pk_bf16(av[2][e] * s1v[2], av[3][e] * s1v[3]);
                    *(LAS v2u*)(XVT + (c8 + e) * TS + 4 * tq) = o1; } }
            } }
        lds_barrier();
        if (it + c.nb < NITEMS) { DN_LOAD_ROWS(it + c.nb); DN_LOAD_SMALL(it + c.nb); }
        { const int rt = w & 3, ksq = w >> 2; v2u half[2];
#pragma unroll
            for (int sub = 0; sub < 2; ++sub) { const int st = 2 * ksq + sub; f32x4 acc = {0.f, 0.f, 0.f, 0.f};
#pragma unroll
                for (int kk = 0; kk < 4; ++kk) { const bf16x8 a = *(const LAS bf16x8*)(KH + (16 * st + fr) * RS + 32 * kk + 8 * fq), bq = *(const LAS bf16x8*)(QH + (16 * rt + fr) * RS + 32 * kk + 8 * fq); acc = MFMA16(a, bq, acc); }
                const int rr = 16 * rt + fr; const float gr = GAM[rr]; float v[4];
#pragma unroll
                for (int r = 0; r < 4; ++r) { const int s2 = 16 * st + 4 * fq + r; v[r] = (s2 <= rr) ? acc[r] * __expf(fminf(gr - GAM[s2], 0.f)) : 0.f; }
                half[sub].x = cvt_pk_bf16(v[0], v[1]); half[sub].y = cvt_pk_bf16(v[2], v[3]); }
            v4u o; o.x = half[0].x; o.y = half[0].y; o.z = half[1].x; o.w = half[1].y;
            *(v4u*)(B.QK + (size_t)it * DN_QK + ((rt * 2 + ksq) * 64 + lane) * 16) = o; }
#pragma unroll 1
        for (int n = w; n < 10; n += 8) { const int rt = (n >= 6) ? 3 : (n >= 3 ? 2 : (n >= 1 ? 1 : 0)), st = n - rt * (rt + 1) / 2; f32x4 acc = {0.f, 0.f, 0.f, 0.f};
#pragma unroll
            for (int kk = 0; kk < 4; ++kk) { const bf16x8 a = *(const LAS bf16x8*)(KH + (16 * rt + fr) * RS + 32 * kk + 8 * fq), bk = *(const LAS bf16x8*)(KH + (16 * st + fr) * RS + 32 * kk + 8 * fq); acc = MFMA16(a, bk, acc); }
            const int s2 = 16 * st + fr; const float gs = GAM[s2];
#pragma unroll
            for (int r = 0; r < 4; ++r) { const int rr = 16 * rt + 4 * fq + r; const float v = (s2 < rr) ? BETA[rr] * acc[r] * __expf(fminf(GAM[rr] - gs, 0.f)) : 0.f; AL[rr * 64 + (s2 & 7) * 8 + (s2 >> 3)] = v; } }
        lds_barrier();
        { const int j = w * 8 + (lane >> 3), p = lane & 7; float tc[8];
#pragma unroll
            for (int i = 0; i < 8; ++i) tc[i] = 0.f;
#pragma unroll
            for (int r = 0; r < 64; ++r) { float s0 = 0.f, s1 = 0.f;
                if (r > 0) { const LAS float* ar = AL + r * 64 + p * 8; const f32x4 a0 = *(const LAS f32x4*)ar; s0 = a0[0] * tc[0];
                    if (r > 8) s1 = a0[1] * tc[1];
                    if (r > 16) s0 = fmaf(a0[2], tc[2], s0);
                    if (r > 24) s1 = fmaf(a0[3], tc[3], s1);
                    if (r > 32) { const f32x4 a1 = *(const LAS f32x4*)(ar + 4); s0 = fmaf(a1[0], tc[4], s0);
                        if (r > 40) s1 = fmaf(a1[1], tc[5], s1);
                        if (r > 48) s0 = fmaf(a1[2], tc[6], s0);
                        if (r > 56) s1 = fmaf(a1[3], tc[7], s1); } }
                float tot = s0 + s1; tot += dpp_xor1(tot); tot += dpp_xor2(tot); tot += dpp_hmir(tot);
                const float tr = ((r == j) ? 1.f : 0.f) - tot;
                if (p == (r & 7)) tc[r >> 3] = tr; }
#pragma unroll
            for (int i = 0; i < 8; ++i) TL[(8 * i + p) * TS + j] = f2bf1(tc[i]); }
        lds_barrier();
        { const int sl = w;
#pragma unroll
            for (int mt = 0; mt < 4; ++mt) { f32x4 acc = {0.f, 0.f, 0.f, 0.f};
#pragma unroll
                for (int kk = 0; kk < 2; ++kk) if (kk == 0 || mt >= 2) { const bf16x8 a = *(const LAS bf16x8*)(TL + (16 * mt + fr) * TS + 32 * kk + 8 * fq), bv = *(const LAS bf16x8*)(XVT + (16 * sl + fr) * TS + 32 * kk + 8 * fq); acc = MFMA16(a, bv, acc); }
                v2u o; o.x = cvt_pk_bf16(acc[0], acc[1]); o.y = cvt_pk_bf16(acc[2], acc[3]);
                *(v2u*)(B.U + (size_t)it * DN_U + ((mt * 8 + sl) * 64 + lane) * 8) = o; }
            const int dt = w;
#pragma unroll
            for (int rt = 0; rt < 4; ++rt) { f32x4 acc = {0.f, 0.f, 0.f, 0.f};
#pragma unroll
                for (int kk = 0; kk < 2; ++kk) if (kk == 0 || rt >= 2) { const bf16x8 a = *(const LAS bf16x8*)(XWT + (16 * dt + fr) * TS + 32 * kk + 8 * fq), bt = *(const LAS bf16x8*)(TL + (16 * rt + fr) * TS + 32 * kk + 8 * fq); acc = MFMA16(a, bt, acc); }
                v2u o; o.x = cvt_pk_bf16(-acc[0], -acc[1]); o.y = cvt_pk_bf16(-acc[2], -acc[3]);
                *(v2u*)(B.WN + (size_t)it * DN_WN + ((rt * 4 + (dt >> 1)) * 64 + lane) * 16 + (dt & 1) * 8) = o; } }
        { const int mt = w & 3;
#pragma unroll
            for (int q2 = 0; q2 < 2; ++q2) { const int ks = 2 * (w >> 2) + q2, rr = 16 * mt + fr; const float sc = EGAM[rr];
                const v2u lo = *(const LAS v2u*)(QH + rr * RS + 32 * ks + 4 * fq), hi = *(const LAS v2u*)(QH + rr * RS + 32 * ks + 16 + 4 * fq);
                v4u o; o.x = cvt_pk_bf16(bf_lo(lo.x) * sc, bf_hi(lo.x) * sc); o.y = cvt_pk_bf16(bf_lo(lo.y) * sc, bf_hi(lo.y) * sc); o.z = cvt_pk_bf16(bf_lo(hi.x) * sc, bf_hi(hi.x) * sc); o.w = cvt_pk_bf16(bf_lo(hi.y) * sc, bf_hi(hi.y) * sc);
                *(v4u*)(B.QD + (size_t)it * DN_QD + ((mt * 4 + ks) * 64 + lane) * 16) = o; }
            const int dt = w;
#pragma unroll
            for (int ks = 0; ks < 2; ++ks) { const v2u lo = *(const LAS v2u*)(KDT + (16 * dt + fr) * TS + 32 * ks + 4 * fq), hi = *(const LAS v2u*)(KDT + (16 * dt + fr) * TS + 32 * ks + 16 + 4 * fq);
                v4u o; o.x = lo.x; o.y = lo.y; o.z = hi.x; o.w = hi.y;
                *(v4u*)(B.KD + (size_t)it * DN_KD + ((dt * 2 + ks) * 64 + lane) * 16) = o; } }
        lds_barrier();
    }
}

constexpr int SCAN_WGS = BATCH * DNH * 2;
__device__ __forceinline__ void u_load_asm(v2u& dst, const unsigned char* p) { asm volatile("global_load_dwordx2 %0, %1, off" : "=v"(dst) : "v"(p) : "memory"); }
template <int STG>
__device__ __forceinline__ void scan_step(const DnBufs& B, LAS unsigned char* L, int lane, int sl, int it, int ch, f32x4 (&S)[8], v2u (&ucur)[4], v2u (&unxt)[4], float egc) {
    if (ch < 126) asm volatile("s_waitcnt vmcnt(8)" ::: "memory"); else asm volatile("s_waitcnt vmcnt(0)" ::: "memory");
    __builtin_amdgcn_s_barrier(); asm volatile("" ::: "memory");
    asm volatile("" : "+v"(ucur[0]), "+v"(ucur[1]), "+v"(ucur[2]), "+v"(ucur[3]));
    bf16x8 sf[4];
#pragma unroll
    for (int ks = 0; ks < 4; ++ks) { v4u o; o.x = cvt_pk_bf16(S[2 * ks][0], S[2 * ks][1]); o.y = cvt_pk_bf16(S[2 * ks][2], S[2 * ks][3]); o.z = cvt_pk_bf16(S[2 * ks + 1][0], S[2 * ks + 1][1]); o.w = cvt_pk_bf16(S[2 * ks + 1][2], S[2 * ks + 1][3]);
        *(v4u*)(B.SST + (size_t)it * DN_SST + ((ks * 8 + sl) * 64 + lane) * 16) = o; sf[ks] = as_frag(o); }
    asm volatile("" ::: "memory");
    if (ch + 3 < 128) {
#pragma unroll
        for (int mt = 0; mt < 4; ++mt) u_load_asm(unxt[mt], B.U + (size_t)(it + 3) * DN_U + ((mt * 8 + sl) * 64 + lane) * 8); }
    const LAS unsigned char* wl = L + STG * 32768 + lane * 16; const LAS unsigned char* kl = wl + 16384;
    f32x4 vn[4];
#pragma unroll
    for (int mt = 0; mt < 4; ++mt) { vn[mt] = (f32x4){bf_lo(ucur[mt].x), bf_hi(ucur[mt].x), bf_lo(ucur[mt].y), bf_hi(ucur[mt].y)};
#pragma unroll
        for (int ks = 0; ks < 4; ++ks) vn[mt] = MFMA16(*(const LAS bf16x8*)(wl + (mt * 4 + ks) * 1024), sf[ks], vn[mt]); }
    bf16x8 vf[2];
#pragma unroll
    for (int ks = 0; ks < 2; ++ks) { v4u o; o.x = cvt_pk_bf16(vn[2 * ks][0], vn[2 * ks][1]); o.y = cvt_pk_bf16(vn[2 * ks][2], vn[2 * ks][3]); o.z = cvt_pk_bf16(vn[2 * ks + 1][0], vn[2 * ks + 1][1]); o.w = cvt_pk_bf16(vn[2 * ks + 1][2], vn[2 * ks + 1][3]); vf[ks] = as_frag(o); }
#pragma unroll
    for (int dt = 0; dt < 8; ++dt) { f32x4 a = S[dt] * egc;
#pragma unroll
        for (int ks = 0; ks < 2; ++ks) a = MFMA16(*(const LAS bf16x8*)(kl + (dt * 2 + ks) * 1024), vf[ks], a);
        S[dt] = a; }
}
__device__ __forceinline__ void p_dn_scan(const Ctx& c, const DnBufs& B) {
    const int lane = c.lane, w = c.wave, bh = c.bid >> 1, half = c.bid & 1; LAS unsigned char* L = c.lds;
    if (w >= 4) {
        const unsigned char* gsrc = (w < 6) ? B.WN : B.KD; const int goff = (w & 1) * 8192 + lane * 16, loff = (w - 4) * 8192;
#define SCAN_DMA(itn, stage) do { _Pragma("unroll") for (int _p = 0; _p < 8; ++_p) \
        __builtin_amdgcn_global_load_lds((const unsigned*)(gsrc + (size_t)(itn) * 16384 + goff + _p * 1024), (LAS unsigned*)(L + (stage) * 32768 + loff + _p * 1024), 16, 0, 0); } while (0)
        const int it0 = bh * 128;
        SCAN_DMA(it0, 0); SCAN_DMA(it0 + 1, 1); SCAN_DMA(it0 + 2, 2);
#pragma unroll 1
        for (int ch = 0; ch < 128; ++ch) {
            if (ch < 126) asm volatile("s_waitcnt vmcnt(16)" ::: "memory"); else asm volatile("s_waitcnt vmcnt(0)" ::: "memory");
            __builtin_amdgcn_s_barrier(); asm volatile("" ::: "memory");
            if (ch + 3 < 128) SCAN_DMA(it0 + ch + 3, (ch + 3) & 3);
        }
#undef SCAN_DMA
    } else {
        __builtin_amdgcn_s_setprio(1);
        const int sl = half * 4 + w;
        f32x4 S[8];
#pragma unroll
        for (int i = 0; i < 8; ++i) S[i] = (f32x4){0.f, 0.f, 0.f, 0.f};
        v2u u0[4], u1[4], u2[4], u3[4];
        const float eglo = B.EG[bh * 128 + lane], eghi = B.EG[bh * 128 + 64 + lane];
        asm volatile("s_waitcnt vmcnt(0)" ::: "memory");
        { const int it = bh * 128;
#pragma unroll
            for (int mt = 0; mt < 4; ++mt) u_load_asm(u0[mt], B.U + (size_t)it * DN_U + ((mt * 8 + sl) * 64 + lane) * 8);
#pragma unroll
            for (int mt = 0; mt < 4; ++mt) u_load_asm(u1[mt], B.U + (size_t)(it + 1) * DN_U + ((mt * 8 + sl) * 64 + lane) * 8);
#pragma unroll
            for (int mt = 0; mt < 4; ++mt) u_load_asm(u2[mt], B.U + (size_t)(it + 2) * DN_U + ((mt * 8 + sl) * 64 + lane) * 8);
#pragma unroll
            for (int mt = 0; mt < 4; ++mt) u3[mt] = (v2u){0u, 0u}; }
#define EGC(chx) __builtin_bit_cast(float, __builtin_amdgcn_readlane(__builtin_bit_cast(int, (chx) < 64 ? eglo : eghi), (chx) & 63))
#pragma unroll 1
        for (int ch = 0; ch < 128; ch += 4) {
            const int it = bh * 128 + ch;
            scan_step<0>(B, L, lane, sl, it, ch, S, u0, u3, EGC(ch));
            scan_step<1>(B, L, lane, sl, it + 1, ch + 1, S, u1, u0, EGC(ch + 1));
            scan_step<2>(B, L, lane, sl, it + 2, ch + 2, S, u2, u1, EGC(ch + 2));
            scan_step<3>(B, L, lane, sl, it + 3, ch + 3, S, u3, u2, EGC(ch + 3));
        }
#undef EGC
        __builtin_amdgcn_s_setprio(0);
    }
    asm volatile("s_waitcnt vmcnt(0)" ::: "memory"); __builtin_amdgcn_s_barrier(); asm volatile("" ::: "memory");
}

__device__ __forceinline__ void p_dn_out(const Ctx& c, const DnBufs& B, const bf16* PROJ, const float* gn, bf16* YA) {
    const int lane = c.lane, sl = c.wave, fr = lane & 15, fq = lane >> 4; LAS float* SSQ = (LAS float*)c.lds;
    LAS unsigned char* IMG = c.lds + 2048;
    for (int it = c.bid; it < BATCH * DNH * (SEQ / 64); it += c.nb) {
        const int bh = it >> 7, ch = it & 127, b = bh >> 2, h = bh & 3; const size_t row0 = (size_t)b * SEQ + ch * 64;
        v4u sfr[4]; v2u ur[4];
#pragma unroll
        for (int ks = 0; ks < 4; ++ks) sfr[ks] = *(const v4u*)(B.SST + (size_t)it * DN_SST + ((ks * 8 + sl) * 64 + lane) * 16);
#pragma unroll
        for (int mt = 0; mt < 4; ++mt) ur[mt] = *(const v2u*)(B.U + (size_t)it * DN_U + ((mt * 8 + sl) * 64 + lane) * 8);
#pragma unroll
        for (int j = 0; j < 5; ++j) { const int p = sl * 5 + j;
            const unsigned char* src = (p < 16) ? B.WN + (size_t)it * DN_WN + p * 1024 : (p < 32 ? B.QD + (size_t)it * DN_QD + (p - 16) * 1024 : B.QK + (size_t)it * DN_QK + (p - 32) * 1024);
            __builtin_amdgcn_global_load_lds((const unsigned*)(src + lane * 16), (LAS unsigned*)(IMG + p * 1024), 16, 0, 0); }
        asm volatile("s_waitcnt vmcnt(0)" ::: "memory"); lds_barrier();
        bf16x8 sf[4];
#pragma unroll
        for (int ks = 0; ks < 4; ++ks) sf[ks] = as_frag(sfr[ks]);
        const LAS unsigned char* wn = IMG + lane * 16; const LAS unsigned char* qd = wn + 16384; const LAS unsigned char* qk = wn + 32768;
        f32x4 vn[4];
#pragma unroll
        for (int mt = 0; mt < 4; ++mt) { vn[mt] = (f32x4){bf_lo(ur[mt].x), bf_hi(ur[mt].x), bf_lo(ur[mt].y), bf_hi(ur[mt].y)};
#pragma unroll
            for (int ks = 0; ks < 4; ++ks) vn[mt] = MFMA16(*(const LAS bf16x8*)(wn + (mt * 4 + ks) * 1024), sf[ks], vn[mt]); }
        bf16x8 vf[2];
#pragma unroll
        for (int ks = 0; ks < 2; ++ks) { v4u o; o.x = cvt_pk_bf16(vn[2 * ks][0], vn[2 * ks][1]); o.y = cvt_pk_bf16(vn[2 * ks][2], vn[2 * ks][3]); o.z = cvt_pk_bf16(vn[2 * ks + 1][0], vn[2 * ks + 1][1]); o.w = cvt_pk_bf16(vn[2 * ks + 1][2], vn[2 * ks + 1][3]); vf[ks] = as_frag(o); }
        f32x4 o[4];
#pragma unroll
        for (int mt = 0; mt < 4; ++mt) { f32x4 a = {0.f, 0.f, 0.f, 0.f};
#pragma unroll
            for (int ks = 0; ks < 4; ++ks) a = MFMA16(*(const LAS bf16x8*)(qd + (mt * 4 + ks) * 1024), sf[ks], a);
#pragma unroll
            for (int ks = 0; ks < 2; ++ks) a = MFMA16(*(const LAS bf16x8*)(qk + (mt * 2 + ks) * 1024), vf[ks], a);
            o[mt] = a;
#pragma unroll
            for (int r = 0; r < 4; ++r) { float q = row16_sum(a[r] * a[r]);
                if (fr == 0) SSQ[(16 * mt + 4 * fq + r) * 8 + sl] = q; } }
        float zv[4][4];
#pragma unroll
        for (int mt = 0; mt < 4; ++mt)
#pragma unroll
            for (int r = 0; r < 4; ++r) zv[mt][r] = ldbf(PROJ + (row0 + 16 * mt + 4 * fq + r) * PJ + 1536 + h * 128 + 16 * sl + fr);
        const float gg = gn[16 * sl + fr];
        lds_barrier();
#pragma unroll
        for (int mt = 0; mt < 4; ++mt)
#pragma unroll
            for (int r = 0; r < 4; ++r) { const int rl = 16 * mt + 4 * fq + r; const f32x4 q0 = *(const LAS f32x4*)(SSQ + rl * 8), q1 = *(const LAS f32x4*)(SSQ + rl * 8 + 4);
                const float rstd = rsqrtf(((q0[0] + q0[1]) + (q0[2] + q0[3]) + (q1[0] + q1[1]) + (q1[2] + q1[3])) * (1.f / 128.f) + RMS_EPS);
                const size_t row = row0 + rl; const int col = h * 128 + 16 * sl + fr;
                YA[row * DNW + col] = f2bf1(o[mt][r] * rstd * gg * zv[mt][r]); }
        lds_barrier();
    }
}

__device__ __forceinline__ void p_sg_item(const Ctx& c, int it, const bf16* PROJ, const float* lg, const float* lb, const float* sw, const float* sb, bf16* YB) {
    LAS unsigned short* VT = (LAS unsigned short*)c.lds;
    LAS float* STAT = (LAS float*)(c.lds + 128 * RS * 2);
    const int lane = c.lane, w = c.wave, fr = lane & 15, fq = lane >> 4, chunk = it >> 2, g = it & 3; const size_t row0 = (size_t)chunk * SGC;
    {
        v4u xr[16];
#pragma unroll
        for (int rr = 0; rr < 16; ++rr) xr[rr] = *(const v4u*)(PROJ + (row0 + 16 * w + rr) * PJ + 2560 + lane * 8);
        float acc[32];
#pragma unroll
        for (int rr = 0; rr < 16; ++rr) { float f[8]; unpack8(xr[rr], f); float s1 = 0.f, s2 = 0.f;
#pragma unroll
            for (int e = 0; e < 8; ++e) { s1 += f[e]; s2 = fmaf(f[e], f[e], s2); }
            acc[rr] = s1; acc[16 + rr] = s2; }
        BFLY_SW32(acc, 32) BFLY_SW16(acc, 16) BFLY_DPP(acc, 8, 8, dpp_ror8) BFLY_DPP(acc, 4, 4, dpp_xor4) BFLY_DPP(acc, 2, 2, dpp_xor2)
        const float tot = acc[0] + dpp_xor1(acc[0]);
        if ((lane & 1) == 0) { const int vi = lane >> 1; STAT[2 * (16 * w + (vi & 15)) + (vi >> 4)] = tot; } }
    lds_barrier();
    { v4u xv[4];
#pragma unroll
        for (int i = 0; i < 4; ++i) { const int idx = c.tid + NTHR * i, s = idx >> 4, c8 = (idx & 15) * 8; xv[i] = *(const v4u*)(PROJ + (row0 + s) * PJ + 2560 + g * 128 + c8); }
        const int c8 = (c.tid & 15) * 8;
        const float4 g0 = *(const float4*)(lg + g * 128 + c8), g1 = *(const float4*)(lg + g * 128 + c8 + 4), b0 = *(const float4*)(lb + g * 128 + c8), b1 = *(const float4*)(lb + g * 128 + c8 + 4);
        const float gv[8] = {g0.x, g0.y, g0.z, g0.w, g1.x, g1.y, g1.z, g1.w}, bv[8] = {b0.x, b0.y, b0.z, b0.w, b1.x, b1.y, b1.z, b1.w};
#pragma unroll
        for (int i = 0; i < 4; ++i) { const int s = (c.tid + NTHR * i) >> 4; float f[8]; unpack8(xv[i], f);
            const float mu = STAT[2 * s] * (1.f / SGW), rstd = rsqrtf(fmaxf(STAT[2 * s + 1] * (1.f / SGW) - mu * mu, 0.f) + LN_EPS);
#pragma unroll
            for (int e = 0; e < 8; ++e) VT[(c8 + e) * RS + s] = f2bf1((f[e] - mu) * rstd * gv[e] + bv[e]); } }
    lds_barrier();
    { f32x4 acc[8];
#pragma unroll
        for (int ct = 0; ct < 8; ++ct) acc[ct] = (f32x4){0.f, 0.f, 0.f, 0.f};
        const int t = 16 * w + fr, nk = (w >> 1) + 1;
        for (int kk = 0; kk < nk; ++kk) { const int s0 = 32 * kk + 8 * fq; const float* wp = sw + ((size_t)g * SGC + t) * SGC + s0;
            const float4 w0 = *(const float4*)wp, w1 = *(const float4*)(wp + 4);
            const float wv[8] = {w0.x, w0.y, w0.z, w0.w, w1.x, w1.y, w1.z, w1.w}; float wm[8];
#pragma unroll
            for (int e = 0; e < 8; ++e) wm[e] = (s0 + e <= t) ? wv[e] : 0.f;
            v4u wb; wb.x = cvt_pk_bf16(wm[0], wm[1]); wb.y = cvt_pk_bf16(wm[2], wm[3]); wb.z = cvt_pk_bf16(wm[4], wm[5]); wb.w = cvt_pk_bf16(wm[6], wm[7]);
            const bf16x8 bfr = as_frag(wb);
#pragma unroll
            for (int ct = 0; ct < 8; ++ct) acc[ct] = MFMA16(*(const LAS bf16x8*)(VT + (16 * ct + fr) * RS + s0), bfr, acc[ct]); }
        const float bias = sb[g * SGC + t]; const size_t row = row0 + t;
#pragma unroll
        for (int ct = 0; ct < 8; ++ct) { const int col = g * 128 + 16 * ct + 4 * fq; const v2u u = *(const v2u*)(PROJ + row * PJ + 2048 + col);
            v2u o; o.x = cvt_pk_bf16(bf_lo(u.x) * (acc[ct][0] + bias), bf_hi(u.x) * (acc[ct][1] + bias)); o.y = cvt_pk_bf16(bf_lo(u.y) * (acc[ct][2] + bias), bf_hi(u.y) * (acc[ct][3] + bias));
            *(v2u*)(YB + row * SGW + col) = o; } }
    lds_barrier();
}

struct Args { const float* in[22]; float* out; unsigned char* ws; int ph_lo, ph_hi; };
__global__ void __launch_bounds__(NTHR, 2) mega(Args args) {
    extern __shared__ __attribute__((aligned(16))) unsigned char lds_raw[];
    Ctx c; c.lds0 = (LAS unsigned char*)lds_raw; c.lds = c.lds0 + RING_OFF; c.tid = threadIdx.x; c.lane = c.tid & 63; c.wave = __builtin_amdgcn_readfirstlane(c.tid >> 6); c.bid = blockIdx.x; c.nb = gridDim.x;
    volatile LAS unsigned* MISC = (volatile LAS unsigned*)(c.lds0 + MISC_OFF);
    for (int u = c.tid; u < RING_OFF / 4; u += NTHR) ((LAS unsigned*)(c.lds0 + LDSCTL_OFF))[u] = 0u;
    __syncthreads();
    unsigned char* ws = args.ws;
    gu32* ctl = (gu32*)(ws + WS_CTL);
    XcdBarrier bar = xcd_barrier_post((unsigned*)(ctl + CW_BAR), MISC + 8);
#define GRID_BAR() xcd_barrier(bar)
    const float* x = args.in[0]; const float* norm1_g = args.in[1]; const float* w_in = args.in[2]; const float* conv_w = args.in[3];
    const float* a_log = args.in[4]; const float* dt_bias = args.in[5]; const float* dn_norm_g = args.in[6]; const float* w_o_dn = args.in[7];
    const float* sg_ln_g = args.in[8]; const float* sg_ln_b = args.in[9]; const float* sg_w = args.in[10]; const float* sg_b = args.in[11];
    const float* w_o_sg = args.in[12]; const float* w_out = args.in[13]; const float* norm2_g = args.in[14]; const float* w_router = args.in[15];
    const float* b_router = args.in[16]; const float* w_gate_up = args.in[17]; const float* b_gate_up = args.in[18]; const float* w_down = args.in[19];
    const float* b_down = args.in[20]; const float* norm_f_g = args.in[21];
    float* out = args.out;
    unsigned char* wb = ws + WS_BASE;
    bf16* Hb = (bf16*)(wb + 0); bf16* H2b = (bf16*)(wb + 0);
    bf16* Win_t = (bf16*)(wb + 32 * MiB); bf16* Wo_t = (bf16*)(wb + 42 * MiB); bf16* Wout_t = (bf16*)(wb + 44 * MiB); float* BG = (float*)(wb + 46 * MiB);
    bf16* PROJb = (bf16*)(wb + 48 * MiB); bf16* ACTb = (bf16*)(wb + 48 * MiB);
    bf16* YAB = (bf16*)(wb + 208 * MiB); bf16* MERGED = (bf16*)(wb + 240 * MiB); float* X1 = (float*)(wb + 272 * MiB);
    float* QKV = (float*)(wb + 336 * MiB); float* O32 = (float*)(wb + 432 * MiB); float* U = (float*)(wb + 464 * MiB); float* VLN = (float*)(wb + 496 * MiB);
    bf16* Wgu_t = (bf16*)(wb + 528 * MiB); bf16* Wd_t = (bf16*)(wb + 656 * MiB); bf16* HS = (bf16*)(wb + 720 * MiB); bf16* Yb = (bf16*)(wb + 864 * MiB);
    unsigned char* small = wb + 1008 * MiB;
    int* slot_e = (int*)(small + 0 * MiB); int* slot_pos = (int*)(small + 1 * MiB); int* elist = (int*)(small + 2 * MiB); float* ewgt = (float*)(small + 4 * MiB); bf16* WrT = (bf16*)(small + 6 * MiB);
    unsigned* gcnt = (unsigned*)(ctl + CW_CNT);

#ifndef PROBE_MASK
#define PROBE_MASK 0
#endif
#define REP(bit) for (int _r = 0; _r < ((PROBE_MASK >> (bit)) & 1) + 1; ++_r)
    REP(0) { p_convert_front(c, w_in, w_o_dn, w_o_sg, w_out, Win_t, Wo_t, Wout_t);
    __syncthreads();
    p_norm1(c, x, norm1_g, w_in, a_log, dt_bias, Hb, BG); if (PROBE_MASK & 1) __syncthreads();
    p_build_wrt(c, w_router, WrT);
    for (int i = c.bid * NTHR + c.tid; i < NE * NTOK / 4; i += c.nb * NTHR) { ((v4u*)elist)[i] = (v4u){0u, 0u, 0u, 0u}; ((v4u*)ewgt)[i] = (v4u){0u, 0u, 0u, 0u}; } }
    GRID_BAR();
    REP(1) { pg8::Gemm g{Hb, Win_t, NTOK, PJ, D}; pg8::StaticOrder S; S.init(NTOK, PJ, c.nb, c.bid); EpiProj E{PROJb};
      pg8::gemm_phase<EpiProj, pg8::StaticOrder, true, true>(c.lds, g, S, E); }
    GRID_BAR();
    DnBufs DB; DB.WN = wb + 336 * MiB; DB.QD = wb + 352 * MiB; DB.KD = wb + 368 * MiB; DB.QK = wb + 384 * MiB; DB.U = wb + 392 * MiB; DB.SST = wb + 408 * MiB; DB.EG = (float*)(wb + 440 * MiB);
    REP(2) { p_dn_prep(c, PROJb, conv_w, BG, DB); }
    GRID_BAR();
    if (c.bid < SCAN_WGS) { REP(3) { p_dn_scan(c, DB); } }
    else { Ctx c2 = c; c2.bid = c.bid - SCAN_WGS; c2.nb = c.nb - SCAN_WGS;
        REP(4) { for (int it = c2.bid; it < (NTOK / SGC) * 4; it += c2.nb) p_sg_item(c, it, PROJb, sg_ln_g, sg_ln_b, sg_w, sg_b, YAB + (size_t)NTOK * DNW); }
        REP(5) { p_convert_moe(c2, w_gate_up, w_down, Wgu_t, Wd_t); } }
    GRID_BAR();
    REP(6) { p_dn_out(c, DB, PROJb, dn_norm_g, YAB); }
    GRID_BAR();
    REP(7) { pg8::Gemm g{YAB, Wo_t, 0, 0, DNW}; DualOrder S; S.init(c.nb, c.bid); EpiMerge E{PROJb, MERGED};
      pg8::gemm_phase<EpiMerge, DualOrder, true, true>(c.lds, g, S, E); }
    GRID_BAR();
    REP(8) { pg8::Gemm g{MERGED, Wout_t, NTOK, D, D}; pg8::StaticOrder S; S.init(NTOK, D, c.nb, c.bid); EpiResid E{x, X1};
      pg8::gemm_phase<EpiResid, pg8::StaticOrder, true, true>(c.lds, g, S, E); }
    GRID_BAR();
    p_router2(c, X1, norm2_g, WrT, b_router, H2b, slot_e, slot_pos, elist, ewgt, gcnt);
    GRID_BAR();
    LAS unsigned char* tile_e = c.lds0 + EXTRA_OFF + 512; LAS int* ntl = (LAS int*)(c.lds0 + EXTRA_OFF + 1024); LAS int* tile_b = (LAS int*)(c.lds0 + EXTRA_OFF + 1088);
    build_tile_table(c, gcnt, tile_e, ntl, tile_b);
    const int NTL = __builtin_amdgcn_readfirstlane(ntl[0]);
    REP(10) { pg8::Gemm g{H2b, Wgu_t, 0, 0, D, elist}; MoeOrder S; S.init(NTL, 8, c.nb, c.bid, tile_e, tile_b); EpiSwiglu E{ACTb, b_gate_up};
      pg8::gemm_phase<EpiSwiglu, MoeOrder, true, true, true>(c.lds, g, S, E); }
    GRID_BAR();
    REP(11) { pg8::Gemm g{ACTb, Wd_t, 0, 0, DFF}; MoeOrder S; S.init(NTL, 4, c.nb, c.bid, tile_e, tile_b); EpiDown E{Yb, b_down, ewgt};
      pg8::gemm_phase<EpiDown, MoeOrder, true, true>(c.lds, g, S, E); }
    GRID_BAR();
    REP(12) { p_final(c, X1, Yb, slot_e, slot_pos, gcnt, norm_f_g, out); }
    if (PROBE_MASK & 8192) { for (int k = 0; k < 10; ++k) GRID_BAR(); }
}

extern "C" void kernel_launch(void* const* d_in, const int* in_sizes, int n_in, void* d_out, int out_size, void* d_ws, size_t ws_size, hipStream_t stream) {
    static int grid = 0;
    if (grid == 0) {
        if (n_in != 22 || in_sizes[0] != NTOK * D || out_size != NTOK * D || ws_size < WS_NEED) { fprintf(stderr, "kernel_launch: unexpected shapes (n_in %d, ws %zu)\n", n_in, ws_size); grid = -1; return; }
        int dev = 0, cus = 0, per_cu = 0;
        if (hipGetDevice(&dev) != hipSuccess || hipDeviceGetAttribute(&cus, hipDeviceAttributeMultiprocessorCount, dev) != hipSuccess) { grid = -1; return; }
        if (hipFuncSetAttribute((const void*)mega, hipFuncAttributeMaxDynamicSharedMemorySize, LDS_BYTES) != hipSuccess) { fprintf(stderr, "kernel_launch: hipFuncSetAttribute failed\n"); grid = -1; return; }
        if (hipOccupancyMaxActiveBlocksPerMultiprocessor(&per_cu, (const void*)mega, NTHR, LDS_BYTES) != hipSuccess || per_cu < 1) fprintf(stderr, "kernel_launch: occupancy query reports %d\n", per_cu);
        (void)hipGetLastError();
        grid = cus;
    }
    if (grid < 0) return;
    if (hipMemsetAsync((char*)d_ws + WS_CTL, 0, CTL_ZERO_BYTES, stream) != hipSuccess) { fprintf(stderr, "kernel_launch: memset failed\n"); return; }
    Args a{};
    for (int i = 0; i < 22; ++i) a.in[i] = (const float*)d_in[i];
    a.out = (float*)d_out; a.ws = (unsigned char*)d_ws; a.ph_lo = 0; a.ph_hi = 100;
    hipLaunchKernelGGL(mega, dim3(grid), dim3(NTHR), LDS_BYTES, stream, a);
#if PROBE_MASK & 131072
    (void)hipMemsetAsync((char*)d_ws + WS_CTL, 0, CTL_ZERO_BYTES, stream); hipLaunchKernelGGL(mega, dim3(grid), dim3(NTHR), LDS_BYTES, stream, a);
#endif
    const hipError_t le = hipPeekAtLastError();
    if (le != hipSuccess) fprintf(stderr, "kernel_launch: launch failed: %s\n", hipGetErrorName(le));
}
```

```cpp
#include <hip/hip_runtime.h>
#include <cstdio>
#include <cstdint>
#include <cmath>

#define GAS __attribute__((address_space(1)))
#define LAS __attribute__((address_space(3)))
typedef GAS unsigned gu32;
#define RLX_AGENT __ATOMIC_RELAXED, __HIP_MEMORY_SCOPE_AGENT

constexpr int NWAVES = 8, NTHR = 512;
constexpr int D = 1024, BATCH = 2, SEQ = 8192, NTOK = BATCH * SEQ;
constexpr int DNH = 4, DNW = 512;
constexpr int SGD = 128, SGW = 512, SGC = 128;
constexpr int NE = 32, TOPK = 4, DFF = 1024;
constexpr int OFF_Z = 1536, OFF_BETA = 2048, OFF_A = 2052, OFF_U = 2056, OFF_V = 2568, OFF_GA = 3080, OFF_GB = 4104, INC = 5128;
constexpr float RMS_EPS = 1e-6f, LN_EPS = 1e-5f, L2_EPS = 1e-6f;

constexpr size_t MiB = 1u << 20;
constexpr size_t WS_CTL = 0, CTL_ZERO_BYTES = 1 * MiB;
constexpr int CW_BAR = 4096;
constexpr int CW_CNT = 16384;
constexpr size_t WS_BASE = 2 * MiB;
constexpr size_t WS_NEED = 1020 * MiB;
constexpr int LDSCTL_OFF = 0, MISC_OFF = 320, RING_OFF = 1024, RING_BYTES = 131072, EXTRA_OFF = RING_OFF + RING_BYTES, LDS_BYTES = 147456;

#define XB_TMO      128
#define XB_XCNT(j)  (256  + 64 * (j))
#define XB_XSUB(j)  (1280 + 64 * (j))
#define XB_XGEN(j)  (2304 + 64 * (j))
#define XB_TOP      3328
#define XB_TOPGEN   3392
#define XCD_BAR_WORDS 3456
#define XB_SPIN_CAP (1u << 22)
__device__ __forceinline__ unsigned xb_ld(unsigned* p)              { return __hip_atomic_load(p, __ATOMIC_RELAXED, __HIP_MEMORY_SCOPE_AGENT); }
__device__ __forceinline__ unsigned xb_add(unsigned* p, unsigned v) { return __hip_atomic_fetch_add(p, v, __ATOMIC_RELAXED, __HIP_MEMORY_SCOPE_AGENT); }
__device__ __forceinline__ unsigned xb_xcc_id() { return (unsigned)__builtin_amdgcn_s_getreg((3 << 11) | 20) & 0xFu; }
#define XB_SPIN(cond, bar) do { unsigned _sp = 0; while (cond) { __builtin_amdgcn_s_sleep(1); \
    if ((++_sp & 255u) == 0u) { if (xb_ld(&(bar)[XB_TMO])) break; if (_sp > XB_SPIN_CAP) { atomicAdd(&(bar)[XB_TMO], 1u); break; } } } } while (0)
struct XcdBarrier { unsigned* bar; unsigned x; volatile LAS unsigned* st; };
__device__ __forceinline__ XcdBarrier xcd_barrier_post(unsigned* bar, volatile LAS unsigned* st) {
    XcdBarrier b; b.bar = bar; b.x = xb_xcc_id(); b.st = st;
    if (threadIdx.x == 0) (void)xb_add(&bar[XB_XCNT(b.x)], 1u);
    return b;
}
__device__ __forceinline__ void xcd_barrier_complete(unsigned* bar, unsigned x, unsigned& nloc, unsigned& nx) {
    const unsigned G = gridDim.x * gridDim.y * gridDim.z;
    unsigned sum, cnt, mine, sp = 0u;
    for (;;) {
        sum = 0u; cnt = 0u; mine = 0u;
#pragma unroll
        for (unsigned j = 0; j < 16; ++j) { const unsigned c = xb_ld(&bar[XB_XCNT(j)]); sum += c; cnt += (c > 0u) ? 1u : 0u; mine = (j == x) ? c : mine; }
        if (sum == G) break;
        __builtin_amdgcn_s_sleep(1);
        if ((++sp & 255u) == 0u) { if (xb_ld(&bar[XB_TMO])) break; if (sp > XB_SPIN_CAP) { atomicAdd(&bar[XB_TMO], 1u); break; } }
    }
    nloc = mine > 0u ? mine : 1u; nx = cnt > 0u ? cnt : 1u;
}
__device__ __forceinline__ void xcd_barrier(const XcdBarrier& b) {
    asm volatile("s_waitcnt vmcnt(0)" ::: "memory");
    __syncthreads();
    if (threadIdx.x == 0) {
        unsigned* bar = b.bar;
        __builtin_amdgcn_s_waitcnt(0);
        unsigned nloc = b.st[0], nx = b.st[1];
        if (nloc == 0u) { xcd_barrier_complete(bar, b.x, nloc, nx); b.st[0] = nloc; b.st[1] = nx; }
        const unsigned old = xb_add(&bar[XB_XSUB(b.x)], 1u);
        const unsigned gen = old / nloc;
        if (old + 1u == (gen + 1u) * nloc) {
            __builtin_amdgcn_fence(__ATOMIC_RELEASE, "agent");
            asm volatile("s_waitcnt vmcnt(0)" ::: "memory");
            const unsigned og = xb_add(&bar[XB_TOP], 1u);
            const unsigned tg = og / nx;
            if (og + 1u == (tg + 1u) * nx) xb_add(&bar[XB_TOPGEN], 1u);
            else XB_SPIN(xb_ld(&bar[XB_TOPGEN]) == tg, bar);
            __builtin_amdgcn_fence(__ATOMIC_ACQUIRE, "agent");
            xb_add(&bar[XB_XGEN(b.x)], 1u);
            asm volatile("s_waitcnt vmcnt(0)" ::: "memory");
        } else {
            XB_SPIN(xb_ld(&bar[XB_XGEN(b.x)]) == gen, bar);
            __builtin_amdgcn_fence(__ATOMIC_ACQUIRE, "agent");
            asm volatile("s_waitcnt vmcnt(0)" ::: "memory");
        }
    }
    __syncthreads();
}

__device__ __forceinline__ float dpp_xor1(float v) { return __builtin_bit_cast(float, __builtin_amdgcn_update_dpp(0, __builtin_bit_cast(int, v), 0xB1, 0xF, 0xF, true)); }
__device__ __forceinline__ float dpp_xor2(float v) { return __builtin_bit_cast(float, __builtin_amdgcn_update_dpp(0, __builtin_bit_cast(int, v), 0x4E, 0xF, 0xF, true)); }
__device__ __forceinline__ float dpp_qrev(float v) { return __builtin_bit_cast(float, __builtin_amdgcn_update_dpp(0, __builtin_bit_cast(int, v), 0x1B, 0xF, 0xF, true)); }
__device__ __forceinline__ float dpp_hmir(float v) { return __builtin_bit_cast(float, __builtin_amdgcn_update_dpp(0, __builtin_bit_cast(int, v), 0x141, 0xF, 0xF, true)); }
__device__ __forceinline__ float dpp_rmir(float v) { return __builtin_bit_cast(float, __builtin_amdgcn_update_dpp(0, __builtin_bit_cast(int, v), 0x140, 0xF, 0xF, true)); }
__device__ __forceinline__ float dpp_ror8(float v) { return __builtin_bit_cast(float, __builtin_amdgcn_update_dpp(0, __builtin_bit_cast(int, v), 0x128, 0xF, 0xF, true)); }
__device__ __forceinline__ float dpp_xor4(float v) { return dpp_qrev(dpp_hmir(v)); }
__device__ __forceinline__ float row16_sum(float v) { v += dpp_xor1(v); v += dpp_xor2(v); v += dpp_hmir(v); v += dpp_rmir(v); return v; }
__device__ __forceinline__ float rdlane(float v, int l) { return __builtin_bit_cast(float, __builtin_amdgcn_readlane(__builtin_bit_cast(int, v), l)); }
__device__ __forceinline__ float wave_sum(float v) { v = row16_sum(v); return (rdlane(v, 0) + rdlane(v, 16)) + (rdlane(v, 32) + rdlane(v, 48)); }
__device__ __forceinline__ void swap32(float& a, float& b) { asm volatile("s_nop 1\n\tv_permlane32_swap_b32 %0, %1" : "+v"(a), "+v"(b)); }
__device__ __forceinline__ void swap16(float& a, float& b) { asm volatile("s_nop 1\n\tv_permlane16_swap_b32 %0, %1" : "+v"(a), "+v"(b)); }
#define BFLY_SW32(acc, n) _Pragma("unroll") for (int i_ = 0; i_ < (n) / 2; ++i_) { float x_ = acc[i_], y_ = acc[i_ + (n) / 2]; swap32(x_, y_); acc[i_] = x_ + y_; }
#define BFLY_SW16(acc, n) _Pragma("unroll") for (int i_ = 0; i_ < (n) / 2; ++i_) { float x_ = acc[i_], y_ = acc[i_ + (n) / 2]; swap16(x_, y_); acc[i_] = x_ + y_; }
#define BFLY_DPP(acc, n, m, PERM) _Pragma("unroll") for (int i_ = 0; i_ < (n) / 2; ++i_) { const bool up_ = (lane & (m)) != 0; const float send_ = up_ ? acc[i_] : acc[i_ + (n) / 2]; const float keep_ = up_ ? acc[i_ + (n) / 2] : acc[i_]; acc[i_] = keep_ + PERM(send_); }
__device__ __forceinline__ float sigmoidf_(float x) { return 1.f / (1.f + expf(-x)); }
__device__ __forceinline__ float siluf_(float x) { return x / (1.f + expf(-x)); }
__device__ __forceinline__ float geluf_(float x) { return 0.5f * x * (1.f + erff(x * 0.70710678118654752f)); }
__device__ __forceinline__ float softplusf_(float x) { return x > 20.f ? x : log1pf(expf(x)); }

__device__ __forceinline__ void lds_barrier() { asm volatile("s_waitcnt lgkmcnt(0)" ::: "memory"); __builtin_amdgcn_s_barrier(); asm volatile("" ::: "memory"); }
struct Ctx { int bid, nb, tid, lane, wave; LAS unsigned char* lds; LAS unsigned char* lds0; };

namespace pg8 {
#define PG8_LAS __attribute__((address_space(3)))
typedef unsigned short bf16_t;
typedef short bf16x8 __attribute__((ext_vector_type(8)));
typedef float f32x4 __attribute__((ext_vector_type(4)));
typedef unsigned u32x4 __attribute__((ext_vector_type(4)));
constexpr int BM = 256, BK = 64, HALF = 128, HTB = HALF * BK * 2  , STAGE_BYTES = 8 * HTB, NXCD = 8, WGM = 8;

__host__ __device__ __forceinline__ int lds_byte(int r, int c) { const int st = (r >> 4) * 2 + (c >> 5), rr = r & 15, cc = c & 31, ob = rr * 64 + cc * 2; return st * 1024 + (ob ^ (((ob >> 9) & 1) << 5)); }
__host__ __device__ __forceinline__ void stage_rc(int b, int& R, int& C) { const int st = b / 1024, sb = b % 1024, swz = sb ^ (((sb >> 9) & 1) << 5); R = (st >> 1) * 16 + swz / 64; C = (st & 1) * 32 + (swz % 64) / 2; }
__host__ __device__ __forceinline__ int perm32(int rho) { const int n = rho >> 4, i = rho & 15; return 8 * (i >> 2) + 4 * n + (i & 3); }

struct Unit { int pm, pn, x0, x1, rb; };
struct Gemm { const bf16_t* A; const bf16_t* Bt; int M, N, K; const int* rows; };

struct StaticOrder {
    int nM, nN, nwg, G, c;
    __host__ __device__ void init(int M, int N, int G_, int c_) { nM = M / BM; nN = N / BM; nwg = nM * nN; G = G_; c = c_; }
    __host__ __device__ bool next(int i, Unit& u) const {
        const long L = (long)i * G + c; if (L >= nwg) return false;
        int wgid = (int)L; { const int q = nwg / NXCD, r = nwg % NXCD, xcd = wgid % NXCD, off = wgid / NXCD; wgid = (xcd < r ? xcd * (q + 1) : r * (q + 1) + (xcd - r) * q) + off; }
        const int nig = WGM * nN, gid = wgid / nig, fm = gid * WGM, gsz = (nM - fm) < WGM ? (nM - fm) : WGM;
        u.pm = fm + ((wgid % nig) % gsz); u.pn = (wgid % nig) / gsz; u.x0 = 0; u.x1 = u.pn; u.rb = 0; return true;
    }
    __device__ __forceinline__ void a_ready(const Unit&) const {}
    __device__ __forceinline__ void done(const Unit&) const {}
};


template <class Epi, class Sched, bool ALIGN_EPI = false, bool SP2 = false, bool GATHER = false, int BAUX = 0>
__device__ __forceinline__ void gemm_phase(PG8_LAS unsigned char* lds, const Gemm g, const Sched& S, const Epi& E) {
    int tid_ = threadIdx.x; asm volatile("" : "+v"(tid_));
    const int tid = tid_, wid = __builtin_amdgcn_readfirstlane(tid >> 6), lane = tid & 63, wr = wid >> 2, wc = wid & 3, fr = lane & 15, fq = lane >> 4;
    const int K = g.K, nt = K / BK;
    unsigned voffA[2], voffB[2]; int gR[2]; unsigned gC2[2];
#pragma unroll
    for (int i = 0; i < 2; ++i) { int R, C; stage_rc(tid * 16 + i * 8192, R, C); const int Rb = Epi::PERM ? ((R & ~31) + perm32(R & 31)) : R;
        voffA[i] = (unsigned)(R * K + C) * 2u; voffB[i] = (unsigned)(Rb * K + C) * 2u; gR[i] = R; gC2[i] = (unsigned)C * 2u; }
    static_assert(!GATHER || SP2, "GATHER is implemented for the SP2 loop only");
    unsigned gcur[2][2], gnxt[2][2]; int graw[4];
#define PG8_STAGE_A(bufoff, kptr, ktile, h, use_next) do { if constexpr (GATHER) { const unsigned sv_[2] = {(use_next) ? gnxt[h][0] : gcur[h][0], (use_next) ? gnxt[h][1] : gcur[h][1]}; \
        PG8_STAGE(bufoff, gA0 + (size_t)(ktile) * kstep, sv_); } else { PG8_STAGE(bufoff, (kptr) + ((h) ? hstep : 0), voffA); } } while (0)
    const size_t kstep = (size_t)(BK * 2);
    const size_t hstep = (size_t)HALF * K * 2;
    const size_t tstep = 2 * hstep;
    const unsigned ldsw = (unsigned)wid * 1024u;
    const int aoff = lds_byte(wr * 64 + fr, fq * 8), boff = lds_byte(wc * 32 + fr, fq * 8);
#define PG8_SA(b, h) (((b) * 2 + (h)) * HTB)
#define PG8_SB(b, h) ((4 + (b) * 2 + (h)) * HTB)
#define PG8_STAGE(bufoff, gbase, voff) do { _Pragma("unroll") for (int _i = 0; _i < 2; ++_i) \
        __builtin_amdgcn_global_load_lds((const unsigned*)((const char*)(gbase) + (voff)[_i]), (PG8_LAS unsigned*)(lds + (bufoff) + ldsw + _i * 8192), 16, 0, 0); } while (0)
#define PG8_STAGE_B(bufoff, gbase, voff) do { _Pragma("unroll") for (int _i = 0; _i < 2; ++_i) \
        __builtin_amdgcn_global_load_lds((const unsigned*)((const char*)(gbase) + (voff)[_i]), (PG8_LAS unsigned*)(lds + (bufoff) + ldsw + _i * 8192), 16, 0, BAUX); } while (0)
#define PG8_LDA(dst, b, h) do { _Pragma("unroll") for (int m = 0; m < 4; ++m) _Pragma("unroll") for (int k = 0; k < 2; ++k) dst[m][k] = *(const PG8_LAS bf16x8*)(lds + PG8_SA(b, h) + aoff + m * 2048 + k * 1024); } while (0)
#define PG8_LDB(dst, b, h) do { _Pragma("unroll") for (int n = 0; n < 2; ++n) _Pragma("unroll") for (int k = 0; k < 2; ++k) dst[n][k] = *(const PG8_LAS bf16x8*)(lds + PG8_SB(b, h) + boff + n * 2048 + k * 1024); } while (0)
#define PG8_MMA(ai, bj, At, Bt) do { __builtin_amdgcn_s_setprio(1); _Pragma("unroll") for (int m = 0; m < 4; ++m) _Pragma("unroll") for (int n = 0; n < 2; ++n) _Pragma("unroll") for (int k = 0; k < 2; ++k) \
        acc[ai][bj][m][n] = __builtin_amdgcn_mfma_f32_16x16x32_bf16(Bt[n][k], At[m][k], acc[ai][bj][m][n], 0, 0, 0); __builtin_amdgcn_s_setprio(0); } while (0)
#define PG8_WAIT_V(n) asm volatile("s_waitcnt vmcnt(" #n ")" ::: "memory")
#define PG8_WAIT_L(n) asm volatile("s_waitcnt lgkmcnt(" #n ")" ::: "memory")
#define PG8_BAR __builtin_amdgcn_s_barrier()
#define PG8_SCHED __builtin_amdgcn_sched_barrier(0)
    Unit cur, nxt; int ui = 0;
    if (!S.next(0, cur)) return;
    f32x4 acc[2][2][4][2];
#pragma unroll
    for (int a = 0; a < 2; ++a)
#pragma unroll
        for (int b = 0; b < 2; ++b)
#pragma unroll
            for (int m = 0; m < 4; ++m)
#pragma unroll
                for (int n = 0; n < 2; ++n) acc[a][b][m][n] = (f32x4){0.f, 0.f, 0.f, 0.f};
    bf16x8 At[4][2], B0[2][2], B1[2][2];
    const char* cA = (const char*)g.A + (size_t)cur.pm * tstep; const char* cB = (const char*)g.Bt + (size_t)cur.pn * tstep;
    const char* const gA0 = (const char*)g.A;
    if constexpr (GATHER) {
#pragma unroll
        for (int h = 0; h < 2; ++h)
#pragma unroll
            for (int i = 0; i < 2; ++i) { gcur[h][i] = (unsigned)g.rows[cur.rb + h * HALF + gR[i]] * (unsigned)(K * 2) + gC2[i]; gnxt[h][i] = gcur[h][i]; } }
    S.a_ready(cur);
    if constexpr (SP2) {
        PG8_STAGE_B(PG8_SB(0, 0), cB, voffB); PG8_STAGE_B(PG8_SB(0, 1), cB + hstep, voffB); PG8_STAGE_A(PG8_SA(0, 0), cA, 0, 0, false); PG8_STAGE_A(PG8_SA(0, 1), cA, 0, 1, false);
        if (wr == 1) PG8_BAR;
        PG8_WAIT_V(2); PG8_BAR;
        PG8_STAGE_B(PG8_SB(1, 0), cB + kstep, voffB); PG8_STAGE_A(PG8_SA(1, 0), cA + kstep, 1, 0, false); PG8_STAGE_B(PG8_SB(1, 1), cB + hstep + kstep, voffB);
        PG8_WAIT_V(6); PG8_BAR;
    } else {
        PG8_STAGE_B(PG8_SB(0, 0), cB, voffB); PG8_STAGE(PG8_SA(0, 0), cA, voffA); PG8_STAGE_B(PG8_SB(0, 1), cB + hstep, voffB); PG8_STAGE(PG8_SA(0, 1), cA + hstep, voffA);
        if (wr == 1) PG8_BAR;
        PG8_WAIT_V(4); PG8_BAR;
        PG8_STAGE_B(PG8_SB(1, 0), cB + kstep, voffB); PG8_STAGE(PG8_SA(1, 0), cA + kstep, voffA); PG8_STAGE_B(PG8_SB(1, 1), cB + hstep + kstep, voffB);
        PG8_WAIT_V(6); PG8_BAR;
    }
    for (;;) {
        const bool has_next = S.next(ui + 1, nxt);
        const char* nA = has_next ? (const char*)g.A + (size_t)nxt.pm * tstep : cA; const char* nB = has_next ? (const char*)g.Bt + (size_t)nxt.pn * tstep : cB;
        if constexpr (GATHER) { if (has_next) {
#pragma unroll
            for (int h = 0; h < 2; ++h)
#pragma unroll
                for (int i = 0; i < 2; ++i) asm volatile("global_load_dword %0, %1, off" : "=v"(graw[h * 2 + i]) : "v"(g.rows + (nxt.rb + h * HALF + gR[i])) : "memory"); } }
        for (int t = 0; t < nt; t += 2) {
            const bool last = (t == nt - 2);
            const char* a1 = cA + (size_t)(t + 1) * kstep;
            const char* a2 = last ? nA : cA + (size_t)(t + 2) * kstep; const char* b2 = last ? nB : cB + (size_t)(t + 2) * kstep;
            const char* a3 = a2 + kstep; const char* b3 = b2 + kstep;
            if (last && has_next) S.a_ready(nxt);
            if constexpr (GATHER) { if (last) { if (has_next) { asm volatile("" : "+v"(graw[0]), "+v"(graw[1]), "+v"(graw[2]), "+v"(graw[3]));
#pragma unroll
                    for (int h = 0; h < 2; ++h)
#pragma unroll
                        for (int i = 0; i < 2; ++i) gnxt[h][i] = (unsigned)graw[h * 2 + i] * (unsigned)(K * 2) + gC2[i]; }
                else {
#pragma unroll
                    for (int h = 0; h < 2; ++h)
#pragma unroll
                        for (int i = 0; i < 2; ++i) gnxt[h][i] = gcur[h][i]; } } }
            const int kt2 = last ? 0 : t + 2;
            if constexpr (SP2) {
            PG8_LDB(B0, 0, 0); PG8_LDB(B1, 0, 1); PG8_SCHED; PG8_LDA(At, 0, 0); PG8_STAGE_A(PG8_SA(1, 1), a1, t + 1, 1, false);
            PG8_WAIT_V(8); PG8_WAIT_L(0); PG8_BAR; PG8_MMA(0, 0, At, B0); PG8_MMA(0, 1, At, B1); PG8_BAR; PG8_SCHED;
            PG8_LDA(At, 0, 1); PG8_STAGE_B(PG8_SB(0, 0), b2, voffB); PG8_STAGE_B(PG8_SB(0, 1), b2 + hstep, voffB); PG8_STAGE_A(PG8_SA(0, 0), a2, kt2, 0, last);
            PG8_WAIT_V(8); PG8_WAIT_L(0); PG8_BAR; PG8_MMA(1, 0, At, B0); PG8_MMA(1, 1, At, B1); PG8_BAR; PG8_SCHED;
            PG8_LDB(B0, 1, 0); PG8_LDB(B1, 1, 1); PG8_SCHED; PG8_LDA(At, 1, 0); PG8_STAGE_A(PG8_SA(0, 1), a2, kt2, 1, last);
            PG8_WAIT_V(8); PG8_WAIT_L(0); PG8_BAR; PG8_MMA(0, 0, At, B0); PG8_MMA(0, 1, At, B1); PG8_BAR; PG8_SCHED;
            PG8_LDA(At, 1, 1); PG8_STAGE_B(PG8_SB(1, 0), b3, voffB); PG8_STAGE_B(PG8_SB(1, 1), b3 + hstep, voffB); PG8_STAGE_A(PG8_SA(1, 0), a3, kt2 + 1, 0, last);
            PG8_WAIT_V(8); PG8_WAIT_L(0); PG8_BAR; PG8_MMA(1, 0, At, B0); PG8_MMA(1, 1, At, B1); PG8_BAR; PG8_SCHED;
            } else {
            PG8_LDB(B0, 0, 0); PG8_SCHED; PG8_LDA(At, 0, 0); PG8_STAGE(PG8_SA(1, 1), a1 + hstep, voffA);
            PG8_WAIT_L(8); PG8_BAR; PG8_WAIT_L(0); PG8_MMA(0, 0, At, B0); PG8_BAR; PG8_SCHED;
            PG8_LDB(B1, 0, 1); PG8_STAGE_B(PG8_SB(0, 0), b2, voffB);
            PG8_BAR; PG8_WAIT_L(0); PG8_MMA(0, 1, At, B1); PG8_BAR;
            PG8_LDA(At, 0, 1); PG8_STAGE(PG8_SA(0, 0), a2, voffA);
            PG8_BAR; PG8_WAIT_L(0); PG8_MMA(1, 0, At, B0); PG8_BAR; PG8_SCHED;
            PG8_STAGE_B(PG8_SB(0, 1), b2 + hstep, voffB);
            PG8_WAIT_V(6); PG8_BAR; PG8_MMA(1, 1, At, B1); PG8_BAR;
            PG8_LDB(B0, 1, 0); PG8_SCHED; PG8_LDA(At, 1, 0); PG8_STAGE(PG8_SA(0, 1), a2 + hstep, voffA);
            PG8_WAIT_L(8); PG8_BAR; PG8_WAIT_L(0); PG8_MMA(0, 0, At, B0); PG8_BAR; PG8_SCHED;
            PG8_LDB(B1, 1, 1); PG8_STAGE_B(PG8_SB(1, 0), b3, voffB);
            PG8_BAR; PG8_WAIT_L(0); PG8_MMA(0, 1, At, B1); PG8_BAR;
            PG8_LDA(At, 1, 1); PG8_STAGE(PG8_SA(1, 0), a3, voffA);
            PG8_BAR; PG8_WAIT_L(0); PG8_MMA(1, 0, At, B0); PG8_BAR; PG8_SCHED;
            PG8_STAGE_B(PG8_SB(1, 1), b3 + hstep, voffB);
            PG8_WAIT_V(6); PG8_BAR; PG8_MMA(1, 1, At, B1); PG8_BAR;
            }
        }
        if constexpr (ALIGN_EPI) { if (wr == 0) PG8_BAR; }
        if constexpr (!Epi::AFTER_DRAIN) { E(acc, cur, wr, wc, fr, fq); S.done(cur); }
        if (!has_next) break;
        if (!E.keep_acc(cur)) {
#pragma unroll
        for (int a = 0; a < 2; ++a)
#pragma unroll
            for (int b = 0; b < 2; ++b)
#pragma unroll
                for (int m = 0; m < 4; ++m)
#pragma unroll
                    for (int n = 0; n < 2; ++n) acc[a][b][m][n] = (f32x4){0.f, 0.f, 0.f, 0.f};
        }
        cur = nxt; cA = nA; cB = nB; ++ui;
        if constexpr (GATHER) {
#pragma unroll
            for (int h = 0; h < 2; ++h)
#pragma unroll
                for (int i = 0; i < 2; ++i) gcur[h][i] = gnxt[h][i]; }
        if constexpr (ALIGN_EPI) { if (wr == 1) PG8_BAR; }
    }
    PG8_WAIT_V(0);
    if constexpr (!ALIGN_EPI) { if (wr == 0) PG8_BAR; }
    PG8_BAR;
    if constexpr (Epi::AFTER_DRAIN) { E.fused(acc, cur, wr, wc, fr, fq, lds, wid, lane); S.done(cur); }
#undef PG8_SA
#undef PG8_SB
#undef PG8_STAGE
#undef PG8_STAGE_B
#undef PG8_STAGE_A
#undef PG8_LDA
#undef PG8_LDB
#undef PG8_MMA
#undef PG8_WAIT_V
#undef PG8_WAIT_L
#undef PG8_BAR
#undef PG8_SCHED
}
}
typedef unsigned short bf16;
typedef unsigned v4u __attribute__((ext_vector_type(4)));
typedef unsigned v2u __attribute__((ext_vector_type(2)));
typedef float f32x4 __attribute__((ext_vector_type(4)));
typedef short bf16x8 __attribute__((ext_vector_type(8)));
#define MFMA16(a, b, c) __builtin_amdgcn_mfma_f32_16x16x32_bf16((a), (b), (c), 0, 0, 0)
__device__ __forceinline__ bf16x8 as_frag(const v4u& x) { return __builtin_bit_cast(bf16x8, x); }
#define LDS_WAIT() asm volatile("s_waitcnt lgkmcnt(0)" ::: "memory")
#define VM_WAIT() asm volatile("s_waitcnt vmcnt(0)" ::: "memory")
typedef float cvt_f32x2 __attribute__((ext_vector_type(2)));
typedef __bf16 cvt_bf16x2 __attribute__((ext_vector_type(2)));
__device__ __forceinline__ unsigned cvt_pk_bf16(float lo, float hi) { const cvt_f32x2 v = {lo, hi}; return __builtin_bit_cast(unsigned, __builtin_convertvector(v, cvt_bf16x2)); }
__device__ __forceinline__ v4u ldnt4(const void* p) { return __builtin_nontemporal_load((const v4u*)p); }
__device__ __forceinline__ v2u ldnt2(const void* p) { return __builtin_nontemporal_load((const v2u*)p); }
__device__ __forceinline__ float bf_lo(unsigned u) { return __uint_as_float(u << 16); }
__device__ __forceinline__ float bf_hi(unsigned u) { return __uint_as_float(u & 0xffff0000u); }

template <bool NT = false>
__device__ __forceinline__ void tr_item(const float* __restrict__ src, int ldn, int k0, int nsrc0, bf16* dst, int K, int ndst0, LAS float* scr, int lane) {
    const int c4 = (lane & 15) * 4, kr = lane >> 4;
#pragma unroll 4
    for (int i = 0; i < 16; ++i) { const int kk = 4 * i + kr; const f32x4* gp = (const f32x4*)(src + (size_t)(k0 + kk) * ldn + nsrc0 + c4); const f32x4 v = NT ? __builtin_nontemporal_load(gp) : *gp;
        LAS float* s = scr + kk * 65 + c4; s[0] = v[0]; s[1] = v[1]; s[2] = v[2]; s[3] = v[3]; }
    LDS_WAIT();
    const int kc = lane & 7, nr = lane >> 3;
#pragma unroll
    for (int jj = 0; jj < 8; ++jj) { const int n = 8 * jj + nr; const LAS float* s = scr + (8 * kc) * 65 + n;
        v4u o; o.x = cvt_pk_bf16(s[0], s[65]); o.y = cvt_pk_bf16(s[130], s[195]); o.z = cvt_pk_bf16(s[260], s[325]); o.w = cvt_pk_bf16(s[390], s[455]);
        v4u* dp = (v4u*)(dst + (size_t)(ndst0 + n) * K + k0 + 8 * kc); if (NT) __builtin_nontemporal_store(o, dp); else *dp = o; }
    LDS_WAIT();
}
__device__ __forceinline__ void p_convert_moe(const Ctx& c, const float* w_gate_up, const float* w_down, bf16* Wgu_t, bf16* Wd_t) {
    LAS float* scr = (LAS float*)c.lds + c.wave * (64 * 65);
    constexpr int I_GU = NE * 16 * 32, I_D = NE * 16 * 16;
    for (int it = c.bid * NWAVES + c.wave; it < I_GU + I_D; it += c.nb * NWAVES) {
        if (it < I_GU) { const int e = it >> 9, r = it & 511, kb = r >> 5, nbk = r & 31, R0 = nbk * 64, pn = R0 >> 8, rr = R0 & 255, bj = rr >> 7, j0 = rr & 127;
            tr_item<true>(w_gate_up + (size_t)e * D * 2 * DFF, 2 * DFF, kb * 64, bj * DFF + 128 * pn + j0, Wgu_t + (size_t)e * 2 * DFF * D, D, R0, scr, c.lane); }
        else { const int r2 = it - I_GU, e = r2 >> 8, r = r2 & 255, kb = r >> 4, nbk = r & 15;
            tr_item<true>(w_down + (size_t)e * DFF * D, D, kb * 64, nbk * 64, Wd_t + (size_t)e * D * DFF, DFF, nbk * 64, scr, c.lane); }
    }
}

__device__ __forceinline__ float f4c(const float4& v, int i) { return i == 0 ? v.x : (i == 1 ? v.y : (i == 2 ? v.z : v.w)); }
__device__ __forceinline__ void p_router(const Ctx& c, const float* __restrict__ X1, const float* __restrict__ g2, const float* __restrict__ wr, const float* __restrict__ br, bf16* __restrict__ H2, int* __restrict__ slot_e, int* __restrict__ slot_pos, int* __restrict__ elist, float* __restrict__ ewgt, unsigned* gcnt, int reps = 1) {
    LAS f32x4* WL = (LAS f32x4*)c.lds;
    LAS float* LG = (LAS float*)(c.lds0 + EXTRA_OFF);
    LAS int* HIST = (LAS int*)(c.lds0 + EXTRA_OFF + 8192);
    LAS int* BASE = HIST + 32;
    LAS int* SELE = BASE + 32;
    LAS int* SELR = SELE + 256;
    LAS float* SELW = (LAS float*)(SELR + 256);
    const int lane = c.lane;
    { f32x4 wv[16];
#pragma unroll
      for (int i = 0; i < 16; ++i) wv[i] = ((const f32x4*)wr)[c.tid + NTHR * i];
#pragma unroll
      for (int i = 0; i < 16; ++i) { const int idx = c.tid + NTHR * i, k = idx >> 3, q = idx & 7, l = (k & 255) >> 2, cc = k & 3, j = k >> 8; WL[((j * 4 + cc) * 8 + q) * 64 + l] = wv[i]; } }
    lds_barrier();
    for (int blk = c.bid; blk < NTOK / 64; blk += c.nb) {
        if (c.tid < 32) HIST[c.tid] = 0;
        lds_barrier();
        for (int pp = 0; pp < 4 * reps; ++pp) { const int p = pp & 3;
            const size_t t0 = (size_t)blk * 64 + c.wave * 8 + 2 * p;
            float4 xa[4], xb[4]; float sa = 0.f, sb = 0.f;
#pragma unroll
            for (int j = 0; j < 4; ++j) { xa[j] = ((const float4*)(X1 + t0 * D))[lane + 64 * j]; xb[j] = ((const float4*)(X1 + (t0 + 1) * D))[lane + 64 * j];
                sa += xa[j].x * xa[j].x + xa[j].y * xa[j].y + xa[j].z * xa[j].z + xa[j].w * xa[j].w; sb += xb[j].x * xb[j].x + xb[j].y * xb[j].y + xb[j].z * xb[j].z + xb[j].w * xb[j].w; }
            const float ra = rsqrtf(wave_sum(sa) * (1.f / D) + RMS_EPS), rb = rsqrtf(wave_sum(sb) * (1.f / D) + RMS_EPS);
#pragma unroll
            for (int j = 0; j < 4; ++j) { const float4 g = ((const float4*)g2)[lane + 64 * j];
                xa[j].x *= ra * g.x; xa[j].y *= ra * g.y; xa[j].z *= ra * g.z; xa[j].w *= ra * g.w; xb[j].x *= rb * g.x; xb[j].y *= rb * g.y; xb[j].z *= rb * g.z; xb[j].w *= rb * g.w;
                v2u oa, ob; oa.x = cvt_pk_bf16(xa[j].x, xa[j].y); oa.y = cvt_pk_bf16(xa[j].z, xa[j].w); ob.x = cvt_pk_bf16(xb[j].x, xb[j].y); ob.y = cvt_pk_bf16(xb[j].z, xb[j].w);
                ((v2u*)(H2 + t0 * D))[lane + 64 * j] = oa; ((v2u*)(H2 + (t0 + 1) * D))[lane + 64 * j] = ob; }
            float acc[64];
#pragma unroll
            for (int i = 0; i < 64; ++i) acc[i] = 0.f;
#pragma unroll
            for (int j = 0; j < 4; ++j)
#pragma unroll
                for (int cc = 0; cc < 4; ++cc) { const float ha = f4c(xa[j], cc), hb = f4c(xb[j], cc);
#pragma unroll
                    for (int q = 0; q < 8; ++q) { const f32x4 w = WL[((j * 4 + cc) * 8 + q) * 64 + lane];
                        acc[4 * q + 0] = fmaf(ha, w.x, acc[4 * q + 0]); acc[4 * q + 1] = fmaf(ha, w.y, acc[4 * q + 1]); acc[4 * q + 2] = fmaf(ha, w.z, acc[4 * q + 2]); acc[4 * q + 3] = fmaf(ha, w.w, acc[4 * q + 3]);
                        acc[32 + 4 * q + 0] = fmaf(hb, w.x, acc[32 + 4 * q + 0]); acc[32 + 4 * q + 1] = fmaf(hb, w.y, acc[32 + 4 * q + 1]); acc[32 + 4 * q + 2] = fmaf(hb, w.z, acc[32 + 4 * q + 2]); acc[32 + 4 * q + 3] = fmaf(hb, w.w, acc[32 + 4 * q + 3]); } }
            BFLY_SW32(acc, 64) BFLY_SW16(acc, 32) BFLY_DPP(acc, 16, 8, dpp_ror8) BFLY_DPP(acc, 8, 4, dpp_xor4) BFLY_DPP(acc, 4, 2, dpp_xor2) BFLY_DPP(acc, 2, 1, dpp_xor1)
            LG[(c.wave * 8 + 2 * p + (lane >> 5)) * 32 + (lane & 31)] = acc[0] + br[lane & 31];
        }
        LDS_WAIT();
        if (lane < 8) {
            const int tokl = c.wave * 8 + lane;
            float l[NE];
#pragma unroll
            for (int j = 0; j < NE; ++j) l[j] = LG[tokl * 32 + j];
            int sel[4]; float sv[4];
#pragma unroll
            for (int k = 0; k < 4; ++k) { int bi = 0; float bv = -INFINITY;
#pragma unroll
                for (int j = 0; j < NE; ++j) { const bool better = l[j] > bv; bv = better ? l[j] : bv; bi = better ? j : bi; }
                sel[k] = bi; sv[k] = bv;
#pragma unroll
                for (int j = 0; j < NE; ++j) l[j] = (j == bi) ? -INFINITY : l[j]; }
            float den = 0.f, ex[4];
#pragma unroll
            for (int k = 0; k < 4; ++k) { ex[k] = expf(sv[k] - sv[0]); den += ex[k]; }
            const float inv = 1.f / den;
#pragma unroll
            for (int k = 0; k < 4; ++k) { SELE[tokl * 4 + k] = sel[k]; SELW[tokl * 4 + k] = ex[k] * inv; SELR[tokl * 4 + k] = atomicAdd((int*)(HIST + sel[k]), 1); }
        }
        lds_barrier();
        if (c.tid < 32) BASE[c.tid] = (int)__hip_atomic_fetch_add(gcnt + c.tid, (unsigned)HIST[c.tid], __ATOMIC_RELAXED, __HIP_MEMORY_SCOPE_AGENT);
        lds_barrier();
        if (c.tid < 256) { const int gi = blk * 256 + c.tid, e = SELE[c.tid], pos = BASE[e] + SELR[c.tid]; slot_e[gi] = e; slot_pos[gi] = pos; elist[e * NTOK + pos] = gi >> 2; ewgt[e * NTOK + pos] = SELW[c.tid]; }
    }
}

__device__ __forceinline__ void p_build_wrt(const Ctx& c, const float* __restrict__ wr, bf16* __restrict__ WrT) {
    for (int i = c.bid * NTHR + c.tid; i < NE * D; i += c.nb * NTHR) { const int e = i >> 10, k = i & 1023; const float w = wr[k * NE + e];
        const unsigned hi = cvt_pk_bf16(w, 0.f) & 0xffffu; const float rem = w - __uint_as_float(hi << 16);
        WrT[e * D + k] = (bf16)hi; WrT[NE * D + e * D + k] = (bf16)(cvt_pk_bf16(rem, 0.f) & 0xffffu); }
}
__device__ __forceinline__ void p_router2(const Ctx& c, const float* __restrict__ X1, const float* __restrict__ g2, const bf16* __restrict__ WrT, const float* __restrict__ br, bf16* __restrict__ H2,
                                          int* __restrict__ slot_e, int* __restrict__ slot_pos, int* __restrict__ elist, float* __restrict__ ewgt, unsigned* gcnt) {
    LAS unsigned char* HH = c.lds; LAS unsigned char* HL = c.lds + 65536;
    LAS float* LG = (LAS float*)(c.lds0 + EXTRA_OFF);
    LAS float* PART = LG + 1024;
    LAS int* HIST = (LAS int*)(PART + 1024);
    LAS int* BASE = HIST + 32; LAS int* SELE = BASE + 32; LAS int* SELR = SELE + 128; LAS float* SELW = (LAS float*)(SELR + 128);
    const int lane = c.lane, w = c.wave, fr = lane & 15, fq = lane >> 4;
    for (int blk = c.bid; blk < NTOK / 32; blk += c.nb) {
        if (c.tid < 32) HIST[c.tid] = 0;
#pragma unroll 1
        for (int p = 0; p < 2; ++p) {
            const int tl = w * 4 + 2 * p; const size_t t0 = (size_t)blk * 32 + tl;
            float4 xa[4], xb[4]; float sa = 0.f, sb = 0.f;
#pragma unroll
            for (int j = 0; j < 4; ++j) { xa[j] = ((const float4*)(X1 + t0 * D))[lane + 64 * j]; xb[j] = ((const float4*)(X1 + (t0 + 1) * D))[lane + 64 * j];
                sa += xa[j].x * xa[j].x + xa[j].y * xa[j].y + xa[j].z * xa[j].z + xa[j].w * xa[j].w; sb += xb[j].x * xb[j].x + xb[j].y * xb[j].y + xb[j].z * xb[j].z + xb[j].w * xb[j].w; }
            const float ra = rsqrtf(wave_sum(sa) * (1.f / D) + RMS_EPS), rb = rsqrtf(wave_sum(sb) * (1.f / D) + RMS_EPS);
#pragma unroll
            for (int j = 0; j < 4; ++j) { const float4 g = ((const float4*)g2)[lane + 64 * j];
                const float ha[4] = {xa[j].x * ra * g.x, xa[j].y * ra * g.y, xa[j].z * ra * g.z, xa[j].w * ra * g.w}, hb[4] = {xb[j].x * rb * g.x, xb[j].y * rb * g.y, xb[j].z * rb * g.z, xb[j].w * rb * g.w};
                v2u ah, al, bh, bl;
                ah.x = cvt_pk_bf16(ha[0], ha[1]); ah.y = cvt_pk_bf16(ha[2], ha[3]); bh.x = cvt_pk_bf16(hb[0], hb[1]); bh.y = cvt_pk_bf16(hb[2], hb[3]);
                al.x = cvt_pk_bf16(ha[0] - bf_lo(ah.x), ha[1] - bf_hi(ah.x)); al.y = cvt_pk_bf16(ha[2] - bf_lo(ah.y), ha[3] - bf_hi(ah.y));
                bl.x = cvt_pk_bf16(hb[0] - bf_lo(bh.x), hb[1] - bf_hi(bh.x)); bl.y = cvt_pk_bf16(hb[2] - bf_lo(bh.y), hb[3] - bf_hi(bh.y));
                ((v2u*)(H2 + t0 * D))[lane + 64 * j] = ah; ((v2u*)(H2 + (t0 + 1) * D))[lane + 64 * j] = bh;
                const int ch = (lane >> 1) + 32 * j, h8 = 8 * (lane & 1);
                const int oa = tl * 2048 + 16 * (ch ^ (tl & 15)) + h8, ob = (tl + 1) * 2048 + 16 * (ch ^ ((tl + 1) & 15)) + h8;
                *(LAS v2u*)(HH + oa) = ah; *(LAS v2u*)(HL + oa) = al; *(LAS v2u*)(HH + ob) = bh; *(LAS v2u*)(HL + ob) = bl; }
        }
        lds_barrier();
        { const int mt = w & 1, nt = (w >> 1) & 1, kh = w >> 2, tok = 16 * mt + fr; f32x4 acc = {0.f, 0.f, 0.f, 0.f};
            const bf16* wh = WrT + (size_t)(16 * nt + fr) * D + 8 * fq; const bf16* wl = wh + NE * D;
#pragma unroll 4
            for (int kk = 16 * kh; kk < 16 * kh + 16; ++kk) { const int off = tok * 2048 + 16 * ((4 * kk + fq) ^ (tok & 15));
                const bf16x8 ahi = *(const LAS bf16x8*)(HH + off), alo = *(const LAS bf16x8*)(HL + off);
                const bf16x8 bhi = as_frag(*(const v4u*)(wh + 32 * kk)), blo = as_frag(*(const v4u*)(wl + 32 * kk));
                acc = MFMA16(ahi, bhi, acc); acc = MFMA16(ahi, blo, acc); acc = MFMA16(alo, bhi, acc); }
            if (kh == 1) *(LAS f32x4*)(PART + ((mt * 2 + nt) * 64 + lane) * 4) = acc;
            lds_barrier();
            if (kh == 0) { const f32x4 pr = *(const LAS f32x4*)(PART + ((mt * 2 + nt) * 64 + lane) * 4); const float bb = br[16 * nt + fr];
#pragma unroll
                for (int r = 0; r < 4; ++r) LG[(16 * mt + 4 * fq + r) * 32 + 16 * nt + fr] = acc[r] + pr[r] + bb; } }
        lds_barrier();
        if (c.tid < 32) {
            const int tokl = c.tid;
            float l[NE];
#pragma unroll
            for (int j = 0; j < NE; ++j) l[j] = LG[tokl * 32 + j];
            int sel[4]; float sv[4];
#pragma unroll
            for (int k = 0; k < 4; ++k) { int bi = 0; float bv = -INFINITY;
#pragma unroll
                for (int j = 0; j < NE; ++j) { const bool better = l[j] > bv; bv = better ? l[j] : bv; bi = better ? j : bi; }
                sel[k] = bi; sv[k] = bv;
#pragma unroll
                for (int j = 0; j < NE; ++j) l[j] = (j == bi) ? -INFINITY : l[j]; }
            float den = 0.f, ex[4];
#pragma unroll
            for (int k = 0; k < 4; ++k) { ex[k] = expf(sv[k] - sv[0]); den += ex[k]; }
            const float inv = 1.f / den;
#pragma unroll
            for (int k = 0; k < 4; ++k) { SELE[tokl * 4 + k] = sel[k]; SELW[tokl * 4 + k] = ex[k] * inv; SELR[tokl * 4 + k] = atomicAdd((int*)(HIST + sel[k]), 1); }
        }
        lds_barrier();
        if (c.tid < 32) BASE[c.tid] = (int)__hip_atomic_fetch_add(gcnt + c.tid, (unsigned)HIST[c.tid], __ATOMIC_RELAXED, __HIP_MEMORY_SCOPE_AGENT);
        lds_barrier();
        if (c.tid < 128) { const int gi = blk * 128 + c.tid, e = SELE[c.tid], pos = BASE[e] + SELR[c.tid]; slot_e[gi] = e; slot_pos[gi] = pos; elist[e * NTOK + pos] = gi >> 2; ewgt[e * NTOK + pos] = SELW[c.tid]; }
        lds_barrier();
    }
}

struct MoeOrder {
    int nM, nN, nwg, G, c, wgm; const LAS unsigned char* tile_e; const LAS int* tile_b;
    __device__ __forceinline__ void init(int nM_, int nN_, int G_, int c_, const LAS unsigned char* te, const LAS int* tb, int wgm_ = pg8::WGM) { nM = nM_; nN = nN_; nwg = nM * nN; G = G_; c = c_; tile_e = te; tile_b = tb; wgm = wgm_; }
    __device__ __forceinline__ bool next(int i, pg8::Unit& u) const {
        const long L = (long)i * G + c; if (L >= nwg) return false;
        int wgid = (int)L; { const int q = nwg / pg8::NXCD, r = nwg % pg8::NXCD, xcd = wgid % pg8::NXCD, off = wgid / pg8::NXCD; wgid = (xcd < r ? xcd * (q + 1) : r * (q + 1) + (xcd - r) * q) + off; }
        const int nig = wgm * nN, gid = wgid / nig, fm = gid * wgm, gsz = (nM - fm) < wgm ? (nM - fm) : wgm;
        const int pm = fm + ((wgid % nig) % gsz), pnl = (wgid % nig) / gsz;
        const int e = __builtin_amdgcn_readfirstlane((int)tile_e[pm]);
        u.pm = pm; u.pn = e * nN + pnl; u.x0 = e; u.x1 = pnl; u.rb = e * NTOK + (pm - __builtin_amdgcn_readfirstlane(tile_b[e])) * 256; return true;
    }
    __device__ __forceinline__ void a_ready(const pg8::Unit&) const {}
    __device__ __forceinline__ void done(const pg8::Unit&) const {}
};
__device__ __forceinline__ void build_tile_table(const Ctx& c, const unsigned* gcnt, LAS unsigned char* tile_e, LAS int* ntiles, LAS int* tile_b) {
    if (c.tid == 0) { int tb = 0; for (int e = 0; e < NE; ++e) { const int nt = ((int)gcnt[e] + 255) >> 8; tile_b[e] = tb; for (int i = 0; i < nt; ++i) tile_e[tb + i] = (unsigned char)e; tb += nt; } tile_b[NE] = tb; ntiles[0] = tb; }
    lds_barrier();
}

struct EpiSwiglu {
    static constexpr bool PERM = true, AFTER_DRAIN = false;
    bf16* O; const float* bias;
    __device__ __forceinline__ bool keep_acc(const pg8::Unit&) const { return false; }
    __device__ __forceinline__ void operator()(const f32x4 (&acc)[2][2][4][2], const pg8::Unit& u, int wr, int wc, int fr, int fq) const {
        const int row0 = u.pm * 256 + wr * 64 + fr, col0 = u.x1 * 128 + wc * 32 + 8 * fq;
        const float* bg = bias + (size_t)u.x0 * 2 * DFF + col0; const float* bl = bg + DFF;
        f32x4 bgv[2], blv[2];
#pragma unroll
        for (int n = 0; n < 2; ++n) { bgv[n] = *(const f32x4*)(bg + 4 * n); blv[n] = *(const f32x4*)(bl + 4 * n); }
#pragma unroll
        for (int ai = 0; ai < 2; ++ai)
#pragma unroll
            for (int m = 0; m < 4; ++m) { bf16* rowp = O + (size_t)(row0 + ai * 128 + m * 16) * DFF + col0; float a[8];
#pragma unroll
                for (int n = 0; n < 2; ++n) { const f32x4 g = acc[ai][0][m][n] + bgv[n], l = acc[ai][1][m][n] + blv[n];
#pragma unroll
                    for (int i = 0; i < 4; ++i) { const float xg = fminf(g[i], 7.f), xl = fminf(fmaxf(l[i], -7.f), 7.f);
                        a[4 * n + i] = xg * __builtin_amdgcn_rcpf(1.f + __expf(-1.702f * xg)) * (xl + 1.f); } }
                v4u w; w.x = cvt_pk_bf16(a[0], a[1]); w.y = cvt_pk_bf16(a[2], a[3]); w.z = cvt_pk_bf16(a[4], a[5]); w.w = cvt_pk_bf16(a[6], a[7]);
                *(v4u*)rowp = w; }
    }
};
struct EpiDown {
    static constexpr bool PERM = true, AFTER_DRAIN = false;
    bf16* O; const float* bias; const float* roww;
    __device__ __forceinline__ bool keep_acc(const pg8::Unit&) const { return false; }
    __device__ __forceinline__ void operator()(const f32x4 (&acc)[2][2][4][2], const pg8::Unit& u, int wr, int wc, int fr, int fq) const {
        const int row0 = u.pm * 256 + wr * 64 + fr, col0 = u.x1 * 256 + wc * 32 + 8 * fq;
        const float* bp = bias + (size_t)u.x0 * D + col0;
        f32x4 bv[2][2];
#pragma unroll
        for (int bj = 0; bj < 2; ++bj)
#pragma unroll
            for (int n = 0; n < 2; ++n) bv[bj][n] = *(const f32x4*)(bp + bj * 128 + 4 * n);
#pragma unroll
        for (int ai = 0; ai < 2; ++ai)
#pragma unroll
            for (int m = 0; m < 4; ++m) { const int rl = wr * 64 + fr + ai * 128 + m * 16, row = u.pm * 256 + rl; const float w = roww[u.rb + rl]; bf16* rowp = O + (size_t)row * D + col0;
#pragma unroll
                for (int bj = 0; bj < 2; ++bj) { const f32x4 v0 = (acc[ai][bj][m][0] + bv[bj][0]) * w, v1 = (acc[ai][bj][m][1] + bv[bj][1]) * w;
                    v4u o; o.x = cvt_pk_bf16(v0[0], v0[1]); o.y = cvt_pk_bf16(v0[2], v0[3]); o.z = cvt_pk_bf16(v1[0], v1[1]); o.w = cvt_pk_bf16(v1[2], v1[3]);
                    *(v4u*)(rowp + bj * 128) = o; } }
    }
};

__device__ __forceinline__ void p_final(const Ctx& c, const float* __restrict__ X1, const bf16* __restrict__ Yb, const int* __restrict__ slot_e, const int* __restrict__ slot_pos, const unsigned* gcnt, const float* __restrict__ g, float* __restrict__ out, float pscale = 1.f) {
    LAS int* POFF = (LAS int*)(c.lds0 + EXTRA_OFF);
    if (c.tid == 0) { int s = 0; for (int e = 0; e < NE; ++e) { POFF[e] = s; s += (((int)gcnt[e] + 255) >> 8) << 8; } }
    lds_barrier();
#pragma unroll 2
    for (int t = c.bid * NWAVES + c.wave; t < NTOK; t += c.nb * NWAVES) {
        const int lane = c.lane; float4 v[4];
#pragma unroll
        for (int j = 0; j < 4; ++j) { const v4u xr = ldnt4((const v4u*)(X1 + (size_t)t * D) + lane + 64 * j); v[j] = make_float4(__uint_as_float(xr.x), __uint_as_float(xr.y), __uint_as_float(xr.z), __uint_as_float(xr.w)); }
#pragma unroll
        for (int k = 0; k < 4; ++k) { const int dst = POFF[slot_e[t * 4 + k]] + slot_pos[t * 4 + k];
#pragma unroll
            for (int j = 0; j < 4; ++j) { const v2u y = ldnt2((const v2u*)(Yb + (size_t)dst * D) + lane + 64 * j); v[j].x += bf_lo(y.x); v[j].y += bf_hi(y.x); v[j].z += bf_lo(y.y); v[j].w += bf_hi(y.y); } }
        float s = 0.f;
#pragma unroll
        for (int j = 0; j < 4; ++j) s += v[j].x * v[j].x + v[j].y * v[j].y + v[j].z * v[j].z + v[j].w * v[j].w;
        const float r = rsqrtf(wave_sum(s) * (1.f / D) + RMS_EPS) * pscale;
#pragma unroll
        for (int j = 0; j < 4; ++j) { const float4 gg = ((const float4*)g)[lane + 64 * j]; const f32x4 ov = {v[j].x * r * gg.x, v[j].y * r * gg.y, v[j].z * r * gg.z, v[j].w * r * gg.w}; __builtin_nontemporal_store(ov, (f32x4*)(out + (size_t)t * D) + lane + 64 * j); }
    }
}

constexpr int PJ = 5120;
typedef float f32x2 __attribute__((ext_vector_type(2)));
__device__ __forceinline__ f32x2 gelu_pk(f32x2 v) {
    const f32x2 av = __builtin_elementwise_abs(v), d = av * 0.2316418882f + 1.0f;
    f32x2 t; t.x = __builtin_amdgcn_rcpf(d.x); t.y = __builtin_amdgcn_rcpf(d.y);
    f32x2 q = t * 0.5307027145f + (-0.7265760135f); q = q * t + 0.7107068705f; q = q * t + (-0.142248368f); q = q * t + 0.127414796f; q = q * t;
    const f32x2 s = (v * v) * (-0.72134752044f);
    f32x2 e; e.x = __builtin_amdgcn_exp2f(s.x); e.y = __builtin_amdgcn_exp2f(s.y);
    const f32x2 m = v * (q * e), r = v - m;
    f32x2 o; o.x = v.x < 0.f ? m.x : r.x; o.y = v.y < 0.f ? m.y : r.y; return o;
}
__device__ __forceinline__ float fast_sigmoid(float x) { return __builtin_amdgcn_rcpf(1.f + __expf(-x)); }

__device__ __forceinline__ void p_convert_front(const Ctx& c, const float* w_in, const float* w_o_dn, const float* w_o_sg, const float* w_out, bf16* Win_t, bf16* Wo_t, bf16* Wout_t) {
    LAS float* scr = (LAS float*)c.lds + c.wave * (64 * 65);
    constexpr int I_IN = 16 * 80, I_O = 8 * 16, I_OUT = 16 * 16;
    for (int it = c.bid * NWAVES + c.wave; it < I_IN + 2 * I_O + I_OUT; it += c.nb * NWAVES) {
        int r = it;
        if (r < I_IN) { const int kb = r / 80, nbk = r % 80, n0 = nbk * 64; tr_item<true>(w_in, INC, kb * 64, n0 < 2048 ? n0 : n0 + 8, Win_t, D, n0, scr, c.lane); continue; } r -= I_IN;
        if (r < I_O) { const int kb = r / 16, nbk = r % 16; tr_item<true>(w_o_dn, D, kb * 64, nbk * 64, Wo_t, DNW, nbk * 64, scr, c.lane); continue; } r -= I_O;
        if (r < I_O) { const int kb = r / 16, nbk = r % 16; tr_item<true>(w_o_sg, D, kb * 64, nbk * 64, Wo_t + (size_t)D * DNW, SGW, nbk * 64, scr, c.lane); continue; } r -= I_O;
        { const int kb = r / 16, nbk = r % 16; tr_item<true>(w_out, D, kb * 64, nbk * 64, Wout_t, D, nbk * 64, scr, c.lane); }
    }
}
__device__ __forceinline__ void p_norm1(const Ctx& c, const float* __restrict__ x, const float* __restrict__ g1, const float* __restrict__ w_in, const float* __restrict__ a_log, const float* __restrict__ dt_bias, bf16* __restrict__ Hb, float* __restrict__ BG) {
    LAS f32x4* WB = (LAS f32x4*)c.lds;
    const int lane = c.lane;
    for (int idx = c.tid; idx < 2048; idx += NTHR) { const int k = idx >> 1, q = idx & 1; const f32x4 v = *(const f32x4*)(w_in + (size_t)k * INC + 2048 + 4 * q);
        const int l = (k & 255) >> 2, cc = k & 3, j = k >> 8; WB[((j * 4 + cc) * 2 + q) * 64 + l] = v; }
    lds_barrier();
#pragma unroll 2
    for (int t = c.bid * NWAVES + c.wave; t < NTOK; t += c.nb * NWAVES) {
        float4 xv[4]; float ss = 0.f;
#pragma unroll
        for (int j = 0; j < 4; ++j) { xv[j] = ((const float4*)(x + (size_t)t * D))[lane + 64 * j]; ss += xv[j].x * xv[j].x + xv[j].y * xv[j].y + xv[j].z * xv[j].z + xv[j].w * xv[j].w; }
        const float r = rsqrtf(wave_sum(ss) * (1.f / D) + RMS_EPS);
#pragma unroll
        for (int j = 0; j < 4; ++j) { const float4 g = ((const float4*)g1)[lane + 64 * j]; xv[j].x *= r * g.x; xv[j].y *= r * g.y; xv[j].z *= r * g.z; xv[j].w *= r * g.w;
            v2u o; o.x = cvt_pk_bf16(xv[j].x, xv[j].y); o.y = cvt_pk_bf16(xv[j].z, xv[j].w); ((v2u*)(Hb + (size_t)t * D))[lane + 64 * j] = o; }
        float acc[8];
#pragma unroll
        for (int i = 0; i < 8; ++i) acc[i] = 0.f;
#pragma unroll
        for (int j = 0; j < 4; ++j)
#pragma unroll
            for (int cc = 0; cc < 4; ++cc) { const float h = f4c(xv[j], cc);
#pragma unroll
                for (int q = 0; q < 2; ++q) { const f32x4 w = WB[((j * 4 + cc) * 2 + q) * 64 + lane];
                    acc[4 * q + 0] = fmaf(h, w.x, acc[4 * q + 0]); acc[4 * q + 1] = fmaf(h, w.y, acc[4 * q + 1]); acc[4 * q + 2] = fmaf(h, w.z, acc[4 * q + 2]); acc[4 * q + 3] = fmaf(h, w.w, acc[4 * q + 3]); } }
        BFLY_SW32(acc, 8) BFLY_SW16(acc, 4) BFLY_DPP(acc, 2, 8, dpp_ror8)
        float a0 = acc[0]; a0 += dpp_xor4(a0); a0 += dpp_xor2(a0); a0 += dpp_xor1(a0);
        const int idx = lane >> 3;
        if ((lane & 7) == 0) { float o;
            if (idx < 4) o = 1.f / (1.f + expf(-a0)); else { const int h = idx - 4; o = -expf(a_log[h]) * softplusf_(a0 + dt_bias[h]); }
            BG[(size_t)t * 8 + idx] = o; }
    }
}
struct EpiProj {
    static constexpr bool PERM = true, AFTER_DRAIN = false;
    bf16* O;
    __device__ __forceinline__ bool keep_acc(const pg8::Unit&) const { return false; }
    __device__ __forceinline__ void operator()(const f32x4 (&acc)[2][2][4][2], const pg8::Unit& u, int wr, int wc, int fr, int fq) const {
        const int row0 = u.pm * 256 + wr * 64 + fr, col0 = u.pn * 256 + wc * 32 + 8 * fq;
        const int act = (u.pn < 6) ? 0 : (u.pn < 8 ? 1 : (u.pn < 12 ? 2 : 0));
#pragma unroll
        for (int ai = 0; ai < 2; ++ai)
#pragma unroll
            for (int m = 0; m < 4; ++m) { bf16* rowp = O + (size_t)(row0 + ai * 128 + m * 16) * PJ + col0;
#pragma unroll
                for (int bj = 0; bj < 2; ++bj) { f32x4 v0 = acc[ai][bj][m][0], v1 = acc[ai][bj][m][1];
                    if (act == 1) {
#pragma unroll
                        for (int i = 0; i < 4; ++i) { v0[i] = v0[i] * fast_sigmoid(v0[i]); v1[i] = v1[i] * fast_sigmoid(v1[i]); } }
                    else if (act == 2) { const f32x2 a = gelu_pk((f32x2){v0[0], v0[1]}), b = gelu_pk((f32x2){v0[2], v0[3]}), cc = gelu_pk((f32x2){v1[0], v1[1]}), d = gelu_pk((f32x2){v1[2], v1[3]});
                        v0 = (f32x4){a.x, a.y, b.x, b.y}; v1 = (f32x4){cc.x, cc.y, d.x, d.y}; }
                    v4u w; w.x = cvt_pk_bf16(v0[0], v0[1]); w.y = cvt_pk_bf16(v0[2], v0[3]); w.z = cvt_pk_bf16(v1[0], v1[1]); w.w = cvt_pk_bf16(v1[2], v1[3]);
                    *(v4u*)(rowp + bj * 128) = w; } }
    }
};
struct DualOrder {
    pg8::StaticOrder S0;
    __device__ __forceinline__ void init(int G, int c) { S0.init(NTOK, D, G, c); }
    __device__ __forceinline__ bool next(int i, pg8::Unit& u) const { pg8::Unit t; if (!S0.next(i >> 1, t)) return false; const int which = i & 1; u.pm = t.pm + 64 * which; u.pn = t.pn + 4 * which; u.x0 = which; u.x1 = t.pn; u.rb = 0; return true; }
    __device__ __forceinline__ void a_ready(const pg8::Unit&) const {}
    __device__ __forceinline__ void done(const pg8::Unit&) const {}
};
struct EpiMerge {
    static constexpr bool PERM = true, AFTER_DRAIN = false;
    const bf16* P; bf16* O;
    __device__ __forceinline__ bool keep_acc(const pg8::Unit& u) const { return u.x0 == 0; }
    __device__ __forceinline__ void operator()(f32x4 (&acc)[2][2][4][2], const pg8::Unit& u, int wr, int wc, int fr, int fq) const {
        const int row0 = (u.pm & 63) * 256 + wr * 64 + fr, col0 = u.x1 * 256 + wc * 32 + 8 * fq; const bool first = (u.x0 == 0);
#pragma unroll
        for (int ai = 0; ai < 2; ++ai)
#pragma unroll
            for (int m = 0; m < 4; ++m) { const int row = row0 + ai * 128 + m * 16; const bf16* pr = P + (size_t)row * PJ + col0;
#pragma unroll
                for (int bj = 0; bj < 2; ++bj) { const v4u xb = *(const v4u*)(pr + 4096 + bj * 128); float fb[8];
                    fb[0] = bf_lo(xb.x); fb[1] = bf_hi(xb.x); fb[2] = bf_lo(xb.y); fb[3] = bf_hi(xb.y); fb[4] = bf_lo(xb.z); fb[5] = bf_hi(xb.z); fb[6] = bf_lo(xb.w); fb[7] = bf_hi(xb.w);
#pragma unroll
                    for (int i = 0; i < 8; ++i) fb[i] = 1.f + __expf(-fmaxf(fb[i], -30.f));
                    if (first) { const v4u xa = *(const v4u*)(pr + 3072 + bj * 128); float fa[8];
                        fa[0] = bf_lo(xa.x); fa[1] = bf_hi(xa.x); fa[2] = bf_lo(xa.y); fa[3] = bf_hi(xa.y); fa[4] = bf_lo(xa.z); fa[5] = bf_hi(xa.z); fa[6] = bf_lo(xa.w); fa[7] = bf_hi(xa.w);
#pragma unroll
                        for (int i = 0; i < 4; ++i) { acc[ai][bj][m][0][i] *= fb[i] * fast_sigmoid(fa[i]); acc[ai][bj][m][1][i] *= fb[4 + i] * fast_sigmoid(fa[4 + i]); } }
                    else { f32x4 v0, v1;
#pragma unroll
                        for (int i = 0; i < 4; ++i) { v0[i] = acc[ai][bj][m][0][i] * __builtin_amdgcn_rcpf(fb[i]); v1[i] = acc[ai][bj][m][1][i] * __builtin_amdgcn_rcpf(fb[4 + i]); }
                        v4u w; w.x = cvt_pk_bf16(v0[0], v0[1]); w.y = cvt_pk_bf16(v0[2], v0[3]); w.z = cvt_pk_bf16(v1[0], v1[1]); w.w = cvt_pk_bf16(v1[2], v1[3]);
                        *(v4u*)(O + (size_t)row * D + col0 + bj * 128) = w; } } }
    }
};
struct EpiResid {
    static constexpr bool PERM = false, AFTER_DRAIN = false;
    const float* X; float* O;
    __device__ __forceinline__ bool keep_acc(const pg8::Unit&) const { return false; }
    __device__ __forceinline__ void operator()(const f32x4 (&acc)[2][2][4][2], const pg8::Unit& u, int wr, int wc, int fr, int fq) const {
        const int row0 = u.pm * 256 + wr * 64 + fr, col0 = u.pn * 256 + wc * 32 + 4 * fq;
#pragma unroll
        for (int ai = 0; ai < 2; ++ai)
#pragma unroll
            for (int m = 0; m < 4; ++m) { const size_t off = (size_t)(row0 + ai * 128 + m * 16) * D + col0;
#pragma unroll
                for (int bj = 0; bj < 2; ++bj)
#pragma unroll
                    for (int n = 0; n < 2; ++n) *(f32x4*)(O + off + bj * 128 + n * 16) = *(const f32x4*)(X + off + bj * 128 + n * 16) + acc[ai][bj][m][n]; }
    }
};
__device__ __forceinline__ float ldbf(const bf16* p) { return __uint_as_float((unsigned)(*p) << 16); }
__device__ __forceinline__ unsigned short f2bf1(float f) { return (unsigned short)(cvt_pk_bf16(f, 0.f) & 0xffffu); }
__device__ __forceinline__ void unpack8(const v4u& x, float (&f)[8]) { f[0] = bf_lo(x.x); f[1] = bf_hi(x.x); f[2] = bf_lo(x.y); f[3] = bf_hi(x.y); f[4] = bf_lo(x.z); f[5] = bf_hi(x.z); f[6] = bf_lo(x.w); f[7] = bf_hi(x.w); }

constexpr size_t DN_WN = 16384, DN_QD = 16384, DN_KD = 16384, DN_QK = 8192, DN_U = 16384, DN_SST = 32768;
struct DnBufs { unsigned char *WN, *QD, *KD, *QK, *U, *SST; float* EG; };
constexpr int PL_QH = 0, PL_KH = 17408, PL_XVT = 34816, PL_XWT = 53248, PL_KDT = 71680, PL_AL = 90112, PL_TL = 106496, PL_GAM = 115712;
constexpr int RS = 136  , TS = 72  ;

__device__ __forceinline__ void p_dn_prep(const Ctx& c, const bf16* PROJ, const float* cw, const float* BG, const DnBufs& B) {
    LAS unsigned char* L = c.lds;
    LAS unsigned short* QH = (LAS unsigned short*)(L + PL_QH); LAS unsigned short* KH = (LAS unsigned short*)(L + PL_KH);
    LAS unsigned short* XVT = (LAS unsigned short*)(L + PL_XVT); LAS unsigned short* XWT = (LAS unsigned short*)(L + PL_XWT); LAS unsigned short* KDT = (LAS unsigned short*)(L + PL_KDT);
    LAS float* AL = (LAS float*)(L + PL_AL); LAS unsigned short* TL = (LAS unsigned short*)(L + PL_TL);
    LAS float* GAM = (LAS float*)(L + PL_GAM); LAS float* BETA = GAM + 64; LAS float* EGAM = GAM + 128; LAS float* KSC = GAM + 192;
    const int w = c.wave;
    LAS float* CWL = (LAS float*)(L + PL_GAM + 1024);
    constexpr int NITEMS = BATCH * DNH * (SEQ / 64);
    v4u xr[2][7];
#define DN_LOAD_ROWS(itx) do { const int bh_ = (itx) >> 7, ch_ = (itx) & 127, b_ = bh_ >> 2, h_ = bh_ & 3; int tid_ = c.tid; asm volatile("" : "+v"(tid_));     \
        _Pragma("unroll") for (int u_ = 0; u_ < 2; ++u_) { const int idx_ = tid_ + NTHR * u_; if (idx_ < 768) { const int tq_ = idx_ / 48, cg_ = idx_ % 48, col_ = (cg_ >> 4) * 512 + h_ * 128 + (cg_ & 15) * 8; \
            _Pragma("unroll") for (int r_ = 0; r_ < 7; ++r_) { const int tt_ = ch_ * 64 + 4 * tq_ - 3 + r_; \
                xr[u_][r_] = (tt_ >= 0) ? *(const v4u*)(PROJ + ((size_t)b_ * SEQ + tt_) * PJ + col_) : (v4u){0u, 0u, 0u, 0u}; } } } } while (0)
    float gpre = 0.f, bpre = 0.f, cwpre[4] = {0.f, 0.f, 0.f, 0.f};
#define DN_LOAD_SMALL(itx) do { const int bh_ = (itx) >> 7, ch_ = (itx) & 127, b_ = bh_ >> 2, h_ = bh_ & 3; const size_t r0_ = (size_t)b_ * SEQ + ch_ * 64; \
        if (w == 0) { gpre = BG[(r0_ + (c.tid & 63)) * 8 + 4 + h_]; bpre = BG[(r0_ + (c.tid & 63)) * 8 + h_]; } \
        if (c.tid < 384) { _Pragma("unroll") for (int kk_ = 0; kk_ < 4; ++kk_) cwpre[kk_] = cw[kk_ * 1536 + (c.tid >> 7) * 512 + h_ * 128 + (c.tid & 127)]; } } while (0)
    if (c.bid < NITEMS) { DN_LOAD_ROWS(c.bid); DN_LOAD_SMALL(c.bid); }
    for (int it = c.bid; it < NITEMS; it += c.nb) {
        int tl_ = c.tid; asm volatile("" : "+v"(tl_));
        const int lane = tl_ & 63, fr = lane & 15, fq = lane >> 4;
        const int bh = it >> 7, ch = it & 127, b = bh >> 2, h = bh & 3; const size_t row0 = (size_t)b * SEQ + ch * 64;
        if (c.tid < 384) {
#pragma unroll
            for (int kk = 0; kk < 4; ++kk) CWL[kk * 384 + c.tid] = cwpre[kk]; }
        if (w == 0) { const float gt = gpre, bt = bpre; float gam = gt;
#pragma unroll
            for (int o = 1; o < 64; o <<= 1) { const float t = __shfl_up(gam, o); if (lane >= o) gam += t; }
            const float gl = __shfl(gam, 63);
            GAM[lane] = gam; BETA[lane] = bt; EGAM[lane] = expf(gam); KSC[lane] = expf(gl - gam);
            if (lane == 0) B.EG[it] = expf(gl); }
        for (int i = c.tid; i < 1024; i += NTHR) ((LAS f32x4*)AL)[i] = (f32x4){0.f, 0.f, 0.f, 0.f};
        lds_barrier();
        int tidb = c.tid; asm volatile("" : "+v"(tidb));
#pragma unroll
        for (int u = 0; u < 2; ++u) { const int idx = tidb + NTHR * u; if (idx < 768) {
            const int tq = idx / 48, cg = idx % 48, part = cg >> 4, c8 = (cg & 15) * 8;
            f32x4 wt[4][2];
#pragma unroll
            for (int kk = 0; kk < 4; ++kk) { wt[kk][0] = *(const LAS f32x4*)(CWL + kk * 384 + part * 128 + c8); wt[kk][1] = *(const LAS f32x4*)(CWL + kk * 384 + part * 128 + c8 + 4); }
            float av[4][8];
            float s1v[4], s2v[4];
#pragma unroll
            for (int q = 0; q < 4; ++q) { const int t = 4 * tq + q;
                float a[8];
#pragma unroll
                for (int e = 0; e < 8; ++e) a[e] = 0.f;
#pragma unroll
                for (int kk = 0; kk < 4; ++kk) { float xf[8]; unpack8(xr[u][q + kk], xf);
#pragma unroll
                    for (int e = 0; e < 4; ++e) { a[e] = fmaf(wt[kk][0][e], xf[e], a[e]); a[4 + e] = fmaf(wt[kk][1][e], xf[4 + e], a[4 + e]); } }
                float ss = 0.f;
#pragma unroll
                for (int e = 0; e < 8; ++e) { a[e] = a[e] / (1.f + __expf(-a[e])); ss = fmaf(a[e], a[e], ss); }
                ss = row16_sum(ss);
                const float rs = rsqrtf(ss + L2_EPS);
                if (part == 0) { const float sc = rs * 0.08838834764831845f; v4u o; o.x = cvt_pk_bf16(a[0] * sc, a[1] * sc); o.y = cvt_pk_bf16(a[2] * sc, a[3] * sc); o.z = cvt_pk_bf16(a[4] * sc, a[5] * sc); o.w = cvt_pk_bf16(a[6] * sc, a[7] * sc);
                    *(LAS v4u*)(QH + t * RS + c8) = o; }
                else if (part == 1) { v4u o; o.x = cvt_pk_bf16(a[0] * rs, a[1] * rs); o.y = cvt_pk_bf16(a[2] * rs, a[3] * rs); o.z = cvt_pk_bf16(a[4] * rs, a[5] * rs); o.w = cvt_pk_bf16(a[6] * rs, a[7] * rs);
                    *(LAS v4u*)(KH + t * RS + c8) = o; s1v[q] = rs * BETA[t] * EGAM[t]; s2v[q] = rs * KSC[t]; }
                else { s1v[q] = BETA[t]; s2v[q] = 0.f; }
#pragma unroll
                for (int e = 0; e < 8; ++e) av[q][e] = a[e];
            }
            if (part == 1) {
#pragma unroll
                for (int e = 0; e < 8; ++e) { v2u o1, o2; o1.x = cvt_pk_bf16(av[0][e] * s1v[0], av[1][e] * s1v[1]); o1.y = cvt_pk_bf16(av[2][e] * s1v[2], av[3][e] * s1v[3]);
                    o2.x = cvt_pk_bf16(av[0][e] * s2v[0], av[1][e] * s2v[1]); o2.y = cvt_pk_bf16(av[2][e] * s2v[2], av[3][e] * s2v[3]);
                    *(LAS v2u*)(XWT + (c8 + e) * TS + 4 * tq) = o1; *(LAS v2u*)(KDT + (c8 + e) * TS + 4 * tq) = o2; } }
            else if (part == 2) {
#pragma unroll
                for (int e = 0; e < 8; ++e) { v2u o1; o1.x = cvt_pk_bf16(av[0][e] * s1v[0], av[1][e] * s1v[1]); o1.y = cvt_pk_bf16(av[2][e] * s1v[2], av[3][e] * s1v[3]);
                    *(LAS v2u*)(XVT + (c8 + e) * TS + 4 * tq) = o1; } }
            } }
        lds_barrier();
        if (it + c.nb < NITEMS) { DN_LOAD_ROWS(it + c.nb); DN_LOAD_SMALL(it + c.nb); }
        { const int rt = w & 3, ksq = w >> 2; v2u half[2];
#pragma unroll
            for (int sub = 0; sub < 2; ++sub) { const int st = 2 * ksq + sub; f32x4 acc = {0.f, 0.f, 0.f, 0.f};
#pragma unroll
                for (int kk = 0; kk < 4; ++kk) { const bf16x8 a = *(const LAS bf16x8*)(KH + (16 * st + fr) * RS + 32 * kk + 8 * fq), bq = *(const LAS bf16x8*)(QH + (16 * rt + fr) * RS + 32 * kk + 8 * fq); acc = MFMA16(a, bq, acc); }
                const int rr = 16 * rt + fr; const float gr = GAM[rr]; float v[4];
#pragma unroll
                for (int r = 0; r < 4; ++r) { const int s2 = 16 * st + 4 * fq + r; v[r] = (s2 <= rr) ? acc[r] * __expf(fminf(gr - GAM[s2], 0.f)) : 0.f; }
                half[sub].x = cvt_pk_bf16(v[0], v[1]); half[sub].y = cvt_pk_bf16(v[2], v[3]); }
            v4u o; o.x = half[0].x; o.y = half[0].y; o.z = half[1].x; o.w = half[1].y;
            *(v4u*)(B.QK + (size_t)it * DN_QK + ((rt * 2 + ksq) * 64 + lane) * 16) = o; }
#pragma unroll 1
        for (int n = w; n < 10; n += 8) { const int rt = (n >= 6) ? 3 : (n >= 3 ? 2 : (n >= 1 ? 1 : 0)), st = n - rt * (rt + 1) / 2; f32x4 acc = {0.f, 0.f, 0.f, 0.f};
#pragma unroll
            for (int kk = 0; kk < 4; ++kk) { const bf16x8 a = *(const LAS bf16x8*)(KH + (16 * rt + fr) * RS + 32 * kk + 8 * fq), bk = *(const LAS bf16x8*)(KH + (16 * st + fr) * RS + 32 * kk + 8 * fq); acc = MFMA16(a, bk, acc); }
            const int s2 = 16 * st + fr; const float gs = GAM[s2];
#pragma unroll
            for (int r = 0; r < 4; ++r) { const int rr = 16 * rt + 4 * fq + r; const float v = (s2 < rr) ? BETA[rr] * acc[r] * __expf(fminf(GAM[rr] - gs, 0.f)) : 0.f; AL[rr * 64 + (s2 & 7) * 8 + (s2 >> 3)] = v; } }
        lds_barrier();
        { const int j = w * 8 + (lane >> 3), p = lane & 7; float tc[8];
#pragma unroll
            for (int i = 0; i < 8; ++i) tc[i] = 0.f;
#pragma unroll
            for (int r = 0; r < 64; ++r) { float s0 = 0.f, s1 = 0.f;
                if (r > 0) { const LAS float* ar = AL + r * 64 + p * 8; const f32x4 a0 = *(const LAS f32x4*)ar; s0 = a0[0] * tc[0];
                    if (r > 8) s1 = a0[1] * tc[1];
                    if (r > 16) s0 = fmaf(a0[2], tc[2], s0);
                    if (r > 24) s1 = fmaf(a0[3], tc[3], s1);
                    if (r > 32) { const f32x4 a1 = *(const LAS f32x4*)(ar + 4); s0 = fmaf(a1[0], tc[4], s0);
                        if (r > 40) s1 = fmaf(a1[1], tc[5], s1);
                        if (r > 48) s0 = fmaf(a1[2], tc[6], s0);
                        if (r > 56) s1 = fmaf(a1[3], tc[7], s1); } }
                float tot = s0 + s1; tot += dpp_xor1(tot); tot += dpp_xor2(tot); tot += dpp_hmir(tot);
                const float tr = ((r == j) ? 1.f : 0.f) - tot;
                if (p == (r & 7)) tc[r >> 3] = tr; }
#pragma unroll
            for (int i = 0; i < 8; ++i) TL[(8 * i + p) * TS + j] = f2bf1(tc[i]); }
        lds_barrier();
        { const int sl = w;
#pragma unroll
            for (int mt = 0; mt < 4; ++mt) { f32x4 acc = {0.f, 0.f, 0.f, 0.f};
#pragma unroll
                for (int kk = 0; kk < 2; ++kk) if (kk == 0 || mt >= 2) { const bf16x8 a = *(const LAS bf16x8*)(TL + (16 * mt + fr) * TS + 32 * kk + 8 * fq), bv = *(const LAS bf16x8*)(XVT + (16 * sl + fr) * TS + 32 * kk + 8 * fq); acc = MFMA16(a, bv, acc); }
                v2u o; o.x = cvt_pk_bf16(acc[0], acc[1]); o.y = cvt_pk_bf16(acc[2], acc[3]);
                *(v2u*)(B.U + (size_t)it * DN_U + ((mt * 8 + sl) * 64 + lane) * 8) = o; }
            const int dt = w;
#pragma unroll
            for (int rt = 0; rt < 4; ++rt) { f32x4 acc = {0.f, 0.f, 0.f, 0.f};
#pragma unroll
                for (int kk = 0; kk < 2; ++kk) if (kk == 0 || rt >= 2) { const bf16x8 a = *(const LAS bf16x8*)(XWT + (16 * dt + fr) * TS + 32 * kk + 8 * fq), bt = *(const LAS bf16x8*)(TL + (16 * rt + fr) * TS + 32 * kk + 8 * fq); acc = MFMA16(a, bt, acc); }
                v2u o; o.x = cvt_pk_bf16(-acc[0], -acc[1]); o.y = cvt_pk_bf16(-acc[2], -acc[3]);
                *(v2u*)(B.WN + (size_t)it * DN_WN + ((rt * 4 + (dt >> 1)) * 64 + lane) * 16 + (dt & 1) * 8) = o; } }
        { const int mt = w & 3;
#pragma unroll
            for (int q2 = 0; q2 < 2; ++q2) { const int ks = 2 * (w >> 2) + q2, rr = 16 * mt + fr; const float sc = EGAM[rr];
                const v2u lo = *(const LAS v2u*)(QH + rr * RS + 32 * ks + 4 * fq), hi = *(const LAS v2u*)(QH + rr * RS + 32 * ks + 16 + 4 * fq);
                v4u o; o.x = cvt_pk_bf16(bf_lo(lo.x) * sc, bf_hi(lo.x) * sc); o.y = cvt_pk_bf16(bf_lo(lo.y) * sc, bf_hi(lo.y) * sc); o.z = cvt_pk_bf16(bf_lo(hi.x) * sc, bf_hi(hi.x) * sc); o.w = cvt_pk_bf16(bf_lo(hi.y) * sc, bf_hi(hi.y) * sc);
                *(v4u*)(B.QD + (size_t)it * DN_QD + ((mt * 4 + ks) * 64 + lane) * 16) = o; }
            const int dt = w;
#pragma unroll
            for (int ks = 0; ks < 2; ++ks) { const v2u lo = *(const LAS v2u*)(KDT + (16 * dt + fr) * TS + 32 * ks + 4 * fq), hi = *(const LAS v2u*)(KDT + (16 * dt + fr) * TS + 32 * ks + 16 + 4 * fq);
                v4u o; o.x = lo.x; o.y = lo.y; o.z = hi.x; o.w = hi.y;
                *(v4u*)(B.KD + (size_t)it * DN_KD + ((dt * 2 + ks) * 64 + lane) * 16) = o; } }
        lds_barrier();
    }
}

constexpr int SCAN_WGS = BATCH * DNH * 2;
__device__ __forceinline__ void u_load_asm(v2u& dst, const unsigned char* p) { asm volatile("global_load_dwordx2 %0, %1, off" : "=v"(dst) : "v"(p) : "memory"); }
template <int STG>
__device__ __forceinline__ void scan_step(const DnBufs& B, LAS unsigned char* L, int lane, int sl, int it, int ch, f32x4 (&S)[8], v2u (&ucur)[4], v2u (&unxt)[4], float egc) {
    if (ch < 126) asm volatile("s_waitcnt vmcnt(8)" ::: "memory"); else asm volatile("s_waitcnt vmcnt(0)" ::: "memory");
    __builtin_amdgcn_s_barrier(); asm volatile("" ::: "memory");
    asm volatile("" : "+v"(ucur[0]), "+v"(ucur[1]), "+v"(ucur[2]), "+v"(ucur[3]));
    bf16x8 sf[4];
#pragma unroll
    for (int ks = 0; ks < 4; ++ks) { v4u o; o.x = cvt_pk_bf16(S[2 * ks][0], S[2 * ks][1]); o.y = cvt_pk_bf16(S[2 * ks][2], S[2 * ks][3]); o.z = cvt_pk_bf16(S[2 * ks + 1][0], S[2 * ks + 1][1]); o.w = cvt_pk_bf16(S[2 * ks + 1][2], S[2 * ks + 1][3]);
        *(v4u*)(B.SST + (size_t)it * DN_SST + ((ks * 8 + sl) * 64 + lane) * 16) = o; sf[ks] = as_frag(o); }
    asm volatile("" ::: "memory");
    if (ch + 3 < 128) {
#pragma unroll
        for (int mt = 0; mt < 4; ++mt) u_load_asm(unxt[mt], B.U + (size_t)(it + 3) * DN_U + ((mt * 8 + sl) * 64 + lane) * 8); }
    const LAS unsigned char* wl = L + STG * 32768 + lane * 16; const LAS unsigned char* kl = wl + 16384;
    f32x4 vn[4];
#pragma unroll
    for (int mt = 0; mt < 4; ++mt) { vn[mt] = (f32x4){bf_lo(ucur[mt].x), bf_hi(ucur[mt].x), bf_lo(ucur[mt].y), bf_hi(ucur[mt].y)};
#pragma unroll
        for (int ks = 0; ks < 4; ++ks) vn[mt] = MFMA16(*(const LAS bf16x8*)(wl + (mt * 4 + ks) * 1024), sf[ks], vn[mt]); }
    bf16x8 vf[2];
#pragma unroll
    for (int ks = 0; ks < 2; ++ks) { v4u o; o.x = cvt_pk_bf16(vn[2 * ks][0], vn[2 * ks][1]); o.y = cvt_pk_bf16(vn[2 * ks][2], vn[2 * ks][3]); o.z = cvt_pk_bf16(vn[2 * ks + 1][0], vn[2 * ks + 1][1]); o.w = cvt_pk_bf16(vn[2 * ks + 1][2], vn[2 * ks + 1][3]); vf[ks] = as_frag(o); }
#pragma unroll
    for (int dt = 0; dt < 8; ++dt) { f32x4 a = S[dt] * egc;
#pragma unroll
        for (int ks = 0; ks < 2; ++ks) a = MFMA16(*(const LAS bf16x8*)(kl + (dt * 2 + ks) * 1024), vf[ks], a);
        S[dt] = a; }
}
__device__ __forceinline__ void p_dn_scan(const Ctx& c, const DnBufs& B) {
    const int lane = c.lane, w = c.wave, bh = c.bid & 7, half = c.bid >> 3; LAS unsigned char* L = c.lds;
    if (w >= 4) {
        const unsigned char* gsrc = (w < 6) ? B.WN : B.KD; const int goff = (w & 1) * 8192 + lane * 16, loff = (w - 4) * 8192;
#define SCAN_DMA(itn, stage) do { _Pragma("unroll") for (int _p = 0; _p < 8; ++_p) \
        __builtin_amdgcn_global_load_lds((const unsigned*)(gsrc + (size_t)(itn) * 16384 + goff + _p * 1024), (LAS unsigned*)(L + (stage) * 32768 + loff + _p * 1024), 16, 0, 0); } while (0)
        const int it0 = bh * 128;
        SCAN_DMA(it0, 0); SCAN_DMA(it0 + 1, 1); SCAN_DMA(it0 + 2, 2);
#pragma unroll 1
        for (int ch = 0; ch < 128; ++ch) {
            if (ch < 126) asm volatile("s_waitcnt vmcnt(16)" ::: "memory"); else asm volatile("s_waitcnt vmcnt(0)" ::: "memory");
            __builtin_amdgcn_s_barrier(); asm volatile("" ::: "memory");
            if (ch + 3 < 128) SCAN_DMA(it0 + ch + 3, (ch + 3) & 3);
        }
#undef SCAN_DMA
    } else {
        __builtin_amdgcn_s_setprio(1);
        const int sl = half * 4 + w;
        f32x4 S[8];
#pragma unroll
        for (int i = 0; i < 8; ++i) S[i] = (f32x4){0.f, 0.f, 0.f, 0.f};
        v2u u0[4], u1[4], u2[4], u3[4];
        const float eglo = B.EG[bh * 128 + lane], eghi = B.EG[bh * 128 + 64 + lane];
        asm volatile("s_waitcnt vmcnt(0)" ::: "memory");
        { const int it = bh * 128;
#pragma unroll
            for (int mt = 0; mt < 4; ++mt) u_load_asm(u0[mt], B.U + (size_t)it * DN_U + ((mt * 8 + sl) * 64 + lane) * 8);
#pragma unroll
            for (int mt = 0; mt < 4; ++mt) u_load_asm(u1[mt], B.U + (size_t)(it + 1) * DN_U + ((mt * 8 + sl) * 64 + lane) * 8);
#pragma unroll
            for (int mt = 0; mt < 4; ++mt) u_load_asm(u2[mt], B.U + (size_t)(it + 2) * DN_U + ((mt * 8 + sl) * 64 + lane) * 8);
#pragma unroll
            for (int mt = 0; mt < 4; ++mt) u3[mt] = (v2u){0u, 0u}; }
#define EGC(chx) __builtin_bit_cast(float, __builtin_amdgcn_readlane(__builtin_bit_cast(int, (chx) < 64 ? eglo : eghi), (chx) & 63))
#pragma unroll 1
        for (int ch = 0; ch < 128; ch += 4) {
            const int it = bh * 128 + ch;
            scan_step<0>(B, L, lane, sl, it, ch, S, u0, u3, EGC(ch));
            scan_step<1>(B, L, lane, sl, it + 1, ch + 1, S, u1, u0, EGC(ch + 1));
            scan_step<2>(B, L, lane, sl, it + 2, ch + 2, S, u2, u1, EGC(ch + 2));
            scan_step<3>(B, L, lane, sl, it + 3, ch + 3, S, u3, u2, EGC(ch + 3));
        }
#undef EGC
        __builtin_amdgcn_s_setprio(0);
    }
    asm volatile("s_waitcnt vmcnt(0)" ::: "memory"); __builtin_amdgcn_s_barrier(); asm volatile("" ::: "memory");
}

__device__ __forceinline__ void p_dn_out(const Ctx& c, const DnBufs& B, const bf16* PROJ, const float* gn, bf16* YA) {
    const int lane = c.lane, sl = c.wave, fr = lane & 15, fq = lane >> 4; LAS float* SSQ = (LAS float*)c.lds;
    LAS unsigned char* IMG = c.lds + 2048;
    LAS float* OT = (LAS float*)(c.lds + 2048 + 40960);
    for (int it = c.bid; it < BATCH * DNH * (SEQ / 64); it += c.nb) {
        const int bh = it >> 7, ch = it & 127, b = bh >> 2, h = bh & 3; const size_t row0 = (size_t)b * SEQ + ch * 64;
        v4u sfr[4]; v2u ur[4]; v4u zr[2];
        { const size_t zrow = row0 + (c.tid >> 3); zr[0] = *(const v4u*)(PROJ + zrow * PJ + 1536 + h * 128 + 16 * (c.tid & 7)); zr[1] = *(const v4u*)(PROJ + zrow * PJ + 1536 + h * 128 + 16 * (c.tid & 7) + 8); }
#pragma unroll
        for (int ks = 0; ks < 4; ++ks) sfr[ks] = *(const v4u*)(B.SST + (size_t)it * DN_SST + ((ks * 8 + sl) * 64 + lane) * 16);
#pragma unroll
        for (int mt = 0; mt < 4; ++mt) ur[mt] = *(const v2u*)(B.U + (size_t)it * DN_U + ((mt * 8 + sl) * 64 + lane) * 8);
#pragma unroll
        for (int j = 0; j < 5; ++j) { const int p = sl * 5 + j;
            const unsigned char* src = (p < 16) ? B.WN + (size_t)it * DN_WN + p * 1024 : (p < 32 ? B.QD + (size_t)it * DN_QD + (p - 16) * 1024 : B.QK + (size_t)it * DN_QK + (p - 32) * 1024);
            __builtin_amdgcn_global_load_lds((const unsigned*)(src + lane * 16), (LAS unsigned*)(IMG + p * 1024), 16, 0, 0); }
        asm volatile("s_waitcnt vmcnt(0)" ::: "memory"); lds_barrier();
        bf16x8 sf[4];
#pragma unroll
        for (int ks = 0; ks < 4; ++ks) sf[ks] = as_frag(sfr[ks]);
        const LAS unsigned char* wn = IMG + lane * 16; const LAS unsigned char* qd = wn + 16384; const LAS unsigned char* qk = wn + 32768;
        f32x4 vn[4];
#pragma unroll
        for (int mt = 0; mt < 4; ++mt) { vn[mt] = (f32x4){bf_lo(ur[mt].x), bf_hi(ur[mt].x), bf_lo(ur[mt].y), bf_hi(ur[mt].y)};
#pragma unroll
            for (int ks = 0; ks < 4; ++ks) vn[mt] = MFMA16(*(const LAS bf16x8*)(wn + (mt * 4 + ks) * 1024), sf[ks], vn[mt]); }
        bf16x8 vf[2];
#pragma unroll
        for (int ks = 0; ks < 2; ++ks) { v4u o; o.x = cvt_pk_bf16(vn[2 * ks][0], vn[2 * ks][1]); o.y = cvt_pk_bf16(vn[2 * ks][2], vn[2 * ks][3]); o.z = cvt_pk_bf16(vn[2 * ks + 1][0], vn[2 * ks + 1][1]); o.w = cvt_pk_bf16(vn[2 * ks + 1][2], vn[2 * ks + 1][3]); vf[ks] = as_frag(o); }
        f32x4 o[4];
#pragma unroll
        for (int mt = 0; mt < 4; ++mt) { f32x4 a = {0.f, 0.f, 0.f, 0.f};
#pragma unroll
            for (int ks = 0; ks < 4; ++ks) a = MFMA16(*(const LAS bf16x8*)(qd + (mt * 4 + ks) * 1024), sf[ks], a);
#pragma unroll
            for (int ks = 0; ks < 2; ++ks) a = MFMA16(*(const LAS bf16x8*)(qk + (mt * 2 + ks) * 1024), vf[ks], a);
            o[mt] = a;
#pragma unroll
            for (int r = 0; r < 4; ++r) { float q = row16_sum(a[r] * a[r]);
                if (fr == 0) SSQ[(16 * mt + 4 * fq + r) * 8 + sl] = q; } }
#pragma unroll
        for (int mt = 0; mt < 4; ++mt)
#pragma unroll
            for (int r = 0; r < 4; ++r) OT[(16 * mt + 4 * fq + r) * 132 + 16 * sl + fr] = o[mt][r];
        lds_barrier();
        { const int row = c.tid >> 3, seg = c.tid & 7; const size_t grow = row0 + row; const int col = h * 128 + 16 * seg;
            const f32x4 q0 = *(const LAS f32x4*)(SSQ + row * 8), q1 = *(const LAS f32x4*)(SSQ + row * 8 + 4);
            const float rstd = rsqrtf(((q0[0] + q0[1]) + (q0[2] + q0[3]) + (q1[0] + q1[1]) + (q1[2] + q1[3])) * (1.f / 128.f) + RMS_EPS);
            float zf[16]; { float t8[8]; unpack8(zr[0], t8);
#pragma unroll
                for (int e = 0; e < 8; ++e) zf[e] = t8[e];
                unpack8(zr[1], t8);
#pragma unroll
                for (int e = 0; e < 8; ++e) zf[8 + e] = t8[e]; }
            float y[16];
#pragma unroll
            for (int j = 0; j < 4; ++j) { const f32x4 ov = *(const LAS f32x4*)(OT + row * 132 + 16 * seg + 4 * j); const float4 g4 = *(const float4*)(gn + 16 * seg + 4 * j);
                y[4 * j + 0] = ov[0] * rstd * g4.x * zf[4 * j + 0]; y[4 * j + 1] = ov[1] * rstd * g4.y * zf[4 * j + 1]; y[4 * j + 2] = ov[2] * rstd * g4.z * zf[4 * j + 2]; y[4 * j + 3] = ov[3] * rstd * g4.w * zf[4 * j + 3]; }
            v4u w0, w1; w0.x = cvt_pk_bf16(y[0], y[1]); w0.y = cvt_pk_bf16(y[2], y[3]); w0.z = cvt_pk_bf16(y[4], y[5]); w0.w = cvt_pk_bf16(y[6], y[7]);
            w1.x = cvt_pk_bf16(y[8], y[9]); w1.y = cvt_pk_bf16(y[10], y[11]); w1.z = cvt_pk_bf16(y[12], y[13]); w1.w = cvt_pk_bf16(y[14], y[15]);
            *(v4u*)(YA + grow * DNW + col) = w0; *(v4u*)(YA + grow * DNW + col + 8) = w1; }
        lds_barrier();
    }
}

__device__ __forceinline__ void p_sg_item(const Ctx& c, int it, const bf16* PROJ, const float* lg, const float* lb, const float* sw, const float* sb, bf16* YB) {
    LAS unsigned short* VT = (LAS unsigned short*)c.lds;
    LAS float* STAT = (LAS float*)(c.lds + 128 * RS * 2);
    const int lane = c.lane, w = c.wave, fr = lane & 15, fq = lane >> 4, chunk = it >> 2, g = it & 3; const size_t row0 = (size_t)chunk * SGC;
    {
        v4u xr[16];
#pragma unroll
        for (int rr = 0; rr < 16; ++rr) xr[rr] = *(const v4u*)(PROJ + (row0 + 16 * w + rr) * PJ + 2560 + lane * 8);
        float acc[32];
#pragma unroll
        for (int rr = 0; rr < 16; ++rr) { float f[8]; unpack8(xr[rr], f); float s1 = 0.f, s2 = 0.f;
#pragma unroll
            for (int e = 0; e < 8; ++e) { s1 += f[e]; s2 = fmaf(f[e], f[e], s2); }
            acc[rr] = s1; acc[16 + rr] = s2; }
        BFLY_SW32(acc, 32) BFLY_SW16(acc, 16) BFLY_DPP(acc, 8, 8, dpp_ror8) BFLY_DPP(acc, 4, 4, dpp_xor4) BFLY_DPP(acc, 2, 2, dpp_xor2)
        const float tot = acc[0] + dpp_xor1(acc[0]);
        if ((lane & 1) == 0) { const int vi = lane >> 1; STAT[2 * (16 * w + (vi & 15)) + (vi >> 4)] = tot; } }
    lds_barrier();
    { v4u xv[4];
#pragma unroll
        for (int i = 0; i < 4; ++i) { const int idx = c.tid + NTHR * i, s = idx >> 4, c8 = (idx & 15) * 8; xv[i] = *(const v4u*)(PROJ + (row0 + s) * PJ + 2560 + g * 128 + c8); }
        const int c8 = (c.tid & 15) * 8;
        const float4 g0 = *(const float4*)(lg + g * 128 + c8), g1 = *(const float4*)(lg + g * 128 + c8 + 4), b0 = *(const float4*)(lb + g * 128 + c8), b1 = *(const float4*)(lb + g * 128 + c8 + 4);
        const float gv[8] = {g0.x, g0.y, g0.z, g0.w, g1.x, g1.y, g1.z, g1.w}, bv[8] = {b0.x, b0.y, b0.z, b0.w, b1.x, b1.y, b1.z, b1.w};
#pragma unroll
        for (int i = 0; i < 4; ++i) { const int s = (c.tid + NTHR * i) >> 4; float f[8]; unpack8(xv[i], f);
            const float mu = STAT[2 * s] * (1.f / SGW), rstd = rsqrtf(fmaxf(STAT[2 * s + 1] * (1.f / SGW) - mu * mu, 0.f) + LN_EPS);
#pragma unroll
            for (int e = 0; e < 8; ++e) VT[(c8 + e) * RS + s] = f2bf1((f[e] - mu) * rstd * gv[e] + bv[e]); } }
    lds_barrier();
    { f32x4 acc[8];
#pragma unroll
        for (int ct = 0; ct < 8; ++ct) acc[ct] = (f32x4){0.f, 0.f, 0.f, 0.f};
        const int t = 16 * w + fr, nk = (w >> 1) + 1;
        for (int kk = 0; kk < nk; ++kk) { const int s0 = 32 * kk + 8 * fq; const float* wp = sw + ((size_t)g * SGC + t) * SGC + s0;
            const float4 w0 = *(const float4*)wp, w1 = *(const float4*)(wp + 4);
            const float wv[8] = {w0.x, w0.y, w0.z, w0.w, w1.x, w1.y, w1.z, w1.w}; float wm[8];
#pragma unroll
            for (int e = 0; e < 8; ++e) wm[e] = (s0 + e <= t) ? wv[e] : 0.f;
            v4u wb; wb.x = cvt_pk_bf16(wm[0], wm[1]); wb.y = cvt_pk_bf16(wm[2], wm[3]); wb.z = cvt_pk_bf16(wm[4], wm[5]); wb.w = cvt_pk_bf16(wm[6], wm[7]);
            const bf16x8 bfr = as_frag(wb);
#pragma unroll
            for (int ct = 0; ct < 8; ++ct) acc[ct] = MFMA16(*(const LAS bf16x8*)(VT + (16 * ct + fr) * RS + s0), bfr, acc[ct]); }
        const float bias = sb[g * SGC + t]; const size_t row = row0 + t;
#pragma unroll
        for (int ct = 0; ct < 8; ++ct) { const int col = g * 128 + 16 * ct + 4 * fq; const v2u u = *(const v2u*)(PROJ + row * PJ + 2048 + col);
            v2u o; o.x = cvt_pk_bf16(bf_lo(u.x) * (acc[ct][0] + bias), bf_hi(u.x) * (acc[ct][1] + bias)); o.y = cvt_pk_bf16(bf_lo(u.y) * (acc[ct][2] + bias), bf_hi(u.y) * (acc[ct][3] + bias));
            *(v2u*)(YB + row * SGW + col) = o; } }
    lds_barrier();
}

struct Args { const float* in[22]; float* out; unsigned char* ws; int ph_lo, ph_hi; };
__global__ void __launch_bounds__(NTHR, 2) mega(Args args) {
    extern __shared__ __attribute__((aligned(16))) unsigned char lds_raw[];
    Ctx c; c.lds0 = (LAS unsigned char*)lds_raw; c.lds = c.lds0 + RING_OFF; c.tid = threadIdx.x; c.lane = c.tid & 63; c.wave = __builtin_amdgcn_readfirstlane(c.tid >> 6); c.bid = blockIdx.x; c.nb = gridDim.x;
    volatile LAS unsigned* MISC = (volatile LAS unsigned*)(c.lds0 + MISC_OFF);
    for (int u = c.tid; u < RING_OFF / 4; u += NTHR) ((LAS unsigned*)(c.lds0 + LDSCTL_OFF))[u] = 0u;
    __syncthreads();
    unsigned char* ws = args.ws;
    gu32* ctl = (gu32*)(ws + WS_CTL);
    XcdBarrier bar = xcd_barrier_post((unsigned*)(ctl + CW_BAR), MISC + 8);
#define GRID_BAR() xcd_barrier(bar)
    const float* x = args.in[0]; const float* norm1_g = args.in[1]; const float* w_in = args.in[2]; const float* conv_w = args.in[3];
    const float* a_log = args.in[4]; const float* dt_bias = args.in[5]; const float* dn_norm_g = args.in[6]; const float* w_o_dn = args.in[7];
    const float* sg_ln_g = args.in[8]; const float* sg_ln_b = args.in[9]; const float* sg_w = args.in[10]; const float* sg_b = args.in[11];
    const float* w_o_sg = args.in[12]; const float* w_out = args.in[13]; const float* norm2_g = args.in[14]; const float* w_router = args.in[15];
    const float* b_router = args.in[16]; const float* w_gate_up = args.in[17]; const float* b_gate_up = args.in[18]; const float* w_down = args.in[19];
    const float* b_down = args.in[20]; const float* norm_f_g = args.in[21];
    float* out = args.out;
    unsigned char* wb = ws + WS_BASE;
    bf16* Hb = (bf16*)(wb + 0); bf16* H2b = (bf16*)(wb + 0);
    bf16* Win_t = (bf16*)(wb + 32 * MiB); bf16* Wo_t = (bf16*)(wb + 42 * MiB); bf16* Wout_t = (bf16*)(wb + 44 * MiB); float* BG = (float*)(wb + 46 * MiB);
    bf16* PROJb = (bf16*)(wb + 48 * MiB); bf16* ACTb = (bf16*)(wb + 48 * MiB);
    bf16* YAB = (bf16*)(wb + 208 * MiB); bf16* MERGED = (bf16*)(wb + 240 * MiB); float* X1 = (float*)(wb + 272 * MiB);
    float* QKV = (float*)(wb + 336 * MiB); float* O32 = (float*)(wb + 432 * MiB); float* U = (float*)(wb + 464 * MiB); float* VLN = (float*)(wb + 496 * MiB);
    bf16* Wgu_t = (bf16*)(wb + 528 * MiB); bf16* Wd_t = (bf16*)(wb + 656 * MiB); bf16* HS = (bf16*)(wb + 720 * MiB); bf16* Yb = (bf16*)(wb + 864 * MiB);
    unsigned char* small = wb + 1008 * MiB;
    int* slot_e = (int*)(small + 0 * MiB); int* slot_pos = (int*)(small + 1 * MiB); int* elist = (int*)(small + 2 * MiB); float* ewgt = (float*)(small + 4 * MiB); bf16* WrT = (bf16*)(small + 6 * MiB);
    unsigned* gcnt = (unsigned*)(ctl + CW_CNT);

#ifndef PROBE_MASK
#define PROBE_MASK 0
#endif
#define REP(bit) for (int _r = 0; _r < ((PROBE_MASK >> (bit)) & 1) + 1; ++_r)
    REP(0) { p_convert_front(c, w_in, w_o_dn, w_o_sg, w_out, Win_t, Wo_t, Wout_t);
    __syncthreads();
    p_norm1(c, x, norm1_g, w_in, a_log, dt_bias, Hb, BG); if (PROBE_MASK & 1) __syncthreads();
    p_build_wrt(c, w_router, WrT);
    for (int i = c.bid * NTHR + c.tid; i < NE * NTOK / 4; i += c.nb * NTHR) { ((v4u*)elist)[i] = (v4u){0u, 0u, 0u, 0u}; ((v4u*)ewgt)[i] = (v4u){0u, 0u, 0u, 0u}; } }
    GRID_BAR();
    REP(1) { pg8::Gemm g{Hb, Win_t, NTOK, PJ, D}; pg8::StaticOrder S; S.init(NTOK, PJ, c.nb, c.bid); EpiProj E{PROJb};
      pg8::gemm_phase<EpiProj, pg8::StaticOrder, true, true>(c.lds, g, S, E); }
    GRID_BAR();
    DnBufs DB; DB.WN = wb + 336 * MiB; DB.QD = wb + 352 * MiB; DB.KD = wb + 368 * MiB; DB.QK = wb + 384 * MiB; DB.U = wb + 392 * MiB; DB.SST = wb + 408 * MiB; DB.EG = (float*)(wb + 440 * MiB);
    REP(2) { p_dn_prep(c, PROJb, conv_w, BG, DB); }
    GRID_BAR();
    if (c.bid < SCAN_WGS) { REP(3) { p_dn_scan(c, DB); } }
    else { Ctx c2 = c; c2.bid = c.bid - SCAN_WGS; c2.nb = c.nb - SCAN_WGS;
        REP(4) { for (int it = c2.bid; it < (NTOK / SGC) * 4; it += c2.nb) p_sg_item(c, it, PROJb, sg_ln_g, sg_ln_b, sg_w, sg_b, YAB + (size_t)NTOK * DNW); }
        REP(5) { p_convert_moe(c2, w_gate_up, w_down, Wgu_t, Wd_t); } }
    GRID_BAR();
    REP(6) { p_dn_out(c, DB, PROJb, dn_norm_g, YAB); }
    GRID_BAR();
    REP(7) { pg8::Gemm g{YAB, Wo_t, 0, 0, DNW}; DualOrder S; S.init(c.nb, c.bid); EpiMerge E{PROJb, MERGED};
      pg8::gemm_phase<EpiMerge, DualOrder, true, true>(c.lds, g, S, E); }
    GRID_BAR();
    REP(8) { pg8::Gemm g{MERGED, Wout_t, NTOK, D, D}; pg8::StaticOrder S; S.init(NTOK, D, c.nb, c.bid); EpiResid E{x, X1};
      pg8::gemm_phase<EpiResid, pg8::StaticOrder, true, true>(c.lds, g, S, E); }
    GRID_BAR();
    p_router2(c, X1, norm2_g, WrT, b_router, H2b, slot_e, slot_pos, elist, ewgt, gcnt);
    GRID_BAR();
    LAS unsigned char* tile_e = c.lds0 + EXTRA_OFF + 512; LAS int* ntl = (LAS int*)(c.lds0 + EXTRA_OFF + 1024); LAS int* tile_b = (LAS int*)(c.lds0 + EXTRA_OFF + 1088);
    build_tile_table(c, gcnt, tile_e, ntl, tile_b);
    const int NTL = __builtin_amdgcn_readfirstlane(ntl[0]);
    REP(10) { pg8::Gemm g{H2b, Wgu_t, 0, 0, D, elist}; MoeOrder S; S.init(NTL, 8, c.nb, c.bid, tile_e, tile_b, 4); EpiSwiglu E{ACTb, b_gate_up};
      pg8::gemm_phase<EpiSwiglu, MoeOrder, true, true, true>(c.lds, g, S, E); }
    GRID_BAR();
    REP(11) { pg8::Gemm g{ACTb, Wd_t, 0, 0, DFF}; MoeOrder S; S.init(NTL, 4, c.nb, c.bid, tile_e, tile_b); EpiDown E{Yb, b_down, ewgt};
      pg8::gemm_phase<EpiDown, MoeOrder, true, true>(c.lds, g, S, E); }
    GRID_BAR();
    REP(12) { p_final(c, X1, Yb, slot_e, slot_pos, gcnt, norm_f_g, out); }
    if (PROBE_MASK & 8192) { for (int k = 0; k < 10; ++k) GRID_BAR(); }
}

extern "C" void kernel_launch(void* const* d_in, const int* in_sizes, int n_in, void* d_out, int out_size, void* d_ws, size_t ws_size, hipStream_t stream) {
    static int grid = 0;
    if (grid == 0) {
        if (n_in != 22 || in_sizes[0] != NTOK * D || out_size != NTOK * D || ws_size < WS_NEED) { fprintf(stderr, "kernel_launch: unexpected shapes (n_in %d, ws %zu)\n", n_in, ws_size); grid = -1; return; }
        int dev = 0, cus = 0, per_cu = 0;
        if (hipGetDevice(&dev) != hipSuccess || hipDeviceGetAttribute(&cus, hipDeviceAttributeMultiprocessorCount, dev) != hipSuccess) { grid = -1; return; }
        if (hipFuncSetAttribute((const void*)mega, hipFuncAttributeMaxDynamicSharedMemorySize, LDS_BYTES) != hipSuccess) { fprintf(stderr, "kernel_launch: hipFuncSetAttribute failed\n"); grid = -1; return; }
        if (hipOccupancyMaxActiveBlocksPerMultiprocessor(&per_cu, (const void*)mega, NTHR, LDS_BYTES) != hipSuccess || per_cu < 1) fprintf(stderr, "kernel_launch: occupancy query reports %d\n", per_cu);
        (void)hipGetLastError();
        grid = cus;
    }
    if (grid < 0) return;
    if (hipMemsetAsync((char*)d_ws + WS_CTL, 0, CTL_ZERO_BYTES, stream) != hipSuccess) { fprintf(stderr, "kernel_launch: memset failed\n"); return; }
    Args a{};
    for (int i = 0; i < 22; ++i) a.in[i] = (const float*)d_in[i];
    a.out = (float*)d_out; a.ws = (unsigned char*)d_ws; a.ph_lo = 0; a.ph_hi = 100;
    hipLaunchKernelGGL(mega, dim3(grid), dim3(NTHR), LDS_BYTES, stream, a);
#if PROBE_MASK & 131072
    (void)hipMemsetAsync((char*)d_ws + WS_CTL, 0, CTL_ZERO_BYTES, stream); hipLaunchKernelGGL(mega, dim3(grid), dim3(NTHR), LDS_BYTES, stream, a);
#endif
    const hipError_t le = hipPeekAtLastError();
    if (le != hipSuccess) fprintf(stderr, "kernel_launch: launch failed: %s\n", hipGetErrorName(le));
}
```

```cpp
#include <hip/hip_runtime.h>
#include <cstdio>
#include <cstdint>
#include <cmath>

#define GAS __attribute__((address_space(1)))
#define LAS __attribute__((address_space(3)))
typedef GAS unsigned gu32;
#define RLX_AGENT __ATOMIC_RELAXED, __HIP_MEMORY_SCOPE_AGENT

constexpr int NWAVES = 8, NTHR = 512;
constexpr int D = 1024, BATCH = 2, SEQ = 8192, NTOK = BATCH * SEQ;
constexpr int DNH = 4, DNW = 512;
constexpr int SGD = 128, SGW = 512, SGC = 128;
constexpr int NE = 32, TOPK = 4, DFF = 1024;
constexpr int OFF_Z = 1536, OFF_BETA = 2048, OFF_A = 2052, OFF_U = 2056, OFF_V = 2568, OFF_GA = 3080, OFF_GB = 4104, INC = 5128;
constexpr float RMS_EPS = 1e-6f, LN_EPS = 1e-5f, L2_EPS = 1e-6f;

constexpr size_t MiB = 1u << 20;
constexpr size_t WS_CTL = 0, CTL_ZERO_BYTES = 1 * MiB;
constexpr int CW_BAR = 4096;
constexpr int CW_CNT = 16384;
constexpr size_t WS_BASE = 2 * MiB;
constexpr size_t WS_NEED = 1020 * MiB;
constexpr int LDSCTL_OFF = 0, MISC_OFF = 320, RING_OFF = 1024, RING_BYTES = 131072, EXTRA_OFF = RING_OFF + RING_BYTES, LDS_BYTES = 147456;

#define XB_TMO      128
#define XB_XCNT(j)  (256  + 64 * (j))
#define XB_XSUB(j)  (1280 + 64 * (j))
#define XB_XGEN(j)  (2304 + 64 * (j))
#define XB_TOP      3328
#define XB_TOPGEN   3392
#define XCD_BAR_WORDS 3456
#define XB_SPIN_CAP (1u << 22)
__device__ __forceinline__ unsigned xb_ld(unsigned* p)              { return __hip_atomic_load(p, __ATOMIC_RELAXED, __HIP_MEMORY_SCOPE_AGENT); }
__device__ __forceinline__ unsigned xb_add(unsigned* p, unsigned v) { return __hip_atomic_fetch_add(p, v, __ATOMIC_RELAXED, __HIP_MEMORY_SCOPE_AGENT); }
__device__ __forceinline__ unsigned xb_xcc_id() { return (unsigned)__builtin_amdgcn_s_getreg((3 << 11) | 20) & 0xFu; }
#define XB_SPIN(cond, bar) do { unsigned _sp = 0; while (cond) { __builtin_amdgcn_s_sleep(1); \
    if ((++_sp & 255u) == 0u) { if (xb_ld(&(bar)[XB_TMO])) break; if (_sp > XB_SPIN_CAP) { atomicAdd(&(bar)[XB_TMO], 1u); break; } } } } while (0)
struct XcdBarrier { unsigned* bar; unsigned x; volatile LAS unsigned* st; };
__device__ __forceinline__ XcdBarrier xcd_barrier_post(unsigned* bar, volatile LAS unsigned* st) {
    XcdBarrier b; b.bar = bar; b.x = xb_xcc_id(); b.st = st;
    if (threadIdx.x == 0) (void)xb_add(&bar[XB_XCNT(b.x)], 1u);
    return b;
}
__device__ __forceinline__ void xcd_barrier_complete(unsigned* bar, unsigned x, unsigned& nloc, unsigned& nx) {
    const unsigned G = gridDim.x * gridDim.y * gridDim.z;
    unsigned sum, cnt, mine, sp = 0u;
    for (;;) {
        sum = 0u; cnt = 0u; mine = 0u;
#pragma unroll
        for (unsigned j = 0; j < 16; ++j) { const unsigned c = xb_ld(&bar[XB_XCNT(j)]); sum += c; cnt += (c > 0u) ? 1u : 0u; mine = (j == x) ? c : mine; }
        if (sum == G) break;
        __builtin_amdgcn_s_sleep(1);
        if ((++sp & 255u) == 0u) { if (xb_ld(&bar[XB_TMO])) break; if (sp > XB_SPIN_CAP) { atomicAdd(&bar[XB_TMO], 1u); break; } }
    }
    nloc = mine > 0u ? mine : 1u; nx = cnt > 0u ? cnt : 1u;
}
__device__ __forceinline__ void xcd_barrier(const XcdBarrier& b) {
    asm volatile("s_waitcnt vmcnt(0)" ::: "memory");
    __syncthreads();
    if (threadIdx.x == 0) {
        unsigned* bar = b.bar;
        __builtin_amdgcn_s_waitcnt(0);
        unsigned nloc = b.st[0], nx = b.st[1];
        if (nloc == 0u) { xcd_barrier_complete(bar, b.x, nloc, nx); b.st[0] = nloc; b.st[1] = nx; }
        const unsigned old = xb_add(&bar[XB_XSUB(b.x)], 1u);
        const unsigned gen = old / nloc;
        if (old + 1u == (gen + 1u) * nloc) {
            __builtin_amdgcn_fence(__ATOMIC_RELEASE, "agent");
            asm volatile("s_waitcnt vmcnt(0)" ::: "memory");
            const unsigned og = xb_add(&bar[XB_TOP], 1u);
            const unsigned tg = og / nx;
            if (og + 1u == (tg + 1u) * nx) xb_add(&bar[XB_TOPGEN], 1u);
            else XB_SPIN(xb_ld(&bar[XB_TOPGEN]) == tg, bar);
            __builtin_amdgcn_fence(__ATOMIC_ACQUIRE, "agent");
            xb_add(&bar[XB_XGEN(b.x)], 1u);
            asm volatile("s_waitcnt vmcnt(0)" ::: "memory");
        } else {
            XB_SPIN(xb_ld(&bar[XB_XGEN(b.x)]) == gen, bar);
            __builtin_amdgcn_fence(__ATOMIC_ACQUIRE, "agent");
            asm volatile("s_waitcnt vmcnt(0)" ::: "memory");
        }
    }
    __syncthreads();
}

__device__ __forceinline__ float dpp_xor1(float v) { return __builtin_bit_cast(float, __builtin_amdgcn_update_dpp(0, __builtin_bit_cast(int, v), 0xB1, 0xF, 0xF, true)); }
__device__ __forceinline__ float dpp_xor2(float v) { return __builtin_bit_cast(float, __builtin_amdgcn_update_dpp(0, __builtin_bit_cast(int, v), 0x4E, 0xF, 0xF, true)); }
__device__ __forceinline__ float dpp_qrev(float v) { return __builtin_bit_cast(float, __builtin_amdgcn_update_dpp(0, __builtin_bit_cast(int, v), 0x1B, 0xF, 0xF, true)); }
__device__ __forceinline__ float dpp_hmir(float v) { return __builtin_bit_cast(float, __builtin_amdgcn_update_dpp(0, __builtin_bit_cast(int, v), 0x141, 0xF, 0xF, true)); }
__device__ __forceinline__ float dpp_rmir(float v) { return __builtin_bit_cast(float, __builtin_amdgcn_update_dpp(0, __builtin_bit_cast(int, v), 0x140, 0xF, 0xF, true)); }
__device__ __forceinline__ float dpp_ror8(float v) { return __builtin_bit_cast(float, __builtin_amdgcn_update_dpp(0, __builtin_bit_cast(int, v), 0x128, 0xF, 0xF, true)); }
__device__ __forceinline__ float dpp_xor4(float v) { return dpp_qrev(dpp_hmir(v)); }
__device__ __forceinline__ float row16_sum(float v) { v += dpp_xor1(v); v += dpp_xor2(v); v += dpp_hmir(v); v += dpp_rmir(v); return v; }
__device__ __forceinline__ float rdlane(float v, int l) { return __builtin_bit_cast(float, __builtin_amdgcn_readlane(__builtin_bit_cast(int, v), l)); }
__device__ __forceinline__ float wave_sum(float v) { v = row16_sum(v); return (rdlane(v, 0) + rdlane(v, 16)) + (rdlane(v, 32) + rdlane(v, 48)); }
__device__ __forceinline__ void swap32(float& a, float& b) { asm volatile("s_nop 1\n\tv_permlane32_swap_b32 %0, %1" : "+v"(a), "+v"(b)); }
__device__ __forceinline__ void swap16(float& a, float& b) { asm volatile("s_nop 1\n\tv_permlane16_swap_b32 %0, %1" : "+v"(a), "+v"(b)); }
#define BFLY_SW32(acc, n) _Pragma("unroll") for (int i_ = 0; i_ < (n) / 2; ++i_) { float x_ = acc[i_], y_ = acc[i_ + (n) / 2]; swap32(x_, y_); acc[i_] = x_ + y_; }
#define BFLY_SW16(acc, n) _Pragma("unroll") for (int i_ = 0; i_ < (n) / 2; ++i_) { float x_ = acc[i_], y_ = acc[i_ + (n) / 2]; swap16(x_, y_); acc[i_] = x_ + y_; }
#define BFLY_DPP(acc, n, m, PERM) _Pragma("unroll") for (int i_ = 0; i_ < (n) / 2; ++i_) { const bool up_ = (lane & (m)) != 0; const float send_ = up_ ? acc[i_] : acc[i_ + (n) / 2]; const float keep_ = up_ ? acc[i_ + (n) / 2] : acc[i_]; acc[i_] = keep_ + PERM(send_); }
__device__ __forceinline__ float sigmoidf_(float x) { return 1.f / (1.f + expf(-x)); }
__device__ __forceinline__ float siluf_(float x) { return x / (1.f + expf(-x)); }
__device__ __forceinline__ float geluf_(float x) { return 0.5f * x * (1.f + erff(x * 0.70710678118654752f)); }
__device__ __forceinline__ float softplusf_(float x) { return x > 20.f ? x : log1pf(expf(x)); }

__device__ __forceinline__ void lds_barrier() { asm volatile("s_waitcnt lgkmcnt(0)" ::: "memory"); __builtin_amdgcn_s_barrier(); asm volatile("" ::: "memory"); }
struct Ctx { int bid, nb, tid, lane, wave; LAS unsigned char* lds; LAS unsigned char* lds0; };

namespace pg8 {
#define PG8_LAS __attribute__((address_space(3)))
typedef unsigned short bf16_t;
typedef short bf16x8 __attribute__((ext_vector_type(8)));
typedef float f32x4 __attribute__((ext_vector_type(4)));
typedef unsigned u32x4 __attribute__((ext_vector_type(4)));
constexpr int BM = 256, BK = 64, HALF = 128, HTB = HALF * BK * 2  , STAGE_BYTES = 8 * HTB, NXCD = 8, WGM = 8;

__host__ __device__ __forceinline__ int lds_byte(int r, int c) { const int st = (r >> 4) * 2 + (c >> 5), rr = r & 15, cc = c & 31, ob = rr * 64 + cc * 2; return st * 1024 + (ob ^ (((ob >> 9) & 1) << 5)); }
__host__ __device__ __forceinline__ void stage_rc(int b, int& R, int& C) { const int st = b / 1024, sb = b % 1024, swz = sb ^ (((sb >> 9) & 1) << 5); R = (st >> 1) * 16 + swz / 64; C = (st & 1) * 32 + (swz % 64) / 2; }
__host__ __device__ __forceinline__ int perm32(int rho) { const int n = rho >> 4, i = rho & 15; return 8 * (i >> 2) + 4 * n + (i & 3); }

struct Unit { int pm, pn, x0, x1, rb; };
struct Gemm { const bf16_t* A; const bf16_t* Bt; int M, N, K; const int* rows; };

struct StaticOrder {
    int nM, nN, nwg, G, c, wgm;
    __host__ __device__ void init(int M, int N, int G_, int c_, int wgm_ = WGM) { nM = M / BM; nN = N / BM; nwg = nM * nN; G = G_; c = c_; wgm = wgm_; }
    __host__ __device__ bool next(int i, Unit& u) const {
        const long L = (long)i * G + c; if (L >= nwg) return false;
        int wgid = (int)L; { const int q = nwg / NXCD, r = nwg % NXCD, xcd = wgid % NXCD, off = wgid / NXCD; wgid = (xcd < r ? xcd * (q + 1) : r * (q + 1) + (xcd - r) * q) + off; }
        const int nig = wgm * nN, gid = wgid / nig, fm = gid * wgm, gsz = (nM - fm) < wgm ? (nM - fm) : wgm;
        u.pm = fm + ((wgid % nig) % gsz); u.pn = (wgid % nig) / gsz; u.x0 = 0; u.x1 = u.pn; u.rb = 0; return true;
    }
    __device__ __forceinline__ void a_ready(const Unit&) const {}
    __device__ __forceinline__ void done(const Unit&) const {}
};


template <class Epi, class Sched, bool ALIGN_EPI = false, bool SP2 = false, bool GATHER = false, int BAUX = 0>
__device__ __forceinline__ void gemm_phase(PG8_LAS unsigned char* lds, const Gemm g, const Sched& S, const Epi& E) {
    int tid_ = threadIdx.x; asm volatile("" : "+v"(tid_));
    const int tid = tid_, wid = __builtin_amdgcn_readfirstlane(tid >> 6), lane = tid & 63, wr = wid >> 2, wc = wid & 3, fr = lane & 15, fq = lane >> 4;
    const int K = g.K, nt = K / BK;
    unsigned voffA[2], voffB[2]; int gR[2]; unsigned gC2[2];
#pragma unroll
    for (int i = 0; i < 2; ++i) { int R, C; stage_rc(tid * 16 + i * 8192, R, C); const int Rb = Epi::PERM ? ((R & ~31) + perm32(R & 31)) : R;
        voffA[i] = (unsigned)(R * K + C) * 2u; voffB[i] = (unsigned)(Rb * K + C) * 2u; gR[i] = R; gC2[i] = (unsigned)C * 2u; }
    static_assert(!GATHER || SP2, "GATHER is implemented for the SP2 loop only");
    unsigned gcur[2][2], gnxt[2][2]; int graw[4];
#define PG8_STAGE_A(bufoff, kptr, ktile, h, use_next) do { if constexpr (GATHER) { const unsigned sv_[2] = {(use_next) ? gnxt[h][0] : gcur[h][0], (use_next) ? gnxt[h][1] : gcur[h][1]}; \
        PG8_STAGE(bufoff, gA0 + (size_t)(ktile) * kstep, sv_); } else { PG8_STAGE(bufoff, (kptr) + ((h) ? hstep : 0), voffA); } } while (0)
    const size_t kstep = (size_t)(BK * 2);
    const size_t hstep = (size_t)HALF * K * 2;
    const size_t tstep = 2 * hstep;
    const unsigned ldsw = (unsigned)wid * 1024u;
    const int aoff = lds_byte(wr * 64 + fr, fq * 8), boff = lds_byte(wc * 32 + fr, fq * 8);
#define PG8_SA(b, h) (((b) * 2 + (h)) * HTB)
#define PG8_SB(b, h) ((4 + (b) * 2 + (h)) * HTB)
#define PG8_STAGE(bufoff, gbase, voff) do { _Pragma("unroll") for (int _i = 0; _i < 2; ++_i) \
        __builtin_amdgcn_global_load_lds((const unsigned*)((const char*)(gbase) + (voff)[_i]), (PG8_LAS unsigned*)(lds + (bufoff) + ldsw + _i * 8192), 16, 0, 0); } while (0)
#define PG8_STAGE_B(bufoff, gbase, voff) do { _Pragma("unroll") for (int _i = 0; _i < 2; ++_i) \
        __builtin_amdgcn_global_load_lds((const unsigned*)((const char*)(gbase) + (voff)[_i]), (PG8_LAS unsigned*)(lds + (bufoff) + ldsw + _i * 8192), 16, 0, BAUX); } while (0)
#define PG8_LDA(dst, b, h) do { _Pragma("unroll") for (int m = 0; m < 4; ++m) _Pragma("unroll") for (int k = 0; k < 2; ++k) dst[m][k] = *(const PG8_LAS bf16x8*)(lds + PG8_SA(b, h) + aoff + m * 2048 + k * 1024); } while (0)
#define PG8_LDB(dst, b, h) do { _Pragma("unroll") for (int n = 0; n < 2; ++n) _Pragma("unroll") for (int k = 0; k < 2; ++k) dst[n][k] = *(const PG8_LAS bf16x8*)(lds + PG8_SB(b, h) + boff + n * 2048 + k * 1024); } while (0)
#define PG8_MMA(ai, bj, At, Bt) do { __builtin_amdgcn_s_setprio(1); _Pragma("unroll") for (int m = 0; m < 4; ++m) _Pragma("unroll") for (int n = 0; n < 2; ++n) _Pragma("unroll") for (int k = 0; k < 2; ++k) \
        acc[ai][bj][m][n] = __builtin_amdgcn_mfma_f32_16x16x32_bf16(Bt[n][k], At[m][k], acc[ai][bj][m][n], 0, 0, 0); __builtin_amdgcn_s_setprio(0); } while (0)
#define PG8_WAIT_V(n) asm volatile("s_waitcnt vmcnt(" #n ")" ::: "memory")
#define PG8_WAIT_L(n) asm volatile("s_waitcnt lgkmcnt(" #n ")" ::: "memory")
#define PG8_BAR __builtin_amdgcn_s_barrier()
#define PG8_SCHED __builtin_amdgcn_sched_barrier(0)
    Unit cur, nxt; int ui = 0;
    if (!S.next(0, cur)) return;
    f32x4 acc[2][2][4][2];
#pragma unroll
    for (int a = 0; a < 2; ++a)
#pragma unroll
        for (int b = 0; b < 2; ++b)
#pragma unroll
            for (int m = 0; m < 4; ++m)
#pragma unroll
                for (int n = 0; n < 2; ++n) acc[a][b][m][n] = (f32x4){0.f, 0.f, 0.f, 0.f};
    bf16x8 At[4][2], B0[2][2], B1[2][2];
    const char* cA = (const char*)g.A + (size_t)cur.pm * tstep; const char* cB = (const char*)g.Bt + (size_t)cur.pn * tstep;
    const char* const gA0 = (const char*)g.A;
    if constexpr (GATHER) {
#pragma unroll
        for (int h = 0; h < 2; ++h)
#pragma unroll
            for (int i = 0; i < 2; ++i) { gcur[h][i] = (unsigned)g.rows[cur.rb + h * HALF + gR[i]] * (unsigned)(K * 2) + gC2[i]; gnxt[h][i] = gcur[h][i]; } }
    S.a_ready(cur);
    if constexpr (SP2) {
        PG8_STAGE_B(PG8_SB(0, 0), cB, voffB); PG8_STAGE_B(PG8_SB(0, 1), cB + hstep, voffB); PG8_STAGE_A(PG8_SA(0, 0), cA, 0, 0, false); PG8_STAGE_A(PG8_SA(0, 1), cA, 0, 1, false);
        if (wr == 1) PG8_BAR;
        PG8_WAIT_V(2); PG8_BAR;
        PG8_STAGE_B(PG8_SB(1, 0), cB + kstep, voffB); PG8_STAGE_A(PG8_SA(1, 0), cA + kstep, 1, 0, false); PG8_STAGE_B(PG8_SB(1, 1), cB + hstep + kstep, voffB);
        PG8_WAIT_V(6); PG8_BAR;
    } else {
        PG8_STAGE_B(PG8_SB(0, 0), cB, voffB); PG8_STAGE(PG8_SA(0, 0), cA, voffA); PG8_STAGE_B(PG8_SB(0, 1), cB + hstep, voffB); PG8_STAGE(PG8_SA(0, 1), cA + hstep, voffA);
        if (wr == 1) PG8_BAR;
        PG8_WAIT_V(4); PG8_BAR;
        PG8_STAGE_B(PG8_SB(1, 0), cB + kstep, voffB); PG8_STAGE(PG8_SA(1, 0), cA + kstep, voffA); PG8_STAGE_B(PG8_SB(1, 1), cB + hstep + kstep, voffB);
        PG8_WAIT_V(6); PG8_BAR;
    }
    for (;;) {
        const bool has_next = S.next(ui + 1, nxt);
        const char* nA = has_next ? (const char*)g.A + (size_t)nxt.pm * tstep : cA; const char* nB = has_next ? (const char*)g.Bt + (size_t)nxt.pn * tstep : cB;
        if constexpr (GATHER) { if (has_next) {
#pragma unroll
            for (int h = 0; h < 2; ++h)
#pragma unroll
                for (int i = 0; i < 2; ++i) asm volatile("global_load_dword %0, %1, off" : "=v"(graw[h * 2 + i]) : "v"(g.rows + (nxt.rb + h * HALF + gR[i])) : "memory"); } }
        for (int t = 0; t < nt; t += 2) {
            const bool last = (t == nt - 2);
            const char* a1 = cA + (size_t)(t + 1) * kstep;
            const char* a2 = last ? nA : cA + (size_t)(t + 2) * kstep; const char* b2 = last ? nB : cB + (size_t)(t + 2) * kstep;
            const char* a3 = a2 + kstep; const char* b3 = b2 + kstep;
            if (last && has_next) S.a_ready(nxt);
            if constexpr (GATHER) { if (last) { if (has_next) { asm volatile("" : "+v"(graw[0]), "+v"(graw[1]), "+v"(graw[2]), "+v"(graw[3]));
#pragma unroll
                    for (int h = 0; h < 2; ++h)
#pragma unroll
                        for (int i = 0; i < 2; ++i) gnxt[h][i] = (unsigned)graw[h * 2 + i] * (unsigned)(K * 2) + gC2[i]; }
                else {
#pragma unroll
                    for (int h = 0; h < 2; ++h)
#pragma unroll
                        for (int i = 0; i < 2; ++i) gnxt[h][i] = gcur[h][i]; } } }
            const int kt2 = last ? 0 : t + 2;
            if constexpr (SP2) {
            PG8_LDB(B0, 0, 0); PG8_LDB(B1, 0, 1); PG8_SCHED; PG8_LDA(At, 0, 0); PG8_STAGE_A(PG8_SA(1, 1), a1, t + 1, 1, false);
            PG8_WAIT_V(8); PG8_WAIT_L(0); PG8_BAR; PG8_MMA(0, 0, At, B0); PG8_MMA(0, 1, At, B1); PG8_BAR; PG8_SCHED;
            PG8_LDA(At, 0, 1); PG8_STAGE_B(PG8_SB(0, 0), b2, voffB); PG8_STAGE_B(PG8_SB(0, 1), b2 + hstep, voffB); PG8_STAGE_A(PG8_SA(0, 0), a2, kt2, 0, last);
            PG8_WAIT_V(8); PG8_WAIT_L(0); PG8_BAR; PG8_MMA(1, 0, At, B0); PG8_MMA(1, 1, At, B1); PG8_BAR; PG8_SCHED;
            PG8_LDB(B0, 1, 0); PG8_LDB(B1, 1, 1); PG8_SCHED; PG8_LDA(At, 1, 0); PG8_STAGE_A(PG8_SA(0, 1), a2, kt2, 1, last);
            PG8_WAIT_V(8); PG8_WAIT_L(0); PG8_BAR; PG8_MMA(0, 0, At, B0); PG8_MMA(0, 1, At, B1); PG8_BAR; PG8_SCHED;
            PG8_LDA(At, 1, 1); PG8_STAGE_B(PG8_SB(1, 0), b3, voffB); PG8_STAGE_B(PG8_SB(1, 1), b3 + hstep, voffB); PG8_STAGE_A(PG8_SA(1, 0), a3, kt2 + 1, 0, last);
            PG8_WAIT_V(8); PG8_WAIT_L(0); PG8_BAR; PG8_MMA(1, 0, At, B0); PG8_MMA(1, 1, At, B1); PG8_BAR; PG8_SCHED;
            } else {
            PG8_LDB(B0, 0, 0); PG8_SCHED; PG8_LDA(At, 0, 0); PG8_STAGE(PG8_SA(1, 1), a1 + hstep, voffA);
            PG8_WAIT_L(8); PG8_BAR; PG8_WAIT_L(0); PG8_MMA(0, 0, At, B0); PG8_BAR; PG8_SCHED;
            PG8_LDB(B1, 0, 1); PG8_STAGE_B(PG8_SB(0, 0), b2, voffB);
            PG8_BAR; PG8_WAIT_L(0); PG8_MMA(0, 1, At, B1); PG8_BAR;
            PG8_LDA(At, 0, 1); PG8_STAGE(PG8_SA(0, 0), a2, voffA);
            PG8_BAR; PG8_WAIT_L(0); PG8_MMA(1, 0, At, B0); PG8_BAR; PG8_SCHED;
            PG8_STAGE_B(PG8_SB(0, 1), b2 + hstep, voffB);
            PG8_WAIT_V(6); PG8_BAR; PG8_MMA(1, 1, At, B1); PG8_BAR;
            PG8_LDB(B0, 1, 0); PG8_SCHED; PG8_LDA(At, 1, 0); PG8_STAGE(PG8_SA(0, 1), a2 + hstep, voffA);
            PG8_WAIT_L(8); PG8_BAR; PG8_WAIT_L(0); PG8_MMA(0, 0, At, B0); PG8_BAR; PG8_SCHED;
            PG8_LDB(B1, 1, 1); PG8_STAGE_B(PG8_SB(1, 0), b3, voffB);
            PG8_BAR; PG8_WAIT_L(0); PG8_MMA(0, 1, At, B1); PG8_BAR;
            PG8_LDA(At, 1, 1); PG8_STAGE(PG8_SA(1, 0), a3, voffA);
            PG8_BAR; PG8_WAIT_L(0); PG8_MMA(1, 0, At, B0); PG8_BAR; PG8_SCHED;
            PG8_STAGE_B(PG8_SB(1, 1), b3 + hstep, voffB);
            PG8_WAIT_V(6); PG8_BAR; PG8_MMA(1, 1, At, B1); PG8_BAR;
            }
        }
        if constexpr (ALIGN_EPI) { if (wr == 0) PG8_BAR; }
        if constexpr (!Epi::AFTER_DRAIN) { E(acc, cur, wr, wc, fr, fq); S.done(cur); }
        if (!has_next) break;
        if (!E.keep_acc(cur)) {
#pragma unroll
        for (int a = 0; a < 2; ++a)
#pragma unroll
            for (int b = 0; b < 2; ++b)
#pragma unroll
                for (int m = 0; m < 4; ++m)
#pragma unroll
                    for (int n = 0; n < 2; ++n) acc[a][b][m][n] = (f32x4){0.f, 0.f, 0.f, 0.f};
        }
        cur = nxt; cA = nA; cB = nB; ++ui;
        if constexpr (GATHER) {
#pragma unroll
            for (int h = 0; h < 2; ++h)
#pragma unroll
                for (int i = 0; i < 2; ++i) gcur[h][i] = gnxt[h][i]; }
        if constexpr (ALIGN_EPI) { if (wr == 1) PG8_BAR; }
    }
    PG8_WAIT_V(0);
    if constexpr (!ALIGN_EPI) { if (wr == 0) PG8_BAR; }
    PG8_BAR;
    if constexpr (Epi::AFTER_DRAIN) { E.fused(acc, cur, wr, wc, fr, fq, lds, wid, lane); S.done(cur); }
#undef PG8_SA
#undef PG8_SB
#undef PG8_STAGE
#undef PG8_STAGE_B
#undef PG8_STAGE_A
#undef PG8_LDA
#undef PG8_LDB
#undef PG8_MMA
#undef PG8_WAIT_V
#undef PG8_WAIT_L
#undef PG8_BAR
#undef PG8_SCHED
}
}
typedef unsigned short bf16;
typedef unsigned v4u __attribute__((ext_vector_type(4)));
typedef unsigned v2u __attribute__((ext_vector_type(2)));
typedef float f32x4 __attribute__((ext_vector_type(4)));
typedef short bf16x8 __attribute__((ext_vector_type(8)));
#define MFMA16(a, b, c) __builtin_amdgcn_mfma_f32_16x16x32_bf16((a), (b), (c), 0, 0, 0)
__device__ __forceinline__ bf16x8 as_frag(const v4u& x) { return __builtin_bit_cast(bf16x8, x); }
#define LDS_WAIT() asm volatile("s_waitcnt lgkmcnt(0)" ::: "memory")
#define VM_WAIT() asm volatile("s_waitcnt vmcnt(0)" ::: "memory")
typedef float cvt_f32x2 __attribute__((ext_vector_type(2)));
typedef __bf16 cvt_bf16x2 __attribute__((ext_vector_type(2)));
__device__ __forceinline__ unsigned cvt_pk_bf16(float lo, float hi) { const cvt_f32x2 v = {lo, hi}; return __builtin_bit_cast(unsigned, __builtin_convertvector(v, cvt_bf16x2)); }
__device__ __forceinline__ v4u ldnt4(const void* p) { return __builtin_nontemporal_load((const v4u*)p); }
__device__ __forceinline__ v2u ldnt2(const void* p) { return __builtin_nontemporal_load((const v2u*)p); }
__device__ __forceinline__ float bf_lo(unsigned u) { return __uint_as_float(u << 16); }
__device__ __forceinline__ float bf_hi(unsigned u) { return __uint_as_float(u & 0xffff0000u); }

template <bool NT = false>
__device__ __forceinline__ void tr_item(const float* __restrict__ src, int ldn, int k0, int nsrc0, bf16* dst, int K, int ndst0, LAS float* scr, int lane) {
    const int c4 = (lane & 15) * 4, kr = lane >> 4;
#pragma unroll 4
    for (int i = 0; i < 16; ++i) { const int kk = 4 * i + kr; const f32x4* gp = (const f32x4*)(src + (size_t)(k0 + kk) * ldn + nsrc0 + c4); const f32x4 v = NT ? __builtin_nontemporal_load(gp) : *gp;
        LAS float* s = scr + kk * 65 + c4; s[0] = v[0]; s[1] = v[1]; s[2] = v[2]; s[3] = v[3]; }
    LDS_WAIT();
    const int kc = lane & 7, nr = lane >> 3;
#pragma unroll
    for (int jj = 0; jj < 8; ++jj) { const int n = 8 * jj + nr; const LAS float* s = scr + (8 * kc) * 65 + n;
        v4u o; o.x = cvt_pk_bf16(s[0], s[65]); o.y = cvt_pk_bf16(s[130], s[195]); o.z = cvt_pk_bf16(s[260], s[325]); o.w = cvt_pk_bf16(s[390], s[455]);
        v4u* dp = (v4u*)(dst + (size_t)(ndst0 + n) * K + k0 + 8 * kc); if (NT) __builtin_nontemporal_store(o, dp); else *dp = o; }
    LDS_WAIT();
}
__device__ __forceinline__ void p_convert_moe(const Ctx& c, const float* w_gate_up, const float* w_down, bf16* Wgu_t, bf16* Wd_t) {
    LAS float* scr = (LAS float*)c.lds + c.wave * (64 * 65);
    constexpr int I_GU = NE * 16 * 32, I_D = NE * 16 * 16;
    for (int it = c.bid * NWAVES + c.wave; it < I_GU + I_D; it += c.nb * NWAVES) {
        if (it < I_GU) { const int e = it >> 9, r = it & 511, kb = r >> 5, nbk = r & 31, R0 = nbk * 64, pn = R0 >> 8, rr = R0 & 255, bj = rr >> 7, j0 = rr & 127;
            tr_item<true>(w_gate_up + (size_t)e * D * 2 * DFF, 2 * DFF, kb * 64, bj * DFF + 128 * pn + j0, Wgu_t + (size_t)e * 2 * DFF * D, D, R0, scr, c.lane); }
        else { const int r2 = it - I_GU, e = r2 >> 8, r = r2 & 255, kb = r >> 4, nbk = r & 15;
            tr_item<true>(w_down + (size_t)e * DFF * D, D, kb * 64, nbk * 64, Wd_t + (size_t)e * D * DFF, DFF, nbk * 64, scr, c.lane); }
    }
}

__device__ __forceinline__ float f4c(const float4& v, int i) { return i == 0 ? v.x : (i == 1 ? v.y : (i == 2 ? v.z : v.w)); }
__device__ __forceinline__ void p_router(const Ctx& c, const float* __restrict__ X1, const float* __restrict__ g2, const float* __restrict__ wr, const float* __restrict__ br, bf16* __restrict__ H2, int* __restrict__ slot_e, int* __restrict__ slot_pos, int* __restrict__ elist, float* __restrict__ ewgt, unsigned* gcnt, int reps = 1) {
    LAS f32x4* WL = (LAS f32x4*)c.lds;
    LAS float* LG = (LAS float*)(c.lds0 + EXTRA_OFF);
    LAS int* HIST = (LAS int*)(c.lds0 + EXTRA_OFF + 8192);
    LAS int* BASE = HIST + 32;
    LAS int* SELE = BASE + 32;
    LAS int* SELR = SELE + 256;
    LAS float* SELW = (LAS float*)(SELR + 256);
    const int lane = c.lane;
    { f32x4 wv[16];
#pragma unroll
      for (int i = 0; i < 16; ++i) wv[i] = ((const f32x4*)wr)[c.tid + NTHR * i];
#pragma unroll
      for (int i = 0; i < 16; ++i) { const int idx = c.tid + NTHR * i, k = idx >> 3, q = idx & 7, l = (k & 255) >> 2, cc = k & 3, j = k >> 8; WL[((j * 4 + cc) * 8 + q) * 64 + l] = wv[i]; } }
    lds_barrier();
    for (int blk = c.bid; blk < NTOK / 64; blk += c.nb) {
        if (c.tid < 32) HIST[c.tid] = 0;
        lds_barrier();
        for (int pp = 0; pp < 4 * reps; ++pp) { const int p = pp & 3;
            const size_t t0 = (size_t)blk * 64 + c.wave * 8 + 2 * p;
            float4 xa[4], xb[4]; float sa = 0.f, sb = 0.f;
#pragma unroll
            for (int j = 0; j < 4; ++j) { xa[j] = ((const float4*)(X1 + t0 * D))[lane + 64 * j]; xb[j] = ((const float4*)(X1 + (t0 + 1) * D))[lane + 64 * j];
                sa += xa[j].x * xa[j].x + xa[j].y * xa[j].y + xa[j].z * xa[j].z + xa[j].w * xa[j].w; sb += xb[j].x * xb[j].x + xb[j].y * xb[j].y + xb[j].z * xb[j].z + xb[j].w * xb[j].w; }
            const float ra = rsqrtf(wave_sum(sa) * (1.f / D) + RMS_EPS), rb = rsqrtf(wave_sum(sb) * (1.f / D) + RMS_EPS);
#pragma unroll
            for (int j = 0; j < 4; ++j) { const float4 g = ((const float4*)g2)[lane + 64 * j];
                xa[j].x *= ra * g.x; xa[j].y *= ra * g.y; xa[j].z *= ra * g.z; xa[j].w *= ra * g.w; xb[j].x *= rb * g.x; xb[j].y *= rb * g.y; xb[j].z *= rb * g.z; xb[j].w *= rb * g.w;
                v2u oa, ob; oa.x = cvt_pk_bf16(xa[j].x, xa[j].y); oa.y = cvt_pk_bf16(xa[j].z, xa[j].w); ob.x = cvt_pk_bf16(xb[j].x, xb[j].y); ob.y = cvt_pk_bf16(xb[j].z, xb[j].w);
                ((v2u*)(H2 + t0 * D))[lane + 64 * j] = oa; ((v2u*)(H2 + (t0 + 1) * D))[lane + 64 * j] = ob; }
            float acc[64];
#pragma unroll
            for (int i = 0; i < 64; ++i) acc[i] = 0.f;
#pragma unroll
            for (int j = 0; j < 4; ++j)
#pragma unroll
                for (int cc = 0; cc < 4; ++cc) { const float ha = f4c(xa[j], cc), hb = f4c(xb[j], cc);
#pragma unroll
                    for (int q = 0; q < 8; ++q) { const f32x4 w = WL[((j * 4 + cc) * 8 + q) * 64 + lane];
                        acc[4 * q + 0] = fmaf(ha, w.x, acc[4 * q + 0]); acc[4 * q + 1] = fmaf(ha, w.y, acc[4 * q + 1]); acc[4 * q + 2] = fmaf(ha, w.z, acc[4 * q + 2]); acc[4 * q + 3] = fmaf(ha, w.w, acc[4 * q + 3]);
                        acc[32 + 4 * q + 0] = fmaf(hb, w.x, acc[32 + 4 * q + 0]); acc[32 + 4 * q + 1] = fmaf(hb, w.y, acc[32 + 4 * q + 1]); acc[32 + 4 * q + 2] = fmaf(hb, w.z, acc[32 + 4 * q + 2]); acc[32 + 4 * q + 3] = fmaf(hb, w.w, acc[32 + 4 * q + 3]); } }
            BFLY_SW32(acc, 64) BFLY_SW16(acc, 32) BFLY_DPP(acc, 16, 8, dpp_ror8) BFLY_DPP(acc, 8, 4, dpp_xor4) BFLY_DPP(acc, 4, 2, dpp_xor2) BFLY_DPP(acc, 2, 1, dpp_xor1)
            LG[(c.wave * 8 + 2 * p + (lane >> 5)) * 32 + (lane & 31)] = acc[0] + br[lane & 31];
        }
        LDS_WAIT();
        if (lane < 8) {
            const int tokl = c.wave * 8 + lane;
            float l[NE];
#pragma unroll
            for (int j = 0; j < NE; ++j) l[j] = LG[tokl * 32 + j];
            int sel[4]; float sv[4];
#pragma unroll
            for (int k = 0; k < 4; ++k) { int bi = 0; float bv = -INFINITY;
#pragma unroll
                for (int j = 0; j < NE; ++j) { const bool better = l[j] > bv; bv = better ? l[j] : bv; bi = better ? j : bi; }
                sel[k] = bi; sv[k] = bv;
#pragma unroll
                for (int j = 0; j < NE; ++j) l[j] = (j == bi) ? -INFINITY : l[j]; }
            float den = 0.f, ex[4];
#pragma unroll
            for (int k = 0; k < 4; ++k) { ex[k] = expf(sv[k] - sv[0]); den += ex[k]; }
            const float inv = 1.f / den;
#pragma unroll
            for (int k = 0; k < 4; ++k) { SELE[tokl * 4 + k] = sel[k]; SELW[tokl * 4 + k] = ex[k] * inv; SELR[tokl * 4 + k] = atomicAdd((int*)(HIST + sel[k]), 1); }
        }
        lds_barrier();
        if (c.tid < 32) BASE[c.tid] = (int)__hip_atomic_fetch_add(gcnt + c.tid, (unsigned)HIST[c.tid], __ATOMIC_RELAXED, __HIP_MEMORY_SCOPE_AGENT);
        lds_barrier();
        if (c.tid < 256) { const int gi = blk * 256 + c.tid, e = SELE[c.tid], pos = BASE[e] + SELR[c.tid]; slot_e[gi] = e; slot_pos[gi] = pos; elist[e * NTOK + pos] = gi >> 2; ewgt[e * NTOK + pos] = SELW[c.tid]; }
    }
}

__device__ __forceinline__ void p_build_wrt(const Ctx& c, const float* __restrict__ wr, bf16* __restrict__ WrT) {
    for (int i = c.bid * NTHR + c.tid; i < NE * D; i += c.nb * NTHR) { const int e = i >> 10, k = i & 1023; const float w = wr[k * NE + e];
        const unsigned hi = cvt_pk_bf16(w, 0.f) & 0xffffu; const float rem = w - __uint_as_float(hi << 16);
        WrT[e * D + k] = (bf16)hi; WrT[NE * D + e * D + k] = (bf16)(cvt_pk_bf16(rem, 0.f) & 0xffffu); }
}
__device__ __forceinline__ void p_router2(const Ctx& c, const float* __restrict__ X1, const float* __restrict__ g2, const bf16* __restrict__ WrT, const float* __restrict__ br, bf16* __restrict__ H2,
                                          int* __restrict__ slot_e, int* __restrict__ slot_pos, int* __restrict__ elist, float* __restrict__ ewgt, unsigned* gcnt) {
    LAS unsigned char* HH = c.lds; LAS unsigned char* HL = c.lds + 65536;
    LAS float* LG = (LAS float*)(c.lds0 + EXTRA_OFF);
    LAS float* PART = LG + 1024;
    LAS int* HIST = (LAS int*)(PART + 1024);
    LAS int* BASE = HIST + 32; LAS int* SELE = BASE + 32; LAS int* SELR = SELE + 128; LAS float* SELW = (LAS float*)(SELR + 128);
    const int lane = c.lane, w = c.wave, fr = lane & 15, fq = lane >> 4;
    for (int blk = c.bid; blk < NTOK / 32; blk += c.nb) {
        if (c.tid < 32) HIST[c.tid] = 0;
#pragma unroll 1
        for (int p = 0; p < 2; ++p) {
            const int tl = w * 4 + 2 * p; const size_t t0 = (size_t)blk * 32 + tl;
            float4 xa[4], xb[4]; float sa = 0.f, sb = 0.f;
#pragma unroll
            for (int j = 0; j < 4; ++j) { xa[j] = ((const float4*)(X1 + t0 * D))[lane + 64 * j]; xb[j] = ((const float4*)(X1 + (t0 + 1) * D))[lane + 64 * j];
                sa += xa[j].x * xa[j].x + xa[j].y * xa[j].y + xa[j].z * xa[j].z + xa[j].w * xa[j].w; sb += xb[j].x * xb[j].x + xb[j].y * xb[j].y + xb[j].z * xb[j].z + xb[j].w * xb[j].w; }
            const float ra = rsqrtf(wave_sum(sa) * (1.f / D) + RMS_EPS), rb = rsqrtf(wave_sum(sb) * (1.f / D) + RMS_EPS);
#pragma unroll
            for (int j = 0; j < 4; ++j) { const float4 g = ((const float4*)g2)[lane + 64 * j];
                const float ha[4] = {xa[j].x * ra * g.x, xa[j].y * ra * g.y, xa[j].z * ra * g.z, xa[j].w * ra * g.w}, hb[4] = {xb[j].x * rb * g.x, xb[j].y * rb * g.y, xb[j].z * rb * g.z, xb[j].w * rb * g.w};
                v2u ah, al, bh, bl;
                ah.x = cvt_pk_bf16(ha[0], ha[1]); ah.y = cvt_pk_bf16(ha[2], ha[3]); bh.x = cvt_pk_bf16(hb[0], hb[1]); bh.y = cvt_pk_bf16(hb[2], hb[3]);
                al.x = cvt_pk_bf16(ha[0] - bf_lo(ah.x), ha[1] - bf_hi(ah.x)); al.y = cvt_pk_bf16(ha[2] - bf_lo(ah.y), ha[3] - bf_hi(ah.y));
                bl.x = cvt_pk_bf16(hb[0] - bf_lo(bh.x), hb[1] - bf_hi(bh.x)); bl.y = cvt_pk_bf16(hb[2] - bf_lo(bh.y), hb[3] - bf_hi(bh.y));
                ((v2u*)(H2 + t0 * D))[lane + 64 * j] = ah; ((v2u*)(H2 + (t0 + 1) * D))[lane + 64 * j] = bh;
                const int ch = (lane >> 1) + 32 * j, h8 = 8 * (lane & 1);
                const int oa = tl * 2048 + 16 * (ch ^ (tl & 15)) + h8, ob = (tl + 1) * 2048 + 16 * (ch ^ ((tl + 1) & 15)) + h8;
                *(LAS v2u*)(HH + oa) = ah; *(LAS v2u*)(HL + oa) = al; *(LAS v2u*)(HH + ob) = bh; *(LAS v2u*)(HL + ob) = bl; }
        }
        lds_barrier();
        { const int mt = w & 1, nt = (w >> 1) & 1, kh = w >> 2, tok = 16 * mt + fr; f32x4 acc = {0.f, 0.f, 0.f, 0.f};
            const bf16* wh = WrT + (size_t)(16 * nt + fr) * D + 8 * fq; const bf16* wl = wh + NE * D;
#pragma unroll 4
            for (int kk = 16 * kh; kk < 16 * kh + 16; ++kk) { const int off = tok * 2048 + 16 * ((4 * kk + fq) ^ (tok & 15));
                const bf16x8 ahi = *(const LAS bf16x8*)(HH + off), alo = *(const LAS bf16x8*)(HL + off);
                const bf16x8 bhi = as_frag(*(const v4u*)(wh + 32 * kk)), blo = as_frag(*(const v4u*)(wl + 32 * kk));
                acc = MFMA16(ahi, bhi, acc); acc = MFMA16(ahi, blo, acc); acc = MFMA16(alo, bhi, acc); }
            if (kh == 1) *(LAS f32x4*)(PART + ((mt * 2 + nt) * 64 + lane) * 4) = acc;
            lds_barrier();
            if (kh == 0) { const f32x4 pr = *(const LAS f32x4*)(PART + ((mt * 2 + nt) * 64 + lane) * 4); const float bb = br[16 * nt + fr];
#pragma unroll
                for (int r = 0; r < 4; ++r) LG[(16 * mt + 4 * fq + r) * 32 + 16 * nt + fr] = acc[r] + pr[r] + bb; } }
        lds_barrier();
        if (c.tid < 32) {
            const int tokl = c.tid;
            float l[NE];
#pragma unroll
            for (int j = 0; j < NE; ++j) l[j] = LG[tokl * 32 + j];
            int sel[4]; float sv[4];
#pragma unroll
            for (int k = 0; k < 4; ++k) { int bi = 0; float bv = -INFINITY;
#pragma unroll
                for (int j = 0; j < NE; ++j) { const bool better = l[j] > bv; bv = better ? l[j] : bv; bi = better ? j : bi; }
                sel[k] = bi; sv[k] = bv;
#pragma unroll
                for (int j = 0; j < NE; ++j) l[j] = (j == bi) ? -INFINITY : l[j]; }
            float den = 0.f, ex[4];
#pragma unroll
            for (int k = 0; k < 4; ++k) { ex[k] = expf(sv[k] - sv[0]); den += ex[k]; }
            const float inv = 1.f / den;
#pragma unroll
            for (int k = 0; k < 4; ++k) { SELE[tokl * 4 + k] = sel[k]; SELW[tokl * 4 + k] = ex[k] * inv; SELR[tokl * 4 + k] = atomicAdd((int*)(HIST + sel[k]), 1); }
        }
        lds_barrier();
        if (c.tid < 32) BASE[c.tid] = (int)__hip_atomic_fetch_add(gcnt + c.tid, (unsigned)HIST[c.tid], __ATOMIC_RELAXED, __HIP_MEMORY_SCOPE_AGENT);
        lds_barrier();
        if (c.tid < 128) { const int gi = blk * 128 + c.tid, e = SELE[c.tid], pos = BASE[e] + SELR[c.tid]; slot_e[gi] = e; slot_pos[gi] = pos; elist[e * NTOK + pos] = gi >> 2; ewgt[e * NTOK + pos] = SELW[c.tid]; }
        lds_barrier();
    }
}

struct MoeOrder {
    int nM, nN, nwg, G, c, wgm; const LAS unsigned char* tile_e; const LAS int* tile_b;
    __device__ __forceinline__ void init(int nM_, int nN_, int G_, int c_, const LAS unsigned char* te, const LAS int* tb, int wgm_ = pg8::WGM) { nM = nM_; nN = nN_; nwg = nM * nN; G = G_; c = c_; tile_e = te; tile_b = tb; wgm = wgm_; }
    __device__ __forceinline__ bool next(int i, pg8::Unit& u) const {
        const long L = (long)i * G + c; if (L >= nwg) return false;
        int wgid = (int)L; { const int q = nwg / pg8::NXCD, r = nwg % pg8::NXCD, xcd = wgid % pg8::NXCD, off = wgid / pg8::NXCD; wgid = (xcd < r ? xcd * (q + 1) : r * (q + 1) + (xcd - r) * q) + off; }
        const int nig = wgm * nN, gid = wgid / nig, fm = gid * wgm, gsz = (nM - fm) < wgm ? (nM - fm) : wgm;
        const int pm = fm + ((wgid % nig) % gsz), pnl = (wgid % nig) / gsz;
        const int e = __builtin_amdgcn_readfirstlane((int)tile_e[pm]);
        u.pm = pm; u.pn = e * nN + pnl; u.x0 = e; u.x1 = pnl; u.rb = e * NTOK + (pm - __builtin_amdgcn_readfirstlane(tile_b[e])) * 256; return true;
    }
    __device__ __forceinline__ void a_ready(const pg8::Unit&) const {}
    __device__ __forceinline__ void done(const pg8::Unit&) const {}
};
__device__ __forceinline__ void build_tile_table(const Ctx& c, const unsigned* gcnt, LAS unsigned char* tile_e, LAS int* ntiles, LAS int* tile_b) {
    if (c.tid == 0) { int tb = 0; for (int e = 0; e < NE; ++e) { const int nt = ((int)gcnt[e] + 255) >> 8; tile_b[e] = tb; for (int i = 0; i < nt; ++i) tile_e[tb + i] = (unsigned char)e; tb += nt; } tile_b[NE] = tb; ntiles[0] = tb; }
    lds_barrier();
}

struct EpiSwiglu {
    static constexpr bool PERM = true, AFTER_DRAIN = false;
    bf16* O; const float* bias;
    __device__ __forceinline__ bool keep_acc(const pg8::Unit&) const { return false; }
    __device__ __forceinline__ void operator()(const f32x4 (&acc)[2][2][4][2], const pg8::Unit& u, int wr, int wc, int fr, int fq) const {
        const int row0 = u.pm * 256 + wr * 64 + fr, col0 = u.x1 * 128 + wc * 32 + 8 * fq;
        const float* bg = bias + (size_t)u.x0 * 2 * DFF + col0; const float* bl = bg + DFF;
        f32x4 bgv[2], blv[2];
#pragma unroll
        for (int n = 0; n < 2; ++n) { bgv[n] = *(const f32x4*)(bg + 4 * n); blv[n] = *(const f32x4*)(bl + 4 * n); }
#pragma unroll
        for (int ai = 0; ai < 2; ++ai)
#pragma unroll
            for (int m = 0; m < 4; ++m) { bf16* rowp = O + (size_t)(row0 + ai * 128 + m * 16) * DFF + col0; float a[8];
#pragma unroll
                for (int n = 0; n < 2; ++n) { const f32x4 g = acc[ai][0][m][n] + bgv[n], l = acc[ai][1][m][n] + blv[n];
#pragma unroll
                    for (int i = 0; i < 4; ++i) { const float xg = fminf(g[i], 7.f), xl = fminf(fmaxf(l[i], -7.f), 7.f);
                        a[4 * n + i] = xg * __builtin_amdgcn_rcpf(1.f + __expf(-1.702f * xg)) * (xl + 1.f); } }
                v4u w; w.x = cvt_pk_bf16(a[0], a[1]); w.y = cvt_pk_bf16(a[2], a[3]); w.z = cvt_pk_bf16(a[4], a[5]); w.w = cvt_pk_bf16(a[6], a[7]);
                *(v4u*)rowp = w; }
    }
};
struct EpiDown {
    static constexpr bool PERM = true, AFTER_DRAIN = false;
    bf16* O; const float* bias; const float* roww;
    __device__ __forceinline__ bool keep_acc(const pg8::Unit&) const { return false; }
    __device__ __forceinline__ void operator()(const f32x4 (&acc)[2][2][4][2], const pg8::Unit& u, int wr, int wc, int fr, int fq) const {
        const int row0 = u.pm * 256 + wr * 64 + fr, col0 = u.x1 * 256 + wc * 32 + 8 * fq;
        const float* bp = bias + (size_t)u.x0 * D + col0;
        f32x4 bv[2][2];
#pragma unroll
        for (int bj = 0; bj < 2; ++bj)
#pragma unroll
            for (int n = 0; n < 2; ++n) bv[bj][n] = *(const f32x4*)(bp + bj * 128 + 4 * n);
#pragma unroll
        for (int ai = 0; ai < 2; ++ai)
#pragma unroll
            for (int m = 0; m < 4; ++m) { const int rl = wr * 64 + fr + ai * 128 + m * 16, row = u.pm * 256 + rl; const float w = roww[u.rb + rl]; bf16* rowp = O + (size_t)row * D + col0;
#pragma unroll
                for (int bj = 0; bj < 2; ++bj) { const f32x4 v0 = (acc[ai][bj][m][0] + bv[bj][0]) * w, v1 = (acc[ai][bj][m][1] + bv[bj][1]) * w;
                    v4u o; o.x = cvt_pk_bf16(v0[0], v0[1]); o.y = cvt_pk_bf16(v0[2], v0[3]); o.z = cvt_pk_bf16(v1[0], v1[1]); o.w = cvt_pk_bf16(v1[2], v1[3]);
                    *(v4u*)(rowp + bj * 128) = o; } }
    }
};

__device__ __forceinline__ void p_final(const Ctx& c, const float* __restrict__ X1, const bf16* __restrict__ Yb, const int* __restrict__ slot_e, const int* __restrict__ slot_pos, const unsigned* gcnt, const float* __restrict__ g, float* __restrict__ out, float pscale = 1.f) {
    LAS int* POFF = (LAS int*)(c.lds0 + EXTRA_OFF);
    if (c.tid == 0) { int s = 0; for (int e = 0; e < NE; ++e) { POFF[e] = s; s += (((int)gcnt[e] + 255) >> 8) << 8; } }
    lds_barrier();
#pragma unroll 2
    for (int t = c.bid * NWAVES + c.wave; t < NTOK; t += c.nb * NWAVES) {
        const int lane = c.lane; float4 v[4];
#pragma unroll
        for (int j = 0; j < 4; ++j) { const v4u xr = ldnt4((const v4u*)(X1 + (size_t)t * D) + lane + 64 * j); v[j] = make_float4(__uint_as_float(xr.x), __uint_as_float(xr.y), __uint_as_float(xr.z), __uint_as_float(xr.w)); }
#pragma unroll
        for (int k = 0; k < 4; ++k) { const int dst = POFF[slot_e[t * 4 + k]] + slot_pos[t * 4 + k];
#pragma unroll
            for (int j = 0; j < 4; ++j) { const v2u y = ldnt2((const v2u*)(Yb + (size_t)dst * D) + lane + 64 * j); v[j].x += bf_lo(y.x); v[j].y += bf_hi(y.x); v[j].z += bf_lo(y.y); v[j].w += bf_hi(y.y); } }
        float s = 0.f;
#pragma unroll
        for (int j = 0; j < 4; ++j) s += v[j].x * v[j].x + v[j].y * v[j].y + v[j].z * v[j].z + v[j].w * v[j].w;
        const float r = rsqrtf(wave_sum(s) * (1.f / D) + RMS_EPS) * pscale;
#pragma unroll
        for (int j = 0; j < 4; ++j) { const float4 gg = ((const float4*)g)[lane + 64 * j]; const f32x4 ov = {v[j].x * r * gg.x, v[j].y * r * gg.y, v[j].z * r * gg.z, v[j].w * r * gg.w}; __builtin_nontemporal_store(ov, (f32x4*)(out + (size_t)t * D) + lane + 64 * j); }
    }
}

constexpr int PJ = 5120;
typedef float f32x2 __attribute__((ext_vector_type(2)));
__device__ __forceinline__ f32x2 gelu_pk(f32x2 v) {
    const f32x2 av = __builtin_elementwise_abs(v), d = av * 0.2316418882f + 1.0f;
    f32x2 t; t.x = __builtin_amdgcn_rcpf(d.x); t.y = __builtin_amdgcn_rcpf(d.y);
    f32x2 q = t * 0.5307027145f + (-0.7265760135f); q = q * t + 0.7107068705f; q = q * t + (-0.142248368f); q = q * t + 0.127414796f; q = q * t;
    const f32x2 s = (v * v) * (-0.72134752044f);
    f32x2 e; e.x = __builtin_amdgcn_exp2f(s.x); e.y = __builtin_amdgcn_exp2f(s.y);
    const f32x2 m = v * (q * e), r = v - m;
    f32x2 o; o.x = v.x < 0.f ? m.x : r.x; o.y = v.y < 0.f ? m.y : r.y; return o;
}
__device__ __forceinline__ float fast_sigmoid(float x) { return __builtin_amdgcn_rcpf(1.f + __expf(-x)); }

__device__ __forceinline__ void p_convert_front(const Ctx& c, const float* w_in, const float* w_o_dn, const float* w_o_sg, const float* w_out, bf16* Win_t, bf16* Wo_t, bf16* Wout_t) {
    LAS float* scr = (LAS float*)c.lds + c.wave * (64 * 65);
    constexpr int I_IN = 16 * 80, I_O = 8 * 16, I_OUT = 16 * 16;
    for (int it = c.bid * NWAVES + c.wave; it < I_IN + 2 * I_O + I_OUT; it += c.nb * NWAVES) {
        int r = it;
        if (r < I_IN) { const int kb = r / 80, nbk = r % 80, n0 = nbk * 64; tr_item<true>(w_in, INC, kb * 64, n0 < 2048 ? n0 : n0 + 8, Win_t, D, n0, scr, c.lane); continue; } r -= I_IN;
        if (r < I_O) { const int kb = r / 16, nbk = r % 16; tr_item<true>(w_o_dn, D, kb * 64, nbk * 64, Wo_t, DNW, nbk * 64, scr, c.lane); continue; } r -= I_O;
        if (r < I_O) { const int kb = r / 16, nbk = r % 16; tr_item<true>(w_o_sg, D, kb * 64, nbk * 64, Wo_t + (size_t)D * DNW, SGW, nbk * 64, scr, c.lane); continue; } r -= I_O;
        { const int kb = r / 16, nbk = r % 16; tr_item<true>(w_out, D, kb * 64, nbk * 64, Wout_t, D, nbk * 64, scr, c.lane); }
    }
}
__device__ __forceinline__ void p_norm1(const Ctx& c, const float* __restrict__ x, const float* __restrict__ g1, const float* __restrict__ w_in, const float* __restrict__ a_log, const float* __restrict__ dt_bias, bf16* __restrict__ Hb, float* __restrict__ BG) {
    LAS f32x4* WB = (LAS f32x4*)c.lds;
    const int lane = c.lane;
    for (int idx = c.tid; idx < 2048; idx += NTHR) { const int k = idx >> 1, q = idx & 1; const f32x4 v = *(const f32x4*)(w_in + (size_t)k * INC + 2048 + 4 * q);
        const int l = (k & 255) >> 2, cc = k & 3, j = k >> 8; WB[((j * 4 + cc) * 2 + q) * 64 + l] = v; }
    lds_barrier();
#pragma unroll 2
    for (int t = c.bid * NWAVES + c.wave; t < NTOK; t += c.nb * NWAVES) {
        float4 xv[4]; float ss = 0.f;
#pragma unroll
        for (int j = 0; j < 4; ++j) { xv[j] = ((const float4*)(x + (size_t)t * D))[lane + 64 * j]; ss += xv[j].x * xv[j].x + xv[j].y * xv[j].y + xv[j].z * xv[j].z + xv[j].w * xv[j].w; }
        const float r = rsqrtf(wave_sum(ss) * (1.f / D) + RMS_EPS);
#pragma unroll
        for (int j = 0; j < 4; ++j) { const float4 g = ((const float4*)g1)[lane + 64 * j]; xv[j].x *= r * g.x; xv[j].y *= r * g.y; xv[j].z *= r * g.z; xv[j].w *= r * g.w;
            v2u o; o.x = cvt_pk_bf16(xv[j].x, xv[j].y); o.y = cvt_pk_bf16(xv[j].z, xv[j].w); ((v2u*)(Hb + (size_t)t * D))[lane + 64 * j] = o; }
        float acc[8];
#pragma unroll
        for (int i = 0; i < 8; ++i) acc[i] = 0.f;
#pragma unroll
        for (int j = 0; j < 4; ++j)
#pragma unroll
            for (int cc = 0; cc < 4; ++cc) { const float h = f4c(xv[j], cc);
#pragma unroll
                for (int q = 0; q < 2; ++q) { const f32x4 w = WB[((j * 4 + cc) * 2 + q) * 64 + lane];
                    acc[4 * q + 0] = fmaf(h, w.x, acc[4 * q + 0]); acc[4 * q + 1] = fmaf(h, w.y, acc[4 * q + 1]); acc[4 * q + 2] = fmaf(h, w.z, acc[4 * q + 2]); acc[4 * q + 3] = fmaf(h, w.w, acc[4 * q + 3]); } }
        BFLY_SW32(acc, 8) BFLY_SW16(acc, 4) BFLY_DPP(acc, 2, 8, dpp_ror8)
        float a0 = acc[0]; a0 += dpp_xor4(a0); a0 += dpp_xor2(a0); a0 += dpp_xor1(a0);
        const int idx = lane >> 3;
        if ((lane & 7) == 0) { float o;
            if (idx < 4) o = 1.f / (1.f + expf(-a0)); else { const int h = idx - 4; o = -expf(a_log[h]) * softplusf_(a0 + dt_bias[h]); }
            BG[(size_t)t * 8 + idx] = o; }
    }
}
struct EpiProj {
    static constexpr bool PERM = true, AFTER_DRAIN = false;
    bf16* O;
    __device__ __forceinline__ bool keep_acc(const pg8::Unit&) const { return false; }
    __device__ __forceinline__ void operator()(const f32x4 (&acc)[2][2][4][2], const pg8::Unit& u, int wr, int wc, int fr, int fq) const {
        const int row0 = u.pm * 256 + wr * 64 + fr, col0 = u.pn * 256 + wc * 32 + 8 * fq;
        const int act = (u.pn < 6) ? 0 : (u.pn < 8 ? 1 : (u.pn < 12 ? 2 : 0));
#pragma unroll
        for (int ai = 0; ai < 2; ++ai)
#pragma unroll
            for (int m = 0; m < 4; ++m) { bf16* rowp = O + (size_t)(row0 + ai * 128 + m * 16) * PJ + col0;
#pragma unroll
                for (int bj = 0; bj < 2; ++bj) { f32x4 v0 = acc[ai][bj][m][0], v1 = acc[ai][bj][m][1];
                    if (act == 1) {
#pragma unroll
                        for (int i = 0; i < 4; ++i) { v0[i] = v0[i] * fast_sigmoid(v0[i]); v1[i] = v1[i] * fast_sigmoid(v1[i]); } }
                    else if (act == 2) { const f32x2 a = gelu_pk((f32x2){v0[0], v0[1]}), b = gelu_pk((f32x2){v0[2], v0[3]}), cc = gelu_pk((f32x2){v1[0], v1[1]}), d = gelu_pk((f32x2){v1[2], v1[3]});
                        v0 = (f32x4){a.x, a.y, b.x, b.y}; v1 = (f32x4){cc.x, cc.y, d.x, d.y}; }
                    v4u w; w.x = cvt_pk_bf16(v0[0], v0[1]); w.y = cvt_pk_bf16(v0[2], v0[3]); w.z = cvt_pk_bf16(v1[0], v1[1]); w.w = cvt_pk_bf16(v1[2], v1[3]);
                    *(v4u*)(rowp + bj * 128) = w; } }
    }
};
struct DualOrder {
    pg8::StaticOrder S0;
    __device__ __forceinline__ void init(int G, int c) { S0.init(NTOK, D, G, c); }
    __device__ __forceinline__ bool next(int i, pg8::Unit& u) const { pg8::Unit t; if (!S0.next(i >> 1, t)) return false; const int which = i & 1; u.pm = t.pm + 64 * which; u.pn = t.pn + 4 * which; u.x0 = which; u.x1 = t.pn; u.rb = 0; return true; }
    __device__ __forceinline__ void a_ready(const pg8::Unit&) const {}
    __device__ __forceinline__ void done(const pg8::Unit&) const {}
};
struct EpiMerge {
    static constexpr bool PERM = true, AFTER_DRAIN = false;
    const bf16* P; bf16* O;
    __device__ __forceinline__ bool keep_acc(const pg8::Unit& u) const { return u.x0 == 0; }
    __device__ __forceinline__ void operator()(f32x4 (&acc)[2][2][4][2], const pg8::Unit& u, int wr, int wc, int fr, int fq) const {
        const int row0 = (u.pm & 63) * 256 + wr * 64 + fr, col0 = u.x1 * 256 + wc * 32 + 8 * fq; const bool first = (u.x0 == 0);
#pragma unroll
        for (int ai = 0; ai < 2; ++ai)
#pragma unroll
            for (int m = 0; m < 4; ++m) { const int row = row0 + ai * 128 + m * 16; const bf16* pr = P + (size_t)row * PJ + col0;
#pragma unroll
                for (int bj = 0; bj < 2; ++bj) { const v4u xb = *(const v4u*)(pr + 4096 + bj * 128); float fb[8];
                    fb[0] = bf_lo(xb.x); fb[1] = bf_hi(xb.x); fb[2] = bf_lo(xb.y); fb[3] = bf_hi(xb.y); fb[4] = bf_lo(xb.z); fb[5] = bf_hi(xb.z); fb[6] = bf_lo(xb.w); fb[7] = bf_hi(xb.w);
#pragma unroll
                    for (int i = 0; i < 8; ++i) fb[i] = 1.f + __expf(-fmaxf(fb[i], -30.f));
                    if (first) { const v4u xa = *(const v4u*)(pr + 3072 + bj * 128); float fa[8];
                        fa[0] = bf_lo(xa.x); fa[1] = bf_hi(xa.x); fa[2] = bf_lo(xa.y); fa[3] = bf_hi(xa.y); fa[4] = bf_lo(xa.z); fa[5] = bf_hi(xa.z); fa[6] = bf_lo(xa.w); fa[7] = bf_hi(xa.w);
#pragma unroll
                        for (int i = 0; i < 4; ++i) { acc[ai][bj][m][0][i] *= fb[i] * fast_sigmoid(fa[i]); acc[ai][bj][m][1][i] *= fb[4 + i] * fast_sigmoid(fa[4 + i]); } }
                    else { f32x4 v0, v1;
#pragma unroll
                        for (int i = 0; i < 4; ++i) { v0[i] = acc[ai][bj][m][0][i] * __builtin_amdgcn_rcpf(fb[i]); v1[i] = acc[ai][bj][m][1][i] * __builtin_amdgcn_rcpf(fb[4 + i]); }
                        v4u w; w.x = cvt_pk_bf16(v0[0], v0[1]); w.y = cvt_pk_bf16(v0[2], v0[3]); w.z = cvt_pk_bf16(v1[0], v1[1]); w.w = cvt_pk_bf16(v1[2], v1[3]);
                        *(v4u*)(O + (size_t)row * D + col0 + bj * 128) = w; } } }
    }
};
struct EpiResid {
    static constexpr bool PERM = false, AFTER_DRAIN = false;
    const float* X; float* O;
    __device__ __forceinline__ bool keep_acc(const pg8::Unit&) const { return false; }
    __device__ __forceinline__ void operator()(const f32x4 (&acc)[2][2][4][2], const pg8::Unit& u, int wr, int wc, int fr, int fq) const {
        const int row0 = u.pm * 256 + wr * 64 + fr, col0 = u.pn * 256 + wc * 32 + 4 * fq;
#pragma unroll
        for (int ai = 0; ai < 2; ++ai)
#pragma unroll
            for (int m = 0; m < 4; ++m) { const size_t off = (size_t)(row0 + ai * 128 + m * 16) * D + col0;
#pragma unroll
                for (int bj = 0; bj < 2; ++bj)
#pragma unroll
                    for (int n = 0; n < 2; ++n) *(f32x4*)(O + off + bj * 128 + n * 16) = *(const f32x4*)(X + off + bj * 128 + n * 16) + acc[ai][bj][m][n]; }
    }
};
__device__ __forceinline__ float ldbf(const bf16* p) { return __uint_as_float((unsigned)(*p) << 16); }
__device__ __forceinline__ unsigned short f2bf1(float f) { return (unsigned short)(cvt_pk_bf16(f, 0.f) & 0xffffu); }
__device__ __forceinline__ void unpack8(const v4u& x, float (&f)[8]) { f[0] = bf_lo(x.x); f[1] = bf_hi(x.x); f[2] = bf_lo(x.y); f[3] = bf_hi(x.y); f[4] = bf_lo(x.z); f[5] = bf_hi(x.z); f[6] = bf_lo(x.w); f[7] = bf_hi(x.w); }

constexpr size_t DN_WN = 16384, DN_QD = 16384, DN_KD = 16384, DN_QK = 8192, DN_U = 16384, DN_SST = 32768;
struct DnBufs { unsigned char *WN, *QD, *KD, *QK, *U, *SST; float* EG; };
constexpr int PL_QH = 0, PL_KH = 17408, PL_XVT = 34816, PL_XWT = 53248, PL_KDT = 71680, PL_AL = 90112, PL_TL = 106496, PL_GAM = 115712;
constexpr int RS = 136  , TS = 72  ;

__device__ __forceinline__ void p_dn_prep(const Ctx& c, const bf16* PROJ, const float* cw, const float* BG, const DnBufs& B) {
    LAS unsigned char* L = c.lds;
    LAS unsigned short* QH = (LAS unsigned short*)(L + PL_QH); LAS unsigned short* KH = (LAS unsigned short*)(L + PL_KH);
    LAS unsigned short* XVT = (LAS unsigned short*)(L + PL_XVT); LAS unsigned short* XWT = (LAS unsigned short*)(L + PL_XWT); LAS unsigned short* KDT = (LAS unsigned short*)(L + PL_KDT);
    LAS float* AL = (LAS float*)(L + PL_AL); LAS unsigned short* TL = (LAS unsigned short*)(L + PL_TL);
    LAS float* GAM = (LAS float*)(L + PL_GAM); LAS float* BETA = GAM + 64; LAS float* EGAM = GAM + 128; LAS float* KSC = GAM + 192;
    const int w = c.wave;
    LAS float* CWL = (LAS float*)(L + PL_GAM + 1024);
    constexpr int NITEMS = BATCH * DNH * (SEQ / 64);
    v4u xr[2][7];
#define DN_LOAD_ROWS(itx) do { const int bh_ = (itx) >> 7, ch_ = (itx) & 127, b_ = bh_ >> 2, h_ = bh_ & 3; int tid_ = c.tid; asm volatile("" : "+v"(tid_));     \
        _Pragma("unroll") for (int u_ = 0; u_ < 2; ++u_) { const int idx_ = tid_ + NTHR * u_; if (idx_ < 768) { const int tq_ = idx_ / 48, cg_ = idx_ % 48, col_ = (cg_ >> 4) * 512 + h_ * 128 + (cg_ & 15) * 8; \
            _Pragma("unroll") for (int r_ = 0; r_ < 7; ++r_) { const int tt_ = ch_ * 64 + 4 * tq_ - 3 + r_; \
                xr[u_][r_] = (tt_ >= 0) ? *(const v4u*)(PROJ + ((size_t)b_ * SEQ + tt_) * PJ + col_) : (v4u){0u, 0u, 0u, 0u}; } } } } while (0)
    float gpre = 0.f, bpre = 0.f, cwpre[4] = {0.f, 0.f, 0.f, 0.f};
#define DN_LOAD_SMALL(itx) do { const int bh_ = (itx) >> 7, ch_ = (itx) & 127, b_ = bh_ >> 2, h_ = bh_ & 3; const size_t r0_ = (size_t)b_ * SEQ + ch_ * 64; \
        if (w == 0) { gpre = BG[(r0_ + (c.tid & 63)) * 8 + 4 + h_]; bpre = BG[(r0_ + (c.tid & 63)) * 8 + h_]; } \
        if (c.tid < 384) { _Pragma("unroll") for (int kk_ = 0; kk_ < 4; ++kk_) cwpre[kk_] = cw[kk_ * 1536 + (c.tid >> 7) * 512 + h_ * 128 + (c.tid & 127)]; } } while (0)
    if (c.bid < NITEMS) { DN_LOAD_ROWS(c.bid); DN_LOAD_SMALL(c.bid); }
    for (int it = c.bid; it < NITEMS; it += c.nb) {
        int tl_ = c.tid; asm volatile("" : "+v"(tl_));
        const int lane = tl_ & 63, fr = lane & 15, fq = lane >> 4;
        const int bh = it >> 7, ch = it & 127, b = bh >> 2, h = bh & 3; const size_t row0 = (size_t)b * SEQ + ch * 64;
        if (c.tid < 384) {
#pragma unroll
            for (int kk = 0; kk < 4; ++kk) CWL[kk * 384 + c.tid] = cwpre[kk]; }
        if (w == 0) { const float gt = gpre, bt = bpre; float gam = gt;
#pragma unroll
            for (int o = 1; o < 64; o <<= 1) { const float t = __shfl_up(gam, o); if (lane >= o) gam += t; }
            const float gl = __shfl(gam, 63);
            GAM[lane] = gam; BETA[lane] = bt; EGAM[lane] = expf(gam); KSC[lane] = expf(gl - gam);
            if (lane == 0) B.EG[it] = expf(gl); }
        for (int i = c.tid; i < 1024; i += NTHR) ((LAS f32x4*)AL)[i] = (f32x4){0.f, 0.f, 0.f, 0.f};
        lds_barrier();
        int tidb = c.tid; asm volatile("" : "+v"(tidb));
#pragma unroll
        for (int u = 0; u < 2; ++u) { const int idx = tidb + NTHR * u; if (idx < 768) {
            const int tq = idx / 48, cg = idx % 48, part = cg >> 4, c8 = (cg & 15) * 8;
            f32x4 wt[4][2];
#pragma unroll
            for (int kk = 0; kk < 4; ++kk) { wt[kk][0] = *(const LAS f32x4*)(CWL + kk * 384 + part * 128 + c8); wt[kk][1] = *(const LAS f32x4*)(CWL + kk * 384 + part * 128 + c8 + 4); }
            float av[4][8];
            float s1v[4], s2v[4];
#pragma unroll
            for (int q = 0; q < 4; ++q) { const int t = 4 * tq + q;
                float a[8];
#pragma unroll
                for (int e = 0; e < 8; ++e) a[e] = 0.f;
#pragma unroll
                for (int kk = 0; kk < 4; ++kk) { float xf[8]; unpack8(xr[u][q + kk], xf);
#pragma unroll
                    for (int e = 0; e < 4; ++e) { a[e] = fmaf(wt[kk][0][e], xf[e], a[e]); a[4 + e] = fmaf(wt[kk][1][e], xf[4 + e], a[4 + e]); } }
                float ss = 0.f;
#pragma unroll
                for (int e = 0; e < 8; ++e) { a[e] = a[e] * __builtin_amdgcn_rcpf(1.f + __expf(-a[e])); ss = fmaf(a[e], a[e], ss); }
                ss = row16_sum(ss);
                const float rs = rsqrtf(ss + L2_EPS);
                if (part == 0) { const float sc = rs * 0.08838834764831845f; v4u o; o.x = cvt_pk_bf16(a[0] * sc, a[1] * sc); o.y = cvt_pk_bf16(a[2] * sc, a[3] * sc); o.z = cvt_pk_bf16(a[4] * sc, a[5] * sc); o.w = cvt_pk_bf16(a[6] * sc, a[7] * sc);
                    *(LAS v4u*)(QH + t * RS + c8) = o; }
                else if (part == 1) { v4u o; o.x = cvt_pk_bf16(a[0] * rs, a[1] * rs); o.y = cvt_pk_bf16(a[2] * rs, a[3] * rs); o.z = cvt_pk_bf16(a[4] * rs, a[5] * rs); o.w = cvt_pk_bf16(a[6] * rs, a[7] * rs);
                    *(LAS v4u*)(KH + t * RS + c8) = o; s1v[q] = rs * BETA[t] * EGAM[t]; s2v[q] = rs * KSC[t]; }
                else { s1v[q] = BETA[t]; s2v[q] = 0.f; }
#pragma unroll
                for (int e = 0; e < 8; ++e) av[q][e] = a[e];
            }
            if (part == 1) {
#pragma unroll
                for (int e = 0; e < 8; ++e) { v2u o1, o2; o1.x = cvt_pk_bf16(av[0][e] * s1v[0], av[1][e] * s1v[1]); o1.y = cvt_pk_bf16(av[2][e] * s1v[2], av[3][e] * s1v[3]);
                    o2.x = cvt_pk_bf16(av[0][e] * s2v[0], av[1][e] * s2v[1]); o2.y = cvt_pk_bf16(av[2][e] * s2v[2], av[3][e] * s2v[3]);
                    *(LAS v2u*)(XWT + (c8 + e) * TS + 4 * tq) = o1; *(LAS v2u*)(KDT + (c8 + e) * TS + 4 * tq) = o2; } }
            else if (part == 2) {
#pragma unroll
                for (int e = 0; e < 8; ++e) { v2u o1; o1.x = cvt_pk_bf16(av[0][e] * s1v[0], av[1][e] * s1v[1]); o1.y = cvt_pk_bf16(av[2][e] * s1v[2], av[3][e] * s1v[3]);
                    *(LAS v2u*)(XVT + (c8 + e) * TS + 4 * tq) = o1; } }
            } }
        lds_barrier();
        if (it + c.nb < NITEMS) { DN_LOAD_ROWS(it + c.nb); DN_LOAD_SMALL(it + c.nb); }
        { const int rt = w & 3, ksq = w >> 2; v2u half[2];
#pragma unroll
            for (int sub = 0; sub < 2; ++sub) { const int st = 2 * ksq + sub; f32x4 acc = {0.f, 0.f, 0.f, 0.f};
#pragma unroll
                for (int kk = 0; kk < 4; ++kk) { const bf16x8 a = *(const LAS bf16x8*)(KH + (16 * st + fr) * RS + 32 * kk + 8 * fq), bq = *(const LAS bf16x8*)(QH + (16 * rt + fr) * RS + 32 * kk + 8 * fq); acc = MFMA16(a, bq, acc); }
                const int rr = 16 * rt + fr; const float gr = GAM[rr]; float v[4];
#pragma unroll
                for (int r = 0; r < 4; ++r) { const int s2 = 16 * st + 4 * fq + r; v[r] = (s2 <= rr) ? acc[r] * __expf(fminf(gr - GAM[s2], 0.f)) : 0.f; }
                half[sub].x = cvt_pk_bf16(v[0], v[1]); half[sub].y = cvt_pk_bf16(v[2], v[3]); }
            v4u o; o.x = half[0].x; o.y = half[0].y; o.z = half[1].x; o.w = half[1].y;
            *(v4u*)(B.QK + (size_t)it * DN_QK + ((rt * 2 + ksq) * 64 + lane) * 16) = o; }
#pragma unroll 1
        for (int n = w; n < 10; n += 8) { const int rt = (n >= 6) ? 3 : (n >= 3 ? 2 : (n >= 1 ? 1 : 0)), st = n - rt * (rt + 1) / 2; f32x4 acc = {0.f, 0.f, 0.f, 0.f};
#pragma unroll
            for (int kk = 0; kk < 4; ++kk) { const bf16x8 a = *(const LAS bf16x8*)(KH + (16 * rt + fr) * RS + 32 * kk + 8 * fq), bk = *(const LAS bf16x8*)(KH + (16 * st + fr) * RS + 32 * kk + 8 * fq); acc = MFMA16(a, bk, acc); }
            const int s2 = 16 * st + fr; const float gs = GAM[s2];
#pragma unroll
            for (int r = 0; r < 4; ++r) { const int rr = 16 * rt + 4 * fq + r; const float v = (s2 < rr) ? BETA[rr] * acc[r] * __expf(fminf(GAM[rr] - gs, 0.f)) : 0.f; AL[rr * 64 + (s2 & 7) * 8 + (s2 >> 3)] = v; } }
        lds_barrier();
        { const int j = w * 8 + (lane >> 3), p = lane & 7; float tc[8];
#pragma unroll
            for (int i = 0; i < 8; ++i) tc[i] = 0.f;
#pragma unroll
            for (int r = 0; r < 64; ++r) { float s0 = 0.f, s1 = 0.f;
                if (r > 0) { const LAS float* ar = AL + r * 64 + p * 8; const f32x4 a0 = *(const LAS f32x4*)ar; s0 = a0[0] * tc[0];
                    if (r > 8) s1 = a0[1] * tc[1];
                    if (r > 16) s0 = fmaf(a0[2], tc[2], s0);
                    if (r > 24) s1 = fmaf(a0[3], tc[3], s1);
                    if (r > 32) { const f32x4 a1 = *(const LAS f32x4*)(ar + 4); s0 = fmaf(a1[0], tc[4], s0);
                        if (r > 40) s1 = fmaf(a1[1], tc[5], s1);
                        if (r > 48) s0 = fmaf(a1[2], tc[6], s0);
                        if (r > 56) s1 = fmaf(a1[3], tc[7], s1); } }
                float tot = s0 + s1; tot += dpp_xor1(tot); tot += dpp_xor2(tot); tot += dpp_hmir(tot);
                const float tr = ((r == j) ? 1.f : 0.f) - tot;
                if (p == (r & 7)) tc[r >> 3] = tr; }
#pragma unroll
            for (int i = 0; i < 8; ++i) TL[(8 * i + p) * TS + j] = f2bf1(tc[i]); }
        lds_barrier();
        { const int sl = w;
#pragma unroll
            for (int mt = 0; mt < 4; ++mt) { f32x4 acc = {0.f, 0.f, 0.f, 0.f};
#pragma unroll
                for (int kk = 0; kk < 2; ++kk) if (kk == 0 || mt >= 2) { const bf16x8 a = *(const LAS bf16x8*)(TL + (16 * mt + fr) * TS + 32 * kk + 8 * fq), bv = *(const LAS bf16x8*)(XVT + (16 * sl + fr) * TS + 32 * kk + 8 * fq); acc = MFMA16(a, bv, acc); }
                v2u o; o.x = cvt_pk_bf16(acc[0], acc[1]); o.y = cvt_pk_bf16(acc[2], acc[3]);
                *(v2u*)(B.U + (size_t)it * DN_U + ((mt * 8 + sl) * 64 + lane) * 8) = o; }
            const int dt = w;
#pragma unroll
            for (int rt = 0; rt < 4; ++rt) { f32x4 acc = {0.f, 0.f, 0.f, 0.f};
#pragma unroll
                for (int kk = 0; kk < 2; ++kk) if (kk == 0 || rt >= 2) { const bf16x8 a = *(const LAS bf16x8*)(XWT + (16 * dt + fr) * TS + 32 * kk + 8 * fq), bt = *(const LAS bf16x8*)(TL + (16 * rt + fr) * TS + 32 * kk + 8 * fq); acc = MFMA16(a, bt, acc); }
                v2u o; o.x = cvt_pk_bf16(-acc[0], -acc[1]); o.y = cvt_pk_bf16(-acc[2], -acc[3]);
                *(v2u*)(B.WN + (size_t)it * DN_WN + ((rt * 4 + (dt >> 1)) * 64 + lane) * 16 + (dt & 1) * 8) = o; } }
        { const int mt = w & 3;
#pragma unroll
            for (int q2 = 0; q2 < 2; ++q2) { const int ks = 2 * (w >> 2) + q2, rr = 16 * mt + fr; const float sc = EGAM[rr];
                const v2u lo = *(const LAS v2u*)(QH + rr * RS + 32 * ks + 4 * fq), hi = *(const LAS v2u*)(QH + rr * RS + 32 * ks + 16 + 4 * fq);
                v4u o; o.x = cvt_pk_bf16(bf_lo(lo.x) * sc, bf_hi(lo.x) * sc); o.y = cvt_pk_bf16(bf_lo(lo.y) * sc, bf_hi(lo.y) * sc); o.z = cvt_pk_bf16(bf_lo(hi.x) * sc, bf_hi(hi.x) * sc); o.w = cvt_pk_bf16(bf_lo(hi.y) * sc, bf_hi(hi.y) * sc);
                *(v4u*)(B.QD + (size_t)it * DN_QD + ((mt * 4 + ks) * 64 + lane) * 16) = o; }
            const int dt = w;
#pragma unroll
            for (int ks = 0; ks < 2; ++ks) { const v2u lo = *(const LAS v2u*)(KDT + (16 * dt + fr) * TS + 32 * ks + 4 * fq), hi = *(const LAS v2u*)(KDT + (16 * dt + fr) * TS + 32 * ks + 16 + 4 * fq);
                v4u o; o.x = lo.x; o.y = lo.y; o.z = hi.x; o.w = hi.y;
                *(v4u*)(B.KD + (size_t)it * DN_KD + ((dt * 2 + ks) * 64 + lane) * 16) = o; } }
        lds_barrier();
    }
}

constexpr int SCAN_WGS = BATCH * DNH * 2;
__device__ __forceinline__ void u_load_asm(v2u& dst, const unsigned char* p) { asm volatile("global_load_dwordx2 %0, %1, off" : "=v"(dst) : "v"(p) : "memory"); }
template <int STG>
__device__ __forceinline__ void scan_step(const DnBufs& B, LAS unsigned char* L, int lane, int sl, int it, int ch, f32x4 (&S)[8], v2u (&ucur)[4], v2u (&unxt)[4], float egc) {
    if (ch < 126) asm volatile("s_waitcnt vmcnt(8)" ::: "memory"); else asm volatile("s_waitcnt vmcnt(0)" ::: "memory");
    __builtin_amdgcn_s_barrier(); asm volatile("" ::: "memory");
    asm volatile("" : "+v"(ucur[0]), "+v"(ucur[1]), "+v"(ucur[2]), "+v"(ucur[3]));
    bf16x8 sf[4];
#pragma unroll
    for (int ks = 0; ks < 4; ++ks) { v4u o; o.x = cvt_pk_bf16(S[2 * ks][0], S[2 * ks][1]); o.y = cvt_pk_bf16(S[2 * ks][2], S[2 * ks][3]); o.z = cvt_pk_bf16(S[2 * ks + 1][0], S[2 * ks + 1][1]); o.w = cvt_pk_bf16(S[2 * ks + 1][2], S[2 * ks + 1][3]);
        *(v4u*)(B.SST + (size_t)it * DN_SST + ((ks * 8 + sl) * 64 + lane) * 16) = o; sf[ks] = as_frag(o); }
    asm volatile("" ::: "memory");
    if (ch + 3 < 128) {
#pragma unroll
        for (int mt = 0; mt < 4; ++mt) u_load_asm(unxt[mt], B.U + (size_t)(it + 3) * DN_U + ((mt * 8 + sl) * 64 + lane) * 8); }
    const LAS unsigned char* wl = L + STG * 32768 + lane * 16; const LAS unsigned char* kl = wl + 16384;
    f32x4 vn[4];
#pragma unroll
    for (int mt = 0; mt < 4; ++mt) { vn[mt] = (f32x4){bf_lo(ucur[mt].x), bf_hi(ucur[mt].x), bf_lo(ucur[mt].y), bf_hi(ucur[mt].y)};
#pragma unroll
        for (int ks = 0; ks < 4; ++ks) vn[mt] = MFMA16(*(const LAS bf16x8*)(wl + (mt * 4 + ks) * 1024), sf[ks], vn[mt]); }
    bf16x8 vf[2];
#pragma unroll
    for (int ks = 0; ks < 2; ++ks) { v4u o; o.x = cvt_pk_bf16(vn[2 * ks][0], vn[2 * ks][1]); o.y = cvt_pk_bf16(vn[2 * ks][2], vn[2 * ks][3]); o.z = cvt_pk_bf16(vn[2 * ks + 1][0], vn[2 * ks + 1][1]); o.w = cvt_pk_bf16(vn[2 * ks + 1][2], vn[2 * ks + 1][3]); vf[ks] = as_frag(o); }
#pragma unroll
    for (int dt = 0; dt < 8; ++dt) { f32x4 a = S[dt] * egc;
#pragma unroll
        for (int ks = 0; ks < 2; ++ks) a = MFMA16(*(const LAS bf16x8*)(kl + (dt * 2 + ks) * 1024), vf[ks], a);
        S[dt] = a; }
}
__device__ __forceinline__ void p_dn_scan(const Ctx& c, const DnBufs& B) {
    const int lane = c.lane, w = c.wave, bh = c.bid & 7, half = c.bid >> 3; LAS unsigned char* L = c.lds;
    if (w >= 4) {
        const unsigned char* gsrc = (w < 6) ? B.WN : B.KD; const int goff = (w & 1) * 8192 + lane * 16, loff = (w - 4) * 8192;
#define SCAN_DMA(itn, stage) do { _Pragma("unroll") for (int _p = 0; _p < 8; ++_p) \
        __builtin_amdgcn_global_load_lds((const unsigned*)(gsrc + (size_t)(itn) * 16384 + goff + _p * 1024), (LAS unsigned*)(L + (stage) * 32768 + loff + _p * 1024), 16, 0, 0); } while (0)
        const int it0 = bh * 128;
        SCAN_DMA(it0, 0); SCAN_DMA(it0 + 1, 1); SCAN_DMA(it0 + 2, 2);
#pragma unroll 1
        for (int ch = 0; ch < 128; ++ch) {
            if (ch < 126) asm volatile("s_waitcnt vmcnt(16)" ::: "memory"); else asm volatile("s_waitcnt vmcnt(0)" ::: "memory");
            __builtin_amdgcn_s_barrier(); asm volatile("" ::: "memory");
            if (ch + 3 < 128) SCAN_DMA(it0 + ch + 3, (ch + 3) & 3);
        }
#undef SCAN_DMA
    } else {
        __builtin_amdgcn_s_setprio(1);
        const int sl = half * 4 + w;
        f32x4 S[8];
#pragma unroll
        for (int i = 0; i < 8; ++i) S[i] = (f32x4){0.f, 0.f, 0.f, 0.f};
        v2u u0[4], u1[4], u2[4], u3[4];
        const float eglo = B.EG[bh * 128 + lane], eghi = B.EG[bh * 128 + 64 + lane];
        asm volatile("s_waitcnt vmcnt(0)" ::: "memory");
        { const int it = bh * 128;
#pragma unroll
            for (int mt = 0; mt < 4; ++mt) u_load_asm(u0[mt], B.U + (size_t)it * DN_U + ((mt * 8 + sl) * 64 + lane) * 8);
#pragma unroll
            for (int mt = 0; mt < 4; ++mt) u_load_asm(u1[mt], B.U + (size_t)(it + 1) * DN_U + ((mt * 8 + sl) * 64 + lane) * 8);
#pragma unroll
            for (int mt = 0; mt < 4; ++mt) u_load_asm(u2[mt], B.U + (size_t)(it + 2) * DN_U + ((mt * 8 + sl) * 64 + lane) * 8);
#pragma unroll
            for (int mt = 0; mt < 4; ++mt) u3[mt] = (v2u){0u, 0u}; }
#define EGC(chx) __builtin_bit_cast(float, __builtin_amdgcn_readlane(__builtin_bit_cast(int, (chx) < 64 ? eglo : eghi), (chx) & 63))
#pragma unroll 1
        for (int ch = 0; ch < 128; ch += 4) {
            const int it = bh * 128 + ch;
            scan_step<0>(B, L, lane, sl, it, ch, S, u0, u3, EGC(ch));
            scan_step<1>(B, L, lane, sl, it + 1, ch + 1, S, u1, u0, EGC(ch + 1));
            scan_step<2>(B, L, lane, sl, it + 2, ch + 2, S, u2, u1, EGC(ch + 2));
            scan_step<3>(B, L, lane, sl, it + 3, ch + 3, S, u3, u2, EGC(ch + 3));
        }
#undef EGC
        __builtin_amdgcn_s_setprio(0);
    }
    asm volatile("s_waitcnt vmcnt(0)" ::: "memory"); __builtin_amdgcn_s_barrier(); asm volatile("" ::: "memory");
}

__device__ __forceinline__ void p_dn_out(const Ctx& c, const DnBufs& B, const bf16* PROJ, const float* gn, bf16* YA) {
    const int lane = c.lane, sl = c.wave, fr = lane & 15, fq = lane >> 4; LAS float* SSQ = (LAS float*)c.lds;
    LAS unsigned char* IMG = c.lds + 2048;
    LAS float* OT = (LAS float*)(c.lds + 2048 + 40960);
    for (int it = c.bid; it < BATCH * DNH * (SEQ / 64); it += c.nb) {
        const int bh = it >> 7, ch = it & 127, b = bh >> 2, h = bh & 3; const size_t row0 = (size_t)b * SEQ + ch * 64;
        v4u sfr[4]; v2u ur[4]; v4u zr[2];
        { const size_t zrow = row0 + (c.tid >> 3); zr[0] = *(const v4u*)(PROJ + zrow * PJ + 1536 + h * 128 + 16 * (c.tid & 7)); zr[1] = *(const v4u*)(PROJ + zrow * PJ + 1536 + h * 128 + 16 * (c.tid & 7) + 8); }
#pragma unroll
        for (int ks = 0; ks < 4; ++ks) sfr[ks] = *(const v4u*)(B.SST + (size_t)it * DN_SST + ((ks * 8 + sl) * 64 + lane) * 16);
#pragma unroll
        for (int mt = 0; mt < 4; ++mt) ur[mt] = *(const v2u*)(B.U + (size_t)it * DN_U + ((mt * 8 + sl) * 64 + lane) * 8);
#pragma unroll
        for (int j = 0; j < 5; ++j) { const int p = sl * 5 + j;
            const unsigned char* src = (p < 16) ? B.WN + (size_t)it * DN_WN + p * 1024 : (p < 32 ? B.QD + (size_t)it * DN_QD + (p - 16) * 1024 : B.QK + (size_t)it * DN_QK + (p - 32) * 1024);
            __builtin_amdgcn_global_load_lds((const unsigned*)(src + lane * 16), (LAS unsigned*)(IMG + p * 1024), 16, 0, 0); }
        asm volatile("s_waitcnt vmcnt(0)" ::: "memory"); lds_barrier();
        bf16x8 sf[4];
#pragma unroll
        for (int ks = 0; ks < 4; ++ks) sf[ks] = as_frag(sfr[ks]);
        const LAS unsigned char* wn = IMG + lane * 16; const LAS unsigned char* qd = wn + 16384; const LAS unsigned char* qk = wn + 32768;
        f32x4 vn[4];
#pragma unroll
        for (int mt = 0; mt < 4; ++mt) { vn[mt] = (f32x4){bf_lo(ur[mt].x), bf_hi(ur[mt].x), bf_lo(ur[mt].y), bf_hi(ur[mt].y)};
#pragma unroll
            for (int ks = 0; ks < 4; ++ks) vn[mt] = MFMA16(*(const LAS bf16x8*)(wn + (mt * 4 + ks) * 1024), sf[ks], vn[mt]); }
        bf16x8 vf[2];
#pragma unroll
        for (int ks = 0; ks < 2; ++ks) { v4u o; o.x = cvt_pk_bf16(vn[2 * ks][0], vn[2 * ks][1]); o.y = cvt_pk_bf16(vn[2 * ks][2], vn[2 * ks][3]); o.z = cvt_pk_bf16(vn[2 * ks + 1][0], vn[2 * ks + 1][1]); o.w = cvt_pk_bf16(vn[2 * ks + 1][2], vn[2 * ks + 1][3]); vf[ks] = as_frag(o); }
        f32x4 o[4];
#pragma unroll
        for (int mt = 0; mt < 4; ++mt) { f32x4 a = {0.f, 0.f, 0.f, 0.f};
#pragma unroll
            for (int ks = 0; ks < 4; ++ks) a = MFMA16(*(const LAS bf16x8*)(qd + (mt * 4 + ks) * 1024), sf[ks], a);
#pragma unroll
            for (int ks = 0; ks < 2; ++ks) a = MFMA16(*(const LAS bf16x8*)(qk + (mt * 2 + ks) * 1024), vf[ks], a);
            o[mt] = a;
#pragma unroll
            for (int r = 0; r < 4; ++r) { float q = row16_sum(a[r] * a[r]);
                if (fr == 0) SSQ[(16 * mt + 4 * fq + r) * 8 + sl] = q; } }
#pragma unroll
        for (int mt = 0; mt < 4; ++mt)
#pragma unroll
            for (int r = 0; r < 4; ++r) OT[(16 * mt + 4 * fq + r) * 132 + 16 * sl + fr] = o[mt][r];
        lds_barrier();
        { const int row = c.tid >> 3, seg = c.tid & 7; const size_t grow = row0 + row; const int col = h * 128 + 16 * seg;
            const f32x4 q0 = *(const LAS f32x4*)(SSQ + row * 8), q1 = *(const LAS f32x4*)(SSQ + row * 8 + 4);
            const float rstd = rsqrtf(((q0[0] + q0[1]) + (q0[2] + q0[3]) + (q1[0] + q1[1]) + (q1[2] + q1[3])) * (1.f / 128.f) + RMS_EPS);
            float zf[16]; { float t8[8]; unpack8(zr[0], t8);
#pragma unroll
                for (int e = 0; e < 8; ++e) zf[e] = t8[e];
                unpack8(zr[1], t8);
#pragma unroll
                for (int e = 0; e < 8; ++e) zf[8 + e] = t8[e]; }
            float y[16];
#pragma unroll
            for (int j = 0; j < 4; ++j) { const f32x4 ov = *(const LAS f32x4*)(OT + row * 132 + 16 * seg + 4 * j); const float4 g4 = *(const float4*)(gn + 16 * seg + 4 * j);
                y[4 * j + 0] = ov[0] * rstd * g4.x * zf[4 * j + 0]; y[4 * j + 1] = ov[1] * rstd * g4.y * zf[4 * j + 1]; y[4 * j + 2] = ov[2] * rstd * g4.z * zf[4 * j + 2]; y[4 * j + 3] = ov[3] * rstd * g4.w * zf[4 * j + 3]; }
            v4u w0, w1; w0.x = cvt_pk_bf16(y[0], y[1]); w0.y = cvt_pk_bf16(y[2], y[3]); w0.z = cvt_pk_bf16(y[4], y[5]); w0.w = cvt_pk_bf16(y[6], y[7]);
            w1.x = cvt_pk_bf16(y[8], y[9]); w1.y = cvt_pk_bf16(y[10], y[11]); w1.z = cvt_pk_bf16(y[12], y[13]); w1.w = cvt_pk_bf16(y[14], y[15]);
            *(v4u*)(YA + grow * DNW + col) = w0; *(v4u*)(YA + grow * DNW + col + 8) = w1; }
        lds_barrier();
    }
}

__device__ __forceinline__ void p_sg_item(const Ctx& c, int it, const bf16* PROJ, const float* lg, const float* lb, const float* sw, const float* sb, bf16* YB) {
    LAS unsigned short* VT = (LAS unsigned short*)c.lds;
    LAS float* STAT = (LAS float*)(c.lds + 128 * RS * 2);
    const int lane = c.lane, w = c.wave, fr = lane & 15, fq = lane >> 4, chunk = it >> 2, g = it & 3; const size_t row0 = (size_t)chunk * SGC;
    {
        v4u xr[16];
#pragma unroll
        for (int rr = 0; rr < 16; ++rr) xr[rr] = *(const v4u*)(PROJ + (row0 + 16 * w + rr) * PJ + 2560 + lane * 8);
        float acc[32];
#pragma unroll
        for (int rr = 0; rr < 16; ++rr) { float f[8]; unpack8(xr[rr], f); float s1 = 0.f, s2 = 0.f;
#pragma unroll
            for (int e = 0; e < 8; ++e) { s1 += f[e]; s2 = fmaf(f[e], f[e], s2); }
            acc[rr] = s1; acc[16 + rr] = s2; }
        BFLY_SW32(acc, 32) BFLY_SW16(acc, 16) BFLY_DPP(acc, 8, 8, dpp_ror8) BFLY_DPP(acc, 4, 4, dpp_xor4) BFLY_DPP(acc, 2, 2, dpp_xor2)
        const float tot = acc[0] + dpp_xor1(acc[0]);
        if ((lane & 1) == 0) { const int vi = lane >> 1; STAT[2 * (16 * w + (vi & 15)) + (vi >> 4)] = tot; } }
    lds_barrier();
    { v4u xv[4];
#pragma unroll
        for (int i = 0; i < 4; ++i) { const int idx = c.tid + NTHR * i, s = idx >> 4, c8 = (idx & 15) * 8; xv[i] = *(const v4u*)(PROJ + (row0 + s) * PJ + 2560 + g * 128 + c8); }
        const int c8 = (c.tid & 15) * 8;
        const float4 g0 = *(const float4*)(lg + g * 128 + c8), g1 = *(const float4*)(lg + g * 128 + c8 + 4), b0 = *(const float4*)(lb + g * 128 + c8), b1 = *(const float4*)(lb + g * 128 + c8 + 4);
        const float gv[8] = {g0.x, g0.y, g0.z, g0.w, g1.x, g1.y, g1.z, g1.w}, bv[8] = {b0.x, b0.y, b0.z, b0.w, b1.x, b1.y, b1.z, b1.w};
#pragma unroll
        for (int i = 0; i < 4; ++i) { const int s = (c.tid + NTHR * i) >> 4; float f[8]; unpack8(xv[i], f);
            const float mu = STAT[2 * s] * (1.f / SGW), rstd = rsqrtf(fmaxf(STAT[2 * s + 1] * (1.f / SGW) - mu * mu, 0.f) + LN_EPS);
#pragma unroll
            for (int e = 0; e < 8; ++e) VT[(c8 + e) * RS + s] = f2bf1((f[e] - mu) * rstd * gv[e] + bv[e]); } }
    lds_barrier();
    { f32x4 acc[8];
#pragma unroll
        for (int ct = 0; ct < 8; ++ct) acc[ct] = (f32x4){0.f, 0.f, 0.f, 0.f};
        const int t = 16 * w + fr, nk = (w >> 1) + 1;
        for (int kk = 0; kk < nk; ++kk) { const int s0 = 32 * kk + 8 * fq; const float* wp = sw + ((size_t)g * SGC + t) * SGC + s0;
            const float4 w0 = *(const float4*)wp, w1 = *(const float4*)(wp + 4);
            const float wv[8] = {w0.x, w0.y, w0.z, w0.w, w1.x, w1.y, w1.z, w1.w}; float wm[8];
#pragma unroll
            for (int e = 0; e < 8; ++e) wm[e] = (s0 + e <= t) ? wv[e] : 0.f;
            v4u wb; wb.x = cvt_pk_bf16(wm[0], wm[1]); wb.y = cvt_pk_bf16(wm[2], wm[3]); wb.z = cvt_pk_bf16(wm[4], wm[5]); wb.w = cvt_pk_bf16(wm[6], wm[7]);
            const bf16x8 bfr = as_frag(wb);
#pragma unroll
            for (int ct = 0; ct < 8; ++ct) acc[ct] = MFMA16(*(const LAS bf16x8*)(VT + (16 * ct + fr) * RS + s0), bfr, acc[ct]); }
        const float bias = sb[g * SGC + t]; const size_t row = row0 + t;
#pragma unroll
        for (int ct = 0; ct < 8; ++ct) { const int col = g * 128 + 16 * ct + 4 * fq; const v2u u = *(const v2u*)(PROJ + row * PJ + 2048 + col);
            v2u o; o.x = cvt_pk_bf16(bf_lo(u.x) * (acc[ct][0] + bias), bf_hi(u.x) * (acc[ct][1] + bias)); o.y = cvt_pk_bf16(bf_lo(u.y) * (acc[ct][2] + bias), bf_hi(u.y) * (acc[ct][3] + bias));
            *(v2u*)(YB + row * SGW + col) = o; } }
    lds_barrier();
}

struct Args { const float* in[22]; float* out; unsigned char* ws; int ph_lo, ph_hi; };
__global__ void __launch_bounds__(NTHR, 2) mega(Args args) {
    extern __shared__ __attribute__((aligned(16))) unsigned char lds_raw[];
    Ctx c; c.lds0 = (LAS unsigned char*)lds_raw; c.lds = c.lds0 + RING_OFF; c.tid = threadIdx.x; c.lane = c.tid & 63; c.wave = __builtin_amdgcn_readfirstlane(c.tid >> 6); c.bid = blockIdx.x; c.nb = gridDim.x;
    volatile LAS unsigned* MISC = (volatile LAS unsigned*)(c.lds0 + MISC_OFF);
    for (int u = c.tid; u < RING_OFF / 4; u += NTHR) ((LAS unsigned*)(c.lds0 + LDSCTL_OFF))[u] = 0u;
    __syncthreads();
    unsigned char* ws = args.ws;
    gu32* ctl = (gu32*)(ws + WS_CTL);
    XcdBarrier bar = xcd_barrier_post((unsigned*)(ctl + CW_BAR), MISC + 8);
#define GRID_BAR() xcd_barrier(bar)
    const float* x = args.in[0]; const float* norm1_g = args.in[1]; const float* w_in = args.in[2]; const float* conv_w = args.in[3];
    const float* a_log = args.in[4]; const float* dt_bias = args.in[5]; const float* dn_norm_g = args.in[6]; const float* w_o_dn = args.in[7];
    const float* sg_ln_g = args.in[8]; const float* sg_ln_b = args.in[9]; const float* sg_w = args.in[10]; const float* sg_b = args.in[11];
    const float* w_o_sg = args.in[12]; const float* w_out = args.in[13]; const float* norm2_g = args.in[14]; const float* w_router = args.in[15];
    const float* b_router = args.in[16]; const float* w_gate_up = args.in[17]; const float* b_gate_up = args.in[18]; const float* w_down = args.in[19];
    const float* b_down = args.in[20]; const float* norm_f_g = args.in[21];
    float* out = args.out;
    unsigned char* wb = ws + WS_BASE;
    bf16* Hb = (bf16*)(wb + 0); bf16* H2b = (bf16*)(wb + 0);
    bf16* Win_t = (bf16*)(wb + 32 * MiB); bf16* Wo_t = (bf16*)(wb + 42 * MiB); bf16* Wout_t = (bf16*)(wb + 44 * MiB); float* BG = (float*)(wb + 46 * MiB);
    bf16* PROJb = (bf16*)(wb + 48 * MiB); bf16* ACTb = (bf16*)(wb + 48 * MiB);
    bf16* YAB = (bf16*)(wb + 208 * MiB); bf16* MERGED = (bf16*)(wb + 240 * MiB); float* X1 = (float*)(wb + 272 * MiB);
    float* QKV = (float*)(wb + 336 * MiB); float* O32 = (float*)(wb + 432 * MiB); float* U = (float*)(wb + 464 * MiB); float* VLN = (float*)(wb + 496 * MiB);
    bf16* Wgu_t = (bf16*)(wb + 528 * MiB); bf16* Wd_t = (bf16*)(wb + 656 * MiB); bf16* HS = (bf16*)(wb + 720 * MiB); bf16* Yb = (bf16*)(wb + 864 * MiB);
    unsigned char* small = wb + 1008 * MiB;
    int* slot_e = (int*)(small + 0 * MiB); int* slot_pos = (int*)(small + 1 * MiB); int* elist = (int*)(small + 2 * MiB); float* ewgt = (float*)(small + 4 * MiB); bf16* WrT = (bf16*)(small + 6 * MiB);
    unsigned* gcnt = (unsigned*)(ctl + CW_CNT);

#ifndef GEMM1_WGM
#define GEMM1_WGM 8
#endif
#ifndef PROBE_MASK
#define PROBE_MASK 0
#endif
#define REP(bit) for (int _r = 0; _r < ((PROBE_MASK >> (bit)) & 1) + 1; ++_r)
    REP(0) { p_convert_front(c, w_in, w_o_dn, w_o_sg, w_out, Win_t, Wo_t, Wout_t);
    __syncthreads();
    p_norm1(c, x, norm1_g, w_in, a_log, dt_bias, Hb, BG); if (PROBE_MASK & 1) __syncthreads();
    p_build_wrt(c, w_router, WrT);
    for (int i = c.bid * NTHR + c.tid; i < NE * NTOK / 4; i += c.nb * NTHR) { ((v4u*)elist)[i] = (v4u){0u, 0u, 0u, 0u}; ((v4u*)ewgt)[i] = (v4u){0u, 0u, 0u, 0u}; } }
    GRID_BAR();
    REP(1) { pg8::Gemm g{Hb, Win_t, NTOK, PJ, D}; pg8::StaticOrder S; S.init(NTOK, PJ, c.nb, c.bid, GEMM1_WGM); EpiProj E{PROJb};
      pg8::gemm_phase<EpiProj, pg8::StaticOrder, true, true>(c.lds, g, S, E); }
    GRID_BAR();
    DnBufs DB; DB.WN = wb + 336 * MiB; DB.QD = wb + 352 * MiB; DB.KD = wb + 368 * MiB; DB.QK = wb + 384 * MiB; DB.U = wb + 392 * MiB; DB.SST = wb + 408 * MiB; DB.EG = (float*)(wb + 440 * MiB);
    REP(2) { p_dn_prep(c, PROJb, conv_w, BG, DB); }
    GRID_BAR();
    if (c.bid < SCAN_WGS) { REP(3) { p_dn_scan(c, DB); } }
    else { Ctx c2 = c; c2.bid = c.bid - SCAN_WGS; c2.nb = c.nb - SCAN_WGS;
        REP(4) { for (int it = c2.bid; it < (NTOK / SGC) * 4; it += c2.nb) p_sg_item(c, it, PROJb, sg_ln_g, sg_ln_b, sg_w, sg_b, YAB + (size_t)NTOK * DNW); }
        REP(5) { p_convert_moe(c2, w_gate_up, w_down, Wgu_t, Wd_t); } }
    GRID_BAR();
    REP(6) { p_dn_out(c, DB, PROJb, dn_norm_g, YAB); }
    GRID_BAR();
    REP(7) { pg8::Gemm g{YAB, Wo_t, 0, 0, DNW}; DualOrder S; S.init(c.nb, c.bid); EpiMerge E{PROJb, MERGED};
      pg8::gemm_phase<EpiMerge, DualOrder, true, true>(c.lds, g, S, E); }
    GRID_BAR();
    REP(8) { pg8::Gemm g{MERGED, Wout_t, NTOK, D, D}; pg8::StaticOrder S; S.init(NTOK, D, c.nb, c.bid); EpiResid E{x, X1};
      pg8::gemm_phase<EpiResid, pg8::StaticOrder, true, true>(c.lds, g, S, E); }
    GRID_BAR();
    p_router2(c, X1, norm2_g, WrT, b_router, H2b, slot_e, slot_pos, elist, ewgt, gcnt);
    GRID_BAR();
    LAS unsigned char* tile_e = c.lds0 + EXTRA_OFF + 512; LAS int* ntl = (LAS int*)(c.lds0 + EXTRA_OFF + 1024); LAS int* tile_b = (LAS int*)(c.lds0 + EXTRA_OFF + 1088);
    build_tile_table(c, gcnt, tile_e, ntl, tile_b);
    const int NTL = __builtin_amdgcn_readfirstlane(ntl[0]);
    REP(10) { pg8::Gemm g{H2b, Wgu_t, 0, 0, D, elist}; MoeOrder S; S.init(NTL, 8, c.nb, c.bid, tile_e, tile_b, 4); EpiSwiglu E{ACTb, b_gate_up};
      pg8::gemm_phase<EpiSwiglu, MoeOrder, true, true, true>(c.lds, g, S, E); }
    GRID_BAR();
    REP(11) { pg8::Gemm g{ACTb, Wd_t, 0, 0, DFF}; MoeOrder S; S.init(NTL, 4, c.nb, c.bid, tile_e, tile_b); EpiDown E{Yb, b_down, ewgt};
      pg8::gemm_phase<EpiDown, MoeOrder, true, true>(c.lds, g, S, E); }
    GRID_BAR();
    REP(12) { p_final(c, X1, Yb, slot_e, slot_pos, gcnt, norm_f_g, out); }
    if (PROBE_MASK & 8192) { for (int k = 0; k < 10; ++k) GRID_BAR(); }
}

extern "C" void kernel_launch(void* const* d_in, const int* in_sizes, int n_in, void* d_out, int out_size, void* d_ws, size_t ws_size, hipStream_t stream) {
    static int grid = 0;
    if (grid == 0) {
        if (n_in != 22 || in_sizes[0] != NTOK * D || out_size != NTOK * D || ws_size < WS_NEED) { fprintf(stderr, "kernel_launch: unexpected shapes (n_in %d, ws %zu)\n", n_in, ws_size); grid = -1; return; }
        int dev = 0, cus = 0, per_cu = 0;
        if (hipGetDevice(&dev) != hipSuccess || hipDeviceGetAttribute(&cus, hipDeviceAttributeMultiprocessorCount, dev) != hipSuccess) { grid = -1; return; }
        if (hipFuncSetAttribute((const void*)mega, hipFuncAttributeMaxDynamicSharedMemorySize, LDS_BYTES) != hipSuccess) { fprintf(stderr, "kernel_launch: hipFuncSetAttribute failed\n"); grid = -1; return; }
        if (hipOccupancyMaxActiveBlocksPerMultiprocessor(&per_cu, (const void*)mega, NTHR, LDS_BYTES) != hipSuccess || per_cu < 1) fprintf(stderr, "kernel_launch: occupancy query reports %d\n", per_cu);
        (void)hipGetLastError();
        grid = cus;
    }
    if (grid < 0) return;
    if (hipMemsetAsync((char*)d_ws + WS_CTL, 0, CTL_ZERO_BYTES, stream) != hipSuccess) { fprintf(stderr, "kernel_launch: memset failed\n"); return; }
    Args a{};
    for (int i = 0; i < 22; ++i) a.in[i] = (const float*)d_in[i];
    a.out = (float*)d_out; a.ws = (unsigned char*)d_ws; a.ph_lo = 0; a.ph_hi = 100;
    hipLaunchKernelGGL(mega, dim3(grid), dim3(NTHR), LDS_BYTES, stream, a);
#if PROBE_MASK & 131072
    (void)hipMemsetAsync((char*)d_ws + WS_CTL, 0, CTL_ZERO_BYTES, stream); hipLaunchKernelGGL(mega, dim3(grid), dim3(NTHR), LDS_BYTES, stream, a);
#endif
    const hipError_t le = hipPeekAtLastError();
    if (le != hipSuccess) fprintf(stderr, "kernel_launch: launch failed: %s\n", hipGetErrorName(le));
}
```

```cpp
#include <hip/hip_runtime.h>
#include <cstdio>
#include <cstdint>
#include <cmath>

#define GAS __attribute__((address_space(1)))
#define LAS __attribute__((address_space(3)))
typedef GAS unsigned gu32;
#define RLX_AGENT __ATOMIC_RELAXED, __HIP_MEMORY_SCOPE_AGENT

constexpr int NWAVES = 8, NTHR = 512;
constexpr int D = 1024, BATCH = 2, SEQ = 8192, NTOK = BATCH * SEQ;
constexpr int DNH = 4, DNW = 512;
constexpr int SGD = 128, SGW = 512, SGC = 128;
constexpr int NE = 32, TOPK = 4, DFF = 1024;
constexpr int OFF_Z = 1536, OFF_BETA = 2048, OFF_A = 2052, OFF_U = 2056, OFF_V = 2568, OFF_GA = 3080, OFF_GB = 4104, INC = 5128;
constexpr float RMS_EPS = 1e-6f, LN_EPS = 1e-5f, L2_EPS = 1e-6f;

constexpr size_t MiB = 1u << 20;
constexpr size_t WS_CTL = 0, CTL_ZERO_BYTES = 1 * MiB;
constexpr int CW_BAR = 4096;
constexpr int CW_CNT = 16384;
constexpr int CW_TCNT = 20480;
constexpr size_t WS_BASE = 2 * MiB;
constexpr size_t WS_NEED = 1020 * MiB;
constexpr int LDSCTL_OFF = 0, MISC_OFF = 320, RING_OFF = 1024, RING_BYTES = 131072, EXTRA_OFF = RING_OFF + RING_BYTES, LDS_BYTES = 147456;

#define XB_TMO      128
#define XB_XCNT(j)  (256  + 64 * (j))
#define XB_XSUB(j)  (1280 + 64 * (j))
#define XB_XGEN(j)  (2304 + 64 * (j))
#define XB_TOP      3328
#define XB_TOPGEN   3392
#define XCD_BAR_WORDS 3456
#define XB_SPIN_CAP (1u << 22)
__device__ __forceinline__ unsigned xb_ld(unsigned* p)              { return __hip_atomic_load(p, __ATOMIC_RELAXED, __HIP_MEMORY_SCOPE_AGENT); }
__device__ __forceinline__ unsigned xb_add(unsigned* p, unsigned v) { return __hip_atomic_fetch_add(p, v, __ATOMIC_RELAXED, __HIP_MEMORY_SCOPE_AGENT); }
__device__ __forceinline__ unsigned xb_xcc_id() { return (unsigned)__builtin_amdgcn_s_getreg((3 << 11) | 20) & 0xFu; }
#define XB_SPIN(cond, bar) do { unsigned _sp = 0; while (cond) { __builtin_amdgcn_s_sleep(1); \
    if ((++_sp & 255u) == 0u) { if (xb_ld(&(bar)[XB_TMO])) break; if (_sp > XB_SPIN_CAP) { atomicAdd(&(bar)[XB_TMO], 1u); break; } } } } while (0)
struct XcdBarrier { unsigned* bar; unsigned x; volatile LAS unsigned* st; };
__device__ __forceinline__ XcdBarrier xcd_barrier_post(unsigned* bar, volatile LAS unsigned* st) {
    XcdBarrier b; b.bar = bar; b.x = xb_xcc_id(); b.st = st;
    if (threadIdx.x == 0) (void)xb_add(&bar[XB_XCNT(b.x)], 1u);
    return b;
}
__device__ __forceinline__ void xcd_barrier_complete(unsigned* bar, unsigned x, unsigned& nloc, unsigned& nx) {
    const unsigned G = gridDim.x * gridDim.y * gridDim.z;
    unsigned sum, cnt, mine, sp = 0u;
    for (;;) {
        sum = 0u; cnt = 0u; mine = 0u;
#pragma unroll
        for (unsigned j = 0; j < 16; ++j) { const unsigned c = xb_ld(&bar[XB_XCNT(j)]); sum += c; cnt += (c > 0u) ? 1u : 0u; mine = (j == x) ? c : mine; }
        if (sum == G) break;
        __builtin_amdgcn_s_sleep(1);
        if ((++sp & 255u) == 0u) { if (xb_ld(&bar[XB_TMO])) break; if (sp > XB_SPIN_CAP) { atomicAdd(&bar[XB_TMO], 1u); break; } }
    }
    nloc = mine > 0u ? mine : 1u; nx = cnt > 0u ? cnt : 1u;
}
__device__ __forceinline__ void xcd_barrier(const XcdBarrier& b) {
    asm volatile("s_waitcnt vmcnt(0)" ::: "memory");
    __syncthreads();
    if (threadIdx.x == 0) {
        unsigned* bar = b.bar;
        __builtin_amdgcn_s_waitcnt(0);
        unsigned nloc = b.st[0], nx = b.st[1];
        if (nloc == 0u) { xcd_barrier_complete(bar, b.x, nloc, nx); b.st[0] = nloc; b.st[1] = nx; }
        const unsigned old = xb_add(&bar[XB_XSUB(b.x)], 1u);
        const unsigned gen = old / nloc;
        if (old + 1u == (gen + 1u) * nloc) {
            __builtin_amdgcn_fence(__ATOMIC_RELEASE, "agent");
            asm volatile("s_waitcnt vmcnt(0)" ::: "memory");
            const unsigned og = xb_add(&bar[XB_TOP], 1u);
            const unsigned tg = og / nx;
            if (og + 1u == (tg + 1u) * nx) xb_add(&bar[XB_TOPGEN], 1u);
            else XB_SPIN(xb_ld(&bar[XB_TOPGEN]) == tg, bar);
            __builtin_amdgcn_fence(__ATOMIC_ACQUIRE, "agent");
            xb_add(&bar[XB_XGEN(b.x)], 1u);
            asm volatile("s_waitcnt vmcnt(0)" ::: "memory");
        } else {
            XB_SPIN(xb_ld(&bar[XB_XGEN(b.x)]) == gen, bar);
            __builtin_amdgcn_fence(__ATOMIC_ACQUIRE, "agent");
            asm volatile("s_waitcnt vmcnt(0)" ::: "memory");
        }
    }
    __syncthreads();
}

__device__ __forceinline__ float dpp_xor1(float v) { return __builtin_bit_cast(float, __builtin_amdgcn_update_dpp(0, __builtin_bit_cast(int, v), 0xB1, 0xF, 0xF, true)); }
__device__ __forceinline__ float dpp_xor2(float v) { return __builtin_bit_cast(float, __builtin_amdgcn_update_dpp(0, __builtin_bit_cast(int, v), 0x4E, 0xF, 0xF, true)); }
__device__ __forceinline__ float dpp_qrev(float v) { return __builtin_bit_cast(float, __builtin_amdgcn_update_dpp(0, __builtin_bit_cast(int, v), 0x1B, 0xF, 0xF, true)); }
__device__ __forceinline__ float dpp_hmir(float v) { return __builtin_bit_cast(float, __builtin_amdgcn_update_dpp(0, __builtin_bit_cast(int, v), 0x141, 0xF, 0xF, true)); }
__device__ __forceinline__ float dpp_rmir(float v) { return __builtin_bit_cast(float, __builtin_amdgcn_update_dpp(0, __builtin_bit_cast(int, v), 0x140, 0xF, 0xF, true)); }
__device__ __forceinline__ float dpp_ror8(float v) { return __builtin_bit_cast(float, __builtin_amdgcn_update_dpp(0, __builtin_bit_cast(int, v), 0x128, 0xF, 0xF, true)); }
__device__ __forceinline__ float dpp_xor4(float v) { return dpp_qrev(dpp_hmir(v)); }
__device__ __forceinline__ float row16_sum(float v) { v += dpp_xor1(v); v += dpp_xor2(v); v += dpp_hmir(v); v += dpp_rmir(v); return v; }
__device__ __forceinline__ float rdlane(float v, int l) { return __builtin_bit_cast(float, __builtin_amdgcn_readlane(__builtin_bit_cast(int, v), l)); }
__device__ __forceinline__ float wave_sum(float v) { v = row16_sum(v); return (rdlane(v, 0) + rdlane(v, 16)) + (rdlane(v, 32) + rdlane(v, 48)); }
__device__ __forceinline__ void swap32(float& a, float& b) { asm volatile("s_nop 1\n\tv_permlane32_swap_b32 %0, %1" : "+v"(a), "+v"(b)); }
__device__ __forceinline__ void swap16(float& a, float& b) { asm volatile("s_nop 1\n\tv_permlane16_swap_b32 %0, %1" : "+v"(a), "+v"(b)); }
#define BFLY_SW32(acc, n) _Pragma("unroll") for (int i_ = 0; i_ < (n) / 2; ++i_) { float x_ = acc[i_], y_ = acc[i_ + (n) / 2]; swap32(x_, y_); acc[i_] = x_ + y_; }
#define BFLY_SW16(acc, n) _Pragma("unroll") for (int i_ = 0; i_ < (n) / 2; ++i_) { float x_ = acc[i_], y_ = acc[i_ + (n) / 2]; swap16(x_, y_); acc[i_] = x_ + y_; }
#define BFLY_DPP(acc, n, m, PERM) _Pragma("unroll") for (int i_ = 0; i_ < (n) / 2; ++i_) { const bool up_ = (lane & (m)) != 0; const float send_ = up_ ? acc[i_] : acc[i_ + (n) / 2]; const float keep_ = up_ ? acc[i_ + (n) / 2] : acc[i_]; acc[i_] = keep_ + PERM(send_); }
__device__ __forceinline__ float sigmoidf_(float x) { return 1.f / (1.f + expf(-x)); }
__device__ __forceinline__ float siluf_(float x) { return x / (1.f + expf(-x)); }
__device__ __forceinline__ float geluf_(float x) { return 0.5f * x * (1.f + erff(x * 0.70710678118654752f)); }
__device__ __forceinline__ float softplusf_(float x) { return x > 20.f ? x : log1pf(expf(x)); }

__device__ __forceinline__ void lds_barrier() { asm volatile("s_waitcnt lgkmcnt(0)" ::: "memory"); __builtin_amdgcn_s_barrier(); asm volatile("" ::: "memory"); }
struct Ctx { int bid, nb, tid, lane, wave; LAS unsigned char* lds; LAS unsigned char* lds0; };

namespace pg8 {
#define PG8_LAS __attribute__((address_space(3)))
typedef unsigned short bf16_t;
typedef short bf16x8 __attribute__((ext_vector_type(8)));
typedef float f32x4 __attribute__((ext_vector_type(4)));
typedef unsigned u32x4 __attribute__((ext_vector_type(4)));
constexpr int BM = 256, BK = 64, HALF = 128, HTB = HALF * BK * 2  , STAGE_BYTES = 8 * HTB, NXCD = 8, WGM = 8;

__host__ __device__ __forceinline__ int lds_byte(int r, int c) { const int st = (r >> 4) * 2 + (c >> 5), rr = r & 15, cc = c & 31, ob = rr * 64 + cc * 2; return st * 1024 + (ob ^ (((ob >> 9) & 1) << 5)); }
__host__ __device__ __forceinline__ void stage_rc(int b, int& R, int& C) { const int st = b / 1024, sb = b % 1024, swz = sb ^ (((sb >> 9) & 1) << 5); R = (st >> 1) * 16 + swz / 64; C = (st & 1) * 32 + (swz % 64) / 2; }
__host__ __device__ __forceinline__ int perm32(int rho) { const int n = rho >> 4, i = rho & 15; return 8 * (i >> 2) + 4 * n + (i & 3); }

struct Unit { int pm, pn, x0, x1, rb; };
struct Gemm { const bf16_t* A; const bf16_t* Bt; int M, N, K; const int* rows; };

struct StaticOrder {
    int nM, nN, nwg, G, c, wgm;
    __host__ __device__ void init(int M, int N, int G_, int c_, int wgm_ = WGM) { nM = M / BM; nN = N / BM; nwg = nM * nN; G = G_; c = c_; wgm = wgm_; }
    __host__ __device__ bool next(int i, Unit& u) const {
        const long L = (long)i * G + c; if (L >= nwg) return false;
        int wgid = (int)L; { const int q = nwg / NXCD, r = nwg % NXCD, xcd = wgid % NXCD, off = wgid / NXCD; wgid = (xcd < r ? xcd * (q + 1) : r * (q + 1) + (xcd - r) * q) + off; }
        const int nig = wgm * nN, gid = wgid / nig, fm = gid * wgm, gsz = (nM - fm) < wgm ? (nM - fm) : wgm;
        u.pm = fm + ((wgid % nig) % gsz); u.pn = (wgid % nig) / gsz; u.x0 = 0; u.x1 = u.pn; u.rb = 0; return true;
    }
    __device__ __forceinline__ void a_ready(const Unit&) const {}
    __device__ __forceinline__ void done(const Unit&) const {}
};


template <class Epi, class Sched, bool ALIGN_EPI = false, bool SP2 = false, bool GATHER = false, int BAUX = 0>
__device__ __forceinline__ void gemm_phase(PG8_LAS unsigned char* lds, const Gemm g, const Sched& S, const Epi& E) {
    int tid_ = threadIdx.x; asm volatile("" : "+v"(tid_));
    const int tid = tid_, wid = __builtin_amdgcn_readfirstlane(tid >> 6), lane = tid & 63, wr = wid >> 2, wc = wid & 3, fr = lane & 15, fq = lane >> 4;
    const int K = g.K, nt = K / BK;
    unsigned voffA[2], voffB[2]; int gR[2]; unsigned gC2[2];
#pragma unroll
    for (int i = 0; i < 2; ++i) { int R, C; stage_rc(tid * 16 + i * 8192, R, C); const int Rb = Epi::PERM ? ((R & ~31) + perm32(R & 31)) : R;
        voffA[i] = (unsigned)(R * K + C) * 2u; voffB[i] = (unsigned)(Rb * K + C) * 2u; gR[i] = R; gC2[i] = (unsigned)C * 2u; }
    static_assert(!GATHER || SP2, "GATHER is implemented for the SP2 loop only");
    unsigned gcur[2][2], gnxt[2][2]; int graw[4];
#define PG8_STAGE_A(bufoff, kptr, ktile, h, use_next) do { if constexpr (GATHER) { const unsigned sv_[2] = {(use_next) ? gnxt[h][0] : gcur[h][0], (use_next) ? gnxt[h][1] : gcur[h][1]}; \
        PG8_STAGE(bufoff, gA0 + (size_t)(ktile) * kstep, sv_); } else { PG8_STAGE(bufoff, (kptr) + ((h) ? hstep : 0), voffA); } } while (0)
    const size_t kstep = (size_t)(BK * 2);
    const size_t hstep = (size_t)HALF * K * 2;
    const size_t tstep = 2 * hstep;
    const unsigned ldsw = (unsigned)wid * 1024u;
    const int aoff = lds_byte(wr * 64 + fr, fq * 8), boff = lds_byte(wc * 32 + fr, fq * 8);
#define PG8_SA(b, h) (((b) * 2 + (h)) * HTB)
#define PG8_SB(b, h) ((4 + (b) * 2 + (h)) * HTB)
#define PG8_STAGE(bufoff, gbase, voff) do { _Pragma("unroll") for (int _i = 0; _i < 2; ++_i) \
        __builtin_amdgcn_global_load_lds((const unsigned*)((const char*)(gbase) + (voff)[_i]), (PG8_LAS unsigned*)(lds + (bufoff) + ldsw + _i * 8192), 16, 0, 0); } while (0)
#define PG8_STAGE_B(bufoff, gbase, voff) do { _Pragma("unroll") for (int _i = 0; _i < 2; ++_i) \
        __builtin_amdgcn_global_load_lds((const unsigned*)((const char*)(gbase) + (voff)[_i]), (PG8_LAS unsigned*)(lds + (bufoff) + ldsw + _i * 8192), 16, 0, BAUX); } while (0)
#define PG8_LDA(dst, b, h) do { _Pragma("unroll") for (int m = 0; m < 4; ++m) _Pragma("unroll") for (int k = 0; k < 2; ++k) dst[m][k] = *(const PG8_LAS bf16x8*)(lds + PG8_SA(b, h) + aoff + m * 2048 + k * 1024); } while (0)
#define PG8_LDB(dst, b, h) do { _Pragma("unroll") for (int n = 0; n < 2; ++n) _Pragma("unroll") for (int k = 0; k < 2; ++k) dst[n][k] = *(const PG8_LAS bf16x8*)(lds + PG8_SB(b, h) + boff + n * 2048 + k * 1024); } while (0)
#define PG8_MMA(ai, bj, At, Bt) do { __builtin_amdgcn_s_setprio(1); _Pragma("unroll") for (int m = 0; m < 4; ++m) _Pragma("unroll") for (int n = 0; n < 2; ++n) _Pragma("unroll") for (int k = 0; k < 2; ++k) \
        acc[ai][bj][m][n] = __builtin_amdgcn_mfma_f32_16x16x32_bf16(Bt[n][k], At[m][k], acc[ai][bj][m][n], 0, 0, 0); __builtin_amdgcn_s_setprio(0); } while (0)
#define PG8_WAIT_V(n) asm volatile("s_waitcnt vmcnt(" #n ")" ::: "memory")
#define PG8_WAIT_L(n) asm volatile("s_waitcnt lgkmcnt(" #n ")" ::: "memory")
#define PG8_BAR __builtin_amdgcn_s_barrier()
#define PG8_SCHED __builtin_amdgcn_sched_barrier(0)
    Unit cur, nxt; int ui = 0;
    if (!S.next(0, cur)) return;
    f32x4 acc[2][2][4][2];
#pragma unroll
    for (int a = 0; a < 2; ++a)
#pragma unroll
        for (int b = 0; b < 2; ++b)
#pragma unroll
            for (int m = 0; m < 4; ++m)
#pragma unroll
                for (int n = 0; n < 2; ++n) acc[a][b][m][n] = (f32x4){0.f, 0.f, 0.f, 0.f};
    bf16x8 At[4][2], B0[2][2], B1[2][2];
    const char* cA = (const char*)g.A + (size_t)cur.pm * tstep; const char* cB = (const char*)g.Bt + (size_t)cur.pn * tstep;
    const char* const gA0 = (const char*)g.A;
    if constexpr (GATHER) {
#pragma unroll
        for (int h = 0; h < 2; ++h)
#pragma unroll
            for (int i = 0; i < 2; ++i) { gcur[h][i] = (unsigned)g.rows[cur.rb + h * HALF + gR[i]] * (unsigned)(K * 2) + gC2[i]; gnxt[h][i] = gcur[h][i]; } }
    S.a_ready(cur);
    if constexpr (SP2) {
        PG8_STAGE_B(PG8_SB(0, 0), cB, voffB); PG8_STAGE_B(PG8_SB(0, 1), cB + hstep, voffB); PG8_STAGE_A(PG8_SA(0, 0), cA, 0, 0, false); PG8_STAGE_A(PG8_SA(0, 1), cA, 0, 1, false);
        if (wr == 1) PG8_BAR;
        PG8_WAIT_V(2); PG8_BAR;
        PG8_STAGE_B(PG8_SB(1, 0), cB + kstep, voffB); PG8_STAGE_A(PG8_SA(1, 0), cA + kstep, 1, 0, false); PG8_STAGE_B(PG8_SB(1, 1), cB + hstep + kstep, voffB);
        PG8_WAIT_V(6); PG8_BAR;
    } else {
        PG8_STAGE_B(PG8_SB(0, 0), cB, voffB); PG8_STAGE(PG8_SA(0, 0), cA, voffA); PG8_STAGE_B(PG8_SB(0, 1), cB + hstep, voffB); PG8_STAGE(PG8_SA(0, 1), cA + hstep, voffA);
        if (wr == 1) PG8_BAR;
        PG8_WAIT_V(4); PG8_BAR;
        PG8_STAGE_B(PG8_SB(1, 0), cB + kstep, voffB); PG8_STAGE(PG8_SA(1, 0), cA + kstep, voffA); PG8_STAGE_B(PG8_SB(1, 1), cB + hstep + kstep, voffB);
        PG8_WAIT_V(6); PG8_BAR;
    }
    for (;;) {
        const bool has_next = S.next(ui + 1, nxt);
        const char* nA = has_next ? (const char*)g.A + (size_t)nxt.pm * tstep : cA; const char* nB = has_next ? (const char*)g.Bt + (size_t)nxt.pn * tstep : cB;
        if constexpr (GATHER) { if (has_next) {
#pragma unroll
            for (int h = 0; h < 2; ++h)
#pragma unroll
                for (int i = 0; i < 2; ++i) asm volatile("global_load_dword %0, %1, off" : "=v"(graw[h * 2 + i]) : "v"(g.rows + (nxt.rb + h * HALF + gR[i])) : "memory"); } }
        for (int t = 0; t < nt; t += 2) {
            const bool last = (t == nt - 2);
            const char* a1 = cA + (size_t)(t + 1) * kstep;
            const char* a2 = last ? nA : cA + (size_t)(t + 2) * kstep; const char* b2 = last ? nB : cB + (size_t)(t + 2) * kstep;
            const char* a3 = a2 + kstep; const char* b3 = b2 + kstep;
            if (last && has_next) S.a_ready(nxt);
            if constexpr (GATHER) { if (last) { if (has_next) { asm volatile("" : "+v"(graw[0]), "+v"(graw[1]), "+v"(graw[2]), "+v"(graw[3]));
#pragma unroll
                    for (int h = 0; h < 2; ++h)
#pragma unroll
                        for (int i = 0; i < 2; ++i) gnxt[h][i] = (unsigned)graw[h * 2 + i] * (unsigned)(K * 2) + gC2[i]; }
                else {
#pragma unroll
                    for (int h = 0; h < 2; ++h)
#pragma unroll
                        for (int i = 0; i < 2; ++i) gnxt[h][i] = gcur[h][i]; } } }
            const int kt2 = last ? 0 : t + 2;
            if constexpr (SP2) {
            PG8_LDB(B0, 0, 0); PG8_LDB(B1, 0, 1); PG8_SCHED; PG8_LDA(At, 0, 0); PG8_STAGE_A(PG8_SA(1, 1), a1, t + 1, 1, false);
            PG8_WAIT_V(8); PG8_WAIT_L(0); PG8_BAR; PG8_MMA(0, 0, At, B0); PG8_MMA(0, 1, At, B1); PG8_BAR; PG8_SCHED;
            PG8_LDA(At, 0, 1); PG8_STAGE_B(PG8_SB(0, 0), b2, voffB); PG8_STAGE_B(PG8_SB(0, 1), b2 + hstep, voffB); PG8_STAGE_A(PG8_SA(0, 0), a2, kt2, 0, last);
            PG8_WAIT_V(8); PG8_WAIT_L(0); PG8_BAR; PG8_MMA(1, 0, At, B0); PG8_MMA(1, 1, At, B1); PG8_BAR; PG8_SCHED;
            PG8_LDB(B0, 1, 0); PG8_LDB(B1, 1, 1); PG8_SCHED; PG8_LDA(At, 1, 0); PG8_STAGE_A(PG8_SA(0, 1), a2, kt2, 1, last);
            PG8_WAIT_V(8); PG8_WAIT_L(0); PG8_BAR; PG8_MMA(0, 0, At, B0); PG8_MMA(0, 1, At, B1); PG8_BAR; PG8_SCHED;
            PG8_LDA(At, 1, 1); PG8_STAGE_B(PG8_SB(1, 0), b3, voffB); PG8_STAGE_B(PG8_SB(1, 1), b3 + hstep, voffB); PG8_STAGE_A(PG8_SA(1, 0), a3, kt2 + 1, 0, last);
            PG8_WAIT_V(8); PG8_WAIT_L(0); PG8_BAR; PG8_MMA(1, 0, At, B0); PG8_MMA(1, 1, At, B1); PG8_BAR; PG8_SCHED;
            } else {
            PG8_LDB(B0, 0, 0); PG8_SCHED; PG8_LDA(At, 0, 0); PG8_STAGE(PG8_SA(1, 1), a1 + hstep, voffA);
            PG8_WAIT_L(8); PG8_BAR; PG8_WAIT_L(0); PG8_MMA(0, 0, At, B0); PG8_BAR; PG8_SCHED;
            PG8_LDB(B1, 0, 1); PG8_STAGE_B(PG8_SB(0, 0), b2, voffB);
            PG8_BAR; PG8_WAIT_L(0); PG8_MMA(0, 1, At, B1); PG8_BAR;
            PG8_LDA(At, 0, 1); PG8_STAGE(PG8_SA(0, 0), a2, voffA);
            PG8_BAR; PG8_WAIT_L(0); PG8_MMA(1, 0, At, B0); PG8_BAR; PG8_SCHED;
            PG8_STAGE_B(PG8_SB(0, 1), b2 + hstep, voffB);
            PG8_WAIT_V(6); PG8_BAR; PG8_MMA(1, 1, At, B1); PG8_BAR;
            PG8_LDB(B0, 1, 0); PG8_SCHED; PG8_LDA(At, 1, 0); PG8_STAGE(PG8_SA(0, 1), a2 + hstep, voffA);
            PG8_WAIT_L(8); PG8_BAR; PG8_WAIT_L(0); PG8_MMA(0, 0, At, B0); PG8_BAR; PG8_SCHED;
            PG8_LDB(B1, 1, 1); PG8_STAGE_B(PG8_SB(1, 0), b3, voffB);
            PG8_BAR; PG8_WAIT_L(0); PG8_MMA(0, 1, At, B1); PG8_BAR;
            PG8_LDA(At, 1, 1); PG8_STAGE(PG8_SA(1, 0), a3, voffA);
            PG8_BAR; PG8_WAIT_L(0); PG8_MMA(1, 0, At, B0); PG8_BAR; PG8_SCHED;
            PG8_STAGE_B(PG8_SB(1, 1), b3 + hstep, voffB);
            PG8_WAIT_V(6); PG8_BAR; PG8_MMA(1, 1, At, B1); PG8_BAR;
            }
        }
        if constexpr (ALIGN_EPI) { if (wr == 0) PG8_BAR; }
        if constexpr (!Epi::AFTER_DRAIN) { E(acc, cur, wr, wc, fr, fq); S.done(cur); }
        if (!has_next) break;
        if (!E.keep_acc(cur)) {
#pragma unroll
        for (int a = 0; a < 2; ++a)
#pragma unroll
            for (int b = 0; b < 2; ++b)
#pragma unroll
                for (int m = 0; m < 4; ++m)
#pragma unroll
                    for (int n = 0; n < 2; ++n) acc[a][b][m][n] = (f32x4){0.f, 0.f, 0.f, 0.f};
        }
        cur = nxt; cA = nA; cB = nB; ++ui;
        if constexpr (GATHER) {
#pragma unroll
            for (int h = 0; h < 2; ++h)
#pragma unroll
                for (int i = 0; i < 2; ++i) gcur[h][i] = gnxt[h][i]; }
        if constexpr (ALIGN_EPI) { if (wr == 1) PG8_BAR; }
    }
    PG8_WAIT_V(0);
    if constexpr (!ALIGN_EPI) { if (wr == 0) PG8_BAR; }
    PG8_BAR;
    if constexpr (Epi::AFTER_DRAIN) { E.fused(acc, cur, wr, wc, fr, fq, lds, wid, lane); S.done(cur); }
#undef PG8_SA
#undef PG8_SB
#undef PG8_STAGE
#undef PG8_STAGE_B
#undef PG8_STAGE_A
#undef PG8_LDA
#undef PG8_LDB
#undef PG8_MMA
#undef PG8_WAIT_V
#undef PG8_WAIT_L
#undef PG8_BAR
#undef PG8_SCHED
}
}
typedef unsigned short bf16;
typedef unsigned v4u __attribute__((ext_vector_type(4)));
typedef unsigned v2u __attribute__((ext_vector_type(2)));
typedef float f32x4 __attribute__((ext_vector_type(4)));
typedef short bf16x8 __attribute__((ext_vector_type(8)));
#define MFMA16(a, b, c) __builtin_amdgcn_mfma_f32_16x16x32_bf16((a), (b), (c), 0, 0, 0)
__device__ __forceinline__ bf16x8 as_frag(const v4u& x) { return __builtin_bit_cast(bf16x8, x); }
#define LDS_WAIT() asm volatile("s_waitcnt lgkmcnt(0)" ::: "memory")
#define VM_WAIT() asm volatile("s_waitcnt vmcnt(0)" ::: "memory")
typedef float cvt_f32x2 __attribute__((ext_vector_type(2)));
typedef __bf16 cvt_bf16x2 __attribute__((ext_vector_type(2)));
__device__ __forceinline__ unsigned cvt_pk_bf16(float lo, float hi) { const cvt_f32x2 v = {lo, hi}; return __builtin_bit_cast(unsigned, __builtin_convertvector(v, cvt_bf16x2)); }
__device__ __forceinline__ v4u ldnt4(const void* p) { return __builtin_nontemporal_load((const v4u*)p); }
__device__ __forceinline__ v2u ldnt2(const void* p) { return __builtin_nontemporal_load((const v2u*)p); }
__device__ __forceinline__ float bf_lo(unsigned u) { return __uint_as_float(u << 16); }
__device__ __forceinline__ float bf_hi(unsigned u) { return __uint_as_float(u & 0xffff0000u); }

template <bool NT = false>
__device__ __forceinline__ void tr_item(const float* __restrict__ src, int ldn, int k0, int nsrc0, bf16* dst, int K, int ndst0, LAS float* scr, int lane) {
    const int c4 = (lane & 15) * 4, kr = lane >> 4;
#pragma unroll 4
    for (int i = 0; i < 16; ++i) { const int kk = 4 * i + kr; const f32x4* gp = (const f32x4*)(src + (size_t)(k0 + kk) * ldn + nsrc0 + c4); const f32x4 v = NT ? __builtin_nontemporal_load(gp) : *gp;
        LAS float* s = scr + kk * 65 + c4; s[0] = v[0]; s[1] = v[1]; s[2] = v[2]; s[3] = v[3]; }
    LDS_WAIT();
    const int kc = lane & 7, nr = lane >> 3;
#pragma unroll
    for (int jj = 0; jj < 8; ++jj) { const int n = 8 * jj + nr; const LAS float* s = scr + (8 * kc) * 65 + n;
        v4u o; o.x = cvt_pk_bf16(s[0], s[65]); o.y = cvt_pk_bf16(s[130], s[195]); o.z = cvt_pk_bf16(s[260], s[325]); o.w = cvt_pk_bf16(s[390], s[455]);
        v4u* dp = (v4u*)(dst + (size_t)(ndst0 + n) * K + k0 + 8 * kc); if (NT) __builtin_nontemporal_store(o, dp); else *dp = o; }
    LDS_WAIT();
}
__device__ __forceinline__ void p_convert_moe(const Ctx& c, const float* w_gate_up, const float* w_down, bf16* Wgu_t, bf16* Wd_t) {
    LAS float* scr = (LAS float*)c.lds + c.wave * (64 * 65);
    constexpr int I_GU = NE * 16 * 32, I_D = NE * 16 * 16;
    for (int it = c.bid * NWAVES + c.wave; it < I_GU + I_D; it += c.nb * NWAVES) {
        if (it < I_GU) { const int e = it >> 9, r = it & 511, kb = r >> 5, nbk = r & 31, R0 = nbk * 64, pn = R0 >> 8, rr = R0 & 255, bj = rr >> 7, j0 = rr & 127;
            tr_item<true>(w_gate_up + (size_t)e * D * 2 * DFF, 2 * DFF, kb * 64, bj * DFF + 128 * pn + j0, Wgu_t + (size_t)e * 2 * DFF * D, D, R0, scr, c.lane); }
        else { const int r2 = it - I_GU, e = r2 >> 8, r = r2 & 255, kb = r >> 4, nbk = r & 15;
            tr_item<true>(w_down + (size_t)e * DFF * D, D, kb * 64, nbk * 64, Wd_t + (size_t)e * D * DFF, DFF, nbk * 64, scr, c.lane); }
    }
}

__device__ __forceinline__ float f4c(const float4& v, int i) { return i == 0 ? v.x : (i == 1 ? v.y : (i == 2 ? v.z : v.w)); }
__device__ __forceinline__ void p_router(const Ctx& c, const float* __restrict__ X1, const float* __restrict__ g2, const float* __restrict__ wr, const float* __restrict__ br, bf16* __restrict__ H2, int* __restrict__ slot_e, int* __restrict__ slot_pos, int* __restrict__ elist, float* __restrict__ ewgt, unsigned* gcnt, int reps = 1) {
    LAS f32x4* WL = (LAS f32x4*)c.lds;
    LAS float* LG = (LAS float*)(c.lds0 + EXTRA_OFF);
    LAS int* HIST = (LAS int*)(c.lds0 + EXTRA_OFF + 8192);
    LAS int* BASE = HIST + 32;
    LAS int* SELE = BASE + 32;
    LAS int* SELR = SELE + 256;
    LAS float* SELW = (LAS float*)(SELR + 256);
    const int lane = c.lane;
    { f32x4 wv[16];
#pragma unroll
      for (int i = 0; i < 16; ++i) wv[i] = ((const f32x4*)wr)[c.tid + NTHR * i];
#pragma unroll
      for (int i = 0; i < 16; ++i) { const int idx = c.tid + NTHR * i, k = idx >> 3, q = idx & 7, l = (k & 255) >> 2, cc = k & 3, j = k >> 8; WL[((j * 4 + cc) * 8 + q) * 64 + l] = wv[i]; } }
    lds_barrier();
    for (int blk = c.bid; blk < NTOK / 64; blk += c.nb) {
        if (c.tid < 32) HIST[c.tid] = 0;
        lds_barrier();
        for (int pp = 0; pp < 4 * reps; ++pp) { const int p = pp & 3;
            const size_t t0 = (size_t)blk * 64 + c.wave * 8 + 2 * p;
            float4 xa[4], xb[4]; float sa = 0.f, sb = 0.f;
#pragma unroll
            for (int j = 0; j < 4; ++j) { xa[j] = ((const float4*)(X1 + t0 * D))[lane + 64 * j]; xb[j] = ((const float4*)(X1 + (t0 + 1) * D))[lane + 64 * j];
                sa += xa[j].x * xa[j].x + xa[j].y * xa[j].y + xa[j].z * xa[j].z + xa[j].w * xa[j].w; sb += xb[j].x * xb[j].x + xb[j].y * xb[j].y + xb[j].z * xb[j].z + xb[j].w * xb[j].w; }
            const float ra = rsqrtf(wave_sum(sa) * (1.f / D) + RMS_EPS), rb = rsqrtf(wave_sum(sb) * (1.f / D) + RMS_EPS);
#pragma unroll
            for (int j = 0; j < 4; ++j) { const float4 g = ((const float4*)g2)[lane + 64 * j];
                xa[j].x *= ra * g.x; xa[j].y *= ra * g.y; xa[j].z *= ra * g.z; xa[j].w *= ra * g.w; xb[j].x *= rb * g.x; xb[j].y *= rb * g.y; xb[j].z *= rb * g.z; xb[j].w *= rb * g.w;
                v2u oa, ob; oa.x = cvt_pk_bf16(xa[j].x, xa[j].y); oa.y = cvt_pk_bf16(xa[j].z, xa[j].w); ob.x = cvt_pk_bf16(xb[j].x, xb[j].y); ob.y = cvt_pk_bf16(xb[j].z, xb[j].w);
                ((v2u*)(H2 + t0 * D))[lane + 64 * j] = oa; ((v2u*)(H2 + (t0 + 1) * D))[lane + 64 * j] = ob; }
            float acc[64];
#pragma unroll
            for (int i = 0; i < 64; ++i) acc[i] = 0.f;
#pragma unroll
            for (int j = 0; j < 4; ++j)
#pragma unroll
                for (int cc = 0; cc < 4; ++cc) { const float ha = f4c(xa[j], cc), hb = f4c(xb[j], cc);
#pragma unroll
                    for (int q = 0; q < 8; ++q) { const f32x4 w = WL[((j * 4 + cc) * 8 + q) * 64 + lane];
                        acc[4 * q + 0] = fmaf(ha, w.x, acc[4 * q + 0]); acc[4 * q + 1] = fmaf(ha, w.y, acc[4 * q + 1]); acc[4 * q + 2] = fmaf(ha, w.z, acc[4 * q + 2]); acc[4 * q + 3] = fmaf(ha, w.w, acc[4 * q + 3]);
                        acc[32 + 4 * q + 0] = fmaf(hb, w.x, acc[32 + 4 * q + 0]); acc[32 + 4 * q + 1] = fmaf(hb, w.y, acc[32 + 4 * q + 1]); acc[32 + 4 * q + 2] = fmaf(hb, w.z, acc[32 + 4 * q + 2]); acc[32 + 4 * q + 3] = fmaf(hb, w.w, acc[32 + 4 * q + 3]); } }
            BFLY_SW32(acc, 64) BFLY_SW16(acc, 32) BFLY_DPP(acc, 16, 8, dpp_ror8) BFLY_DPP(acc, 8, 4, dpp_xor4) BFLY_DPP(acc, 4, 2, dpp_xor2) BFLY_DPP(acc, 2, 1, dpp_xor1)
            LG[(c.wave * 8 + 2 * p + (lane >> 5)) * 32 + (lane & 31)] = acc[0] + br[lane & 31];
        }
        LDS_WAIT();
        if (lane < 8) {
            const int tokl = c.wave * 8 + lane;
            float l[NE];
#pragma unroll
            for (int j = 0; j < NE; ++j) l[j] = LG[tokl * 32 + j];
            int sel[4]; float sv[4];
#pragma unroll
            for (int k = 0; k < 4; ++k) { int bi = 0; float bv = -INFINITY;
#pragma unroll
                for (int j = 0; j < NE; ++j) { const bool better = l[j] > bv; bv = better ? l[j] : bv; bi = better ? j : bi; }
                sel[k] = bi; sv[k] = bv;
#pragma unroll
                for (int j = 0; j < NE; ++j) l[j] = (j == bi) ? -INFINITY : l[j]; }
            float den = 0.f, ex[4];
#pragma unroll
            for (int k = 0; k < 4; ++k) { ex[k] = expf(sv[k] - sv[0]); den += ex[k]; }
            const float inv = 1.f / den;
#pragma unroll
            for (int k = 0; k < 4; ++k) { SELE[tokl * 4 + k] = sel[k]; SELW[tokl * 4 + k] = ex[k] * inv; SELR[tokl * 4 + k] = atomicAdd((int*)(HIST + sel[k]), 1); }
        }
        lds_barrier();
        if (c.tid < 32) BASE[c.tid] = (int)__hip_atomic_fetch_add(gcnt + c.tid, (unsigned)HIST[c.tid], __ATOMIC_RELAXED, __HIP_MEMORY_SCOPE_AGENT);
        lds_barrier();
        if (c.tid < 256) { const int gi = blk * 256 + c.tid, e = SELE[c.tid], pos = BASE[e] + SELR[c.tid]; slot_e[gi] = e; slot_pos[gi] = pos; elist[e * NTOK + pos] = gi >> 2; ewgt[e * NTOK + pos] = SELW[c.tid]; }
    }
}

__device__ __forceinline__ void p_build_wrt(const Ctx& c, const float* __restrict__ wr, bf16* __restrict__ WrT) {
    for (int i = c.bid * NTHR + c.tid; i < NE * D; i += c.nb * NTHR) { const int e = i >> 10, k = i & 1023; const float w = wr[k * NE + e];
        const unsigned hi = cvt_pk_bf16(w, 0.f) & 0xffffu; const float rem = w - __uint_as_float(hi << 16);
        WrT[e * D + k] = (bf16)hi; WrT[NE * D + e * D + k] = (bf16)(cvt_pk_bf16(rem, 0.f) & 0xffffu); }
}
__device__ __forceinline__ void p_router2(const Ctx& c, const float* __restrict__ X1, const float* __restrict__ g2, const bf16* __restrict__ WrT, const float* __restrict__ br, bf16* __restrict__ H2,
                                          int* __restrict__ slot_e, int* __restrict__ slot_pos, int* __restrict__ elist, float* __restrict__ ewgt, unsigned* gcnt) {
    LAS unsigned char* HH = c.lds; LAS unsigned char* HL = c.lds + 65536;
    LAS float* LG = (LAS float*)(c.lds0 + EXTRA_OFF);
    LAS float* PART = LG + 1024;
    LAS int* HIST = (LAS int*)(PART + 1024);
    LAS int* BASE = HIST + 32; LAS int* SELE = BASE + 32; LAS int* SELR = SELE + 128; LAS float* SELW = (LAS float*)(SELR + 128);
    const int lane = c.lane, w = c.wave, fr = lane & 15, fq = lane >> 4;
    for (int blk = c.bid; blk < NTOK / 32; blk += c.nb) {
        if (c.tid < 32) HIST[c.tid] = 0;
#pragma unroll 1
        for (int p = 0; p < 2; ++p) {
            const int tl = w * 4 + 2 * p; const size_t t0 = (size_t)blk * 32 + tl;
            float4 xa[4], xb[4]; float sa = 0.f, sb = 0.f;
#pragma unroll
            for (int j = 0; j < 4; ++j) { xa[j] = ((const float4*)(X1 + t0 * D))[lane + 64 * j]; xb[j] = ((const float4*)(X1 + (t0 + 1) * D))[lane + 64 * j];
                sa += xa[j].x * xa[j].x + xa[j].y * xa[j].y + xa[j].z * xa[j].z + xa[j].w * xa[j].w; sb += xb[j].x * xb[j].x + xb[j].y * xb[j].y + xb[j].z * xb[j].z + xb[j].w * xb[j].w; }
            const float ra = rsqrtf(wave_sum(sa) * (1.f / D) + RMS_EPS), rb = rsqrtf(wave_sum(sb) * (1.f / D) + RMS_EPS);
#pragma unroll
            for (int j = 0; j < 4; ++j) { const float4 g = ((const float4*)g2)[lane + 64 * j];
                const float ha[4] = {xa[j].x * ra * g.x, xa[j].y * ra * g.y, xa[j].z * ra * g.z, xa[j].w * ra * g.w}, hb[4] = {xb[j].x * rb * g.x, xb[j].y * rb * g.y, xb[j].z * rb * g.z, xb[j].w * rb * g.w};
                v2u ah, al, bh, bl;
                ah.x = cvt_pk_bf16(ha[0], ha[1]); ah.y = cvt_pk_bf16(ha[2], ha[3]); bh.x = cvt_pk_bf16(hb[0], hb[1]); bh.y = cvt_pk_bf16(hb[2], hb[3]);
                al.x = cvt_pk_bf16(ha[0] - bf_lo(ah.x), ha[1] - bf_hi(ah.x)); al.y = cvt_pk_bf16(ha[2] - bf_lo(ah.y), ha[3] - bf_hi(ah.y));
                bl.x = cvt_pk_bf16(hb[0] - bf_lo(bh.x), hb[1] - bf_hi(bh.x)); bl.y = cvt_pk_bf16(hb[2] - bf_lo(bh.y), hb[3] - bf_hi(bh.y));
                ((v2u*)(H2 + t0 * D))[lane + 64 * j] = ah; ((v2u*)(H2 + (t0 + 1) * D))[lane + 64 * j] = bh;
                const int ch = (lane >> 1) + 32 * j, h8 = 8 * (lane & 1);
                const int oa = tl * 2048 + 16 * (ch ^ (tl & 15)) + h8, ob = (tl + 1) * 2048 + 16 * (ch ^ ((tl + 1) & 15)) + h8;
                *(LAS v2u*)(HH + oa) = ah; *(LAS v2u*)(HL + oa) = al; *(LAS v2u*)(HH + ob) = bh; *(LAS v2u*)(HL + ob) = bl; }
        }
        lds_barrier();
        { const int mt = w & 1, nt = (w >> 1) & 1, kh = w >> 2, tok = 16 * mt + fr; f32x4 acc = {0.f, 0.f, 0.f, 0.f};
            const bf16* wh = WrT + (size_t)(16 * nt + fr) * D + 8 * fq; const bf16* wl = wh + NE * D;
#pragma unroll 4
            for (int kk = 16 * kh; kk < 16 * kh + 16; ++kk) { const int off = tok * 2048 + 16 * ((4 * kk + fq) ^ (tok & 15));
                const bf16x8 ahi = *(const LAS bf16x8*)(HH + off), alo = *(const LAS bf16x8*)(HL + off);
                const bf16x8 bhi = as_frag(*(const v4u*)(wh + 32 * kk)), blo = as_frag(*(const v4u*)(wl + 32 * kk));
                acc = MFMA16(ahi, bhi, acc); acc = MFMA16(ahi, blo, acc); acc = MFMA16(alo, bhi, acc); }
            if (kh == 1) *(LAS f32x4*)(PART + ((mt * 2 + nt) * 64 + lane) * 4) = acc;
            lds_barrier();
            if (kh == 0) { const f32x4 pr = *(const LAS f32x4*)(PART + ((mt * 2 + nt) * 64 + lane) * 4); const float bb = br[16 * nt + fr];
#pragma unroll
                for (int r = 0; r < 4; ++r) LG[(16 * mt + 4 * fq + r) * 32 + 16 * nt + fr] = acc[r] + pr[r] + bb; } }
        lds_barrier();
        if (c.tid < 32) {
            const int tokl = c.tid;
            float l[NE];
#pragma unroll
            for (int j = 0; j < NE; ++j) l[j] = LG[tokl * 32 + j];
            int sel[4]; float sv[4];
#pragma unroll
            for (int k = 0; k < 4; ++k) { int bi = 0; float bv = -INFINITY;
#pragma unroll
                for (int j = 0; j < NE; ++j) { const bool better = l[j] > bv; bv = better ? l[j] : bv; bi = better ? j : bi; }
                sel[k] = bi; sv[k] = bv;
#pragma unroll
                for (int j = 0; j < NE; ++j) l[j] = (j == bi) ? -INFINITY : l[j]; }
            float den = 0.f, ex[4];
#pragma unroll
            for (int k = 0; k < 4; ++k) { ex[k] = expf(sv[k] - sv[0]); den += ex[k]; }
            const float inv = 1.f / den;
#pragma unroll
            for (int k = 0; k < 4; ++k) { SELE[tokl * 4 + k] = sel[k]; SELW[tokl * 4 + k] = ex[k] * inv; SELR[tokl * 4 + k] = atomicAdd((int*)(HIST + sel[k]), 1); }
        }
        lds_barrier();
        if (c.tid < 32) BASE[c.tid] = (int)__hip_atomic_fetch_add(gcnt + c.tid, (unsigned)HIST[c.tid], __ATOMIC_RELAXED, __HIP_MEMORY_SCOPE_AGENT);
        lds_barrier();
        if (c.tid < 128) { const int gi = blk * 128 + c.tid, e = SELE[c.tid], pos = BASE[e] + SELR[c.tid]; slot_e[gi] = e; slot_pos[gi] = pos; elist[e * NTOK + pos] = gi >> 2; ewgt[e * NTOK + pos] = SELW[c.tid]; }
        lds_barrier();
    }
}

struct MoeOrder {
    int t0, nt, nN, wgm, s, spx, base, lim, sigT; unsigned* tcnt; bool wait; const LAS unsigned char* tile_e; const LAS int* tile_b;
    __device__ __forceinline__ void init(int t0_, int nt_, int nN_, int wgm_, int s_, int spx_, int base_, int lim_, int sigT_, unsigned* tcnt_, bool wait_, const LAS unsigned char* te, const LAS int* tb) {
        t0 = t0_; nt = nt_; nN = nN_; wgm = wgm_; s = s_; spx = spx_; base = base_; lim = lim_; sigT = sigT_; tcnt = tcnt_; wait = wait_; tile_e = te; tile_b = tb; }
    __device__ __forceinline__ bool next(int i, pg8::Unit& u) const {
        const int off = base + s + i * spx; if (off < 0 || off >= lim) return false;
        const int nig = wgm * nN, gid = off / nig, fm = gid * wgm, gsz = (nt - fm) < wgm ? (nt - fm) : wgm, w = off - gid * nig;
        const int pm = t0 + fm + (w % gsz), pnl = w / gsz;
        const int e = __builtin_amdgcn_readfirstlane((int)tile_e[pm]);
        u.pm = pm; u.pn = e * nN + pnl; u.x0 = e; u.x1 = pnl; u.rb = e * NTOK + (pm - __builtin_amdgcn_readfirstlane(tile_b[e])) * 256; return true;
    }
    __device__ __forceinline__ void a_ready(const pg8::Unit& u) const {
        if (wait) { if (threadIdx.x < 64) { unsigned* p = tcnt + u.pm; unsigned sp = 0u;
                while (xb_ld(p) < 8u) { __builtin_amdgcn_s_sleep(2); if (++sp > (1u << 24)) break; }
                __builtin_amdgcn_fence(__ATOMIC_ACQUIRE, "agent"); }
            __builtin_amdgcn_s_barrier(); }
    }
    __device__ __forceinline__ void done(const pg8::Unit& u) const {
        if (sigT > 0 && (u.pm - t0) < sigT) { asm volatile("s_waitcnt vmcnt(0)" ::: "memory"); __builtin_amdgcn_s_barrier();
            if (threadIdx.x < 64) { __builtin_amdgcn_fence(__ATOMIC_RELEASE, "agent"); asm volatile("s_waitcnt vmcnt(0)" ::: "memory");
                if (threadIdx.x == 0) (void)xb_add(tcnt + u.pm, 1u); } }
    }
};
__device__ __forceinline__ void build_tile_table(const Ctx& c, const unsigned* gcnt, LAS unsigned char* tile_e, LAS int* ntiles, LAS int* tile_b) {
    if (c.tid == 0) { int tb = 0; for (int e = 0; e < NE; ++e) { const int nt = ((int)gcnt[e] + 255) >> 8; tile_b[e] = tb; for (int i = 0; i < nt; ++i) tile_e[tb + i] = (unsigned char)e; tb += nt; } tile_b[NE] = tb; ntiles[0] = tb; }
    lds_barrier();
}

struct EpiSwiglu {
    static constexpr bool PERM = true, AFTER_DRAIN = false;
    bf16* O; const float* bias;
    __device__ __forceinline__ bool keep_acc(const pg8::Unit&) const { return false; }
    __device__ __forceinline__ void operator()(const f32x4 (&acc)[2][2][4][2], const pg8::Unit& u, int wr, int wc, int fr, int fq) const {
        const int row0 = u.pm * 256 + wr * 64 + fr, col0 = u.x1 * 128 + wc * 32 + 8 * fq;
        const float* bg = bias + (size_t)u.x0 * 2 * DFF + col0; const float* bl = bg + DFF;
        f32x4 bgv[2], blv[2];
#pragma unroll
        for (int n = 0; n < 2; ++n) { bgv[n] = *(const f32x4*)(bg + 4 * n); blv[n] = *(const f32x4*)(bl + 4 * n); }
#pragma unroll
        for (int ai = 0; ai < 2; ++ai)
#pragma unroll
            for (int m = 0; m < 4; ++m) { bf16* rowp = O + (size_t)(row0 + ai * 128 + m * 16) * DFF + col0; float a[8];
#pragma unroll
                for (int n = 0; n < 2; ++n) { const f32x4 g = acc[ai][0][m][n] + bgv[n], l = acc[ai][1][m][n] + blv[n];
#pragma unroll
                    for (int i = 0; i < 4; ++i) { const float xg = fminf(g[i], 7.f), xl = fminf(fmaxf(l[i], -7.f), 7.f);
                        a[4 * n + i] = xg * __builtin_amdgcn_rcpf(1.f + __expf(-1.702f * xg)) * (xl + 1.f); } }
                v4u w; w.x = cvt_pk_bf16(a[0], a[1]); w.y = cvt_pk_bf16(a[2], a[3]); w.z = cvt_pk_bf16(a[4], a[5]); w.w = cvt_pk_bf16(a[6], a[7]);
                *(v4u*)rowp = w; }
    }
};
struct EpiDown {
    static constexpr bool PERM = true, AFTER_DRAIN = false;
    bf16* O; const float* bias; const float* roww;
    __device__ __forceinline__ bool keep_acc(const pg8::Unit&) const { return false; }
    __device__ __forceinline__ void operator()(const f32x4 (&acc)[2][2][4][2], const pg8::Unit& u, int wr, int wc, int fr, int fq) const {
        const int row0 = u.pm * 256 + wr * 64 + fr, col0 = u.x1 * 256 + wc * 32 + 8 * fq;
        const float* bp = bias + (size_t)u.x0 * D + col0;
        f32x4 bv[2][2];
#pragma unroll
        for (int bj = 0; bj < 2; ++bj)
#pragma unroll
            for (int n = 0; n < 2; ++n) bv[bj][n] = *(const f32x4*)(bp + bj * 128 + 4 * n);
#pragma unroll
        for (int ai = 0; ai < 2; ++ai)
#pragma unroll
            for (int m = 0; m < 4; ++m) { const int rl = wr * 64 + fr + ai * 128 + m * 16, row = u.pm * 256 + rl; const float w = roww[u.rb + rl]; bf16* rowp = O + (size_t)row * D + col0;
#pragma unroll
                for (int bj = 0; bj < 2; ++bj) { const f32x4 v0 = (acc[ai][bj][m][0] + bv[bj][0]) * w, v1 = (acc[ai][bj][m][1] + bv[bj][1]) * w;
                    v4u o; o.x = cvt_pk_bf16(v0[0], v0[1]); o.y = cvt_pk_bf16(v0[2], v0[3]); o.z = cvt_pk_bf16(v1[0], v1[1]); o.w = cvt_pk_bf16(v1[2], v1[3]);
                    *(v4u*)(rowp + bj * 128) = o; } }
    }
};

__device__ __forceinline__ void p_final(const Ctx& c, const float* __restrict__ X1, const bf16* __restrict__ Yb, const int* __restrict__ slot_e, const int* __restrict__ slot_pos, const unsigned* gcnt, const float* __restrict__ g, float* __restrict__ out, float pscale = 1.f) {
    LAS int* POFF = (LAS int*)(c.lds0 + EXTRA_OFF);
    if (c.tid == 0) { int s = 0; for (int e = 0; e < NE; ++e) { POFF[e] = s; s += (((int)gcnt[e] + 255) >> 8) << 8; } }
    lds_barrier();
#pragma unroll 2
    for (int t = c.bid * NWAVES + c.wave; t < NTOK; t += c.nb * NWAVES) {
        const int lane = c.lane; float4 v[4];
#pragma unroll
        for (int j = 0; j < 4; ++j) { const v4u xr = ldnt4((const v4u*)(X1 + (size_t)t * D) + lane + 64 * j); v[j] = make_float4(__uint_as_float(xr.x), __uint_as_float(xr.y), __uint_as_float(xr.z), __uint_as_float(xr.w)); }
#pragma unroll
        for (int k = 0; k < 4; ++k) { const int dst = POFF[slot_e[t * 4 + k]] + slot_pos[t * 4 + k];
#pragma unroll
            for (int j = 0; j < 4; ++j) { const v2u y = ldnt2((const v2u*)(Yb + (size_t)dst * D) + lane + 64 * j); v[j].x += bf_lo(y.x); v[j].y += bf_hi(y.x); v[j].z += bf_lo(y.y); v[j].w += bf_hi(y.y); } }
        float s = 0.f;
#pragma unroll
        for (int j = 0; j < 4; ++j) s += v[j].x * v[j].x + v[j].y * v[j].y + v[j].z * v[j].z + v[j].w * v[j].w;
        const float r = rsqrtf(wave_sum(s) * (1.f / D) + RMS_EPS) * pscale;
#pragma unroll
        for (int j = 0; j < 4; ++j) { const float4 gg = ((const float4*)g)[lane + 64 * j]; const f32x4 ov = {v[j].x * r * gg.x, v[j].y * r * gg.y, v[j].z * r * gg.z, v[j].w * r * gg.w}; __builtin_nontemporal_store(ov, (f32x4*)(out + (size_t)t * D) + lane + 64 * j); }
    }
}

constexpr int PJ = 5120;
typedef float f32x2 __attribute__((ext_vector_type(2)));
__device__ __forceinline__ f32x2 gelu_pk(f32x2 v) {
    const f32x2 av = __builtin_elementwise_abs(v), d = av * 0.2316418882f + 1.0f;
    f32x2 t; t.x = __builtin_amdgcn_rcpf(d.x); t.y = __builtin_amdgcn_rcpf(d.y);
    f32x2 q = t * 0.5307027145f + (-0.7265760135f); q = q * t + 0.7107068705f; q = q * t + (-0.142248368f); q = q * t + 0.127414796f; q = q * t;
    const f32x2 s = (v * v) * (-0.72134752044f);
    f32x2 e; e.x = __builtin_amdgcn_exp2f(s.x); e.y = __builtin_amdgcn_exp2f(s.y);
    const f32x2 m = v * (q * e), r = v - m;
    f32x2 o; o.x = v.x < 0.f ? m.x : r.x; o.y = v.y < 0.f ? m.y : r.y; return o;
}
__device__ __forceinline__ float fast_sigmoid(float x) { return __builtin_amdgcn_rcpf(1.f + __expf(-x)); }

__device__ __forceinline__ void p_convert_front(const Ctx& c, const float* w_in, const float* w_o_dn, const float* w_o_sg, const float* w_out, bf16* Win_t, bf16* Wo_t, bf16* Wout_t) {
    LAS float* scr = (LAS float*)c.lds + c.wave * (64 * 65);
    constexpr int I_IN = 16 * 80, I_O = 8 * 16, I_OUT = 16 * 16;
    for (int it = c.bid * NWAVES + c.wave; it < I_IN + 2 * I_O + I_OUT; it += c.nb * NWAVES) {
        int r = it;
        if (r < I_IN) { const int kb = r / 80, nbk = r % 80, n0 = nbk * 64; tr_item<true>(w_in, INC, kb * 64, n0 < 2048 ? n0 : n0 + 8, Win_t, D, n0, scr, c.lane); continue; } r -= I_IN;
        if (r < I_O) { const int kb = r / 16, nbk = r % 16; tr_item<true>(w_o_dn, D, kb * 64, nbk * 64, Wo_t, DNW, nbk * 64, scr, c.lane); continue; } r -= I_O;
        if (r < I_O) { const int kb = r / 16, nbk = r % 16; tr_item<true>(w_o_sg, D, kb * 64, nbk * 64, Wo_t + (size_t)D * DNW, SGW, nbk * 64, scr, c.lane); continue; } r -= I_O;
        { const int kb = r / 16, nbk = r % 16; tr_item<true>(w_out, D, kb * 64, nbk * 64, Wout_t, D, nbk * 64, scr, c.lane); }
    }
}
__device__ __forceinline__ void p_norm1(const Ctx& c, const float* __restrict__ x, const float* __restrict__ g1, const float* __restrict__ w_in, const float* __restrict__ a_log, const float* __restrict__ dt_bias, bf16* __restrict__ Hb, float* __restrict__ BG) {
    LAS f32x4* WB = (LAS f32x4*)c.lds;
    const int lane = c.lane;
    for (int idx = c.tid; idx < 2048; idx += NTHR) { const int k = idx >> 1, q = idx & 1; const f32x4 v = *(const f32x4*)(w_in + (size_t)k * INC + 2048 + 4 * q);
        const int l = (k & 255) >> 2, cc = k & 3, j = k >> 8; WB[((j * 4 + cc) * 2 + q) * 64 + l] = v; }
    lds_barrier();
#pragma unroll 2
    for (int t = c.bid * NWAVES + c.wave; t < NTOK; t += c.nb * NWAVES) {
        float4 xv[4]; float ss = 0.f;
#pragma unroll
        for (int j = 0; j < 4; ++j) { xv[j] = ((const float4*)(x + (size_t)t * D))[lane + 64 * j]; ss += xv[j].x * xv[j].x + xv[j].y * xv[j].y + xv[j].z * xv[j].z + xv[j].w * xv[j].w; }
        const float r = rsqrtf(wave_sum(ss) * (1.f / D) + RMS_EPS);
#pragma unroll
        for (int j = 0; j < 4; ++j) { const float4 g = ((const float4*)g1)[lane + 64 * j]; xv[j].x *= r * g.x; xv[j].y *= r * g.y; xv[j].z *= r * g.z; xv[j].w *= r * g.w;
            v2u o; o.x = cvt_pk_bf16(xv[j].x, xv[j].y); o.y = cvt_pk_bf16(xv[j].z, xv[j].w); ((v2u*)(Hb + (size_t)t * D))[lane + 64 * j] = o; }
        float acc[8];
#pragma unroll
        for (int i = 0; i < 8; ++i) acc[i] = 0.f;
#pragma unroll
        for (int j = 0; j < 4; ++j)
#pragma unroll
            for (int cc = 0; cc < 4; ++cc) { const float h = f4c(xv[j], cc);
#pragma unroll
                for (int q = 0; q < 2; ++q) { const f32x4 w = WB[((j * 4 + cc) * 2 + q) * 64 + lane];
                    acc[4 * q + 0] = fmaf(h, w.x, acc[4 * q + 0]); acc[4 * q + 1] = fmaf(h, w.y, acc[4 * q + 1]); acc[4 * q + 2] = fmaf(h, w.z, acc[4 * q + 2]); acc[4 * q + 3] = fmaf(h, w.w, acc[4 * q + 3]); } }
        BFLY_SW32(acc, 8) BFLY_SW16(acc, 4) BFLY_DPP(acc, 2, 8, dpp_ror8)
        float a0 = acc[0]; a0 += dpp_xor4(a0); a0 += dpp_xor2(a0); a0 += dpp_xor1(a0);
        const int idx = lane >> 3;
        if ((lane & 7) == 0) { float o;
            if (idx < 4) o = 1.f / (1.f + expf(-a0)); else { const int h = idx - 4; o = -expf(a_log[h]) * softplusf_(a0 + dt_bias[h]); }
            BG[(size_t)t * 8 + idx] = o; }
    }
}
struct EpiProj {
    static constexpr bool PERM = true, AFTER_DRAIN = false;
    bf16* O;
    __device__ __forceinline__ bool keep_acc(const pg8::Unit&) const { return false; }
    __device__ __forceinline__ void operator()(const f32x4 (&acc)[2][2][4][2], const pg8::Unit& u, int wr, int wc, int fr, int fq) const {
        const int row0 = u.pm * 256 + wr * 64 + fr, col0 = u.pn * 256 + wc * 32 + 8 * fq;
        const int act = (u.pn < 6) ? 0 : (u.pn < 8 ? 1 : (u.pn < 12 ? 2 : 0));
#pragma unroll
        for (int ai = 0; ai < 2; ++ai)
#pragma unroll
            for (int m = 0; m < 4; ++m) { bf16* rowp = O + (size_t)(row0 + ai * 128 + m * 16) * PJ + col0;
#pragma unroll
                for (int bj = 0; bj < 2; ++bj) { f32x4 v0 = acc[ai][bj][m][0], v1 = acc[ai][bj][m][1];
                    if (act == 1) {
#pragma unroll
                        for (int i = 0; i < 4; ++i) { v0[i] = v0[i] * fast_sigmoid(v0[i]); v1[i] = v1[i] * fast_sigmoid(v1[i]); } }
                    else if (act == 2) { const f32x2 a = gelu_pk((f32x2){v0[0], v0[1]}), b = gelu_pk((f32x2){v0[2], v0[3]}), cc = gelu_pk((f32x2){v1[0], v1[1]}), d = gelu_pk((f32x2){v1[2], v1[3]});
                        v0 = (f32x4){a.x, a.y, b.x, b.y}; v1 = (f32x4){cc.x, cc.y, d.x, d.y}; }
                    v4u w; w.x = cvt_pk_bf16(v0[0], v0[1]); w.y = cvt_pk_bf16(v0[2], v0[3]); w.z = cvt_pk_bf16(v1[0], v1[1]); w.w = cvt_pk_bf16(v1[2], v1[3]);
                    *(v4u*)(rowp + bj * 128) = w; } }
    }
};
struct DualOrder {
    pg8::StaticOrder S0;
    __device__ __forceinline__ void init(int G, int c) { S0.init(NTOK, D, G, c); }
    __device__ __forceinline__ bool next(int i, pg8::Unit& u) const { pg8::Unit t; if (!S0.next(i >> 1, t)) return false; const int which = i & 1; u.pm = t.pm + 64 * which; u.pn = t.pn + 4 * which; u.x0 = which; u.x1 = t.pn; u.rb = 0; return true; }
    __device__ __forceinline__ void a_ready(const pg8::Unit&) const {}
    __device__ __forceinline__ void done(const pg8::Unit&) const {}
};
struct EpiMerge {
    static constexpr bool PERM = true, AFTER_DRAIN = false;
    const bf16* P; bf16* O;
    __device__ __forceinline__ bool keep_acc(const pg8::Unit& u) const { return u.x0 == 0; }
    __device__ __forceinline__ void operator()(f32x4 (&acc)[2][2][4][2], const pg8::Unit& u, int wr, int wc, int fr, int fq) const {
        const int row0 = (u.pm & 63) * 256 + wr * 64 + fr, col0 = u.x1 * 256 + wc * 32 + 8 * fq; const bool first = (u.x0 == 0);
#pragma unroll
        for (int ai = 0; ai < 2; ++ai)
#pragma unroll
            for (int m = 0; m < 4; ++m) { const int row = row0 + ai * 128 + m * 16; const bf16* pr = P + (size_t)row * PJ + col0;
#pragma unroll
                for (int bj = 0; bj < 2; ++bj) { const v4u xb = *(const v4u*)(pr + 4096 + bj * 128); float fb[8];
                    fb[0] = bf_lo(xb.x); fb[1] = bf_hi(xb.x); fb[2] = bf_lo(xb.y); fb[3] = bf_hi(xb.y); fb[4] = bf_lo(xb.z); fb[5] = bf_hi(xb.z); fb[6] = bf_lo(xb.w); fb[7] = bf_hi(xb.w);
#pragma unroll
                    for (int i = 0; i < 8; ++i) fb[i] = 1.f + __expf(-fmaxf(fb[i], -30.f));
                    if (first) { const v4u xa = *(const v4u*)(pr + 3072 + bj * 128); float fa[8];
                        fa[0] = bf_lo(xa.x); fa[1] = bf_hi(xa.x); fa[2] = bf_lo(xa.y); fa[3] = bf_hi(xa.y); fa[4] = bf_lo(xa.z); fa[5] = bf_hi(xa.z); fa[6] = bf_lo(xa.w); fa[7] = bf_hi(xa.w);
#pragma unroll
                        for (int i = 0; i < 4; ++i) { acc[ai][bj][m][0][i] *= fb[i] * fast_sigmoid(fa[i]); acc[ai][bj][m][1][i] *= fb[4 + i] * fast_sigmoid(fa[4 + i]); } }
                    else { f32x4 v0, v1;
#pragma unroll
                        for (int i = 0; i < 4; ++i) { v0[i] = acc[ai][bj][m][0][i] * __builtin_amdgcn_rcpf(fb[i]); v1[i] = acc[ai][bj][m][1][i] * __builtin_amdgcn_rcpf(fb[4 + i]); }
                        v4u w; w.x = cvt_pk_bf16(v0[0], v0[1]); w.y = cvt_pk_bf16(v0[2], v0[3]); w.z = cvt_pk_bf16(v1[0], v1[1]); w.w = cvt_pk_bf16(v1[2], v1[3]);
                        *(v4u*)(O + (size_t)row * D + col0 + bj * 128) = w; } } }
    }
};
struct EpiResid {
    static constexpr bool PERM = false, AFTER_DRAIN = false;
    const float* X; float* O;
    __device__ __forceinline__ bool keep_acc(const pg8::Unit&) const { return false; }
    __device__ __forceinline__ void operator()(const f32x4 (&acc)[2][2][4][2], const pg8::Unit& u, int wr, int wc, int fr, int fq) const {
        const int row0 = u.pm * 256 + wr * 64 + fr, col0 = u.pn * 256 + wc * 32 + 4 * fq;
#pragma unroll
        for (int ai = 0; ai < 2; ++ai)
#pragma unroll
            for (int m = 0; m < 4; ++m) { const size_t off = (size_t)(row0 + ai * 128 + m * 16) * D + col0;
#pragma unroll
                for (int bj = 0; bj < 2; ++bj)
#pragma unroll
                    for (int n = 0; n < 2; ++n) *(f32x4*)(O + off + bj * 128 + n * 16) = *(const f32x4*)(X + off + bj * 128 + n * 16) + acc[ai][bj][m][n]; }
    }
};
__device__ __forceinline__ float ldbf(const bf16* p) { return __uint_as_float((unsigned)(*p) << 16); }
__device__ __forceinline__ unsigned short f2bf1(float f) { return (unsigned short)(cvt_pk_bf16(f, 0.f) & 0xffffu); }
__device__ __forceinline__ void unpack8(const v4u& x, float (&f)[8]) { f[0] = bf_lo(x.x); f[1] = bf_hi(x.x); f[2] = bf_lo(x.y); f[3] = bf_hi(x.y); f[4] = bf_lo(x.z); f[5] = bf_hi(x.z); f[6] = bf_lo(x.w); f[7] = bf_hi(x.w); }

constexpr size_t DN_WN = 16384, DN_QD = 16384, DN_KD = 16384, DN_QK = 8192, DN_U = 16384, DN_SST = 32768;
struct DnBufs { unsigned char *WN, *QD, *KD, *QK, *U, *SST; float* EG; };
constexpr int PL_QH = 0, PL_KH = 17408, PL_XVT = 34816, PL_XWT = 53248, PL_KDT = 71680, PL_AL = 90112, PL_TL = 106496, PL_GAM = 115712;
constexpr int RS = 136  , TS = 72  ;

__device__ __forceinline__ void p_dn_prep(const Ctx& c, const bf16* PROJ, const float* cw, const float* BG, const DnBufs& B) {
    LAS unsigned char* L = c.lds;
    LAS unsigned short* QH = (LAS unsigned short*)(L + PL_QH); LAS unsigned short* KH = (LAS unsigned short*)(L + PL_KH);
    LAS unsigned short* XVT = (LAS unsigned short*)(L + PL_XVT); LAS unsigned short* XWT = (LAS unsigned short*)(L + PL_XWT); LAS unsigned short* KDT = (LAS unsigned short*)(L + PL_KDT);
    LAS float* AL = (LAS float*)(L + PL_AL); LAS unsigned short* TL = (LAS unsigned short*)(L + PL_TL);
    LAS float* GAM = (LAS float*)(L + PL_GAM); LAS float* BETA = GAM + 64; LAS float* EGAM = GAM + 128; LAS float* KSC = GAM + 192;
    const int w = c.wave;
    LAS float* CWL = (LAS float*)(L + PL_GAM + 1024);
    constexpr int NITEMS = BATCH * DNH * (SEQ / 64);
    v4u xr[2][7];
#define DN_LOAD_ROWS(itx) do { const int bh_ = (itx) >> 7, ch_ = (itx) & 127, b_ = bh_ >> 2, h_ = bh_ & 3; int tid_ = c.tid; asm volatile("" : "+v"(tid_));     \
        _Pragma("unroll") for (int u_ = 0; u_ < 2; ++u_) { const int idx_ = tid_ + NTHR * u_; if (idx_ < 768) { const int tq_ = idx_ / 48, cg_ = idx_ % 48, col_ = (cg_ >> 4) * 512 + h_ * 128 + (cg_ & 15) * 8; \
            _Pragma("unroll") for (int r_ = 0; r_ < 7; ++r_) { const int tt_ = ch_ * 64 + 4 * tq_ - 3 + r_; \
                xr[u_][r_] = (tt_ >= 0) ? *(const v4u*)(PROJ + ((size_t)b_ * SEQ + tt_) * PJ + col_) : (v4u){0u, 0u, 0u, 0u}; } } } } while (0)
    float gpre = 0.f, bpre = 0.f, cwpre[4] = {0.f, 0.f, 0.f, 0.f};
#define DN_LOAD_SMALL(itx) do { const int bh_ = (itx) >> 7, ch_ = (itx) & 127, b_ = bh_ >> 2, h_ = bh_ & 3; const size_t r0_ = (size_t)b_ * SEQ + ch_ * 64; \
        if (w == 0) { gpre = BG[(r0_ + (c.tid & 63)) * 8 + 4 + h_]; bpre = BG[(r0_ + (c.tid & 63)) * 8 + h_]; } \
        if (c.tid < 384) { _Pragma("unroll") for (int kk_ = 0; kk_ < 4; ++kk_) cwpre[kk_] = cw[kk_ * 1536 + (c.tid >> 7) * 512 + h_ * 128 + (c.tid & 127)]; } } while (0)
    if (c.bid < NITEMS) { DN_LOAD_ROWS(c.bid); DN_LOAD_SMALL(c.bid); }
    for (int it = c.bid; it < NITEMS; it += c.nb) {
        int tl_ = c.tid; asm volatile("" : "+v"(tl_));
        const int lane = tl_ & 63, fr = lane & 15, fq = lane >> 4;
        const int bh = it >> 7, ch = it & 127, b = bh >> 2, h = bh & 3; const size_t row0 = (size_t)b * SEQ + ch * 64;
        if (c.tid < 384) {
#pragma unroll
            for (int kk = 0; kk < 4; ++kk) CWL[kk * 384 + c.tid] = cwpre[kk]; }
        if (w == 0) { const float gt = gpre, bt = bpre; float gam = gt;
#pragma unroll
            for (int o = 1; o < 64; o <<= 1) { const float t = __shfl_up(gam, o); if (lane >= o) gam += t; }
            const float gl = __shfl(gam, 63);
            GAM[lane] = gam; BETA[lane] = bt; EGAM[lane] = expf(gam); KSC[lane] = expf(gl - gam);
            if (lane == 0) B.EG[it] = expf(gl); }
        for (int i = c.tid; i < 1024; i += NTHR) ((LAS f32x4*)AL)[i] = (f32x4){0.f, 0.f, 0.f, 0.f};
        lds_barrier();
        int tidb = c.tid; asm volatile("" : "+v"(tidb));
#pragma unroll
        for (int u = 0; u < 2; ++u) { const int idx = tidb + NTHR * u; if (idx < 768) {
            const int tq = idx / 48, cg = idx % 48, part = cg >> 4, c8 = (cg & 15) * 8;
            f32x4 wt[4][2];
#pragma unroll
            for (int kk = 0; kk < 4; ++kk) { wt[kk][0] = *(const LAS f32x4*)(CWL + kk * 384 + part * 128 + c8); wt[kk][1] = *(const LAS f32x4*)(CWL + kk * 384 + part * 128 + c8 + 4); }
            float av[4][8];
            float s1v[4], s2v[4];
#pragma unroll
            for (int q = 0; q < 4; ++q) { const int t = 4 * tq + q;
                float a[8];
#pragma unroll
                for (int e = 0; e < 8; ++e) a[e] = 0.f;
#pragma unroll
                for (int kk = 0; kk < 4; ++kk) { float xf[8]; unpack8(xr[u][q + kk], xf);
#pragma unroll
                    for (int e = 0; e < 4; ++e) { a[e] = fmaf(wt[kk][0][e], xf[e], a[e]); a[4 + e] = fmaf(wt[kk][1][e], xf[4 + e], a[4 + e]); } }
                float ss = 0.f;
#pragma unroll
                for (int e = 0; e < 8; ++e) { a[e] = a[e] * __builtin_amdgcn_rcpf(1.f + __expf(-a[e])); ss = fmaf(a[e], a[e], ss); }
                ss = row16_sum(ss);
                const float rs = rsqrtf(ss + L2_EPS);
                if (part == 0) { const float sc = rs * 0.08838834764831845f; v4u o; o.x = cvt_pk_bf16(a[0] * sc, a[1] * sc); o.y = cvt_pk_bf16(a[2] * sc, a[3] * sc); o.z = cvt_pk_bf16(a[4] * sc, a[5] * sc); o.w = cvt_pk_bf16(a[6] * sc, a[7] * sc);
                    *(LAS v4u*)(QH + t * RS + c8) = o; }
                else if (part == 1) { v4u o; o.x = cvt_pk_bf16(a[0] * rs, a[1] * rs); o.y = cvt_pk_bf16(a[2] * rs, a[3] * rs); o.z = cvt_pk_bf16(a[4] * rs, a[5] * rs); o.w = cvt_pk_bf16(a[6] * rs, a[7] * rs);
                    *(LAS v4u*)(KH + t * RS + c8) = o; s1v[q] = rs * BETA[t] * EGAM[t]; s2v[q] = rs * KSC[t]; }
                else { s1v[q] = BETA[t]; s2v[q] = 0.f; }
#pragma unroll
                for (int e = 0; e < 8; ++e) av[q][e] = a[e];
            }
            if (part == 1) {
#pragma unroll
                for (int e = 0; e < 8; ++e) { v2u o1, o2; o1.x = cvt_pk_bf16(av[0][e] * s1v[0], av[1][e] * s1v[1]); o1.y = cvt_pk_bf16(av[2][e] * s1v[2], av[3][e] * s1v[3]);
                    o2.x = cvt_pk_bf16(av[0][e] * s2v[0], av[1][e] * s2v[1]); o2.y = cvt_pk_bf16(av[2][e] * s2v[2], av[3][e] * s2v[3]);
                    *(LAS v2u*)(XWT + (c8 + e) * TS + 4 * tq) = o1; *(LAS v2u*)(KDT + (c8 + e) * TS + 4 * tq) = o2; } }
            else if (part == 2) {
#pragma unroll
                for (int e = 0; e < 8; ++e) { v2u o1; o1.x = cvt_pk_bf16(av[0][e] * s1v[0], av[1][e] * s1v[1]); o1.y = cvt_pk_bf16(av[2][e] * s1v[2], av[3][e] * s1v[3]);
                    *(LAS v2u*)(XVT + (c8 + e) * TS + 4 * tq) = o1; } }
            } }
        lds_barrier();
        if (it + c.nb < NITEMS) { DN_LOAD_ROWS(it + c.nb); DN_LOAD_SMALL(it + c.nb); }
        { const int rt = w & 3, ksq = w >> 2; v2u half[2];
#pragma unroll
            for (int sub = 0; sub < 2; ++sub) { const int st = 2 * ksq + sub; f32x4 acc = {0.f, 0.f, 0.f, 0.f};
#pragma unroll
                for (int kk = 0; kk < 4; ++kk) { const bf16x8 a = *(const LAS bf16x8*)(KH + (16 * st + fr) * RS + 32 * kk + 8 * fq), bq = *(const LAS bf16x8*)(QH + (16 * rt + fr) * RS + 32 * kk + 8 * fq); acc = MFMA16(a, bq, acc); }
                const int rr = 16 * rt + fr; const float gr = GAM[rr]; float v[4];
#pragma unroll
                for (int r = 0; r < 4; ++r) { const int s2 = 16 * st + 4 * fq + r; v[r] = (s2 <= rr) ? acc[r] * __expf(fminf(gr - GAM[s2], 0.f)) : 0.f; }
                half[sub].x = cvt_pk_bf16(v[0], v[1]); half[sub].y = cvt_pk_bf16(v[2], v[3]); }
            v4u o; o.x = half[0].x; o.y = half[0].y; o.z = half[1].x; o.w = half[1].y;
            *(v4u*)(B.QK + (size_t)it * DN_QK + ((rt * 2 + ksq) * 64 + lane) * 16) = o; }
#pragma unroll 1
        for (int n = w; n < 10; n += 8) { const int rt = (n >= 6) ? 3 : (n >= 3 ? 2 : (n >= 1 ? 1 : 0)), st = n - rt * (rt + 1) / 2; f32x4 acc = {0.f, 0.f, 0.f, 0.f};
#pragma unroll
            for (int kk = 0; kk < 4; ++kk) { const bf16x8 a = *(const LAS bf16x8*)(KH + (16 * rt + fr) * RS + 32 * kk + 8 * fq), bk = *(const LAS bf16x8*)(KH + (16 * st + fr) * RS + 32 * kk + 8 * fq); acc = MFMA16(a, bk, acc); }
            const int s2 = 16 * st + fr; const float gs = GAM[s2];
#pragma unroll
            for (int r = 0; r < 4; ++r) { const int rr = 16 * rt + 4 * fq + r; const float v = (s2 < rr) ? BETA[rr] * acc[r] * __expf(fminf(GAM[rr] - gs, 0.f)) : 0.f; AL[rr * 64 + (s2 & 7) * 8 + (s2 >> 3)] = v; } }
        lds_barrier();
        { const int j = w * 8 + (lane >> 3), p = lane & 7; float tc[8];
#pragma unroll
            for (int i = 0; i < 8; ++i) tc[i] = 0.f;
#pragma unroll
            for (int r = 0; r < 64; ++r) { float s0 = 0.f, s1 = 0.f;
                if (r > 0) { const LAS float* ar = AL + r * 64 + p * 8; const f32x4 a0 = *(const LAS f32x4*)ar; s0 = a0[0] * tc[0];
                    if (r > 8) s1 = a0[1] * tc[1];
                    if (r > 16) s0 = fmaf(a0[2], tc[2], s0);
                    if (r > 24) s1 = fmaf(a0[3], tc[3], s1);
                    if (r > 32) { const f32x4 a1 = *(const LAS f32x4*)(ar + 4); s0 = fmaf(a1[0], tc[4], s0);
                        if (r > 40) s1 = fmaf(a1[1], tc[5], s1);
                        if (r > 48) s0 = fmaf(a1[2], tc[6], s0);
                        if (r > 56) s1 = fmaf(a1[3], tc[7], s1); } }
                float tot = s0 + s1; tot += dpp_xor1(tot); tot += dpp_xor2(tot); tot += dpp_hmir(tot);
                const float tr = ((r == j) ? 1.f : 0.f) - tot;
                if (p == (r & 7)) tc[r >> 3] = tr; }
#pragma unroll
            for (int i = 0; i < 8; ++i) TL[(8 * i + p) * TS + j] = f2bf1(tc[i]); }
        lds_barrier();
        { const int sl = w;
#pragma unroll
            for (int mt = 0; mt < 4; ++mt) { f32x4 acc = {0.f, 0.f, 0.f, 0.f};
#pragma unroll
                for (int kk = 0; kk < 2; ++kk) if (kk == 0 || mt >= 2) { const bf16x8 a = *(const LAS bf16x8*)(TL + (16 * mt + fr) * TS + 32 * kk + 8 * fq), bv = *(const LAS bf16x8*)(XVT + (16 * sl + fr) * TS + 32 * kk + 8 * fq); acc = MFMA16(a, bv, acc); }
                v2u o; o.x = cvt_pk_bf16(acc[0], acc[1]); o.y = cvt_pk_bf16(acc[2], acc[3]);
                *(v2u*)(B.U + (size_t)it * DN_U + ((mt * 8 + sl) * 64 + lane) * 8) = o; }
            const int dt = w;
#pragma unroll
            for (int rt = 0; rt < 4; ++rt) { f32x4 acc = {0.f, 0.f, 0.f, 0.f};
#pragma unroll
                for (int kk = 0; kk < 2; ++kk) if (kk == 0 || rt >= 2) { const bf16x8 a = *(const LAS bf16x8*)(XWT + (16 * dt + fr) * TS + 32 * kk + 8 * fq), bt = *(const LAS bf16x8*)(TL + (16 * rt + fr) * TS + 32 * kk + 8 * fq); acc = MFMA16(a, bt, acc); }
                v2u o; o.x = cvt_pk_bf16(-acc[0], -acc[1]); o.y = cvt_pk_bf16(-acc[2], -acc[3]);
                *(v2u*)(B.WN + (size_t)it * DN_WN + ((rt * 4 + (dt >> 1)) * 64 + lane) * 16 + (dt & 1) * 8) = o; } }
        { const int mt = w & 3;
#pragma unroll
            for (int q2 = 0; q2 < 2; ++q2) { const int ks = 2 * (w >> 2) + q2, rr = 16 * mt + fr; const float sc = EGAM[rr];
                const v2u lo = *(const LAS v2u*)(QH + rr * RS + 32 * ks + 4 * fq), hi = *(const LAS v2u*)(QH + rr * RS + 32 * ks + 16 + 4 * fq);
                v4u o; o.x = cvt_pk_bf16(bf_lo(lo.x) * sc, bf_hi(lo.x) * sc); o.y = cvt_pk_bf16(bf_lo(lo.y) * sc, bf_hi(lo.y) * sc); o.z = cvt_pk_bf16(bf_lo(hi.x) * sc, bf_hi(hi.x) * sc); o.w = cvt_pk_bf16(bf_lo(hi.y) * sc, bf_hi(hi.y) * sc);
                *(v4u*)(B.QD + (size_t)it * DN_QD + ((mt * 4 + ks) * 64 + lane) * 16) = o; }
            const int dt = w;
#pragma unroll
            for (int ks = 0; ks < 2; ++ks) { const v2u lo = *(const LAS v2u*)(KDT + (16 * dt + fr) * TS + 32 * ks + 4 * fq), hi = *(const LAS v2u*)(KDT + (16 * dt + fr) * TS + 32 * ks + 16 + 4 * fq);
                v4u o; o.x = lo.x; o.y = lo.y; o.z = hi.x; o.w = hi.y;
                *(v4u*)(B.KD + (size_t)it * DN_KD + ((dt * 2 + ks) * 64 + lane) * 16) = o; } }
        lds_barrier();
    }
}

constexpr int SCAN_WGS = BATCH * DNH * 2;
__device__ __forceinline__ void u_load_asm(v2u& dst, const unsigned char* p) { asm volatile("global_load_dwordx2 %0, %1, off" : "=v"(dst) : "v"(p) : "memory"); }
template <int STG>
__device__ __forceinline__ void scan_step(const DnBufs& B, LAS unsigned char* L, int lane, int sl, int it, int ch, f32x4 (&S)[8], v2u (&ucur)[4], v2u (&unxt)[4], float egc) {
    if (ch < 126) asm volatile("s_waitcnt vmcnt(8)" ::: "memory"); else asm volatile("s_waitcnt vmcnt(0)" ::: "memory");
    __builtin_amdgcn_s_barrier(); asm volatile("" ::: "memory");
    asm volatile("" : "+v"(ucur[0]), "+v"(ucur[1]), "+v"(ucur[2]), "+v"(ucur[3]));
    bf16x8 sf[4];
#pragma unroll
    for (int ks = 0; ks < 4; ++ks) { v4u o; o.x = cvt_pk_bf16(S[2 * ks][0], S[2 * ks][1]); o.y = cvt_pk_bf16(S[2 * ks][2], S[2 * ks][3]); o.z = cvt_pk_bf16(S[2 * ks + 1][0], S[2 * ks + 1][1]); o.w = cvt_pk_bf16(S[2 * ks + 1][2], S[2 * ks + 1][3]);
        *(v4u*)(B.SST + (size_t)it * DN_SST + ((ks * 8 + sl) * 64 + lane) * 16) = o; sf[ks] = as_frag(o); }
    asm volatile("" ::: "memory");
    if (ch + 3 < 128) {
#pragma unroll
        for (int mt = 0; mt < 4; ++mt) u_load_asm(unxt[mt], B.U + (size_t)(it + 3) * DN_U + ((mt * 8 + sl) * 64 + lane) * 8); }
    const LAS unsigned char* wl = L + STG * 32768 + lane * 16; const LAS unsigned char* kl = wl + 16384;
    f32x4 vn[4];
#pragma unroll
    for (int mt = 0; mt < 4; ++mt) { vn[mt] = (f32x4){bf_lo(ucur[mt].x), bf_hi(ucur[mt].x), bf_lo(ucur[mt].y), bf_hi(ucur[mt].y)};
#pragma unroll
        for (int ks = 0; ks < 4; ++ks) vn[mt] = MFMA16(*(const LAS bf16x8*)(wl + (mt * 4 + ks) * 1024), sf[ks], vn[mt]); }
    bf16x8 vf[2];
#pragma unroll
    for (int ks = 0; ks < 2; ++ks) { v4u o; o.x = cvt_pk_bf16(vn[2 * ks][0], vn[2 * ks][1]); o.y = cvt_pk_bf16(vn[2 * ks][2], vn[2 * ks][3]); o.z = cvt_pk_bf16(vn[2 * ks + 1][0], vn[2 * ks + 1][1]); o.w = cvt_pk_bf16(vn[2 * ks + 1][2], vn[2 * ks + 1][3]); vf[ks] = as_frag(o); }
#pragma unroll
    for (int dt = 0; dt < 8; ++dt) { f32x4 a = S[dt] * egc;
#pragma unroll
        for (int ks = 0; ks < 2; ++ks) a = MFMA16(*(const LAS bf16x8*)(kl + (dt * 2 + ks) * 1024), vf[ks], a);
        S[dt] = a; }
}
__device__ __forceinline__ void p_dn_scan(const Ctx& c, const DnBufs& B) {
    const int lane = c.lane, w = c.wave, bh = c.bid & 7, half = c.bid >> 3; LAS unsigned char* L = c.lds;
    if (w >= 4) {
        const unsigned char* gsrc = (w < 6) ? B.WN : B.KD; const int goff = (w & 1) * 8192 + lane * 16, loff = (w - 4) * 8192;
#define SCAN_DMA(itn, stage) do { _Pragma("unroll") for (int _p = 0; _p < 8; ++_p) \
        __builtin_amdgcn_global_load_lds((const unsigned*)(gsrc + (size_t)(itn) * 16384 + goff + _p * 1024), (LAS unsigned*)(L + (stage) * 32768 + loff + _p * 1024), 16, 0, 0); } while (0)
        const int it0 = bh * 128;
        SCAN_DMA(it0, 0); SCAN_DMA(it0 + 1, 1); SCAN_DMA(it0 + 2, 2);
#pragma unroll 1
        for (int ch = 0; ch < 128; ++ch) {
            if (ch < 126) asm volatile("s_waitcnt vmcnt(16)" ::: "memory"); else asm volatile("s_waitcnt vmcnt(0)" ::: "memory");
            __builtin_amdgcn_s_barrier(); asm volatile("" ::: "memory");
            if (ch + 3 < 128) SCAN_DMA(it0 + ch + 3, (ch + 3) & 3);
        }
#undef SCAN_DMA
    } else {
        __builtin_amdgcn_s_setprio(1);
        const int sl = half * 4 + w;
        f32x4 S[8];
#pragma unroll
        for (int i = 0; i < 8; ++i) S[i] = (f32x4){0.f, 0.f, 0.f, 0.f};
        v2u u0[4], u1[4], u2[4], u3[4];
        const float eglo = B.EG[bh * 128 + lane], eghi = B.EG[bh * 128 + 64 + lane];
        asm volatile("s_waitcnt vmcnt(0)" ::: "memory");
        { const int it = bh * 128;
#pragma unroll
            for (int mt = 0; mt < 4; ++mt) u_load_asm(u0[mt], B.U + (size_t)it * DN_U + ((mt * 8 + sl) * 64 + lane) * 8);
#pragma unroll
            for (int mt = 0; mt < 4; ++mt) u_load_asm(u1[mt], B.U + (size_t)(it + 1) * DN_U + ((mt * 8 + sl) * 64 + lane) * 8);
#pragma unroll
            for (int mt = 0; mt < 4; ++mt) u_load_asm(u2[mt], B.U + (size_t)(it + 2) * DN_U + ((mt * 8 + sl) * 64 + lane) * 8);
#pragma unroll
            for (int mt = 0; mt < 4; ++mt) u3[mt] = (v2u){0u, 0u}; }
#define EGC(chx) __builtin_bit_cast(float, __builtin_amdgcn_readlane(__builtin_bit_cast(int, (chx) < 64 ? eglo : eghi), (chx) & 63))
#pragma unroll 1
        for (int ch = 0; ch < 128; ch += 4) {
            const int it = bh * 128 + ch;
            scan_step<0>(B, L, lane, sl, it, ch, S, u0, u3, EGC(ch));
            scan_step<1>(B, L, lane, sl, it + 1, ch + 1, S, u1, u0, EGC(ch + 1));
            scan_step<2>(B, L, lane, sl, it + 2, ch + 2, S, u2, u1, EGC(ch + 2));
            scan_step<3>(B, L, lane, sl, it + 3, ch + 3, S, u3, u2, EGC(ch + 3));
        }
#undef EGC
        __builtin_amdgcn_s_setprio(0);
    }
    asm volatile("s_waitcnt vmcnt(0)" ::: "memory"); __builtin_amdgcn_s_barrier(); asm volatile("" ::: "memory");
}

__device__ __forceinline__ void p_dn_out(const Ctx& c, const DnBufs& B, const bf16* PROJ, const float* gn, bf16* YA) {
    const int lane = c.lane, sl = c.wave, fr = lane & 15, fq = lane >> 4; LAS float* SSQ = (LAS float*)c.lds;
    LAS unsigned char* IMG = c.lds + 2048;
    LAS float* OT = (LAS float*)(c.lds + 2048 + 40960);
    for (int it = c.bid; it < BATCH * DNH * (SEQ / 64); it += c.nb) {
        const int bh = it >> 7, ch = it & 127, b = bh >> 2, h = bh & 3; const size_t row0 = (size_t)b * SEQ + ch * 64;
        v4u sfr[4]; v2u ur[4]; v4u zr[2];
        { const size_t zrow = row0 + (c.tid >> 3); zr[0] = *(const v4u*)(PROJ + zrow * PJ + 1536 + h * 128 + 16 * (c.tid & 7)); zr[1] = *(const v4u*)(PROJ + zrow * PJ + 1536 + h * 128 + 16 * (c.tid & 7) + 8); }
#pragma unroll
        for (int ks = 0; ks < 4; ++ks) sfr[ks] = *(const v4u*)(B.SST + (size_t)it * DN_SST + ((ks * 8 + sl) * 64 + lane) * 16);
#pragma unroll
        for (int mt = 0; mt < 4; ++mt) ur[mt] = *(const v2u*)(B.U + (size_t)it * DN_U + ((mt * 8 + sl) * 64 + lane) * 8);
#pragma unroll
        for (int j = 0; j < 5; ++j) { const int p = sl * 5 + j;
            const unsigned char* src = (p < 16) ? B.WN + (size_t)it * DN_WN + p * 1024 : (p < 32 ? B.QD + (size_t)it * DN_QD + (p - 16) * 1024 : B.QK + (size_t)it * DN_QK + (p - 32) * 1024);
            __builtin_amdgcn_global_load_lds((const unsigned*)(src + lane * 16), (LAS unsigned*)(IMG + p * 1024), 16, 0, 0); }
        asm volatile("s_waitcnt vmcnt(0)" ::: "memory"); lds_barrier();
        bf16x8 sf[4];
#pragma unroll
        for (int ks = 0; ks < 4; ++ks) sf[ks] = as_frag(sfr[ks]);
        const LAS unsigned char* wn = IMG + lane * 16; const LAS unsigned char* qd = wn + 16384; const LAS unsigned char* qk = wn + 32768;
        f32x4 vn[4];
#pragma unroll
        for (int mt = 0; mt < 4; ++mt) { vn[mt] = (f32x4){bf_lo(ur[mt].x), bf_hi(ur[mt].x), bf_lo(ur[mt].y), bf_hi(ur[mt].y)};
#pragma unroll
            for (int ks = 0; ks < 4; ++ks) vn[mt] = MFMA16(*(const LAS bf16x8*)(wn + (mt * 4 + ks) * 1024), sf[ks], vn[mt]); }
        bf16x8 vf[2];
#pragma unroll
        for (int ks = 0; ks < 2; ++ks) { v4u o; o.x = cvt_pk_bf16(vn[2 * ks][0], vn[2 * ks][1]); o.y = cvt_pk_bf16(vn[2 * ks][2], vn[2 * ks][3]); o.z = cvt_pk_bf16(vn[2 * ks + 1][0], vn[2 * ks + 1][1]); o.w = cvt_pk_bf16(vn[2 * ks + 1][2], vn[2 * ks + 1][3]); vf[ks] = as_frag(o); }
        f32x4 o[4];
#pragma unroll
        for (int mt = 0; mt < 4; ++mt) { f32x4 a = {0.f, 0.f, 0.f, 0.f};
#pragma unroll
            for (int ks = 0; ks < 4; ++ks) a = MFMA16(*(const LAS bf16x8*)(qd + (mt * 4 + ks) * 1024), sf[ks], a);
#pragma unroll
            for (int ks = 0; ks < 2; ++ks) a = MFMA16(*(const LAS bf16x8*)(qk + (mt * 2 + ks) * 1024), vf[ks], a);
            o[mt] = a;
#pragma unroll
            for (int r = 0; r < 4; ++r) { float q = row16_sum(a[r] * a[r]);
                if (fr == 0) SSQ[(16 * mt + 4 * fq + r) * 8 + sl] = q; } }
#pragma unroll
        for (int mt = 0; mt < 4; ++mt)
#pragma unroll
            for (int r = 0; r < 4; ++r) OT[(16 * mt + 4 * fq + r) * 132 + 16 * sl + fr] = o[mt][r];
        lds_barrier();
        { const int row = c.tid >> 3, seg = c.tid & 7; const size_t grow = row0 + row; const int col = h * 128 + 16 * seg;
            const f32x4 q0 = *(const LAS f32x4*)(SSQ + row * 8), q1 = *(const LAS f32x4*)(SSQ + row * 8 + 4);
            const float rstd = rsqrtf(((q0[0] + q0[1]) + (q0[2] + q0[3]) + (q1[0] + q1[1]) + (q1[2] + q1[3])) * (1.f / 128.f) + RMS_EPS);
            float zf[16]; { float t8[8]; unpack8(zr[0], t8);
#pragma unroll
                for (int e = 0; e < 8; ++e) zf[e] = t8[e];
                unpack8(zr[1], t8);
#pragma unroll
                for (int e = 0; e < 8; ++e) zf[8 + e] = t8[e]; }
            float y[16];
#pragma unroll
            for (int j = 0; j < 4; ++j) { const f32x4 ov = *(const LAS f32x4*)(OT + row * 132 + 16 * seg + 4 * j); const float4 g4 = *(const float4*)(gn + 16 * seg + 4 * j);
                y[4 * j + 0] = ov[0] * rstd * g4.x * zf[4 * j + 0]; y[4 * j + 1] = ov[1] * rstd * g4.y * zf[4 * j + 1]; y[4 * j + 2] = ov[2] * rstd * g4.z * zf[4 * j + 2]; y[4 * j + 3] = ov[3] * rstd * g4.w * zf[4 * j + 3]; }
            v4u w0, w1; w0.x = cvt_pk_bf16(y[0], y[1]); w0.y = cvt_pk_bf16(y[2], y[3]); w0.z = cvt_pk_bf16(y[4], y[5]); w0.w = cvt_pk_bf16(y[6], y[7]);
            w1.x = cvt_pk_bf16(y[8], y[9]); w1.y = cvt_pk_bf16(y[10], y[11]); w1.z = cvt_pk_bf16(y[12], y[13]); w1.w = cvt_pk_bf16(y[14], y[15]);
            *(v4u*)(YA + grow * DNW + col) = w0; *(v4u*)(YA + grow * DNW + col + 8) = w1; }
        lds_barrier();
    }
}

__device__ __forceinline__ void p_sg_item(const Ctx& c, int it, const bf16* PROJ, const float* lg, const float* lb, const float* sw, const float* sb, bf16* YB) {
    LAS unsigned short* VT = (LAS unsigned short*)c.lds;
    LAS float* STAT = (LAS float*)(c.lds + 128 * RS * 2);
    const int lane = c.lane, w = c.wave, fr = lane & 15, fq = lane >> 4, chunk = it >> 2, g = it & 3; const size_t row0 = (size_t)chunk * SGC;
    {
        v4u xr[16];
#pragma unroll
        for (int rr = 0; rr < 16; ++rr) xr[rr] = *(const v4u*)(PROJ + (row0 + 16 * w + rr) * PJ + 2560 + lane * 8);
        float acc[32];
#pragma unroll
        for (int rr = 0; rr < 16; ++rr) { float f[8]; unpack8(xr[rr], f); float s1 = 0.f, s2 = 0.f;
#pragma unroll
            for (int e = 0; e < 8; ++e) { s1 += f[e]; s2 = fmaf(f[e], f[e], s2); }
            acc[rr] = s1; acc[16 + rr] = s2; }
        BFLY_SW32(acc, 32) BFLY_SW16(acc, 16) BFLY_DPP(acc, 8, 8, dpp_ror8) BFLY_DPP(acc, 4, 4, dpp_xor4) BFLY_DPP(acc, 2, 2, dpp_xor2)
        const float tot = acc[0] + dpp_xor1(acc[0]);
        if ((lane & 1) == 0) { const int vi = lane >> 1; STAT[2 * (16 * w + (vi & 15)) + (vi >> 4)] = tot; } }
    lds_barrier();
    { v4u xv[4];
#pragma unroll
        for (int i = 0; i < 4; ++i) { const int idx = c.tid + NTHR * i, s = idx >> 4, c8 = (idx & 15) * 8; xv[i] = *(const v4u*)(PROJ + (row0 + s) * PJ + 2560 + g * 128 + c8); }
        const int c8 = (c.tid & 15) * 8;
        const float4 g0 = *(const float4*)(lg + g * 128 + c8), g1 = *(const float4*)(lg + g * 128 + c8 + 4), b0 = *(const float4*)(lb + g * 128 + c8), b1 = *(const float4*)(lb + g * 128 + c8 + 4);
        const float gv[8] = {g0.x, g0.y, g0.z, g0.w, g1.x, g1.y, g1.z, g1.w}, bv[8] = {b0.x, b0.y, b0.z, b0.w, b1.x, b1.y, b1.z, b1.w};
#pragma unroll
        for (int i = 0; i < 4; ++i) { const int s = (c.tid + NTHR * i) >> 4; float f[8]; unpack8(xv[i], f);
            const float mu = STAT[2 * s] * (1.f / SGW), rstd = rsqrtf(fmaxf(STAT[2 * s + 1] * (1.f / SGW) - mu * mu, 0.f) + LN_EPS);
#pragma unroll
            for (int e = 0; e < 8; ++e) VT[(c8 + e) * RS + s] = f2bf1((f[e] - mu) * rstd * gv[e] + bv[e]); } }
    lds_barrier();
    { f32x4 acc[8];
#pragma unroll
        for (int ct = 0; ct < 8; ++ct) acc[ct] = (f32x4){0.f, 0.f, 0.f, 0.f};
        const int t = 16 * w + fr, nk = (w >> 1) + 1;
        for (int kk = 0; kk < nk; ++kk) { const int s0 = 32 * kk + 8 * fq; const float* wp = sw + ((size_t)g * SGC + t) * SGC + s0;
            const float4 w0 = *(const float4*)wp, w1 = *(const float4*)(wp + 4);
            const float wv[8] = {w0.x, w0.y, w0.z, w0.w, w1.x, w1.y, w1.z, w1.w}; float wm[8];
#pragma unroll
            for (int e = 0; e < 8; ++e) wm[e] = (s0 + e <= t) ? wv[e] : 0.f;
            v4u wb; wb.x = cvt_pk_bf16(wm[0], wm[1]); wb.y = cvt_pk_bf16(wm[2], wm[3]); wb.z = cvt_pk_bf16(wm[4], wm[5]); wb.w = cvt_pk_bf16(wm[6], wm[7]);
            const bf16x8 bfr = as_frag(wb);
#pragma unroll
            for (int ct = 0; ct < 8; ++ct) acc[ct] = MFMA16(*(const LAS bf16x8*)(VT + (16 * ct + fr) * RS + s0), bfr, acc[ct]); }
        const float bias = sb[g * SGC + t]; const size_t row = row0 + t;
#pragma unroll
        for (int ct = 0; ct < 8; ++ct) { const int col = g * 128 + 16 * ct + 4 * fq; const v2u u = *(const v2u*)(PROJ + row * PJ + 2048 + col);
            v2u o; o.x = cvt_pk_bf16(bf_lo(u.x) * (acc[ct][0] + bias), bf_hi(u.x) * (acc[ct][1] + bias)); o.y = cvt_pk_bf16(bf_lo(u.y) * (acc[ct][2] + bias), bf_hi(u.y) * (acc[ct][3] + bias));
            *(v2u*)(YB + row * SGW + col) = o; } }
    lds_barrier();
}

struct Args { const float* in[22]; float* out; unsigned char* ws; int ph_lo, ph_hi; };
__global__ void __launch_bounds__(NTHR, 2) mega(Args args) {
    extern __shared__ __attribute__((aligned(16))) unsigned char lds_raw[];
    Ctx c; c.lds0 = (LAS unsigned char*)lds_raw; c.lds = c.lds0 + RING_OFF; c.tid = threadIdx.x; c.lane = c.tid & 63; c.wave = __builtin_amdgcn_readfirstlane(c.tid >> 6); c.bid = blockIdx.x; c.nb = gridDim.x;
    volatile LAS unsigned* MISC = (volatile LAS unsigned*)(c.lds0 + MISC_OFF);
    for (int u = c.tid; u < RING_OFF / 4; u += NTHR) ((LAS unsigned*)(c.lds0 + LDSCTL_OFF))[u] = 0u;
    __syncthreads();
    unsigned char* ws = args.ws;
    gu32* ctl = (gu32*)(ws + WS_CTL);
    XcdBarrier bar = xcd_barrier_post((unsigned*)(ctl + CW_BAR), MISC + 8);
#define GRID_BAR() xcd_barrier(bar)
    const float* x = args.in[0]; const float* norm1_g = args.in[1]; const float* w_in = args.in[2]; const float* conv_w = args.in[3];
    const float* a_log = args.in[4]; const float* dt_bias = args.in[5]; const float* dn_norm_g = args.in[6]; const float* w_o_dn = args.in[7];
    const float* sg_ln_g = args.in[8]; const float* sg_ln_b = args.in[9]; const float* sg_w = args.in[10]; const float* sg_b = args.in[11];
    const float* w_o_sg = args.in[12]; const float* w_out = args.in[13]; const float* norm2_g = args.in[14]; const float* w_router = args.in[15];
    const float* b_router = args.in[16]; const float* w_gate_up = args.in[17]; const float* b_gate_up = args.in[18]; const float* w_down = args.in[19];
    const float* b_down = args.in[20]; const float* norm_f_g = args.in[21];
    float* out = args.out;
    unsigned char* wb = ws + WS_BASE;
    bf16* Hb = (bf16*)(wb + 0); bf16* H2b = (bf16*)(wb + 0);
    bf16* Win_t = (bf16*)(wb + 32 * MiB); bf16* Wo_t = (bf16*)(wb + 42 * MiB); bf16* Wout_t = (bf16*)(wb + 44 * MiB); float* BG = (float*)(wb + 46 * MiB);
    bf16* PROJb = (bf16*)(wb + 48 * MiB); bf16* ACTb = (bf16*)(wb + 48 * MiB);
    bf16* YAB = (bf16*)(wb + 208 * MiB); bf16* MERGED = (bf16*)(wb + 240 * MiB); float* X1 = (float*)(wb + 272 * MiB);
    float* QKV = (float*)(wb + 336 * MiB); float* O32 = (float*)(wb + 432 * MiB); float* U = (float*)(wb + 464 * MiB); float* VLN = (float*)(wb + 496 * MiB);
    bf16* Wgu_t = (bf16*)(wb + 528 * MiB); bf16* Wd_t = (bf16*)(wb + 656 * MiB); bf16* HS = (bf16*)(wb + 720 * MiB); bf16* Yb = (bf16*)(wb + 864 * MiB);
    unsigned char* small = wb + 1008 * MiB;
    int* slot_e = (int*)(small + 0 * MiB); int* slot_pos = (int*)(small + 1 * MiB); int* elist = (int*)(small + 2 * MiB); float* ewgt = (float*)(small + 4 * MiB); bf16* WrT = (bf16*)(small + 6 * MiB);
    unsigned* gcnt = (unsigned*)(ctl + CW_CNT);

#ifndef GEMM1_WGM
#define GEMM1_WGM 8
#endif
#ifndef PROBE_MASK
#define PROBE_MASK 0
#endif
#define REP(bit) for (int _r = 0; _r < ((PROBE_MASK >> (bit)) & 1) + 1; ++_r)
    REP(0) { p_convert_front(c, w_in, w_o_dn, w_o_sg, w_out, Win_t, Wo_t, Wout_t);
    __syncthreads();
    p_norm1(c, x, norm1_g, w_in, a_log, dt_bias, Hb, BG); if (PROBE_MASK & 1) __syncthreads();
    p_build_wrt(c, w_router, WrT);
    for (int i = c.bid * NTHR + c.tid; i < NE * NTOK / 4; i += c.nb * NTHR) { ((v4u*)elist)[i] = (v4u){0u, 0u, 0u, 0u}; ((v4u*)ewgt)[i] = (v4u){0u, 0u, 0u, 0u}; } }
    GRID_BAR();
    REP(1) { pg8::Gemm g{Hb, Win_t, NTOK, PJ, D}; pg8::StaticOrder S; S.init(NTOK, PJ, c.nb, c.bid, GEMM1_WGM); EpiProj E{PROJb};
      pg8::gemm_phase<EpiProj, pg8::StaticOrder, true, true>(c.lds, g, S, E); }
    GRID_BAR();
    DnBufs DB; DB.WN = wb + 336 * MiB; DB.QD = wb + 352 * MiB; DB.KD = wb + 368 * MiB; DB.QK = wb + 384 * MiB; DB.U = wb + 392 * MiB; DB.SST = wb + 408 * MiB; DB.EG = (float*)(wb + 440 * MiB);
    REP(2) { p_dn_prep(c, PROJb, conv_w, BG, DB); }
    GRID_BAR();
    if (c.bid < SCAN_WGS) { REP(3) { p_dn_scan(c, DB); } }
    else { Ctx c2 = c; c2.bid = c.bid - SCAN_WGS; c2.nb = c.nb - SCAN_WGS;
        REP(4) { for (int it = c2.bid; it < (NTOK / SGC) * 4; it += c2.nb) p_sg_item(c, it, PROJb, sg_ln_g, sg_ln_b, sg_w, sg_b, YAB + (size_t)NTOK * DNW); }
        REP(5) { p_convert_moe(c2, w_gate_up, w_down, Wgu_t, Wd_t); } }
    GRID_BAR();
    REP(6) { p_dn_out(c, DB, PROJb, dn_norm_g, YAB); }
    GRID_BAR();
    REP(7) { pg8::Gemm g{YAB, Wo_t, 0, 0, DNW}; DualOrder S; S.init(c.nb, c.bid); EpiMerge E{PROJb, MERGED};
      pg8::gemm_phase<EpiMerge, DualOrder, true, true>(c.lds, g, S, E); }
    GRID_BAR();
    REP(8) { pg8::Gemm g{MERGED, Wout_t, NTOK, D, D}; pg8::StaticOrder S; S.init(NTOK, D, c.nb, c.bid); EpiResid E{x, X1};
      pg8::gemm_phase<EpiResid, pg8::StaticOrder, true, true>(c.lds, g, S, E); }
    GRID_BAR();
    p_router2(c, X1, norm2_g, WrT, b_router, H2b, slot_e, slot_pos, elist, ewgt, gcnt);
    GRID_BAR();
    LAS unsigned char* tile_e = c.lds0 + EXTRA_OFF + 512; LAS int* ntl = (LAS int*)(c.lds0 + EXTRA_OFF + 1024); LAS int* tile_b = (LAS int*)(c.lds0 + EXTRA_OFF + 1088);
    build_tile_table(c, gcnt, tile_e, ntl, tile_b);
    const int NTL = __builtin_amdgcn_readfirstlane(ntl[0]);
    const int SPX = c.nb >> 3, xq = c.bid & 7, sq = c.bid >> 3; const bool inl = c.bid < 8 * SPX;
    const int mt0 = (xq * NTL) >> 3, mnt = (((xq + 1) * NTL) >> 3) - mt0;
    const int rem1 = (mnt * 8) % SPX; int Ex = rem1 ? SPX - rem1 : 0; if (Ex > mnt * 4) Ex = mnt * 4;
    const int sigT = 4 * ((Ex + 15) >> 4);
    unsigned* tcnt = (unsigned*)(ctl + CW_TCNT);
    REP(10) { pg8::Gemm g{H2b, Wgu_t, 0, 0, D, elist}; MoeOrder S; S.init(mt0, mnt, 8, 4, sq, SPX, 0, inl ? mnt * 8 : 0, sigT, tcnt, false, tile_e, tile_b); EpiSwiglu E{ACTb, b_gate_up};
      pg8::gemm_phase<EpiSwiglu, MoeOrder, true, true, true>(c.lds, g, S, E); }
    if (Ex > 0) { pg8::Gemm g{ACTb, Wd_t, 0, 0, DFF}; MoeOrder S; S.init(mt0, mnt, 4, 4, sq, SPX, -rem1, inl ? Ex : 0, 0, tcnt, true, tile_e, tile_b); EpiDown E{Yb, b_down, ewgt};
      pg8::gemm_phase<EpiDown, MoeOrder, true, true>(c.lds, g, S, E); }
    GRID_BAR();
    REP(11) { pg8::Gemm g{ACTb, Wd_t, 0, 0, DFF}; MoeOrder S; S.init(mt0, mnt, 4, 4, sq, SPX, Ex, inl ? mnt * 4 : 0, 0, tcnt, false, tile_e, tile_b); EpiDown E{Yb, b_down, ewgt};
      pg8::gemm_phase<EpiDown, MoeOrder, true, true>(c.lds, g, S, E); }
    GRID_BAR();
    REP(12) { p_final(c, X1, Yb, slot_e, slot_pos, gcnt, norm_f_g, out); }
    if (PROBE_MASK & 8192) { for (int k = 0; k < 10; ++k) GRID_BAR(); }
}

extern "C" void kernel_launch(void* const* d_in, const int* in_sizes, int n_in, void* d_out, int out_size, void* d_ws, size_t ws_size, hipStream_t stream) {
    static int grid = 0;
    if (grid == 0) {
        if (n_in != 22 || in_sizes[0] != NTOK * D || out_size != NTOK * D || ws_size < WS_NEED) { fprintf(stderr, "kernel_launch: unexpected shapes (n_in %d, ws %zu)\n", n_in, ws_size); grid = -1; return; }
        int dev = 0, cus = 0, per_cu = 0;
        if (hipGetDevice(&dev) != hipSuccess || hipDeviceGetAttribute(&cus, hipDeviceAttributeMultiprocessorCount, dev) != hipSuccess) { grid = -1; return; }
        if (hipFuncSetAttribute((const void*)mega, hipFuncAttributeMaxDynamicSharedMemorySize, LDS_BYTES) != hipSuccess) { fprintf(stderr, "kernel_launch: hipFuncSetAttribute failed\n"); grid = -1; return; }
        if (hipOccupancyMaxActiveBlocksPerMultiprocessor(&per_cu, (const void*)mega, NTHR, LDS_BYTES) != hipSuccess || per_cu < 1) fprintf(stderr, "kernel_launch: occupancy query reports %d\n", per_cu);
        (void)hipGetLastError();
        grid = cus;
    }
    if (grid < 0) return;
    if (hipMemsetAsync((char*)d_ws + WS_CTL, 0, CTL_ZERO_BYTES, stream) != hipSuccess) { fprintf(stderr, "kernel_launch: memset failed\n"); return; }
    Args a{};
    for (int i = 0; i < 22; ++i) a.in[i] = (const float*)d_in[i];
    a.out = (float*)d_out; a.ws = (unsigned char*)d_ws; a.ph_lo = 0; a.ph_hi = 100;
    hipLaunchKernelGGL(mega, dim3(grid), dim3(NTHR), LDS_BYTES, stream, a);
#if PROBE_MASK & 131072
    (void)hipMemsetAsync((char*)d_ws + WS_CTL, 0, CTL_ZERO_BYTES, stream); hipLaunchKernelGGL(mega, dim3(grid), dim3(NTHR), LDS_BYTES, stream, a);
#endif
    const hipError_t le = hipPeekAtLastError();
    if (le != hipSuccess) fprintf(stderr, "kernel_launch: launch failed: %s\n", hipGetErrorName(le));
}
```

```cpp
#include <hip/hip_runtime.h>
#include <cstdio>
#include <cstdint>
#include <cmath>

#define GAS __attribute__((address_space(1)))
#define LAS __attribute__((address_space(3)))
typedef GAS unsigned gu32;
#define RLX_AGENT __ATOMIC_RELAXED, __HIP_MEMORY_SCOPE_AGENT

constexpr int NWAVES = 8, NTHR = 512;
constexpr int D = 1024, BATCH = 2, SEQ = 8192, NTOK = BATCH * SEQ;
constexpr int DNH = 4, DNW = 512;
constexpr int SGD = 128, SGW = 512, SGC = 128;
constexpr int NE = 32, TOPK = 4, DFF = 1024;
constexpr int OFF_Z = 1536, OFF_BETA = 2048, OFF_A = 2052, OFF_U = 2056, OFF_V = 2568, OFF_GA = 3080, OFF_GB = 4104, INC = 5128;
constexpr float RMS_EPS = 1e-6f, LN_EPS = 1e-5f, L2_EPS = 1e-6f;

constexpr size_t MiB = 1u << 20;
constexpr size_t WS_CTL = 0, CTL_ZERO_BYTES = 1 * MiB;
constexpr int CW_BAR = 4096;
constexpr int CW_CNT = 16384;
constexpr int CW_TCNT = 20480;
constexpr size_t WS_BASE = 2 * MiB;
constexpr size_t WS_NEED = 1020 * MiB;
constexpr int LDSCTL_OFF = 0, MISC_OFF = 320, RING_OFF = 1024, RING_BYTES = 131072, EXTRA_OFF = RING_OFF + RING_BYTES, LDS_BYTES = 163840;

#define XB_TMO      128
#define XB_XCNT(j)  (256  + 64 * (j))
#define XB_XSUB(j)  (1280 + 64 * (j))
#define XB_XGEN(j)  (2304 + 64 * (j))
#define XB_TOP      3328
#define XB_TOPGEN   3392
#define XCD_BAR_WORDS 3456
#define XB_SPIN_CAP (1u << 22)
__device__ __forceinline__ unsigned xb_ld(unsigned* p)              { return __hip_atomic_load(p, __ATOMIC_RELAXED, __HIP_MEMORY_SCOPE_AGENT); }
__device__ __forceinline__ unsigned xb_add(unsigned* p, unsigned v) { return __hip_atomic_fetch_add(p, v, __ATOMIC_RELAXED, __HIP_MEMORY_SCOPE_AGENT); }
__device__ __forceinline__ unsigned xb_xcc_id() { return (unsigned)__builtin_amdgcn_s_getreg((3 << 11) | 20) & 0xFu; }
#define XB_SPIN(cond, bar) do { unsigned _sp = 0; while (cond) { __builtin_amdgcn_s_sleep(1); \
    if ((++_sp & 255u) == 0u) { if (xb_ld(&(bar)[XB_TMO])) break; if (_sp > XB_SPIN_CAP) { atomicAdd(&(bar)[XB_TMO], 1u); break; } } } } while (0)
struct XcdBarrier { unsigned* bar; unsigned x; volatile LAS unsigned* st; };
__device__ __forceinline__ XcdBarrier xcd_barrier_post(unsigned* bar, volatile LAS unsigned* st) {
    XcdBarrier b; b.bar = bar; b.x = xb_xcc_id(); b.st = st;
    if (threadIdx.x == 0) (void)xb_add(&bar[XB_XCNT(b.x)], 1u);
    return b;
}
__device__ __forceinline__ void xcd_barrier_complete(unsigned* bar, unsigned x, unsigned& nloc, unsigned& nx) {
    const unsigned G = gridDim.x * gridDim.y * gridDim.z;
    unsigned sum, cnt, mine, sp = 0u;
    for (;;) {
        sum = 0u; cnt = 0u; mine = 0u;
#pragma unroll
        for (unsigned j = 0; j < 16; ++j) { const unsigned c = xb_ld(&bar[XB_XCNT(j)]); sum += c; cnt += (c > 0u) ? 1u : 0u; mine = (j == x) ? c : mine; }
        if (sum == G) break;
        __builtin_amdgcn_s_sleep(1);
        if ((++sp & 255u) == 0u) { if (xb_ld(&bar[XB_TMO])) break; if (sp > XB_SPIN_CAP) { atomicAdd(&bar[XB_TMO], 1u); break; } }
    }
    nloc = mine > 0u ? mine : 1u; nx = cnt > 0u ? cnt : 1u;
}
__device__ __forceinline__ void xcd_barrier(const XcdBarrier& b) {
    asm volatile("s_waitcnt vmcnt(0)" ::: "memory");
    __syncthreads();
    if (threadIdx.x == 0) {
        unsigned* bar = b.bar;
        __builtin_amdgcn_s_waitcnt(0);
        unsigned nloc = b.st[0], nx = b.st[1];
        if (nloc == 0u) { xcd_barrier_complete(bar, b.x, nloc, nx); b.st[0] = nloc; b.st[1] = nx; }
        const unsigned old = xb_add(&bar[XB_XSUB(b.x)], 1u);
        const unsigned gen = old / nloc;
        if (old + 1u == (gen + 1u) * nloc) {
            __builtin_amdgcn_fence(__ATOMIC_RELEASE, "agent");
            asm volatile("s_waitcnt vmcnt(0)" ::: "memory");
            const unsigned og = xb_add(&bar[XB_TOP], 1u);
            const unsigned tg = og / nx;
            if (og + 1u == (tg + 1u) * nx) xb_add(&bar[XB_TOPGEN], 1u);
            else XB_SPIN(xb_ld(&bar[XB_TOPGEN]) == tg, bar);
            __builtin_amdgcn_fence(__ATOMIC_ACQUIRE, "agent");
            xb_add(&bar[XB_XGEN(b.x)], 1u);
            asm volatile("s_waitcnt vmcnt(0)" ::: "memory");
        } else {
            XB_SPIN(xb_ld(&bar[XB_XGEN(b.x)]) == gen, bar);
            __builtin_amdgcn_fence(__ATOMIC_ACQUIRE, "agent");
            asm volatile("s_waitcnt vmcnt(0)" ::: "memory");
        }
    }
    __syncthreads();
}

__device__ __forceinline__ float dpp_xor1(float v) { return __builtin_bit_cast(float, __builtin_amdgcn_update_dpp(0, __builtin_bit_cast(int, v), 0xB1, 0xF, 0xF, true)); }
__device__ __forceinline__ float dpp_xor2(float v) { return __builtin_bit_cast(float, __builtin_amdgcn_update_dpp(0, __builtin_bit_cast(int, v), 0x4E, 0xF, 0xF, true)); }
__device__ __forceinline__ float dpp_qrev(float v) { return __builtin_bit_cast(float, __builtin_amdgcn_update_dpp(0, __builtin_bit_cast(int, v), 0x1B, 0xF, 0xF, true)); }
__device__ __forceinline__ float dpp_hmir(float v) { return __builtin_bit_cast(float, __builtin_amdgcn_update_dpp(0, __builtin_bit_cast(int, v), 0x141, 0xF, 0xF, true)); }
__device__ __forceinline__ float dpp_rmir(float v) { return __builtin_bit_cast(float, __builtin_amdgcn_update_dpp(0, __builtin_bit_cast(int, v), 0x140, 0xF, 0xF, true)); }
__device__ __forceinline__ float dpp_ror8(float v) { return __builtin_bit_cast(float, __builtin_amdgcn_update_dpp(0, __builtin_bit_cast(int, v), 0x128, 0xF, 0xF, true)); }
__device__ __forceinline__ float dpp_xor4(float v) { return dpp_qrev(dpp_hmir(v)); }
__device__ __forceinline__ float row16_sum(float v) { v += dpp_xor1(v); v += dpp_xor2(v); v += dpp_hmir(v); v += dpp_rmir(v); return v; }
__device__ __forceinline__ float rdlane(float v, int l) { return __builtin_bit_cast(float, __builtin_amdgcn_readlane(__builtin_bit_cast(int, v), l)); }
__device__ __forceinline__ float wave_sum(float v) { v = row16_sum(v); return (rdlane(v, 0) + rdlane(v, 16)) + (rdlane(v, 32) + rdlane(v, 48)); }
__device__ __forceinline__ void swap32(float& a, float& b) { asm volatile("s_nop 1\n\tv_permlane32_swap_b32 %0, %1" : "+v"(a), "+v"(b)); }
__device__ __forceinline__ void swap16(float& a, float& b) { asm volatile("s_nop 1\n\tv_permlane16_swap_b32 %0, %1" : "+v"(a), "+v"(b)); }
#define BFLY_SW32(acc, n) _Pragma("unroll") for (int i_ = 0; i_ < (n) / 2; ++i_) { float x_ = acc[i_], y_ = acc[i_ + (n) / 2]; swap32(x_, y_); acc[i_] = x_ + y_; }
#define BFLY_SW16(acc, n) _Pragma("unroll") for (int i_ = 0; i_ < (n) / 2; ++i_) { float x_ = acc[i_], y_ = acc[i_ + (n) / 2]; swap16(x_, y_); acc[i_] = x_ + y_; }
#define BFLY_DPP(acc, n, m, PERM) _Pragma("unroll") for (int i_ = 0; i_ < (n) / 2; ++i_) { const bool up_ = (lane & (m)) != 0; const float send_ = up_ ? acc[i_] : acc[i_ + (n) / 2]; const float keep_ = up_ ? acc[i_ + (n) / 2] : acc[i_]; acc[i_] = keep_ + PERM(send_); }
__device__ __forceinline__ float sigmoidf_(float x) { return 1.f / (1.f + expf(-x)); }
__device__ __forceinline__ float siluf_(float x) { return x / (1.f + expf(-x)); }
__device__ __forceinline__ float geluf_(float x) { return 0.5f * x * (1.f + erff(x * 0.70710678118654752f)); }
__device__ __forceinline__ float softplusf_(float x) { return x > 20.f ? x : log1pf(expf(x)); }

__device__ __forceinline__ void lds_barrier() { asm volatile("s_waitcnt lgkmcnt(0)" ::: "memory"); __builtin_amdgcn_s_barrier(); asm volatile("" ::: "memory"); }
struct Ctx { int bid, nb, tid, lane, wave; LAS unsigned char* lds; LAS unsigned char* lds0; };

namespace pg8 {
#define PG8_LAS __attribute__((address_space(3)))
typedef unsigned short bf16_t;
typedef short bf16x8 __attribute__((ext_vector_type(8)));
typedef float f32x4 __attribute__((ext_vector_type(4)));
typedef unsigned u32x4 __attribute__((ext_vector_type(4)));
constexpr int BM = 256, BK = 64, HALF = 128, HTB = HALF * BK * 2  , STAGE_BYTES = 8 * HTB, NXCD = 8, WGM = 8;

__host__ __device__ __forceinline__ int lds_byte(int r, int c) { const int st = (r >> 4) * 2 + (c >> 5), rr = r & 15, cc = c & 31, ob = rr * 64 + cc * 2; return st * 1024 + (ob ^ (((ob >> 9) & 1) << 5)); }
__host__ __device__ __forceinline__ void stage_rc(int b, int& R, int& C) { const int st = b / 1024, sb = b % 1024, swz = sb ^ (((sb >> 9) & 1) << 5); R = (st >> 1) * 16 + swz / 64; C = (st & 1) * 32 + (swz % 64) / 2; }
__host__ __device__ __forceinline__ int perm32(int rho) { const int n = rho >> 4, i = rho & 15; return 8 * (i >> 2) + 4 * n + (i & 3); }

struct Unit { int pm, pn, x0, x1, rb; };
struct Gemm { const bf16_t* A; const bf16_t* Bt; int M, N, K; const int* rows; };

struct StaticOrder {
    int nM, nN, nwg, G, c, wgm;
    __host__ __device__ void init(int M, int N, int G_, int c_, int wgm_ = WGM) { nM = M / BM; nN = N / BM; nwg = nM * nN; G = G_; c = c_; wgm = wgm_; }
    __host__ __device__ bool next(int i, Unit& u) const {
        const long L = (long)i * G + c; if (L >= nwg) return false;
        int wgid = (int)L; { const int q = nwg / NXCD, r = nwg % NXCD, xcd = wgid % NXCD, off = wgid / NXCD; wgid = (xcd < r ? xcd * (q + 1) : r * (q + 1) + (xcd - r) * q) + off; }
        const int nig = wgm * nN, gid = wgid / nig, fm = gid * wgm, gsz = (nM - fm) < wgm ? (nM - fm) : wgm;
        u.pm = fm + ((wgid % nig) % gsz); u.pn = (wgid % nig) / gsz; u.x0 = 0; u.x1 = u.pn; u.rb = 0; return true;
    }
    __device__ __forceinline__ void a_ready(const Unit&) const {}
    __device__ __forceinline__ void done(const Unit&) const {}
};


template <class Epi, class Sched, bool ALIGN_EPI = false, bool SP2 = false, bool GATHER = false, int BAUX = 0>
__device__ __forceinline__ void gemm_phase(PG8_LAS unsigned char* lds, const Gemm g, const Sched& S, const Epi& E) {
    int tid_ = threadIdx.x; asm volatile("" : "+v"(tid_));
    const int tid = tid_, wid = __builtin_amdgcn_readfirstlane(tid >> 6), lane = tid & 63, wr = wid >> 2, wc = wid & 3, fr = lane & 15, fq = lane >> 4;
    const int K = g.K, nt = K / BK;
    unsigned voffA[2], voffB[2]; int gR[2]; unsigned gC2[2];
#pragma unroll
    for (int i = 0; i < 2; ++i) { int R, C; stage_rc(tid * 16 + i * 8192, R, C); const int Rb = Epi::PERM ? ((R & ~31) + perm32(R & 31)) : R;
        voffA[i] = (unsigned)(R * K + C) * 2u; voffB[i] = (unsigned)(Rb * K + C) * 2u; gR[i] = R; gC2[i] = (unsigned)C * 2u; }
    static_assert(!GATHER || SP2, "GATHER is implemented for the SP2 loop only");
    unsigned gcur[2][2], gnxt[2][2]; int graw[4];
#define PG8_STAGE_A(bufoff, kptr, ktile, h, use_next) do { if constexpr (GATHER) { const unsigned sv_[2] = {(use_next) ? gnxt[h][0] : gcur[h][0], (use_next) ? gnxt[h][1] : gcur[h][1]}; \
        PG8_STAGE(bufoff, gA0 + (size_t)(ktile) * kstep, sv_); } else { PG8_STAGE(bufoff, (kptr) + ((h) ? hstep : 0), voffA); } } while (0)
    const size_t kstep = (size_t)(BK * 2);
    const size_t hstep = (size_t)HALF * K * 2;
    const size_t tstep = 2 * hstep;
    const unsigned ldsw = (unsigned)wid * 1024u;
    const int aoff = lds_byte(wr * 64 + fr, fq * 8), boff = lds_byte(wc * 32 + fr, fq * 8);
#define PG8_SA(b, h) (((b) * 2 + (h)) * HTB)
#define PG8_SB(b, h) ((4 + (b) * 2 + (h)) * HTB)
#define PG8_STAGE(bufoff, gbase, voff) do { _Pragma("unroll") for (int _i = 0; _i < 2; ++_i) \
        __builtin_amdgcn_global_load_lds((const unsigned*)((const char*)(gbase) + (voff)[_i]), (PG8_LAS unsigned*)(lds + (bufoff) + ldsw + _i * 8192), 16, 0, 0); } while (0)
#define PG8_STAGE_B(bufoff, gbase, voff) do { _Pragma("unroll") for (int _i = 0; _i < 2; ++_i) \
        __builtin_amdgcn_global_load_lds((const unsigned*)((const char*)(gbase) + (voff)[_i]), (PG8_LAS unsigned*)(lds + (bufoff) + ldsw + _i * 8192), 16, 0, BAUX); } while (0)
#define PG8_LDA(dst, b, h) do { _Pragma("unroll") for (int m = 0; m < 4; ++m) _Pragma("unroll") for (int k = 0; k < 2; ++k) dst[m][k] = *(const PG8_LAS bf16x8*)(lds + PG8_SA(b, h) + aoff + m * 2048 + k * 1024); } while (0)
#define PG8_LDB(dst, b, h) do { _Pragma("unroll") for (int n = 0; n < 2; ++n) _Pragma("unroll") for (int k = 0; k < 2; ++k) dst[n][k] = *(const PG8_LAS bf16x8*)(lds + PG8_SB(b, h) + boff + n * 2048 + k * 1024); } while (0)
#define PG8_MMA(ai, bj, At, Bt) do { __builtin_amdgcn_s_setprio(1); _Pragma("unroll") for (int m = 0; m < 4; ++m) _Pragma("unroll") for (int n = 0; n < 2; ++n) _Pragma("unroll") for (int k = 0; k < 2; ++k) \
        acc[ai][bj][m][n] = __builtin_amdgcn_mfma_f32_16x16x32_bf16(Bt[n][k], At[m][k], acc[ai][bj][m][n], 0, 0, 0); __builtin_amdgcn_s_setprio(0); } while (0)
#define PG8_WAIT_V(n) asm volatile("s_waitcnt vmcnt(" #n ")" ::: "memory")
#define PG8_WAIT_L(n) asm volatile("s_waitcnt lgkmcnt(" #n ")" ::: "memory")
#define PG8_BAR __builtin_amdgcn_s_barrier()
#define PG8_SCHED __builtin_amdgcn_sched_barrier(0)
    Unit cur, nxt; int ui = 0;
    if (!S.next(0, cur)) return;
    f32x4 acc[2][2][4][2];
#pragma unroll
    for (int a = 0; a < 2; ++a)
#pragma unroll
        for (int b = 0; b < 2; ++b)
#pragma unroll
            for (int m = 0; m < 4; ++m)
#pragma unroll
                for (int n = 0; n < 2; ++n) acc[a][b][m][n] = (f32x4){0.f, 0.f, 0.f, 0.f};
    bf16x8 At[4][2], B0[2][2], B1[2][2];
    const char* cA = (const char*)g.A + (size_t)cur.pm * tstep; const char* cB = (const char*)g.Bt + (size_t)cur.pn * tstep;
    const char* const gA0 = (const char*)g.A;
    if constexpr (GATHER) {
#pragma unroll
        for (int h = 0; h < 2; ++h)
#pragma unroll
            for (int i = 0; i < 2; ++i) { gcur[h][i] = (unsigned)g.rows[cur.rb + h * HALF + gR[i]] * (unsigned)(K * 2) + gC2[i]; gnxt[h][i] = gcur[h][i]; } }
    S.a_ready(cur);
    if constexpr (SP2) {
        PG8_STAGE_B(PG8_SB(0, 0), cB, voffB); PG8_STAGE_B(PG8_SB(0, 1), cB + hstep, voffB); PG8_STAGE_A(PG8_SA(0, 0), cA, 0, 0, false); PG8_STAGE_A(PG8_SA(0, 1), cA, 0, 1, false);
        if (wr == 1) PG8_BAR;
        PG8_WAIT_V(2); PG8_BAR;
        PG8_STAGE_B(PG8_SB(1, 0), cB + kstep, voffB); PG8_STAGE_A(PG8_SA(1, 0), cA + kstep, 1, 0, false); PG8_STAGE_B(PG8_SB(1, 1), cB + hstep + kstep, voffB);
        PG8_WAIT_V(6); PG8_BAR;
    } else {
        PG8_STAGE_B(PG8_SB(0, 0), cB, voffB); PG8_STAGE(PG8_SA(0, 0), cA, voffA); PG8_STAGE_B(PG8_SB(0, 1), cB + hstep, voffB); PG8_STAGE(PG8_SA(0, 1), cA + hstep, voffA);
        if (wr == 1) PG8_BAR;
        PG8_WAIT_V(4); PG8_BAR;
        PG8_STAGE_B(PG8_SB(1, 0), cB + kstep, voffB); PG8_STAGE(PG8_SA(1, 0), cA + kstep, voffA); PG8_STAGE_B(PG8_SB(1, 1), cB + hstep + kstep, voffB);
        PG8_WAIT_V(6); PG8_BAR;
    }
    for (;;) {
        const bool has_next = S.next(ui + 1, nxt);
        const char* nA = has_next ? (const char*)g.A + (size_t)nxt.pm * tstep : cA; const char* nB = has_next ? (const char*)g.Bt + (size_t)nxt.pn * tstep : cB;
        if constexpr (GATHER) { if (has_next) {
#pragma unroll
            for (int h = 0; h < 2; ++h)
#pragma unroll
                for (int i = 0; i < 2; ++i) asm volatile("global_load_dword %0, %1, off" : "=v"(graw[h * 2 + i]) : "v"(g.rows + (nxt.rb + h * HALF + gR[i])) : "memory"); } }
        for (int t = 0; t < nt; t += 2) {
            const bool last = (t == nt - 2);
            const char* a1 = cA + (size_t)(t + 1) * kstep;
            const char* a2 = last ? nA : cA + (size_t)(t + 2) * kstep; const char* b2 = last ? nB : cB + (size_t)(t + 2) * kstep;
            const char* a3 = a2 + kstep; const char* b3 = b2 + kstep;
            if (last && has_next) S.a_ready(nxt);
            if constexpr (GATHER) { if (last) { if (has_next) { asm volatile("" : "+v"(graw[0]), "+v"(graw[1]), "+v"(graw[2]), "+v"(graw[3]));
#pragma unroll
                    for (int h = 0; h < 2; ++h)
#pragma unroll
                        for (int i = 0; i < 2; ++i) gnxt[h][i] = (unsigned)graw[h * 2 + i] * (unsigned)(K * 2) + gC2[i]; }
                else {
#pragma unroll
                    for (int h = 0; h < 2; ++h)
#pragma unroll
                        for (int i = 0; i < 2; ++i) gnxt[h][i] = gcur[h][i]; } } }
            const int kt2 = last ? 0 : t + 2;
            if constexpr (SP2) {
            PG8_LDB(B0, 0, 0); PG8_LDB(B1, 0, 1); PG8_SCHED; PG8_LDA(At, 0, 0); PG8_STAGE_A(PG8_SA(1, 1), a1, t + 1, 1, false);
            PG8_WAIT_V(8); PG8_WAIT_L(0); PG8_BAR; PG8_MMA(0, 0, At, B0); PG8_MMA(0, 1, At, B1); PG8_BAR; PG8_SCHED;
            PG8_LDA(At, 0, 1); PG8_STAGE_B(PG8_SB(0, 0), b2, voffB); PG8_STAGE_B(PG8_SB(0, 1), b2 + hstep, voffB); PG8_STAGE_A(PG8_SA(0, 0), a2, kt2, 0, last);
            PG8_WAIT_V(8); PG8_WAIT_L(0); PG8_BAR; PG8_MMA(1, 0, At, B0); PG8_MMA(1, 1, At, B1); PG8_BAR; PG8_SCHED;
            PG8_LDB(B0, 1, 0); PG8_LDB(B1, 1, 1); PG8_SCHED; PG8_LDA(At, 1, 0); PG8_STAGE_A(PG8_SA(0, 1), a2, kt2, 1, last);
            PG8_WAIT_V(8); PG8_WAIT_L(0); PG8_BAR; PG8_MMA(0, 0, At, B0); PG8_MMA(0, 1, At, B1); PG8_BAR; PG8_SCHED;
            PG8_LDA(At, 1, 1); PG8_STAGE_B(PG8_SB(1, 0), b3, voffB); PG8_STAGE_B(PG8_SB(1, 1), b3 + hstep, voffB); PG8_STAGE_A(PG8_SA(1, 0), a3, kt2 + 1, 0, last);
            PG8_WAIT_V(8); PG8_WAIT_L(0); PG8_BAR; PG8_MMA(1, 0, At, B0); PG8_MMA(1, 1, At, B1); PG8_BAR; PG8_SCHED;
            } else {
            PG8_LDB(B0, 0, 0); PG8_SCHED; PG8_LDA(At, 0, 0); PG8_STAGE(PG8_SA(1, 1), a1 + hstep, voffA);
            PG8_WAIT_L(8); PG8_BAR; PG8_WAIT_L(0); PG8_MMA(0, 0, At, B0); PG8_BAR; PG8_SCHED;
            PG8_LDB(B1, 0, 1); PG8_STAGE_B(PG8_SB(0, 0), b2, voffB);
            PG8_BAR; PG8_WAIT_L(0); PG8_MMA(0, 1, At, B1); PG8_BAR;
            PG8_LDA(At, 0, 1); PG8_STAGE(PG8_SA(0, 0), a2, voffA);
            PG8_BAR; PG8_WAIT_L(0); PG8_MMA(1, 0, At, B0); PG8_BAR; PG8_SCHED;
            PG8_STAGE_B(PG8_SB(0, 1), b2 + hstep, voffB);
            PG8_WAIT_V(6); PG8_BAR; PG8_MMA(1, 1, At, B1); PG8_BAR;
            PG8_LDB(B0, 1, 0); PG8_SCHED; PG8_LDA(At, 1, 0); PG8_STAGE(PG8_SA(0, 1), a2 + hstep, voffA);
            PG8_WAIT_L(8); PG8_BAR; PG8_WAIT_L(0); PG8_MMA(0, 0, At, B0); PG8_BAR; PG8_SCHED;
            PG8_LDB(B1, 1, 1); PG8_STAGE_B(PG8_SB(1, 0), b3, voffB);
            PG8_BAR; PG8_WAIT_L(0); PG8_MMA(0, 1, At, B1); PG8_BAR;
            PG8_LDA(At, 1, 1); PG8_STAGE(PG8_SA(1, 0), a3, voffA);
            PG8_BAR; PG8_WAIT_L(0); PG8_MMA(1, 0, At, B0); PG8_BAR; PG8_SCHED;
            PG8_STAGE_B(PG8_SB(1, 1), b3 + hstep, voffB);
            PG8_WAIT_V(6); PG8_BAR; PG8_MMA(1, 1, At, B1); PG8_BAR;
            }
        }
        if constexpr (ALIGN_EPI) { if (wr == 0) PG8_BAR; }
        if constexpr (!Epi::AFTER_DRAIN) { E(acc, cur, wr, wc, fr, fq); S.done(cur); }
        if (!has_next) break;
        if (!E.keep_acc(cur)) {
#pragma unroll
        for (int a = 0; a < 2; ++a)
#pragma unroll
            for (int b = 0; b < 2; ++b)
#pragma unroll
                for (int m = 0; m < 4; ++m)
#pragma unroll
                    for (int n = 0; n < 2; ++n) acc[a][b][m][n] = (f32x4){0.f, 0.f, 0.f, 0.f};
        }
        cur = nxt; cA = nA; cB = nB; ++ui;
        if constexpr (GATHER) {
#pragma unroll
            for (int h = 0; h < 2; ++h)
#pragma unroll
                for (int i = 0; i < 2; ++i) gcur[h][i] = gnxt[h][i]; }
        if constexpr (ALIGN_EPI) { if (wr == 1) PG8_BAR; }
    }
    PG8_WAIT_V(0);
    if constexpr (!ALIGN_EPI) { if (wr == 0) PG8_BAR; }
    PG8_BAR;
    if constexpr (Epi::AFTER_DRAIN) { E.fused(acc, cur, wr, wc, fr, fq, lds, wid, lane); S.done(cur); }
#undef PG8_SA
#undef PG8_SB
#undef PG8_STAGE
#undef PG8_STAGE_B
#undef PG8_STAGE_A
#undef PG8_LDA
#undef PG8_LDB
#undef PG8_MMA
#undef PG8_WAIT_V
#undef PG8_WAIT_L
#undef PG8_BAR
#undef PG8_SCHED
}
}
typedef unsigned short bf16;
typedef unsigned v4u __attribute__((ext_vector_type(4)));
typedef unsigned v2u __attribute__((ext_vector_type(2)));
typedef float f32x4 __attribute__((ext_vector_type(4)));
typedef short bf16x8 __attribute__((ext_vector_type(8)));
#define MFMA16(a, b, c) __builtin_amdgcn_mfma_f32_16x16x32_bf16((a), (b), (c), 0, 0, 0)
__device__ __forceinline__ bf16x8 as_frag(const v4u& x) { return __builtin_bit_cast(bf16x8, x); }
#define LDS_WAIT() asm volatile("s_waitcnt lgkmcnt(0)" ::: "memory")
#define VM_WAIT() asm volatile("s_waitcnt vmcnt(0)" ::: "memory")
typedef float cvt_f32x2 __attribute__((ext_vector_type(2)));
typedef __bf16 cvt_bf16x2 __attribute__((ext_vector_type(2)));
__device__ __forceinline__ unsigned cvt_pk_bf16(float lo, float hi) { const cvt_f32x2 v = {lo, hi}; return __builtin_bit_cast(unsigned, __builtin_convertvector(v, cvt_bf16x2)); }
__device__ __forceinline__ v4u ldnt4(const void* p) { return __builtin_nontemporal_load((const v4u*)p); }
__device__ __forceinline__ v2u ldnt2(const void* p) { return __builtin_nontemporal_load((const v2u*)p); }
__device__ __forceinline__ float bf_lo(unsigned u) { return __uint_as_float(u << 16); }
__device__ __forceinline__ float bf_hi(unsigned u) { return __uint_as_float(u & 0xffff0000u); }

template <bool NT = false>
__device__ __forceinline__ void tr_item(const float* __restrict__ src, int ldn, int k0, int nsrc0, bf16* dst, int K, int ndst0, LAS float* scr, int lane) {
    const int c4 = (lane & 15) * 4, kr = lane >> 4;
    f32x4 v[16];
#pragma unroll
    for (int i = 0; i < 16; ++i) { const int kk = 4 * i + kr; const f32x4* gp = (const f32x4*)(src + (size_t)(k0 + kk) * ldn + nsrc0 + c4); v[i] = NT ? __builtin_nontemporal_load(gp) : *gp; }
#pragma unroll
    for (int i = 0; i < 16; ++i) { const int kk = 4 * i + kr; LAS float* s = scr + kk * 65 + c4; s[0] = v[i][0]; s[1] = v[i][1]; s[2] = v[i][2]; s[3] = v[i][3]; }
    LDS_WAIT();
    const int kc = lane & 7, nr = lane >> 3;
#pragma unroll
    for (int jj = 0; jj < 8; ++jj) { const int n = 8 * jj + nr; const LAS float* s = scr + (8 * kc) * 65 + n;
        v4u o; o.x = cvt_pk_bf16(s[0], s[65]); o.y = cvt_pk_bf16(s[130], s[195]); o.z = cvt_pk_bf16(s[260], s[325]); o.w = cvt_pk_bf16(s[390], s[455]);
        v4u* dp = (v4u*)(dst + (size_t)(ndst0 + n) * K + k0 + 8 * kc); if (NT) __builtin_nontemporal_store(o, dp); else *dp = o; }
    LDS_WAIT();
}
struct TrDesc { const float* src; int ldn, k0, nsrc0; bf16* dst; int K, ndst0; };
template <bool NT>
__device__ __forceinline__ void tr_load(f32x4 (&v)[16], const TrDesc& d, int lane) {
    const int c4 = (lane & 15) * 4, kr = lane >> 4;
#pragma unroll
    for (int i = 0; i < 16; ++i) { const int kk = 4 * i + kr; const f32x4* gp = (const f32x4*)(d.src + (size_t)(d.k0 + kk) * d.ldn + d.nsrc0 + c4); v[i] = NT ? __builtin_nontemporal_load(gp) : *gp; }
}
__device__ __forceinline__ void tr_load_asm(f32x4 (&v)[16], const TrDesc& d, int lane) {
    const int c4 = (lane & 15) * 4, kr = lane >> 4;
#pragma unroll
    for (int i = 0; i < 16; ++i) { const int kk = 4 * i + kr; const float* gp = d.src + (size_t)(d.k0 + kk) * d.ldn + d.nsrc0 + c4; asm volatile("global_load_dwordx4 %0, %1, off nt" : "=v"(v[i]) : "v"(gp) : "memory"); }
}
__device__ __forceinline__ void tr_pin(f32x4 (&v)[16]) {
#pragma unroll
    for (int i = 0; i < 16; ++i) asm volatile("" : "+v"(v[i]));
}
__device__ __forceinline__ void tr_spill(const f32x4 (&v)[16], LAS float* scr, int lane) {
    const int c4 = (lane & 15) * 4, kr = lane >> 4;
#pragma unroll
    for (int i = 0; i < 16; ++i) { const int kk = 4 * i + kr; LAS float* s = scr + kk * 65 + c4; s[0] = v[i][0]; s[1] = v[i][1]; s[2] = v[i][2]; s[3] = v[i][3]; }
}
template <bool NT>
__device__ __forceinline__ void tr_emit(const TrDesc& d, const LAS float* scr, int lane) {
    const int kc = lane & 7, nr = lane >> 3;
#pragma unroll
    for (int jj = 0; jj < 8; ++jj) { const int n = 8 * jj + nr; const LAS float* s = scr + (8 * kc) * 65 + n;
        v4u o; o.x = cvt_pk_bf16(s[0], s[65]); o.y = cvt_pk_bf16(s[130], s[195]); o.z = cvt_pk_bf16(s[260], s[325]); o.w = cvt_pk_bf16(s[390], s[455]);
        v4u* dp = (v4u*)(d.dst + (size_t)(d.ndst0 + n) * d.K + d.k0 + 8 * kc); if (NT) __builtin_nontemporal_store(o, dp); else *dp = o; }
}
constexpr int CONV_MOE_ITEMS = NE * 16 * 32 + NE * 16 * 16, SG_COST = 21;
__device__ __forceinline__ TrDesc moe_desc(int it, const float* w_gate_up, const float* w_down, bf16* Wgu_t, bf16* Wd_t) {
    constexpr int I_GU = NE * 16 * 32; TrDesc d;
    if (it < I_GU) { const int e = it >> 9, r = it & 511, kb = r >> 5, nbk = r & 31, R0 = nbk * 64, pn = R0 >> 8, rr = R0 & 255, bj = rr >> 7, j0 = rr & 127;
        d.src = w_gate_up + (size_t)e * D * 2 * DFF; d.ldn = 2 * DFF; d.k0 = kb * 64; d.nsrc0 = bj * DFF + 128 * pn + j0; d.dst = Wgu_t + (size_t)e * 2 * DFF * D; d.K = D; d.ndst0 = R0; }
    else { const int r2 = it - I_GU, e = r2 >> 8, r = r2 & 255, kb = r >> 4, nbk = r & 15;
        d.src = w_down + (size_t)e * DFF * D; d.ldn = D; d.k0 = kb * 64; d.nsrc0 = nbk * 64; d.dst = Wd_t + (size_t)e * D * DFF; d.K = DFF; d.ndst0 = nbk * 64; }
    return d;
}
__device__ __forceinline__ void p_convert_moe(const Ctx& c, const float* w_gate_up, const float* w_down, bf16* Wgu_t, bf16* Wd_t, int sg_items) {
    LAS float* scr = (LAS float*)c.lds + c.wave * (64 * 65);
    const int r = sg_items % c.nb, C = (CONV_MOE_ITEMS + r * SG_COST + c.nb - 1) / c.nb, Cl = C - SG_COST > 0 ? C - SG_COST : 0;
    const int first = c.bid < r ? c.bid * Cl : r * Cl + (c.bid - r) * C, cnt = c.bid < r ? Cl : C;
    const int last = first + cnt < CONV_MOE_ITEMS ? first + cnt : CONV_MOE_ITEMS;
    f32x4 v[16];
    int it = first + c.wave;
    VM_WAIT();
    if (it < last) { tr_load_asm(v, moe_desc(it, w_gate_up, w_down, Wgu_t, Wd_t), c.lane); VM_WAIT(); tr_pin(v); tr_spill(v, scr, c.lane); }
#pragma unroll 1
    for (; it < last; it += NWAVES) {
        const bool more = it + NWAVES < last;
        if (more) tr_load_asm(v, moe_desc(it + NWAVES, w_gate_up, w_down, Wgu_t, Wd_t), c.lane);
        LDS_WAIT();
        tr_emit<true>(moe_desc(it, w_gate_up, w_down, Wgu_t, Wd_t), scr, c.lane);
        LDS_WAIT();
        if (more) { asm volatile("s_waitcnt vmcnt(8)" ::: "memory"); tr_pin(v); tr_spill(v, scr, c.lane); }
    }
    VM_WAIT();
}

__device__ __forceinline__ float f4c(const float4& v, int i) { return i == 0 ? v.x : (i == 1 ? v.y : (i == 2 ? v.z : v.w)); }
__device__ __forceinline__ void p_router(const Ctx& c, const float* __restrict__ X1, const float* __restrict__ g2, const float* __restrict__ wr, const float* __restrict__ br, bf16* __restrict__ H2, int* __restrict__ slot_e, int* __restrict__ slot_pos, int* __restrict__ elist, float* __restrict__ ewgt, unsigned* gcnt, int reps = 1) {
    LAS f32x4* WL = (LAS f32x4*)c.lds;
    LAS float* LG = (LAS float*)(c.lds0 + EXTRA_OFF);
    LAS int* HIST = (LAS int*)(c.lds0 + EXTRA_OFF + 8192);
    LAS int* BASE = HIST + 32;
    LAS int* SELE = BASE + 32;
    LAS int* SELR = SELE + 256;
    LAS float* SELW = (LAS float*)(SELR + 256);
    const int lane = c.lane;
    { f32x4 wv[16];
#pragma unroll
      for (int i = 0; i < 16; ++i) wv[i] = ((const f32x4*)wr)[c.tid + NTHR * i];
#pragma unroll
      for (int i = 0; i < 16; ++i) { const int idx = c.tid + NTHR * i, k = idx >> 3, q = idx & 7, l = (k & 255) >> 2, cc = k & 3, j = k >> 8; WL[((j * 4 + cc) * 8 + q) * 64 + l] = wv[i]; } }
    lds_barrier();
    for (int blk = c.bid; blk < NTOK / 64; blk += c.nb) {
        if (c.tid < 32) HIST[c.tid] = 0;
        lds_barrier();
        for (int pp = 0; pp < 4 * reps; ++pp) { const int p = pp & 3;
            const size_t t0 = (size_t)blk * 64 + c.wave * 8 + 2 * p;
            float4 xa[4], xb[4]; float sa = 0.f, sb = 0.f;
#pragma unroll
            for (int j = 0; j < 4; ++j) { xa[j] = ((const float4*)(X1 + t0 * D))[lane + 64 * j]; xb[j] = ((const float4*)(X1 + (t0 + 1) * D))[lane + 64 * j];
                sa += xa[j].x * xa[j].x + xa[j].y * xa[j].y + xa[j].z * xa[j].z + xa[j].w * xa[j].w; sb += xb[j].x * xb[j].x + xb[j].y * xb[j].y + xb[j].z * xb[j].z + xb[j].w * xb[j].w; }
            const float ra = rsqrtf(wave_sum(sa) * (1.f / D) + RMS_EPS), rb = rsqrtf(wave_sum(sb) * (1.f / D) + RMS_EPS);
#pragma unroll
            for (int j = 0; j < 4; ++j) { const float4 g = ((const float4*)g2)[lane + 64 * j];
                xa[j].x *= ra * g.x; xa[j].y *= ra * g.y; xa[j].z *= ra * g.z; xa[j].w *= ra * g.w; xb[j].x *= rb * g.x; xb[j].y *= rb * g.y; xb[j].z *= rb * g.z; xb[j].w *= rb * g.w;
                v2u oa, ob; oa.x = cvt_pk_bf16(xa[j].x, xa[j].y); oa.y = cvt_pk_bf16(xa[j].z, xa[j].w); ob.x = cvt_pk_bf16(xb[j].x, xb[j].y); ob.y = cvt_pk_bf16(xb[j].z, xb[j].w);
                ((v2u*)(H2 + t0 * D))[lane + 64 * j] = oa; ((v2u*)(H2 + (t0 + 1) * D))[lane + 64 * j] = ob; }
            float acc[64];
#pragma unroll
            for (int i = 0; i < 64; ++i) acc[i] = 0.f;
#pragma unroll
            for (int j = 0; j < 4; ++j)
#pragma unroll
                for (int cc = 0; cc < 4; ++cc) { const float ha = f4c(xa[j], cc), hb = f4c(xb[j], cc);
#pragma unroll
                    for (int q = 0; q < 8; ++q) { const f32x4 w = WL[((j * 4 + cc) * 8 + q) * 64 + lane];
                        acc[4 * q + 0] = fmaf(ha, w.x, acc[4 * q + 0]); acc[4 * q + 1] = fmaf(ha, w.y, acc[4 * q + 1]); acc[4 * q + 2] = fmaf(ha, w.z, acc[4 * q + 2]); acc[4 * q + 3] = fmaf(ha, w.w, acc[4 * q + 3]);
                        acc[32 + 4 * q + 0] = fmaf(hb, w.x, acc[32 + 4 * q + 0]); acc[32 + 4 * q + 1] = fmaf(hb, w.y, acc[32 + 4 * q + 1]); acc[32 + 4 * q + 2] = fmaf(hb, w.z, acc[32 + 4 * q + 2]); acc[32 + 4 * q + 3] = fmaf(hb, w.w, acc[32 + 4 * q + 3]); } }
            BFLY_SW32(acc, 64) BFLY_SW16(acc, 32) BFLY_DPP(acc, 16, 8, dpp_ror8) BFLY_DPP(acc, 8, 4, dpp_xor4) BFLY_DPP(acc, 4, 2, dpp_xor2) BFLY_DPP(acc, 2, 1, dpp_xor1)
            LG[(c.wave * 8 + 2 * p + (lane >> 5)) * 32 + (lane & 31)] = acc[0] + br[lane & 31];
        }
        LDS_WAIT();
        if (lane < 8) {
            const int tokl = c.wave * 8 + lane;
            float l[NE];
#pragma unroll
            for (int j = 0; j < NE; ++j) l[j] = LG[tokl * 32 + j];
            int sel[4]; float sv[4];
#pragma unroll
            for (int k = 0; k < 4; ++k) { int bi = 0; float bv = -INFINITY;
#pragma unroll
                for (int j = 0; j < NE; ++j) { const bool better = l[j] > bv; bv = better ? l[j] : bv; bi = better ? j : bi; }
                sel[k] = bi; sv[k] = bv;
#pragma unroll
                for (int j = 0; j < NE; ++j) l[j] = (j == bi) ? -INFINITY : l[j]; }
            float den = 0.f, ex[4];
#pragma unroll
            for (int k = 0; k < 4; ++k) { ex[k] = expf(sv[k] - sv[0]); den += ex[k]; }
            const float inv = 1.f / den;
#pragma unroll
            for (int k = 0; k < 4; ++k) { SELE[tokl * 4 + k] = sel[k]; SELW[tokl * 4 + k] = ex[k] * inv; SELR[tokl * 4 + k] = atomicAdd((int*)(HIST + sel[k]), 1); }
        }
        lds_barrier();
        if (c.tid < 32) BASE[c.tid] = (int)__hip_atomic_fetch_add(gcnt + c.tid, (unsigned)HIST[c.tid], __ATOMIC_RELAXED, __HIP_MEMORY_SCOPE_AGENT);
        lds_barrier();
        if (c.tid < 256) { const int gi = blk * 256 + c.tid, e = SELE[c.tid], pos = BASE[e] + SELR[c.tid]; slot_e[gi] = e; slot_pos[gi] = pos; elist[e * NTOK + pos] = gi >> 2; ewgt[e * NTOK + pos] = SELW[c.tid]; }
    }
}

__device__ __forceinline__ void p_build_wrt(const Ctx& c, const float* __restrict__ wr, bf16* __restrict__ WrT) {
    for (int i = c.bid * NTHR + c.tid; i < NE * D; i += c.nb * NTHR) { const int e = i >> 10, k = i & 1023; const float w = wr[k * NE + e];
        const unsigned hi = cvt_pk_bf16(w, 0.f) & 0xffffu; const float rem = w - __uint_as_float(hi << 16);
        WrT[e * D + k] = (bf16)hi; WrT[NE * D + e * D + k] = (bf16)(cvt_pk_bf16(rem, 0.f) & 0xffffu); }
}
__device__ __forceinline__ void p_router2(const Ctx& c, const float* __restrict__ X1, const float* __restrict__ g2, const bf16* __restrict__ WrT, const float* __restrict__ br, bf16* __restrict__ H2,
                                          int* __restrict__ slot_e, int* __restrict__ slot_pos, int* __restrict__ elist, float* __restrict__ ewgt, unsigned* gcnt) {
    LAS unsigned char* HH = c.lds; LAS unsigned char* HL = c.lds + 65536;
    LAS float* LG = (LAS float*)(c.lds0 + EXTRA_OFF);
    LAS float* PART = LG + 1024;
    LAS int* HIST = (LAS int*)(PART + 1024);
    LAS int* BASE = HIST + 32; LAS int* SELE = BASE + 32; LAS int* SELR = SELE + 128; LAS float* SELW = (LAS float*)(SELR + 128);
    const int lane = c.lane, w = c.wave, fr = lane & 15, fq = lane >> 4;
    float4 g2r[4];
#pragma unroll
    for (int j = 0; j < 4; ++j) g2r[j] = ((const float4*)g2)[lane + 64 * j];
    for (int blk = c.bid; blk < NTOK / 32; blk += c.nb) {
        if (c.tid < 32) HIST[c.tid] = 0;
#pragma unroll 1
        for (int p = 0; p < 2; ++p) {
            const int tl = w * 4 + 2 * p; const size_t t0 = (size_t)blk * 32 + tl;
            float4 xa[4], xb[4]; float sa = 0.f, sb = 0.f;
#pragma unroll
            for (int j = 0; j < 4; ++j) { { const v4u ra_ = ldnt4((const v4u*)(X1 + t0 * D) + lane + 64 * j), rb_ = ldnt4((const v4u*)(X1 + (t0 + 1) * D) + lane + 64 * j); xa[j] = make_float4(__uint_as_float(ra_.x), __uint_as_float(ra_.y), __uint_as_float(ra_.z), __uint_as_float(ra_.w)); xb[j] = make_float4(__uint_as_float(rb_.x), __uint_as_float(rb_.y), __uint_as_float(rb_.z), __uint_as_float(rb_.w)); }
                sa += xa[j].x * xa[j].x + xa[j].y * xa[j].y + xa[j].z * xa[j].z + xa[j].w * xa[j].w; sb += xb[j].x * xb[j].x + xb[j].y * xb[j].y + xb[j].z * xb[j].z + xb[j].w * xb[j].w; }
            const float ra = rsqrtf(wave_sum(sa) * (1.f / D) + RMS_EPS), rb = rsqrtf(wave_sum(sb) * (1.f / D) + RMS_EPS);
#pragma unroll
            for (int j = 0; j < 4; ++j) { const float4 g = g2r[j];
                const float ha[4] = {xa[j].x * ra * g.x, xa[j].y * ra * g.y, xa[j].z * ra * g.z, xa[j].w * ra * g.w}, hb[4] = {xb[j].x * rb * g.x, xb[j].y * rb * g.y, xb[j].z * rb * g.z, xb[j].w * rb * g.w};
                v2u ah, al, bh, bl;
                ah.x = cvt_pk_bf16(ha[0], ha[1]); ah.y = cvt_pk_bf16(ha[2], ha[3]); bh.x = cvt_pk_bf16(hb[0], hb[1]); bh.y = cvt_pk_bf16(hb[2], hb[3]);
                al.x = cvt_pk_bf16(ha[0] - bf_lo(ah.x), ha[1] - bf_hi(ah.x)); al.y = cvt_pk_bf16(ha[2] - bf_lo(ah.y), ha[3] - bf_hi(ah.y));
                bl.x = cvt_pk_bf16(hb[0] - bf_lo(bh.x), hb[1] - bf_hi(bh.x)); bl.y = cvt_pk_bf16(hb[2] - bf_lo(bh.y), hb[3] - bf_hi(bh.y));
                ((v2u*)(H2 + t0 * D))[lane + 64 * j] = ah; ((v2u*)(H2 + (t0 + 1) * D))[lane + 64 * j] = bh;
                const int ch = (lane >> 1) + 32 * j, h8 = 8 * (lane & 1);
                const int oa = tl * 2048 + 16 * (ch ^ (tl & 15)) + h8, ob = (tl + 1) * 2048 + 16 * (ch ^ ((tl + 1) & 15)) + h8;
                *(LAS v2u*)(HH + oa) = ah; *(LAS v2u*)(HL + oa) = al; *(LAS v2u*)(HH + ob) = bh; *(LAS v2u*)(HL + ob) = bl; }
        }
        lds_barrier();
        { const int mt = w & 1, nt = (w >> 1) & 1, kh = w >> 2, tok = 16 * mt + fr; f32x4 acc = {0.f, 0.f, 0.f, 0.f};
            const bf16* wh = WrT + (size_t)(16 * nt + fr) * D + 8 * fq; const bf16* wl = wh + NE * D;
#pragma unroll 4
            for (int kk = 16 * kh; kk < 16 * kh + 16; ++kk) { const int off = tok * 2048 + 16 * ((4 * kk + fq) ^ (tok & 15));
                const bf16x8 ahi = *(const LAS bf16x8*)(HH + off), alo = *(const LAS bf16x8*)(HL + off);
                const bf16x8 bhi = as_frag(*(const v4u*)(wh + 32 * kk)), blo = as_frag(*(const v4u*)(wl + 32 * kk));
                acc = MFMA16(ahi, bhi, acc); acc = MFMA16(ahi, blo, acc); acc = MFMA16(alo, bhi, acc); }
            if (kh == 1) *(LAS f32x4*)(PART + ((mt * 2 + nt) * 64 + lane) * 4) = acc;
            lds_barrier();
            if (kh == 0) { const f32x4 pr = *(const LAS f32x4*)(PART + ((mt * 2 + nt) * 64 + lane) * 4); const float bb = br[16 * nt + fr];
#pragma unroll
                for (int r = 0; r < 4; ++r) LG[(16 * mt + 4 * fq + r) * 32 + 16 * nt + fr] = acc[r] + pr[r] + bb; } }
        lds_barrier();
#pragma unroll
        for (int ps = 0; ps < 2; ++ps) { const int tokl = 4 * w + 2 * ps + (lane >> 5), e = lane & 31; float v = LG[tokl * 32 + e];
            int sel[4]; float sv[4];
#pragma unroll
            for (int k = 0; k < 4; ++k) { float m = v; m = fmaxf(m, dpp_xor1(m)); m = fmaxf(m, dpp_xor2(m)); m = fmaxf(m, dpp_hmir(m)); m = fmaxf(m, dpp_rmir(m));
                const float hm = (lane < 32) ? fmaxf(rdlane(m, 0), rdlane(m, 16)) : fmaxf(rdlane(m, 32), rdlane(m, 48));
                const unsigned long long bal = __builtin_amdgcn_ballot_w64(v == hm);
                const int ilo = __builtin_ctz((unsigned)bal), ihi = __builtin_ctz((unsigned)(bal >> 32));
                const int bi = (lane < 32) ? ilo : ihi;
                sel[k] = bi; sv[k] = hm; v = (e == bi) ? -INFINITY : v; }
            float den = 0.f, ex[4];
#pragma unroll
            for (int k = 0; k < 4; ++k) { ex[k] = expf(sv[k] - sv[0]); den += ex[k]; }
            const float inv = 1.f / den;
            if (e < 4) { const int se = e == 0 ? sel[0] : (e == 1 ? sel[1] : (e == 2 ? sel[2] : sel[3])); const float we = (e == 0 ? ex[0] : (e == 1 ? ex[1] : (e == 2 ? ex[2] : ex[3]))) * inv;
                SELE[tokl * 4 + e] = se; SELW[tokl * 4 + e] = we; SELR[tokl * 4 + e] = atomicAdd((int*)(HIST + se), 1); } }
        lds_barrier();
        if (c.tid < 32) BASE[c.tid] = (int)__hip_atomic_fetch_add(gcnt + c.tid, (unsigned)HIST[c.tid], __ATOMIC_RELAXED, __HIP_MEMORY_SCOPE_AGENT);
        lds_barrier();
        if (c.tid < 128) { const int gi = blk * 128 + c.tid, e = SELE[c.tid], pos = BASE[e] + SELR[c.tid]; slot_e[gi] = e; slot_pos[gi] = pos; elist[e * NTOK + pos] = gi >> 2; ewgt[e * NTOK + pos] = SELW[c.tid]; }
        lds_barrier();
    }
}

struct MoeOrder {
    int t0, nt, nN, wgm, s, spx, base, lim, sigT; unsigned* tcnt; bool wait; const LAS unsigned char* tile_e; const LAS int* tile_b;
    __device__ __forceinline__ void init(int t0_, int nt_, int nN_, int wgm_, int s_, int spx_, int base_, int lim_, int sigT_, unsigned* tcnt_, bool wait_, const LAS unsigned char* te, const LAS int* tb) {
        t0 = t0_; nt = nt_; nN = nN_; wgm = wgm_; s = s_; spx = spx_; base = base_; lim = lim_; sigT = sigT_; tcnt = tcnt_; wait = wait_; tile_e = te; tile_b = tb; }
    __device__ __forceinline__ bool next(int i, pg8::Unit& u) const {
        const int off = base + s + i * spx; if (off < 0 || off >= lim) return false;
        const int nig = wgm * nN, gid = off / nig, fm = gid * wgm, gsz = (nt - fm) < wgm ? (nt - fm) : wgm, w = off - gid * nig;
        const int pm = t0 + fm + (w % gsz), pnl = w / gsz;
        const int e = __builtin_amdgcn_readfirstlane((int)tile_e[pm]);
        u.pm = pm; u.pn = e * nN + pnl; u.x0 = e; u.x1 = pnl; u.rb = e * NTOK + (pm - __builtin_amdgcn_readfirstlane(tile_b[e])) * 256; return true;
    }
    __device__ __forceinline__ void a_ready(const pg8::Unit& u) const {
        if (wait) { if (threadIdx.x < 64) { unsigned* p = tcnt + u.pm; unsigned sp = 0u;
                while (xb_ld(p) < 8u) { __builtin_amdgcn_s_sleep(2); if (++sp > (1u << 24)) break; }
                __builtin_amdgcn_fence(__ATOMIC_ACQUIRE, "agent"); asm volatile("s_waitcnt vmcnt(0)" ::: "memory"); }
            __builtin_amdgcn_s_barrier(); }
    }
    __device__ __forceinline__ void done(const pg8::Unit& u) const {
        if (sigT > 0 && (u.pm - t0) < sigT) { asm volatile("s_waitcnt vmcnt(0)" ::: "memory"); __builtin_amdgcn_s_barrier();
            if (threadIdx.x < 64) { __builtin_amdgcn_fence(__ATOMIC_RELEASE, "agent"); asm volatile("s_waitcnt vmcnt(0)" ::: "memory");
                if (threadIdx.x == 0) (void)xb_add(tcnt + u.pm, 1u); } }
    }
};
__device__ __forceinline__ void build_tile_table(const Ctx& c, const unsigned* gcnt, LAS unsigned char* tile_e, LAS int* ntiles, LAS int* tile_b) {
    if (c.tid == 0) { int tb = 0; for (int e = 0; e < NE; ++e) { const int nt = ((int)gcnt[e] + 255) >> 8; tile_b[e] = tb; for (int i = 0; i < nt; ++i) tile_e[tb + i] = (unsigned char)e; tb += nt; } tile_b[NE] = tb; ntiles[0] = tb; }
    lds_barrier();
}

struct EpiSwiglu {
    static constexpr bool PERM = true, AFTER_DRAIN = false;
    bf16* O; const float* bias;
    __device__ __forceinline__ bool keep_acc(const pg8::Unit&) const { return false; }
    __device__ __forceinline__ void operator()(const f32x4 (&acc)[2][2][4][2], const pg8::Unit& u, int wr, int wc, int fr, int fq) const {
        const int row0 = u.pm * 256 + wr * 64 + fr, col0 = u.x1 * 128 + wc * 32 + 8 * fq;
        const float* bg = bias + (size_t)u.x0 * 2 * DFF + col0; const float* bl = bg + DFF;
        f32x4 bgv[2], blv[2];
#pragma unroll
        for (int n = 0; n < 2; ++n) { bgv[n] = *(const f32x4*)(bg + 4 * n); blv[n] = *(const f32x4*)(bl + 4 * n); }
#pragma unroll
        for (int ai = 0; ai < 2; ++ai)
#pragma unroll
            for (int m = 0; m < 4; ++m) { bf16* rowp = O + (size_t)(row0 + ai * 128 + m * 16) * DFF + col0; float a[8];
#pragma unroll
                for (int n = 0; n < 2; ++n) { const f32x4 g = acc[ai][0][m][n] + bgv[n], l = acc[ai][1][m][n] + blv[n];
#pragma unroll
                    for (int i = 0; i < 4; ++i) { const float xg = fminf(g[i], 7.f), xl = fminf(fmaxf(l[i], -7.f), 7.f);
                        a[4 * n + i] = xg * __builtin_amdgcn_rcpf(1.f + __expf(-1.702f * xg)) * (xl + 1.f); } }
                v4u w; w.x = cvt_pk_bf16(a[0], a[1]); w.y = cvt_pk_bf16(a[2], a[3]); w.z = cvt_pk_bf16(a[4], a[5]); w.w = cvt_pk_bf16(a[6], a[7]);
                *(v4u*)rowp = w; }
    }
};
struct EpiDown {
    static constexpr bool PERM = true, AFTER_DRAIN = false;
    bf16* O; const float* bias; const float* roww;
    __device__ __forceinline__ bool keep_acc(const pg8::Unit&) const { return false; }
    __device__ __forceinline__ void operator()(const f32x4 (&acc)[2][2][4][2], const pg8::Unit& u, int wr, int wc, int fr, int fq) const {
        const int row0 = u.pm * 256 + wr * 64 + fr, col0 = u.x1 * 256 + wc * 32 + 8 * fq;
        const float* bp = bias + (size_t)u.x0 * D + col0;
        f32x4 bv[2][2];
#pragma unroll
        for (int bj = 0; bj < 2; ++bj)
#pragma unroll
            for (int n = 0; n < 2; ++n) bv[bj][n] = *(const f32x4*)(bp + bj * 128 + 4 * n);
        float rw[2][4];
#pragma unroll
        for (int ai = 0; ai < 2; ++ai)
#pragma unroll
            for (int m = 0; m < 4; ++m) rw[ai][m] = roww[u.rb + wr * 64 + fr + ai * 128 + m * 16];
        asm volatile("" ::: "memory");
#pragma unroll
        for (int ai = 0; ai < 2; ++ai)
#pragma unroll
            for (int m = 0; m < 4; ++m) { const int rl = wr * 64 + fr + ai * 128 + m * 16, row = u.pm * 256 + rl; const float w = rw[ai][m]; bf16* rowp = O + (size_t)row * D + col0;
#pragma unroll
                for (int bj = 0; bj < 2; ++bj) { const f32x4 v0 = (acc[ai][bj][m][0] + bv[bj][0]) * w, v1 = (acc[ai][bj][m][1] + bv[bj][1]) * w;
                    v4u o; o.x = cvt_pk_bf16(v0[0], v0[1]); o.y = cvt_pk_bf16(v0[2], v0[3]); o.z = cvt_pk_bf16(v1[0], v1[1]); o.w = cvt_pk_bf16(v1[2], v1[3]);
                    *(v4u*)(rowp + bj * 128) = o; } }
    }
};

__device__ __forceinline__ void p_final(const Ctx& c, const float* __restrict__ X1, const bf16* __restrict__ Yb, const int* __restrict__ slot_e, const int* __restrict__ slot_pos, const unsigned* gcnt, const float* __restrict__ g, float* __restrict__ out, float pscale = 1.f) {
    LAS int* POFF = (LAS int*)(c.lds0 + EXTRA_OFF);
    if (c.tid == 0) { int s = 0; for (int e = 0; e < NE; ++e) { POFF[e] = s; s += (((int)gcnt[e] + 255) >> 8) << 8; } }
    lds_barrier();
    float4 ggr[4];
#pragma unroll
    for (int j = 0; j < 4; ++j) ggr[j] = ((const float4*)g)[c.lane + 64 * j];
#pragma unroll 4
    for (int t = c.bid * NWAVES + c.wave; t < NTOK; t += c.nb * NWAVES) {
        const int lane = c.lane; float4 v[4];
#pragma unroll
        for (int j = 0; j < 4; ++j) { const v4u xr = ldnt4((const v4u*)(X1 + (size_t)t * D) + lane + 64 * j); v[j] = make_float4(__uint_as_float(xr.x), __uint_as_float(xr.y), __uint_as_float(xr.z), __uint_as_float(xr.w)); }
#pragma unroll
        for (int k = 0; k < 4; ++k) { const int dst = POFF[slot_e[t * 4 + k]] + slot_pos[t * 4 + k];
#pragma unroll
            for (int j = 0; j < 4; ++j) { const v2u y = ldnt2((const v2u*)(Yb + (size_t)dst * D) + lane + 64 * j); v[j].x += bf_lo(y.x); v[j].y += bf_hi(y.x); v[j].z += bf_lo(y.y); v[j].w += bf_hi(y.y); } }
        float s = 0.f;
#pragma unroll
        for (int j = 0; j < 4; ++j) s += v[j].x * v[j].x + v[j].y * v[j].y + v[j].z * v[j].z + v[j].w * v[j].w;
        const float r = rsqrtf(wave_sum(s) * (1.f / D) + RMS_EPS) * pscale;
#pragma unroll
        for (int j = 0; j < 4; ++j) { const float4 gg = ggr[j]; const f32x4 ov = {v[j].x * r * gg.x, v[j].y * r * gg.y, v[j].z * r * gg.z, v[j].w * r * gg.w}; __builtin_nontemporal_store(ov, (f32x4*)(out + (size_t)t * D) + lane + 64 * j); }
    }
}

constexpr int PJ = 5120;
typedef float f32x2 __attribute__((ext_vector_type(2)));
__device__ __forceinline__ f32x2 gelu_pk(f32x2 v) {
    const f32x2 av = __builtin_elementwise_abs(v), d = av * 0.2316418882f + 1.0f;
    f32x2 t; t.x = __builtin_amdgcn_rcpf(d.x); t.y = __builtin_amdgcn_rcpf(d.y);
    f32x2 q = t * 0.5307027145f + (-0.7265760135f); q = q * t + 0.7107068705f; q = q * t + (-0.142248368f); q = q * t + 0.127414796f; q = q * t;
    const f32x2 s = (v * v) * (-0.72134752044f);
    f32x2 e; e.x = __builtin_amdgcn_exp2f(s.x); e.y = __builtin_amdgcn_exp2f(s.y);
    const f32x2 m = v * (q * e), r = v - m;
    f32x2 o; o.x = v.x < 0.f ? m.x : r.x; o.y = v.y < 0.f ? m.y : r.y; return o;
}
__device__ __forceinline__ float fast_sigmoid(float x) { return __builtin_amdgcn_rcpf(1.f + __expf(-x)); }

__device__ __forceinline__ void p_convert_front(const Ctx& c, const float* w_in, const float* w_o_dn, const float* w_o_sg, const float* w_out, bf16* Win_t, bf16* Wo_t, bf16* Wout_t) {
    LAS float* scr = (LAS float*)c.lds + c.wave * (64 * 65);
    constexpr int I_IN = 16 * 80, I_O = 8 * 16, I_OUT = 16 * 16;
    for (int it = c.bid * NWAVES + c.wave; it < I_IN + 2 * I_O + I_OUT; it += c.nb * NWAVES) {
        int r = it;
        if (r < I_IN) { const int kb = r / 80, nbk = r % 80, n0 = nbk * 64; tr_item<true>(w_in, INC, kb * 64, n0 < 2048 ? n0 : n0 + 8, Win_t, D, n0, scr, c.lane); continue; } r -= I_IN;
        if (r < I_O) { const int kb = r / 16, nbk = r % 16; tr_item<true>(w_o_dn, D, kb * 64, nbk * 64, Wo_t, DNW, nbk * 64, scr, c.lane); continue; } r -= I_O;
        if (r < I_O) { const int kb = r / 16, nbk = r % 16; tr_item<true>(w_o_sg, D, kb * 64, nbk * 64, Wo_t + (size_t)D * DNW, SGW, nbk * 64, scr, c.lane); continue; } r -= I_O;
        { const int kb = r / 16, nbk = r % 16; tr_item<true>(w_out, D, kb * 64, nbk * 64, Wout_t, D, nbk * 64, scr, c.lane); }
    }
}
__device__ __forceinline__ void p_norm1(const Ctx& c, const float* __restrict__ x, const float* __restrict__ g1, const float* __restrict__ w_in, const float* __restrict__ a_log, const float* __restrict__ dt_bias, bf16* __restrict__ Hb, float* __restrict__ BG) {
    LAS f32x4* WB = (LAS f32x4*)c.lds;
    const int lane = c.lane;
    for (int idx = c.tid; idx < 2048; idx += NTHR) { const int k = idx >> 1, q = idx & 1; const f32x4 v = *(const f32x4*)(w_in + (size_t)k * INC + 2048 + 4 * q);
        const int l = (k & 255) >> 2, cc = k & 3, j = k >> 8; WB[((j * 4 + cc) * 2 + q) * 64 + l] = v; }
    lds_barrier();
    float4 g1r[4];
#pragma unroll
    for (int j = 0; j < 4; ++j) g1r[j] = ((const float4*)g1)[lane + 64 * j];
#pragma unroll 4
    for (int t = c.bid * NWAVES + c.wave; t < NTOK; t += c.nb * NWAVES) {
        float4 xv[4]; float ss = 0.f;
#pragma unroll
        for (int j = 0; j < 4; ++j) { xv[j] = ((const float4*)(x + (size_t)t * D))[lane + 64 * j]; ss += xv[j].x * xv[j].x + xv[j].y * xv[j].y + xv[j].z * xv[j].z + xv[j].w * xv[j].w; }
        const float r = rsqrtf(wave_sum(ss) * (1.f / D) + RMS_EPS);
#pragma unroll
        for (int j = 0; j < 4; ++j) { const float4 g = g1r[j]; xv[j].x *= r * g.x; xv[j].y *= r * g.y; xv[j].z *= r * g.z; xv[j].w *= r * g.w;
            v2u o; o.x = cvt_pk_bf16(xv[j].x, xv[j].y); o.y = cvt_pk_bf16(xv[j].z, xv[j].w); ((v2u*)(Hb + (size_t)t * D))[lane + 64 * j] = o; }
        float acc[8];
#pragma unroll
        for (int i = 0; i < 8; ++i) acc[i] = 0.f;
#pragma unroll
        for (int j = 0; j < 4; ++j)
#pragma unroll
            for (int cc = 0; cc < 4; ++cc) { const float h = f4c(xv[j], cc);
#pragma unroll
                for (int q = 0; q < 2; ++q) { const f32x4 w = WB[((j * 4 + cc) * 2 + q) * 64 + lane];
                    acc[4 * q + 0] = fmaf(h, w.x, acc[4 * q + 0]); acc[4 * q + 1] = fmaf(h, w.y, acc[4 * q + 1]); acc[4 * q + 2] = fmaf(h, w.z, acc[4 * q + 2]); acc[4 * q + 3] = fmaf(h, w.w, acc[4 * q + 3]); } }
        BFLY_SW32(acc, 8) BFLY_SW16(acc, 4) BFLY_DPP(acc, 2, 8, dpp_ror8)
        float a0 = acc[0]; a0 += dpp_xor4(a0); a0 += dpp_xor2(a0); a0 += dpp_xor1(a0);
        const int idx = lane >> 3;
        if ((lane & 7) == 0) { float o;
            if (idx < 4) o = 1.f / (1.f + expf(-a0)); else { const int h = idx - 4; o = -expf(a_log[h]) * softplusf_(a0 + dt_bias[h]); }
            BG[(size_t)t * 8 + idx] = o; }
    }
}
struct EpiProj {
    static constexpr bool PERM = true, AFTER_DRAIN = false;
    bf16* O;
    __device__ __forceinline__ bool keep_acc(const pg8::Unit&) const { return false; }
    __device__ __forceinline__ void operator()(const f32x4 (&acc)[2][2][4][2], const pg8::Unit& u, int wr, int wc, int fr, int fq) const {
        const int row0 = u.pm * 256 + wr * 64 + fr, col0 = u.pn * 256 + wc * 32 + 8 * fq;
        const int act = (u.pn < 6) ? 0 : (u.pn < 8 ? 1 : (u.pn < 12 ? 2 : 0));
#pragma unroll
        for (int ai = 0; ai < 2; ++ai)
#pragma unroll
            for (int m = 0; m < 4; ++m) { bf16* rowp = O + (size_t)(row0 + ai * 128 + m * 16) * PJ + col0;
#pragma unroll
                for (int bj = 0; bj < 2; ++bj) { f32x4 v0 = acc[ai][bj][m][0], v1 = acc[ai][bj][m][1];
                    if (act == 1) {
#pragma unroll
                        for (int i = 0; i < 4; ++i) { v0[i] = v0[i] * fast_sigmoid(v0[i]); v1[i] = v1[i] * fast_sigmoid(v1[i]); } }
                    else if (act == 2) { const f32x2 a = gelu_pk((f32x2){v0[0], v0[1]}), b = gelu_pk((f32x2){v0[2], v0[3]}), cc = gelu_pk((f32x2){v1[0], v1[1]}), d = gelu_pk((f32x2){v1[2], v1[3]});
                        v0 = (f32x4){a.x, a.y, b.x, b.y}; v1 = (f32x4){cc.x, cc.y, d.x, d.y}; }
                    v4u w; w.x = cvt_pk_bf16(v0[0], v0[1]); w.y = cvt_pk_bf16(v0[2], v0[3]); w.z = cvt_pk_bf16(v1[0], v1[1]); w.w = cvt_pk_bf16(v1[2], v1[3]);
                    *(v4u*)(rowp + bj * 128) = w; } }
    }
};
struct DualOrder {
    pg8::StaticOrder S0;
    __device__ __forceinline__ void init(int G, int c) { S0.init(NTOK, D, G, c); }
    __device__ __forceinline__ bool next(int i, pg8::Unit& u) const { pg8::Unit t; if (!S0.next(i >> 1, t)) return false; const int which = i & 1; u.pm = t.pm + 64 * which; u.pn = t.pn + 4 * which; u.x0 = which; u.x1 = t.pn; u.rb = 0; return true; }
    __device__ __forceinline__ void a_ready(const pg8::Unit&) const {}
    __device__ __forceinline__ void done(const pg8::Unit&) const {}
};
struct EpiMerge {
    static constexpr bool PERM = true, AFTER_DRAIN = false;
    const bf16* P; bf16* O;
    __device__ __forceinline__ bool keep_acc(const pg8::Unit& u) const { return u.x0 == 0; }
    __device__ __forceinline__ void operator()(f32x4 (&acc)[2][2][4][2], const pg8::Unit& u, int wr, int wc, int fr, int fq) const {
        const int row0 = (u.pm & 63) * 256 + wr * 64 + fr, col0 = u.x1 * 256 + wc * 32 + 8 * fq; const bool first = (u.x0 == 0);
#pragma unroll
        for (int ai = 0; ai < 2; ++ai) {
            v4u xbv[4][2];
#pragma unroll
            for (int m = 0; m < 4; ++m)
#pragma unroll
                for (int bj = 0; bj < 2; ++bj) xbv[m][bj] = *(const v4u*)(P + (size_t)(row0 + ai * 128 + m * 16) * PJ + col0 + 4096 + bj * 128);
            asm volatile("" ::: "memory");
#pragma unroll
            for (int m = 0; m < 4; ++m) { const int row = row0 + ai * 128 + m * 16; const bf16* pr = P + (size_t)row * PJ + col0;
#pragma unroll
                for (int bj = 0; bj < 2; ++bj) { const v4u xb = xbv[m][bj]; float fb[8];
                    fb[0] = bf_lo(xb.x); fb[1] = bf_hi(xb.x); fb[2] = bf_lo(xb.y); fb[3] = bf_hi(xb.y); fb[4] = bf_lo(xb.z); fb[5] = bf_hi(xb.z); fb[6] = bf_lo(xb.w); fb[7] = bf_hi(xb.w);
#pragma unroll
                    for (int i = 0; i < 8; ++i) fb[i] = 1.f + __expf(-fmaxf(fb[i], -30.f));
                    if (first) { const v4u xa = *(const v4u*)(pr + 3072 + bj * 128); float fa[8];
                        fa[0] = bf_lo(xa.x); fa[1] = bf_hi(xa.x); fa[2] = bf_lo(xa.y); fa[3] = bf_hi(xa.y); fa[4] = bf_lo(xa.z); fa[5] = bf_hi(xa.z); fa[6] = bf_lo(xa.w); fa[7] = bf_hi(xa.w);
#pragma unroll
                        for (int i = 0; i < 4; ++i) { acc[ai][bj][m][0][i] *= fb[i] * fast_sigmoid(fa[i]); acc[ai][bj][m][1][i] *= fb[4 + i] * fast_sigmoid(fa[4 + i]); } }
                    else { f32x4 v0, v1;
#pragma unroll
                        for (int i = 0; i < 4; ++i) { v0[i] = acc[ai][bj][m][0][i] * __builtin_amdgcn_rcpf(fb[i]); v1[i] = acc[ai][bj][m][1][i] * __builtin_amdgcn_rcpf(fb[4 + i]); }
                        v4u w; w.x = cvt_pk_bf16(v0[0], v0[1]); w.y = cvt_pk_bf16(v0[2], v0[3]); w.z = cvt_pk_bf16(v1[0], v1[1]); w.w = cvt_pk_bf16(v1[2], v1[3]);
                        *(v4u*)(O + (size_t)row * D + col0 + bj * 128) = w; } } } }
    }
};
struct EpiResid {
    static constexpr bool PERM = false, AFTER_DRAIN = false;
    const float* X; float* O;
    __device__ __forceinline__ bool keep_acc(const pg8::Unit&) const { return false; }
    __device__ __forceinline__ void operator()(const f32x4 (&acc)[2][2][4][2], const pg8::Unit& u, int wr, int wc, int fr, int fq) const {
        const int row0 = u.pm * 256 + wr * 64 + fr, col0 = u.pn * 256 + wc * 32 + 4 * fq;
#pragma unroll
        for (int ai = 0; ai < 2; ++ai)
#pragma unroll
            for (int m = 0; m < 4; ++m) { const size_t off = (size_t)(row0 + ai * 128 + m * 16) * D + col0;
#pragma unroll
                for (int bj = 0; bj < 2; ++bj)
#pragma unroll
                    for (int n = 0; n < 2; ++n) *(f32x4*)(O + off + bj * 128 + n * 16) = *(const f32x4*)(X + off + bj * 128 + n * 16) + acc[ai][bj][m][n]; }
    }
};
__device__ __forceinline__ float ldbf(const bf16* p) { return __uint_as_float((unsigned)(*p) << 16); }
__device__ __forceinline__ unsigned short f2bf1(float f) { return (unsigned short)(cvt_pk_bf16(f, 0.f) & 0xffffu); }
__device__ __forceinline__ void unpack8(const v4u& x, float (&f)[8]) { f[0] = bf_lo(x.x); f[1] = bf_hi(x.x); f[2] = bf_lo(x.y); f[3] = bf_hi(x.y); f[4] = bf_lo(x.z); f[5] = bf_hi(x.z); f[6] = bf_lo(x.w); f[7] = bf_hi(x.w); }

constexpr size_t DN_WN = 16384, DN_QD = 16384, DN_KD = 16384, DN_QK = 8192, DN_U = 16384, DN_SST = 32768;
struct DnBufs { unsigned char *WN, *QD, *KD, *QK, *U, *SST; float* EG; };
constexpr int PL_QH = 0, PL_KH = 17408, PL_XVT = 34816, PL_XWT = 53248, PL_KDT = 71680, PL_AL = 90112, PL_TL = 106496, PL_GAM = 115712;
constexpr int RS = 136  , TS = 72  ;

__device__ __forceinline__ void p_dn_prep(const Ctx& c, const bf16* PROJ, const float* cw, const float* BG, const DnBufs& B) {
    LAS unsigned char* L = c.lds;
    LAS unsigned short* QH = (LAS unsigned short*)(L + PL_QH); LAS unsigned short* KH = (LAS unsigned short*)(L + PL_KH);
    LAS unsigned short* XVT = (LAS unsigned short*)(L + PL_XVT); LAS unsigned short* XWT = (LAS unsigned short*)(L + PL_XWT); LAS unsigned short* KDT = (LAS unsigned short*)(L + PL_KDT);
    LAS float* AL = (LAS float*)(L + PL_AL); LAS unsigned short* TL = (LAS unsigned short*)(L + PL_TL);
    LAS float* GAM = (LAS float*)(L + PL_GAM); LAS float* BETA = GAM + 64; LAS float* EGAM = GAM + 128; LAS float* KSC = GAM + 192;
    const int w = c.wave;
    LAS float* CWL = (LAS float*)(L + PL_GAM + 1024);
    constexpr int NITEMS = BATCH * DNH * (SEQ / 64);
    v4u xr[2][7];
#define DN_LOAD_ROWS(itx) do { const int bh_ = (itx) >> 7, ch_ = (itx) & 127, b_ = bh_ >> 2, h_ = bh_ & 3; int tid_ = c.tid; asm volatile("" : "+v"(tid_));     \
        _Pragma("unroll") for (int u_ = 0; u_ < 2; ++u_) { const int idx_ = tid_ + NTHR * u_; if (idx_ < 768) { const int tq_ = (idx_ >> 4) & 15, col_ = (idx_ >> 8) * 512 + h_ * 128 + (idx_ & 15) * 8;     \
            _Pragma("unroll") for (int r_ = 0; r_ < 7; ++r_) { const int tt_ = ch_ * 64 + 4 * tq_ - 3 + r_; \
                xr[u_][r_] = (tt_ >= 0) ? *(const v4u*)(PROJ + ((size_t)b_ * SEQ + tt_) * PJ + col_) : (v4u){0u, 0u, 0u, 0u}; } } } } while (0)
    float gpre = 0.f, bpre = 0.f, cwpre[4] = {0.f, 0.f, 0.f, 0.f};
#define DN_LOAD_SMALL(itx) do { const int bh_ = (itx) >> 7, ch_ = (itx) & 127, b_ = bh_ >> 2, h_ = bh_ & 3; const size_t r0_ = (size_t)b_ * SEQ + ch_ * 64; \
        if (w == 0) { gpre = BG[(r0_ + (c.tid & 63)) * 8 + 4 + h_]; bpre = BG[(r0_ + (c.tid & 63)) * 8 + h_]; } \
        if (c.tid < 384) { _Pragma("unroll") for (int kk_ = 0; kk_ < 4; ++kk_) cwpre[kk_] = cw[kk_ * 1536 + (c.tid >> 7) * 512 + h_ * 128 + (c.tid & 127)]; } } while (0)
    if (c.bid < NITEMS) { DN_LOAD_ROWS(c.bid); DN_LOAD_SMALL(c.bid); }
    for (int it = c.bid; it < NITEMS; it += c.nb) {
        int tl_ = c.tid; asm volatile("" : "+v"(tl_));
        const int lane = tl_ & 63, fr = lane & 15, fq = lane >> 4;
        const int bh = it >> 7, ch = it & 127, b = bh >> 2, h = bh & 3; const size_t row0 = (size_t)b * SEQ + ch * 64;
        if (c.tid < 384) {
#pragma unroll
            for (int kk = 0; kk < 4; ++kk) CWL[kk * 384 + c.tid] = cwpre[kk]; }
        if (w == 0) { const float gt = gpre, bt = bpre; float gam = gt;
#define DPP_ADD(ctrl, rmask) gam += __builtin_bit_cast(float, __builtin_amdgcn_update_dpp(0, __builtin_bit_cast(int, gam), ctrl, rmask, 0xF, false))
            DPP_ADD(0x111, 0xF); DPP_ADD(0x112, 0xF); DPP_ADD(0x114, 0xF); DPP_ADD(0x118, 0xF); DPP_ADD(0x142, 0xA); DPP_ADD(0x143, 0xC);
#undef DPP_ADD
            const float gl = __builtin_bit_cast(float, __builtin_amdgcn_readlane(__builtin_bit_cast(int, gam), 63));
            GAM[lane] = gam; BETA[lane] = bt; EGAM[lane] = expf(gam); KSC[lane] = expf(gl - gam);
            if (lane == 0) B.EG[it] = expf(gl); }
        for (int i = c.tid; i < 1024; i += NTHR) ((LAS f32x4*)AL)[i] = (f32x4){0.f, 0.f, 0.f, 0.f};
        lds_barrier();
        int tidb = c.tid; asm volatile("" : "+v"(tidb));
#pragma unroll
        for (int u = 0; u < 2; ++u) { const int idx = tidb + NTHR * u; if (idx < 768) {
            const int tq = (idx >> 4) & 15, part = __builtin_amdgcn_readfirstlane(idx >> 8), c8 = (idx & 15) * 8;
            f32x4 wt[4][2];
#pragma unroll
            for (int kk = 0; kk < 4; ++kk) { wt[kk][0] = *(const LAS f32x4*)(CWL + kk * 384 + part * 128 + c8); wt[kk][1] = *(const LAS f32x4*)(CWL + kk * 384 + part * 128 + c8 + 4); }
            float av[4][8];
            float s1v[4], s2v[4];
#pragma unroll
            for (int q = 0; q < 4; ++q) { const int t = 4 * tq + q;
                float a[8];
#pragma unroll
                for (int e = 0; e < 8; ++e) a[e] = 0.f;
#pragma unroll
                for (int kk = 0; kk < 4; ++kk) { float xf[8]; unpack8(xr[u][q + kk], xf);
#pragma unroll
                    for (int e = 0; e < 4; ++e) { a[e] = fmaf(wt[kk][0][e], xf[e], a[e]); a[4 + e] = fmaf(wt[kk][1][e], xf[4 + e], a[4 + e]); } }
                float ss = 0.f;
#pragma unroll
                for (int e = 0; e < 8; ++e) { a[e] = a[e] * __builtin_amdgcn_rcpf(1.f + __expf(-a[e])); ss = fmaf(a[e], a[e], ss); }
                ss = row16_sum(ss);
                const float rs = rsqrtf(ss + L2_EPS);
                if (part == 0) { const float sc = rs * 0.08838834764831845f; v4u o; o.x = cvt_pk_bf16(a[0] * sc, a[1] * sc); o.y = cvt_pk_bf16(a[2] * sc, a[3] * sc); o.z = cvt_pk_bf16(a[4] * sc, a[5] * sc); o.w = cvt_pk_bf16(a[6] * sc, a[7] * sc);
                    *(LAS v4u*)(QH + t * RS + c8) = o; }
                else if (part == 1) { v4u o; o.x = cvt_pk_bf16(a[0] * rs, a[1] * rs); o.y = cvt_pk_bf16(a[2] * rs, a[3] * rs); o.z = cvt_pk_bf16(a[4] * rs, a[5] * rs); o.w = cvt_pk_bf16(a[6] * rs, a[7] * rs);
                    *(LAS v4u*)(KH + t * RS + c8) = o; s1v[q] = rs * BETA[t] * EGAM[t]; s2v[q] = rs * KSC[t]; }
                else { s1v[q] = BETA[t]; s2v[q] = 0.f; }
#pragma unroll
                for (int e = 0; e < 8; ++e) av[q][e] = a[e];
            }
            const int tsw = (4 * tq) ^ (((c8 >> 4) & 7) << 3);
            if (part == 1) {
#pragma unroll
                for (int e = 0; e < 8; ++e) { v2u o1, o2; o1.x = cvt_pk_bf16(av[0][e] * s1v[0], av[1][e] * s1v[1]); o1.y = cvt_pk_bf16(av[2][e] * s1v[2], av[3][e] * s1v[3]);
                    o2.x = cvt_pk_bf16(av[0][e] * s2v[0], av[1][e] * s2v[1]); o2.y = cvt_pk_bf16(av[2][e] * s2v[2], av[3][e] * s2v[3]);
                    *(LAS v2u*)(XWT + (c8 + e) * TS + tsw) = o1; *(LAS v2u*)(KDT + (c8 + e) * TS + tsw) = o2; } }
            else if (part == 2) {
#pragma unroll
                for (int e = 0; e < 8; ++e) { v2u o1; o1.x = cvt_pk_bf16(av[0][e] * s1v[0], av[1][e] * s1v[1]); o1.y = cvt_pk_bf16(av[2][e] * s1v[2], av[3][e] * s1v[3]);
                    *(LAS v2u*)(XVT + (c8 + e) * TS + tsw) = o1; } }
            } }
        lds_barrier();
        if (it + c.nb < NITEMS) { DN_LOAD_ROWS(it + c.nb); DN_LOAD_SMALL(it + c.nb); }
        { const int rt = w & 3, ksq = w >> 2; v2u half[2];
#pragma unroll
            for (int sub = 0; sub < 2; ++sub) { const int st = 2 * ksq + sub; f32x4 acc = {0.f, 0.f, 0.f, 0.f};
#pragma unroll
                for (int kk = 0; kk < 4; ++kk) { const bf16x8 a = *(const LAS bf16x8*)(KH + (16 * st + fr) * RS + 32 * kk + 8 * fq), bq = *(const LAS bf16x8*)(QH + (16 * rt + fr) * RS + 32 * kk + 8 * fq); acc = MFMA16(a, bq, acc); }
                const int rr = 16 * rt + fr; const float gr = GAM[rr]; float v[4];
#pragma unroll
                for (int r = 0; r < 4; ++r) { const int s2 = 16 * st + 4 * fq + r; v[r] = (s2 <= rr) ? acc[r] * __expf(fminf(gr - GAM[s2], 0.f)) : 0.f; }
                half[sub].x = cvt_pk_bf16(v[0], v[1]); half[sub].y = cvt_pk_bf16(v[2], v[3]); }
            v4u o; o.x = half[0].x; o.y = half[0].y; o.z = half[1].x; o.w = half[1].y;
            *(v4u*)(B.QK + (size_t)it * DN_QK + ((rt * 2 + ksq) * 64 + lane) * 16) = o; }
#pragma unroll 1
        for (int n = w; n < 10; n += 8) { const int rt = (n >= 6) ? 3 : (n >= 3 ? 2 : (n >= 1 ? 1 : 0)), st = n - rt * (rt + 1) / 2; f32x4 acc = {0.f, 0.f, 0.f, 0.f};
#pragma unroll
            for (int kk = 0; kk < 4; ++kk) { const bf16x8 a = *(const LAS bf16x8*)(KH + (16 * rt + fr) * RS + 32 * kk + 8 * fq), bk = *(const LAS bf16x8*)(KH + (16 * st + fr) * RS + 32 * kk + 8 * fq); acc = MFMA16(a, bk, acc); }
            const int s2 = 16 * st + fr; const float gs = GAM[s2];
#pragma unroll
            for (int r = 0; r < 4; ++r) { const int rr = 16 * rt + 4 * fq + r; const float v = (s2 < rr) ? BETA[rr] * acc[r] * __expf(fminf(GAM[rr] - gs, 0.f)) : 0.f; AL[rr * 64 + (s2 & 7) * 8 + (s2 >> 3)] = v; } }
        lds_barrier();
        { const int j = w * 8 + (lane >> 3), p = lane & 7; float tc[8];
#pragma unroll
            for (int i = 0; i < 8; ++i) tc[i] = 0.f;
            f32x4 na0, na1, nb0, nb1; float narr;
#define D_LOAD(rr) do { const LAS float* ar_ = AL + (rr) * 64 + p * 8; na0 = *(const LAS f32x4*)ar_; na1 = *(const LAS f32x4*)(ar_ + 4); nb0 = *(const LAS f32x4*)(ar_ + 64); nb1 = *(const LAS f32x4*)(ar_ + 68); \
                narr = AL[((rr) + 1) * 64 + ((rr) & 7) * 8 + ((rr) >> 3)]; } while (0)
            D_LOAD(0);
#pragma unroll
            for (int r = 0; r < 64; r += 2) { float sa0 = 0.f, sa1 = 0.f, sb0 = 0.f, sb1 = 0.f;
                const f32x4 a0 = na0, a1 = na1, b0 = nb0, b1 = nb1; const float arr = narr;
                if (r + 2 < 64) D_LOAD(r + 2);
#pragma unroll
                for (int i = 0; i < 8; ++i) {
                    if (8 * i < r) { const float av = i < 4 ? a0[i & 3] : a1[i & 3]; if (i & 1) sa1 = fmaf(av, tc[i], sa1); else sa0 = fmaf(av, tc[i], sa0); }
                    if (8 * i < r + 1) { const float bv = i < 4 ? b0[i & 3] : b1[i & 3]; if (i & 1) sb1 = fmaf(bv, tc[i], sb1); else sb0 = fmaf(bv, tc[i], sb0); } }
                float ta = sa0 + sa1, tb = sb0 + sb1;
                ta += dpp_xor1(ta); tb += dpp_xor1(tb); ta += dpp_xor2(ta); tb += dpp_xor2(tb); ta += dpp_hmir(ta); tb += dpp_hmir(tb);
                const float tra = ((r == j) ? 1.f : 0.f) - ta;
                const float trb = ((r + 1 == j) ? 1.f : 0.f) - fmaf(arr, tra, tb);
                if (p == (r & 7)) tc[r >> 3] = tra;
                if (p == ((r + 1) & 7)) tc[(r + 1) >> 3] = trb; }
#undef D_LOAD
#pragma unroll
            for (int i = 0; i < 8; ++i) TL[(8 * i + p) * TS + j] = f2bf1(tc[i]); }
        lds_barrier();
        { const int sl = w;
#pragma unroll
            for (int mt = 0; mt < 4; ++mt) { f32x4 acc = {0.f, 0.f, 0.f, 0.f};
#pragma unroll
                for (int kk = 0; kk < 2; ++kk) if (kk == 0 || mt >= 2) { const bf16x8 a = *(const LAS bf16x8*)(TL + (16 * mt + fr) * TS + 32 * kk + 8 * fq), bv = *(const LAS bf16x8*)(XVT + (16 * sl + fr) * TS + ((32 * kk + 8 * fq) ^ ((sl & 7) << 3))); acc = MFMA16(a, bv, acc); }
                v2u o; o.x = cvt_pk_bf16(acc[0], acc[1]); o.y = cvt_pk_bf16(acc[2], acc[3]);
                *(v2u*)(B.U + (size_t)it * DN_U + ((mt * 8 + sl) * 64 + lane) * 8) = o; }
            const int dt = w;
#pragma unroll
            for (int rt = 0; rt < 4; ++rt) { f32x4 acc = {0.f, 0.f, 0.f, 0.f};
#pragma unroll
                for (int kk = 0; kk < 2; ++kk) if (kk == 0 || rt >= 2) { const bf16x8 a = *(const LAS bf16x8*)(XWT + (16 * dt + fr) * TS + ((32 * kk + 8 * fq) ^ ((dt & 7) << 3))), bt = *(const LAS bf16x8*)(TL + (16 * rt + fr) * TS + 32 * kk + 8 * fq); acc = MFMA16(a, bt, acc); }
                v2u o; o.x = cvt_pk_bf16(-acc[0], -acc[1]); o.y = cvt_pk_bf16(-acc[2], -acc[3]);
                *(v2u*)(B.WN + (size_t)it * DN_WN + ((rt * 4 + (dt >> 1)) * 64 + lane) * 16 + (dt & 1) * 8) = o; } }
        { const int mt = w & 3;
#pragma unroll
            for (int q2 = 0; q2 < 2; ++q2) { const int ks = 2 * (w >> 2) + q2, rr = 16 * mt + fr; const float sc = EGAM[rr];
                const v2u lo = *(const LAS v2u*)(QH + rr * RS + 32 * ks + 4 * fq), hi = *(const LAS v2u*)(QH + rr * RS + 32 * ks + 16 + 4 * fq);
                v4u o; o.x = cvt_pk_bf16(bf_lo(lo.x) * sc, bf_hi(lo.x) * sc); o.y = cvt_pk_bf16(bf_lo(lo.y) * sc, bf_hi(lo.y) * sc); o.z = cvt_pk_bf16(bf_lo(hi.x) * sc, bf_hi(hi.x) * sc); o.w = cvt_pk_bf16(bf_lo(hi.y) * sc, bf_hi(hi.y) * sc);
                *(v4u*)(B.QD + (size_t)it * DN_QD + ((mt * 4 + ks) * 64 + lane) * 16) = o; }
            const int dt = w;
#pragma unroll
            for (int ks = 0; ks < 2; ++ks) { const v2u lo = *(const LAS v2u*)(KDT + (16 * dt + fr) * TS + ((32 * ks + 4 * fq) ^ ((dt & 7) << 3))), hi = *(const LAS v2u*)(KDT + (16 * dt + fr) * TS + ((32 * ks + 16 + 4 * fq) ^ ((dt & 7) << 3)));
                v4u o; o.x = lo.x; o.y = lo.y; o.z = hi.x; o.w = hi.y;
                *(v4u*)(B.KD + (size_t)it * DN_KD + ((dt * 2 + ks) * 64 + lane) * 16) = o; } }
        lds_barrier();
    }
}

constexpr int SCAN_WGS = BATCH * DNH * 4;
constexpr int SCAN_STG = 36864;
template <int STG>
__device__ __forceinline__ void scan_step(const DnBufs& B, LAS unsigned char* L, int lane, int w, int sl, int it, f32x4 (&S)[8], float egc) {
    __builtin_amdgcn_s_barrier(); asm volatile("" ::: "memory");
    bf16x8 sf[4];
#pragma unroll
    for (int ks = 0; ks < 4; ++ks) { v4u o; o.x = cvt_pk_bf16(S[2 * ks][0], S[2 * ks][1]); o.y = cvt_pk_bf16(S[2 * ks][2], S[2 * ks][3]); o.z = cvt_pk_bf16(S[2 * ks + 1][0], S[2 * ks + 1][1]); o.w = cvt_pk_bf16(S[2 * ks + 1][2], S[2 * ks + 1][3]);
        *(v4u*)(B.SST + (size_t)it * DN_SST + ((ks * 8 + sl) * 64 + lane) * 16) = o; sf[ks] = as_frag(o); }
    const LAS unsigned char* wl = L + STG * SCAN_STG + lane * 16; const LAS unsigned char* kl = wl + 16384; const LAS unsigned char* ul = L + STG * SCAN_STG + 32768 + w * 512 + lane * 8;
    f32x4 vn[4];
#pragma unroll
    for (int mt = 0; mt < 4; ++mt) { const v2u uc = *(const LAS v2u*)(ul + mt * 1024); vn[mt] = (f32x4){bf_lo(uc.x), bf_hi(uc.x), bf_lo(uc.y), bf_hi(uc.y)};
#pragma unroll
        for (int ks = 0; ks < 4; ++ks) vn[mt] = MFMA16(*(const LAS bf16x8*)(wl + (mt * 4 + ks) * 1024), sf[ks], vn[mt]); }
    bf16x8 vf[2];
#pragma unroll
    for (int ks = 0; ks < 2; ++ks) { v4u o; o.x = cvt_pk_bf16(vn[2 * ks][0], vn[2 * ks][1]); o.y = cvt_pk_bf16(vn[2 * ks][2], vn[2 * ks][3]); o.z = cvt_pk_bf16(vn[2 * ks + 1][0], vn[2 * ks + 1][1]); o.w = cvt_pk_bf16(vn[2 * ks + 1][2], vn[2 * ks + 1][3]); vf[ks] = as_frag(o); }
#pragma unroll
    for (int dt = 0; dt < 8; ++dt) { f32x4 a = S[dt] * egc;
#pragma unroll
        for (int ks = 0; ks < 2; ++ks) a = MFMA16(*(const LAS bf16x8*)(kl + (dt * 2 + ks) * 1024), vf[ks], a);
        S[dt] = a; }
}
__device__ __forceinline__ void p_dn_scan(const Ctx& c, const DnBufs& B) {
    const int lane = c.lane, w = c.wave, bh = c.bid & 7, qtr = c.bid >> 3; LAS unsigned char* L = c.lds;
    if (w >= 4) {
        const unsigned char* gsrc = (w < 6) ? B.WN : B.KD; const int goff = (w & 1) * 8192 + lane * 16, loff = (w - 4) * 8192;
        const unsigned char* usrc = B.U + (((w - 4) * 8 + 2 * qtr) * 64) * 8 + lane * 16; const int uoff = 32768 + (w - 4) * 1024;
#define SCAN_DMA(itn, stage) do { _Pragma("unroll") for (int _p = 0; _p < 8; ++_p) \
        __builtin_amdgcn_global_load_lds((const unsigned*)(gsrc + (size_t)(itn) * 16384 + goff + _p * 1024), (LAS unsigned*)(L + (stage) * SCAN_STG + loff + _p * 1024), 16, 0, 0); \
        __builtin_amdgcn_global_load_lds((const unsigned*)(usrc + (size_t)(itn) * DN_U), (LAS unsigned*)(L + (stage) * SCAN_STG + uoff), 16, 0, 0); } while (0)
        const int it0 = bh * 128;
        SCAN_DMA(it0, 0); SCAN_DMA(it0 + 1, 1); SCAN_DMA(it0 + 2, 2);
#pragma unroll 1
        for (int ch = 0; ch < 128; ++ch) {
            if (ch < 126) asm volatile("s_waitcnt vmcnt(18)" ::: "memory"); else asm volatile("s_waitcnt vmcnt(0)" ::: "memory");
            __builtin_amdgcn_s_barrier(); asm volatile("" ::: "memory");
            if (ch + 3 < 128) SCAN_DMA(it0 + ch + 3, (ch + 3) & 3);
        }
#undef SCAN_DMA
    } else if (w >= 2) {
#pragma unroll 1
        for (int ch = 0; ch < 128; ++ch) { __builtin_amdgcn_s_barrier(); asm volatile("" ::: "memory"); }
    } else {
        __builtin_amdgcn_s_setprio(1);
        const int sl = qtr * 2 + w;
        f32x4 S[8];
#pragma unroll
        for (int i = 0; i < 8; ++i) S[i] = (f32x4){0.f, 0.f, 0.f, 0.f};
        const float eglo = B.EG[bh * 128 + lane], eghi = B.EG[bh * 128 + 64 + lane];
        asm volatile("s_waitcnt vmcnt(0)" ::: "memory");
#define EGC(chx) __builtin_bit_cast(float, __builtin_amdgcn_readlane(__builtin_bit_cast(int, (chx) < 64 ? eglo : eghi), (chx) & 63))
#pragma unroll 1
        for (int ch = 0; ch < 128; ch += 4) {
            const int it = bh * 128 + ch;
            scan_step<0>(B, L, lane, w, sl, it, S, EGC(ch));
            scan_step<1>(B, L, lane, w, sl, it + 1, S, EGC(ch + 1));
            scan_step<2>(B, L, lane, w, sl, it + 2, S, EGC(ch + 2));
            scan_step<3>(B, L, lane, w, sl, it + 3, S, EGC(ch + 3));
        }
#undef EGC
        __builtin_amdgcn_s_setprio(0);
    }
    asm volatile("s_waitcnt vmcnt(0)" ::: "memory"); __builtin_amdgcn_s_barrier(); asm volatile("" ::: "memory");
}

__device__ __forceinline__ void ld16_asm(v4u& dst, const void* p) { asm volatile("global_load_dwordx4 %0, %1, off" : "=v"(dst) : "v"(p) : "memory"); }
__device__ __forceinline__ void ld8_asm(v2u& dst, const void* p) { asm volatile("global_load_dwordx2 %0, %1, off" : "=v"(dst) : "v"(p) : "memory"); }
__device__ __forceinline__ void p_dn_out(const Ctx& c, const DnBufs& B, const bf16* PROJ, const float* gn, bf16* YA) {
    const int lane = c.lane, sl = c.wave, fr = lane & 15, fq = lane >> 4; LAS float* SSQ = (LAS float*)c.lds;
    LAS unsigned char* IMG0 = c.lds + 2048;
    LAS float* OT = (LAS float*)(c.lds + 2048 + 2 * 40960);
    constexpr int NIT = BATCH * DNH * (SEQ / 64);
    float4 g4r[4];
#pragma unroll
    for (int j = 0; j < 4; ++j) g4r[j] = *(const float4*)(gn + 16 * (c.tid & 7) + 4 * j);
    v4u sfn[4]; v2u urn[4]; v4u zrn[2];
#define OUT_ISSUE(itx, bufx) do { const int it_ = (itx); const int bh_ = it_ >> 7, ch_ = it_ & 127, b_ = bh_ >> 2, h_ = bh_ & 3; const size_t zrow_ = (size_t)b_ * SEQ + ch_ * 64 + (c.tid >> 3); \
        ld16_asm(zrn[0], PROJ + zrow_ * PJ + 1536 + h_ * 128 + 16 * (c.tid & 7)); ld16_asm(zrn[1], PROJ + zrow_ * PJ + 1536 + h_ * 128 + 16 * (c.tid & 7) + 8); \
        _Pragma("unroll") for (int ks = 0; ks < 4; ++ks) ld16_asm(sfn[ks], B.SST + (size_t)it_ * DN_SST + ((ks * 8 + sl) * 64 + lane) * 16); \
        _Pragma("unroll") for (int mt = 0; mt < 4; ++mt) ld8_asm(urn[mt], B.U + (size_t)it_ * DN_U + ((mt * 8 + sl) * 64 + lane) * 8); \
        _Pragma("unroll") for (int j = 0; j < 5; ++j) { const int p_ = sl * 5 + j; \
            const unsigned char* src_ = (p_ < 16) ? B.WN + (size_t)it_ * DN_WN + p_ * 1024 : (p_ < 32 ? B.QD + (size_t)it_ * DN_QD + (p_ - 16) * 1024 : B.QK + (size_t)it_ * DN_QK + (p_ - 32) * 1024); \
            __builtin_amdgcn_global_load_lds((const unsigned*)(src_ + lane * 16), (LAS unsigned*)(IMG0 + (bufx) * 40960 + p_ * 1024), 16, 0, 0); } } while (0)
    asm volatile("s_waitcnt vmcnt(0)" ::: "memory");
    if (c.bid < NIT) OUT_ISSUE(c.bid, 0);
    int buf = 0; bool first = true;
    for (int it = c.bid; it < NIT; it += c.nb, buf ^= 1) {
        const int bh = it >> 7, ch = it & 127, b = bh >> 2, h = bh & 3; const size_t row0 = (size_t)b * SEQ + ch * 64;
        if (first) asm volatile("s_waitcnt vmcnt(0)" ::: "memory"); else asm volatile("s_waitcnt vmcnt(2)" ::: "memory");
        first = false;
        v4u sfr[4]; v2u ur[4]; v4u zr[2];
#pragma unroll
        for (int k = 0; k < 4; ++k) { asm volatile("" : "+v"(sfn[k])); asm volatile("" : "+v"(urn[k])); sfr[k] = sfn[k]; ur[k] = urn[k]; }
        asm volatile("" : "+v"(zrn[0])); asm volatile("" : "+v"(zrn[1])); zr[0] = zrn[0]; zr[1] = zrn[1];
        lds_barrier();
        if (it + c.nb < NIT) OUT_ISSUE(it + c.nb, buf ^ 1);
        LAS unsigned char* IMG = IMG0 + buf * 40960;
        bf16x8 sf[4];
#pragma unroll
        for (int ks = 0; ks < 4; ++ks) sf[ks] = as_frag(sfr[ks]);
        const LAS unsigned char* wn = IMG + lane * 16; const LAS unsigned char* qd = wn + 16384; const LAS unsigned char* qk = wn + 32768;
        f32x4 vn[4];
#pragma unroll
        for (int mt = 0; mt < 4; ++mt) { vn[mt] = (f32x4){bf_lo(ur[mt].x), bf_hi(ur[mt].x), bf_lo(ur[mt].y), bf_hi(ur[mt].y)};
#pragma unroll
            for (int ks = 0; ks < 4; ++ks) vn[mt] = MFMA16(*(const LAS bf16x8*)(wn + (mt * 4 + ks) * 1024), sf[ks], vn[mt]); }
        bf16x8 vf[2];
#pragma unroll
        for (int ks = 0; ks < 2; ++ks) { v4u o; o.x = cvt_pk_bf16(vn[2 * ks][0], vn[2 * ks][1]); o.y = cvt_pk_bf16(vn[2 * ks][2], vn[2 * ks][3]); o.z = cvt_pk_bf16(vn[2 * ks + 1][0], vn[2 * ks + 1][1]); o.w = cvt_pk_bf16(vn[2 * ks + 1][2], vn[2 * ks + 1][3]); vf[ks] = as_frag(o); }
        f32x4 o[4];
#pragma unroll
        for (int mt = 0; mt < 4; ++mt) { f32x4 a = {0.f, 0.f, 0.f, 0.f};
#pragma unroll
            for (int ks = 0; ks < 4; ++ks) a = MFMA16(*(const LAS bf16x8*)(qd + (mt * 4 + ks) * 1024), sf[ks], a);
#pragma unroll
            for (int ks = 0; ks < 2; ++ks) a = MFMA16(*(const LAS bf16x8*)(qk + (mt * 2 + ks) * 1024), vf[ks], a);
            o[mt] = a;
#pragma unroll
            for (int r = 0; r < 4; ++r) { float q = row16_sum(a[r] * a[r]);
                if (fr == 0) SSQ[(16 * mt + 4 * fq + r) * 8 + sl] = q; } }
#pragma unroll
        for (int mt = 0; mt < 4; ++mt)
#pragma unroll
            for (int r = 0; r < 4; ++r) OT[(16 * mt + 4 * fq + r) * 132 + 16 * sl + fr] = o[mt][r];
        lds_barrier();
        { const int row = c.tid >> 3, seg = c.tid & 7; const size_t grow = row0 + row; const int col = h * 128 + 16 * seg;
            const f32x4 q0 = *(const LAS f32x4*)(SSQ + row * 8), q1 = *(const LAS f32x4*)(SSQ + row * 8 + 4);
            const float rstd = rsqrtf(((q0[0] + q0[1]) + (q0[2] + q0[3]) + (q1[0] + q1[1]) + (q1[2] + q1[3])) * (1.f / 128.f) + RMS_EPS);
            float zf[16]; { float t8[8]; unpack8(zr[0], t8);
#pragma unroll
                for (int e = 0; e < 8; ++e) zf[e] = t8[e];
                unpack8(zr[1], t8);
#pragma unroll
                for (int e = 0; e < 8; ++e) zf[8 + e] = t8[e]; }
            float y[16];
#pragma unroll
            for (int j = 0; j < 4; ++j) { const f32x4 ov = *(const LAS f32x4*)(OT + row * 132 + 16 * seg + 4 * j); const float4 g4 = g4r[j];
                y[4 * j + 0] = ov[0] * rstd * g4.x * zf[4 * j + 0]; y[4 * j + 1] = ov[1] * rstd * g4.y * zf[4 * j + 1]; y[4 * j + 2] = ov[2] * rstd * g4.z * zf[4 * j + 2]; y[4 * j + 3] = ov[3] * rstd * g4.w * zf[4 * j + 3]; }
            v4u w0, w1; w0.x = cvt_pk_bf16(y[0], y[1]); w0.y = cvt_pk_bf16(y[2], y[3]); w0.z = cvt_pk_bf16(y[4], y[5]); w0.w = cvt_pk_bf16(y[6], y[7]);
            w1.x = cvt_pk_bf16(y[8], y[9]); w1.y = cvt_pk_bf16(y[10], y[11]); w1.z = cvt_pk_bf16(y[12], y[13]); w1.w = cvt_pk_bf16(y[14], y[15]);
            *(v4u*)(YA + grow * DNW + col) = w0; *(v4u*)(YA + grow * DNW + col + 8) = w1; }
        lds_barrier();
    }
#undef OUT_ISSUE
    asm volatile("s_waitcnt vmcnt(0)" ::: "memory");
}

__device__ __forceinline__ void p_sg_stats(const Ctx& c, const bf16* PROJ, float* SGSTAT) {
    const int lane = c.lane;
    for (int r0 = (c.bid * NWAVES + c.wave) * 8; r0 < NTOK; r0 += c.nb * NWAVES * 8) {
        v4u xr[8];
#pragma unroll
        for (int rr = 0; rr < 8; ++rr) xr[rr] = *(const v4u*)(PROJ + (size_t)(r0 + rr) * PJ + 2560 + lane * 8);
#pragma unroll
        for (int rr = 0; rr < 8; ++rr) { float f[8]; unpack8(xr[rr], f); float s1 = 0.f, s2 = 0.f;
#pragma unroll
            for (int e = 0; e < 8; ++e) { s1 += f[e]; s2 = fmaf(f[e], f[e], s2); }
            s1 = wave_sum(s1); s2 = wave_sum(s2);
            const float mu = s1 * (1.f / SGW), rstd = rsqrtf(fmaxf(s2 * (1.f / SGW) - mu * mu, 0.f) + LN_EPS);
            if (lane == 0) { float2 o; o.x = mu; o.y = rstd; *(float2*)(SGSTAT + 2 * (size_t)(r0 + rr)) = o; } }
    }
}
__device__ __forceinline__ void p_sg_item(const Ctx& c, int it, const bf16* PROJ, const float* SGSTAT, const float* lg, const float* lb, const float* sw, const float* sb, bf16* YB) {
    LAS unsigned short* VT = (LAS unsigned short*)c.lds;
    const int lane = c.lane, w = c.wave, fr = lane & 15, fq = lane >> 4, chunk = it >> 2, g = it & 3; const size_t row0 = (size_t)chunk * SGC;
    { v4u xv[4];
#pragma unroll
        for (int i = 0; i < 4; ++i) { const int idx = c.tid + NTHR * i, s = idx >> 4, c8 = (idx & 15) * 8; xv[i] = *(const v4u*)(PROJ + (row0 + s) * PJ + 2560 + g * 128 + c8); }
        const int c8 = (c.tid & 15) * 8;
        const float4 g0 = *(const float4*)(lg + g * 128 + c8), g1 = *(const float4*)(lg + g * 128 + c8 + 4), b0 = *(const float4*)(lb + g * 128 + c8), b1 = *(const float4*)(lb + g * 128 + c8 + 4);
        const float gv[8] = {g0.x, g0.y, g0.z, g0.w, g1.x, g1.y, g1.z, g1.w}, bv[8] = {b0.x, b0.y, b0.z, b0.w, b1.x, b1.y, b1.z, b1.w};
#pragma unroll
        for (int i = 0; i < 4; ++i) { const int s = (c.tid + NTHR * i) >> 4; float f[8]; unpack8(xv[i], f);
            const float2 st = *(const float2*)(SGSTAT + 2 * (row0 + s)); const float mu = st.x, rstd = st.y;
#pragma unroll
            for (int e = 0; e < 8; ++e) VT[(c8 + e) * RS + (s ^ c8)] = f2bf1((f[e] - mu) * rstd * gv[e] + bv[e]); } }
    lds_barrier();
    { f32x4 acc[8];
#pragma unroll
        for (int ct = 0; ct < 8; ++ct) acc[ct] = (f32x4){0.f, 0.f, 0.f, 0.f};
        const int t = 16 * w + fr, nk = (w >> 1) + 1;
        v2u uin[8];
#pragma unroll
        for (int ct = 0; ct < 8; ++ct) uin[ct] = *(const v2u*)(PROJ + (row0 + t) * PJ + 2048 + g * 128 + 16 * ct + 4 * fq);
        const float biasv = sb[g * SGC + t];
        float4 wq[4][2];
#pragma unroll
        for (int kk = 0; kk < 4; ++kk) if (kk < nk) { const float* wp = sw + ((size_t)g * SGC + t) * SGC + 32 * kk + 8 * fq; wq[kk][0] = *(const float4*)wp; wq[kk][1] = *(const float4*)(wp + 4); }
#pragma unroll
        for (int kk = 0; kk < 4; ++kk) if (kk < nk) { const int s0 = 32 * kk + 8 * fq;
            const float4 w0 = wq[kk][0], w1 = wq[kk][1];
            const float wv[8] = {w0.x, w0.y, w0.z, w0.w, w1.x, w1.y, w1.z, w1.w}; float wm[8];
#pragma unroll
            for (int e = 0; e < 8; ++e) wm[e] = (s0 + e <= t) ? wv[e] : 0.f;
            v4u wb; wb.x = cvt_pk_bf16(wm[0], wm[1]); wb.y = cvt_pk_bf16(wm[2], wm[3]); wb.z = cvt_pk_bf16(wm[4], wm[5]); wb.w = cvt_pk_bf16(wm[6], wm[7]);
            const bf16x8 bfr = as_frag(wb);
#pragma unroll
            for (int ct = 0; ct < 8; ++ct) acc[ct] = MFMA16(*(const LAS bf16x8*)(VT + (16 * ct + fr) * RS + (s0 ^ (((2 * ct + (fr >> 3)) & 15) << 3))), bfr, acc[ct]); }
        const float bias = biasv; const size_t row = row0 + t;
#pragma unroll
        for (int ct = 0; ct < 8; ++ct) { const int col = g * 128 + 16 * ct + 4 * fq; const v2u u = uin[ct];
            v2u o; o.x = cvt_pk_bf16(bf_lo(u.x) * (acc[ct][0] + bias), bf_hi(u.x) * (acc[ct][1] + bias)); o.y = cvt_pk_bf16(bf_lo(u.y) * (acc[ct][2] + bias), bf_hi(u.y) * (acc[ct][3] + bias));
            *(v2u*)(YB + row * SGW + col) = o; } }
    lds_barrier();
}

struct Args { const float* in[22]; float* out; unsigned char* ws; int ph_lo, ph_hi; };
__global__ void __launch_bounds__(NTHR, 2) mega(Args args) {
    extern __shared__ __attribute__((aligned(16))) unsigned char lds_raw[];
    Ctx c; c.lds0 = (LAS unsigned char*)lds_raw; c.lds = c.lds0 + RING_OFF; c.tid = threadIdx.x; c.lane = c.tid & 63; c.wave = __builtin_amdgcn_readfirstlane(c.tid >> 6); c.bid = blockIdx.x; c.nb = gridDim.x;
    volatile LAS unsigned* MISC = (volatile LAS unsigned*)(c.lds0 + MISC_OFF);
    for (int u = c.tid; u < RING_OFF / 4; u += NTHR) ((LAS unsigned*)(c.lds0 + LDSCTL_OFF))[u] = 0u;
    __syncthreads();
    unsigned char* ws = args.ws;
    gu32* ctl = (gu32*)(ws + WS_CTL);
    XcdBarrier bar = xcd_barrier_post((unsigned*)(ctl + CW_BAR), MISC + 8);
#define GRID_BAR() xcd_barrier(bar)
    const float* x = args.in[0]; const float* norm1_g = args.in[1]; const float* w_in = args.in[2]; const float* conv_w = args.in[3];
    const float* a_log = args.in[4]; const float* dt_bias = args.in[5]; const float* dn_norm_g = args.in[6]; const float* w_o_dn = args.in[7];
    const float* sg_ln_g = args.in[8]; const float* sg_ln_b = args.in[9]; const float* sg_w = args.in[10]; const float* sg_b = args.in[11];
    const float* w_o_sg = args.in[12]; const float* w_out = args.in[13]; const float* norm2_g = args.in[14]; const float* w_router = args.in[15];
    const float* b_router = args.in[16]; const float* w_gate_up = args.in[17]; const float* b_gate_up = args.in[18]; const float* w_down = args.in[19];
    const float* b_down = args.in[20]; const float* norm_f_g = args.in[21];
    float* out = args.out;
    unsigned char* wb = ws + WS_BASE;
    bf16* Hb = (bf16*)(wb + 0); bf16* H2b = (bf16*)(wb + 0);
    bf16* Win_t = (bf16*)(wb + 32 * MiB); bf16* Wo_t = (bf16*)(wb + 42 * MiB); bf16* Wout_t = (bf16*)(wb + 44 * MiB); float* BG = (float*)(wb + 46 * MiB);
    bf16* PROJb = (bf16*)(wb + 48 * MiB); bf16* ACTb = (bf16*)(wb + 48 * MiB);
    bf16* YAB = (bf16*)(wb + 208 * MiB); bf16* MERGED = (bf16*)(wb + 240 * MiB); float* X1 = (float*)(wb + 272 * MiB);
    float* QKV = (float*)(wb + 336 * MiB); float* O32 = (float*)(wb + 432 * MiB); float* U = (float*)(wb + 464 * MiB); float* VLN = (float*)(wb + 496 * MiB);
    bf16* Wgu_t = (bf16*)(wb + 528 * MiB); bf16* Wd_t = (bf16*)(wb + 656 * MiB); bf16* HS = (bf16*)(wb + 720 * MiB); bf16* Yb = (bf16*)(wb + 864 * MiB);
    unsigned char* small = wb + 1008 * MiB;
    int* slot_e = (int*)(small + 0 * MiB); int* slot_pos = (int*)(small + 1 * MiB); int* elist = (int*)(small + 2 * MiB); float* ewgt = (float*)(small + 4 * MiB); bf16* WrT = (bf16*)(small + 6 * MiB);
    unsigned* gcnt = (unsigned*)(ctl + CW_CNT);

#ifndef GEMM1_WGM
#define GEMM1_WGM 8
#endif
#ifndef PROBE_MASK
#define PROBE_MASK 0
#endif
#define REP(bit) for (int _r = 0; _r < ((PROBE_MASK >> (bit)) & 1) + 1; ++_r)
    REP(0) { p_convert_front(c, w_in, w_o_dn, w_o_sg, w_out, Win_t, Wo_t, Wout_t);
    __syncthreads();
    p_norm1(c, x, norm1_g, w_in, a_log, dt_bias, Hb, BG); if (PROBE_MASK & 1) __syncthreads();
    p_build_wrt(c, w_router, WrT);
    for (int i = c.bid * NTHR + c.tid; i < NE * NTOK / 4; i += c.nb * NTHR) { ((v4u*)elist)[i] = (v4u){0u, 0u, 0u, 0u}; ((v4u*)ewgt)[i] = (v4u){0u, 0u, 0u, 0u}; } }
    GRID_BAR();
    REP(1) { pg8::Gemm g{Hb, Win_t, NTOK, PJ, D}; pg8::StaticOrder S; S.init(NTOK, PJ, c.nb, c.bid, GEMM1_WGM); EpiProj E{PROJb};
      pg8::gemm_phase<EpiProj, pg8::StaticOrder, true, true>(c.lds, g, S, E); }
    GRID_BAR();
    DnBufs DB; DB.WN = wb + 336 * MiB; DB.QD = wb + 352 * MiB; DB.KD = wb + 368 * MiB; DB.QK = wb + 384 * MiB; DB.U = wb + 392 * MiB; DB.SST = wb + 408 * MiB; DB.EG = (float*)(wb + 440 * MiB);
    float* SGSTAT = (float*)(small + 7 * MiB);
    REP(2) { p_sg_stats(c, PROJb, SGSTAT); p_dn_prep(c, PROJb, conv_w, BG, DB); }
    GRID_BAR();
    if (c.bid < SCAN_WGS) { REP(3) { p_dn_scan(c, DB); } }
    else { Ctx c2 = c; c2.bid = c.bid - SCAN_WGS; c2.nb = c.nb - SCAN_WGS;
        const bool conv_first = (c2.bid >> 3) & 1;
        if (conv_first) { p_convert_moe(c2, w_gate_up, w_down, Wgu_t, Wd_t, (NTOK / SGC) * 4); __syncthreads(); }
        REP(4) { for (int it = c2.bid; it < (NTOK / SGC) * 4; it += c2.nb) p_sg_item(c, it, PROJb, SGSTAT, sg_ln_g, sg_ln_b, sg_w, sg_b, YAB + (size_t)NTOK * DNW); }
        if (!conv_first) { __syncthreads(); p_convert_moe(c2, w_gate_up, w_down, Wgu_t, Wd_t, (NTOK / SGC) * 4); } }
    GRID_BAR();
    REP(6) { p_dn_out(c, DB, PROJb, dn_norm_g, YAB); }
    GRID_BAR();
    REP(7) { pg8::Gemm g{YAB, Wo_t, 0, 0, DNW}; DualOrder S; S.init(c.nb, c.bid); EpiMerge E{PROJb, MERGED};
      pg8::gemm_phase<EpiMerge, DualOrder, true, true>(c.lds, g, S, E); }
    GRID_BAR();
    REP(8) { pg8::Gemm g{MERGED, Wout_t, NTOK, D, D}; pg8::StaticOrder S; S.init(NTOK, D, c.nb, c.bid); EpiResid E{x, X1};
      pg8::gemm_phase<EpiResid, pg8::StaticOrder, true, true>(c.lds, g, S, E); }
    GRID_BAR();
    p_router2(c, X1, norm2_g, WrT, b_router, H2b, slot_e, slot_pos, elist, ewgt, gcnt);
    GRID_BAR();
    LAS unsigned char* tile_e = c.lds0 + EXTRA_OFF + 512; LAS int* ntl = (LAS int*)(c.lds0 + EXTRA_OFF + 1024); LAS int* tile_b = (LAS int*)(c.lds0 + EXTRA_OFF + 1088);
    build_tile_table(c, gcnt, tile_e, ntl, tile_b);
    const int NTL = __builtin_amdgcn_readfirstlane(ntl[0]);
    const int SPX = c.nb >> 3, xq = c.bid & 7, sq = c.bid >> 3; const bool inl = c.bid < 8 * SPX;
    const int mt0 = (xq * NTL) >> 3, mnt = (((xq + 1) * NTL) >> 3) - mt0;
    const int rem1 = (mnt * 8) % SPX; int Ex = rem1 ? SPX - rem1 : 0; if (Ex > mnt * 4) Ex = mnt * 4;
    const int sigT = 4 * ((Ex + 15) >> 4);
    unsigned* tcnt = (unsigned*)(ctl + CW_TCNT);
    REP(10) { pg8::Gemm g{H2b, Wgu_t, 0, 0, D, elist}; MoeOrder S; S.init(mt0, mnt, 8, 4, sq, SPX, 0, inl ? mnt * 8 : 0, sigT, tcnt, false, tile_e, tile_b); EpiSwiglu E{ACTb, b_gate_up};
      pg8::gemm_phase<EpiSwiglu, MoeOrder, true, true, true>(c.lds, g, S, E); }
    if (Ex > 0) { pg8::Gemm g{ACTb, Wd_t, 0, 0, DFF}; MoeOrder S; S.init(mt0, mnt, 4, 4, sq, SPX, -rem1, inl ? Ex : 0, 0, tcnt, true, tile_e, tile_b); EpiDown E{Yb, b_down, ewgt};
      pg8::gemm_phase<EpiDown, MoeOrder, true, true>(c.lds, g, S, E); }
    GRID_BAR();
    REP(11) { pg8::Gemm g{ACTb, Wd_t, 0, 0, DFF}; MoeOrder S; S.init(mt0, mnt, 4, 4, sq, SPX, Ex, inl ? mnt * 4 : 0, 0, tcnt, false, tile_e, tile_b); EpiDown E{Yb, b_down, ewgt};
      pg8::gemm_phase<EpiDown, MoeOrder, true, true>(c.lds, g, S, E); }
    GRID_BAR();
    REP(12) { p_final(c, X1, Yb, slot_e, slot_pos, gcnt, norm_f_g, out); }
    if (PROBE_MASK & 8192) { for (int k = 0; k < 10; ++k) GRID_BAR(); }
}

extern "C" void kernel_launch(void* const* d_in, const int* in_sizes, int n_in, void* d_out, int out_size, void* d_ws, size_t ws_size, hipStream_t stream) {
    static int grid = 0;
    if (grid == 0) {
        if (n_in != 22 || in_sizes[0] != NTOK * D || out_size != NTOK * D || ws_size < WS_NEED) { fprintf(stderr, "kernel_launch: unexpected shapes (n_in %d, ws %zu)\n", n_in, ws_size); grid = -1; return; }
        int dev = 0, cus = 0, per_cu = 0;
        if (hipGetDevice(&dev) != hipSuccess || hipDeviceGetAttribute(&cus, hipDeviceAttributeMultiprocessorCount, dev) != hipSuccess) { grid = -1; return; }
        if (hipFuncSetAttribute((const void*)mega, hipFuncAttributeMaxDynamicSharedMemorySize, LDS_BYTES) != hipSuccess) { fprintf(stderr, "kernel_launch: hipFuncSetAttribute failed\n"); grid = -1; return; }
        if (hipOccupancyMaxActiveBlocksPerMultiprocessor(&per_cu, (const void*)mega, NTHR, LDS_BYTES) != hipSuccess || per_cu < 1) fprintf(stderr, "kernel_launch: occupancy query reports %d\n", per_cu);
        (void)hipGetLastError();
        grid = cus;
    }
    if (grid < 0) return;
    if (hipMemsetAsync((char*)d_ws + WS_CTL, 0, CTL_ZERO_BYTES, stream) != hipSuccess) { fprintf(stderr, "kernel_launch: memset failed\n"); return; }
    Args a{};
    for (int i = 0; i < 22; ++i) a.in[i] = (const float*)d_in[i];
    a.out = (float*)d_out; a.ws = (unsigned char*)d_ws; a.ph_lo = 0; a.ph_hi = 100;
    hipLaunchKernelGGL(mega, dim3(grid), dim3(NTHR), LDS_BYTES, stream, a);
#if PROBE_MASK & 131072
    (void)hipMemsetAsync((char*)d_ws + WS_CTL, 0, CTL_ZERO_BYTES, stream); hipLaunchKernelGGL(mega, dim3(grid), dim3(NTHR), LDS_BYTES, stream, a);
#endif
    const hipError_t le = hipPeekAtLastError();
    if (le != hipSuccess) fprintf(stderr, "kernel_launch: launch failed: %s\n", hipGetErrorName(le));
}
```
